# Optimizing an MI355X kernel written in HIP

```python
import jax, jax.numpy as jnp
from jax import lax
import numpy as np


D_MODEL = 2048
BATCH = 4
SEQ = 2048
DEPTH = 1

RWKV_WIDTH = D_MODEL // 2
HEAD_SIZE = 64
N_RWKV_HEADS = RWKV_WIDTH // HEAD_SIZE
DECAY_LORA = 64
ICLR_LORA = 64
GATE_LORA = 160
GN_EPS = 64e-5
POOL_WIDTH = D_MODEL // 2
POOL_WINDOWS = (2, 4, 8, 16)
N_POOL_GROUPS = len(POOL_WINDOWS)
POOL_GROUP = POOL_WIDTH // N_POOL_GROUPS
POOL_OUT_GROUP = D_MODEL // N_POOL_GROUPS
N_SHIFT = 3 * RWKV_WIDTH + DECAY_LORA + ICLR_LORA + GATE_LORA
N_IN = N_SHIFT + POOL_WIDTH + 2 * D_MODEL
N_EXPERTS = 32
TOP_K = 4
D_FF = D_MODEL
SWIGLU_LIMIT = 7.0
SWIGLU_ALPHA = 1.702
MOE_BLOCK = 256
LN_EPS = 1e-5
DEEPNORM_ALPHA = (2 * DEPTH) ** 0.25
DEEPNORM_BETA = (8 * DEPTH) ** -0.25

kernel_name = 'hybrid_rwkv7_pool_moe_deepnorm_adaln'

F32 = jnp.float32


def layer_norm(x, g, b):
    xf = x.astype(F32)
    mu = jnp.mean(xf, axis=-1, keepdims=True)
    var = jnp.mean(jnp.square(xf - mu), axis=-1, keepdims=True)
    return ((xf - mu) * lax.rsqrt(var + LN_EPS) * g + b).astype(x.dtype)


def token_shift(u):
    return jnp.pad(u, ((0, 0), (1, 0), (0, 0)))[:, :-1]


def wkv7_scan(r, w, k, v, a, b):
    bsz, _, h, n = r.shape

    def step(S, inp):
        r_t, w_t, k_t, v_t, a_t, b_t = inp
        sa = jnp.einsum('bhvk,bhk->bhv', S, a_t)
        S = S * w_t[:, :, None, :] + sa[..., None] * b_t[:, :, None, :] + v_t[..., None] * k_t[:, :, None, :]
        return S, jnp.einsum('bhvk,bhk->bhv', S, r_t)

    xs = tuple(jnp.moveaxis(t, 1, 0) for t in (r, w, k, v, a, b))
    _, y = lax.scan(step, jnp.zeros((bsz, h, n, n), F32), xs)
    return jnp.moveaxis(y, 0, 1)


def rwkv7_branch(p, w0, w_decay_up, a0, w_iclr_up, w_glora_up, k_k, k_a, r_k, lnx_g, lnx_b):
    bsz, t, _ = p.shape
    C = RWKV_WIDTH
    r, k, v = p[..., :C], p[..., C:2 * C], p[..., 2 * C:3 * C]
    o = 3 * C
    wd = p[..., o:o + DECAY_LORA]; o += DECAY_LORA
    ad = p[..., o:o + ICLR_LORA]; o += ICLR_LORA
    gd = p[..., o:o + GATE_LORA]
    heads = lambda z: z.reshape(bsz, t, N_RWKV_HEADS, HEAD_SIZE)
    w_log = -jax.nn.softplus(-(w0 + jnp.tanh(wd) @ w_decay_up).astype(F32)) - 0.5
    decay = jnp.exp(-jnp.exp(w_log))
    iclr = jax.nn.sigmoid((a0 + ad @ w_iclr_up).astype(F32))
    g = jax.nn.sigmoid(gd) @ w_glora_up
    kk = heads((k * k_k).astype(F32))
    kk = kk / jnp.maximum(jnp.sqrt(jnp.sum(kk * kk, axis=-1, keepdims=True)), 1e-12)
    k_mod = k.astype(F32) * (1.0 + (iclr - 1.0) * k_a.astype(F32))
    rh, kh, vh = heads(r.astype(F32)), heads(k_mod), heads(v.astype(F32))
    y = wkv7_scan(rh, heads(decay), kh, vh, -kk, kk * heads(iclr))
    mu = jnp.mean(y, axis=-1, keepdims=True)
    var = jnp.mean(jnp.square(y - mu), axis=-1, keepdims=True)
    yn = ((y - mu) * lax.rsqrt(var + GN_EPS)).reshape(bsz, t, C) * lnx_g + lnx_b
    bonus = jnp.sum(rh * kh * r_k.astype(F32), axis=-1, keepdims=True) * vh
    out = (yn + bonus.reshape(bsz, t, C)) * g
    return out.astype(p.dtype)


def pool_branch(u, w_pool, pool_scale):
    bsz, t, _ = u.shape
    uf = u.astype(F32).reshape(bsz, t, N_POOL_GROUPS, POOL_GROUP)
    cs = jnp.cumsum(uf, axis=1)
    pos = jnp.arange(t)
    outs = []
    for gi, win in enumerate(POOL_WINDOWS):
        c_g = cs[:, :, gi]
        lagged = jnp.pad(c_g, ((0, 0), (win, 0), (0, 0)))[:, :t]
        cnt = jnp.minimum(pos + 1, win).astype(F32)
        outs.append((c_g - lagged) / cnt[None, :, None] - uf[:, :, gi])
    d = jnp.stack(outs, axis=2).astype(u.dtype)
    y = jnp.einsum('btgc,gcd->btgd', d, w_pool).reshape(bsz, t, D_MODEL)
    return y * pool_scale


def moe_ffn(h, w_router, b_router, w_gu, b_gu, w_down, b_down):
    bsz, t, d = h.shape
    m = bsz * t
    mk = m * TOP_K
    n_blocks = -(-mk // MOE_BLOCK) + N_EXPERTS
    hf = h.reshape(m, d)
    logits = (hf @ w_router).astype(F32) + b_router.astype(F32)
    top_val, top_idx = lax.top_k(logits, TOP_K)
    probs = jax.nn.softmax(top_val, axis=-1)
    flat_e = top_idx.reshape(mk)
    order = jnp.argsort(flat_e)
    sorted_e = flat_e[order]
    counts = jnp.bincount(flat_e, length=N_EXPERTS)
    padded = (counts + MOE_BLOCK - 1) // MOE_BLOCK * MOE_BLOCK
    pad_end = jnp.cumsum(padded)
    pad_start = pad_end - padded
    grp_start = jnp.cumsum(counts) - counts
    rank = jnp.arange(mk) - grp_start[sorted_e]
    dest_sorted = (pad_start[sorted_e] + rank).astype(jnp.int32)
    dest = jnp.zeros((mk,), jnp.int32).at[order].set(dest_sorted)
    tok = jnp.arange(mk) // TOP_K
    x_buf = jnp.zeros((n_blocks * MOE_BLOCK, d), h.dtype).at[dest].set(hf[tok])
    block_expert = jnp.minimum(
        jnp.searchsorted(pad_end, jnp.arange(n_blocks) * MOE_BLOCK, side='right'), N_EXPERTS - 1)

    def expert_block(args):
        xb, e = args
        gu = xb @ w_gu[e] + b_gu[e]
        gate = jnp.minimum(gu[:, ::2], SWIGLU_LIMIT)
        up = jnp.clip(gu[:, 1::2], -SWIGLU_LIMIT, SWIGLU_LIMIT)
        glu = gate * jax.nn.sigmoid(gate * SWIGLU_ALPHA)
        return ((up + 1.0) * glu) @ w_down[e] + b_down[e]

    y_buf = lax.map(expert_block, (x_buf.reshape(n_blocks, MOE_BLOCK, d), block_expert))
    y = y_buf.reshape(n_blocks * MOE_BLOCK, d)[dest].reshape(m, TOP_K, d)
    out = jnp.einsum('mkd,mk->md', y, probs.astype(y.dtype))
    return out.reshape(bsz, t, d)


def setup_inputs(seed: int = 0) -> dict:
    key = jax.random.key(seed)
    ks = jax.random.split(key, 32)
    L, D, C = DEPTH, D_MODEL, RWKV_WIDTH
    nrm = lambda k, shape, s: jax.random.normal(k, shape, F32) * s
    return {
        'x': nrm(ks[0], (BATCH, SEQ, D), 1.0),
        'c': nrm(ks[1], (BATCH, D), 1.0),
        'w_ada': nrm(ks[2], (L, D, 6 * D), 0.5 * D ** -0.5),
        'b_ada': nrm(ks[3], (L, 6 * D), 0.02),
        'w_in': nrm(ks[4], (L, D, N_IN), D ** -0.5),
        'mu_shift': jax.random.uniform(ks[5], (L, N_SHIFT), F32),
        'w0': jax.random.uniform(ks[6], (L, C), F32, -3.0, 1.0),
        'w_decay_up': nrm(ks[7], (L, DECAY_LORA, C), 0.5 * DECAY_LORA ** -0.5),
        'a0': nrm(ks[8], (L, C), 0.5),
        'w_iclr_up': nrm(ks[9], (L, ICLR_LORA, C), ICLR_LORA ** -0.5),
        'w_glora_up': nrm(ks[10], (L, GATE_LORA, C), GATE_LORA ** -0.5),
        'k_k': 0.85 + nrm(ks[11], (L, C), 0.02),
        'k_a': 1.0 + nrm(ks[12], (L, C), 0.02),
        'r_k': nrm(ks[13], (L, N_RWKV_HEADS, HEAD_SIZE), 0.1),
        'lnx_g': 1.0 + nrm(ks[14], (L, C), 0.02),
        'lnx_b': nrm(ks[15], (L, C), 0.02),
        'w_rwkv_out': nrm(ks[16], (L, C, D), C ** -0.5),
        'w_pool': nrm(ks[17], (L, N_POOL_GROUPS, POOL_GROUP, POOL_OUT_GROUP), POOL_GROUP ** -0.5),
        'pool_scale': 1.0 + nrm(ks[18], (L, D), 0.02),
        'w_out': nrm(ks[19], (L, D, D), DEEPNORM_BETA * D ** -0.5),
        'ln1_g': 1.0 + nrm(ks[20], (L, D), 0.02),
        'ln1_b': nrm(ks[21], (L, D), 0.02),
        'w_router': nrm(ks[22], (L, D, N_EXPERTS), D ** -0.5),
        'b_router': nrm(ks[23], (L, N_EXPERTS), 0.01),
        'w_gu': nrm(ks[24], (L, N_EXPERTS, D, 2 * D_FF), D ** -0.5),
        'b_gu': nrm(ks[25], (L, N_EXPERTS, 2 * D_FF), 0.02),
        'w_down': nrm(ks[26], (L, N_EXPERTS, D_FF, D), DEEPNORM_BETA * D_FF ** -0.5),
        'b_down': nrm(ks[27], (L, N_EXPERTS, D), 0.02),
        'ln2_g': 1.0 + nrm(ks[28], (L, D), 0.02),
        'ln2_b': nrm(ks[29], (L, D), 0.02),
    }


def reference(x, c, w_ada, b_ada, w_in, mu_shift, w0, w_decay_up, a0, w_iclr_up, w_glora_up,
              k_k, k_a, r_k, lnx_g, lnx_b, w_rwkv_out, w_pool, pool_scale, w_out, ln1_g, ln1_b,
              w_router, b_router, w_gu, b_gu, w_down, b_down, ln2_g, ln2_b):
    cond = jax.nn.silu(c)
    for l in range(DEPTH):
        mod = cond @ w_ada[l] + b_ada[l]
        sh1, sc1, g1, sh2, sc2, g2 = jnp.split(mod, 6, axis=-1)
        h = x * (1.0 + sc1[:, None]) + sh1[:, None]
        p = h @ w_in[l]
        ps = p[..., :N_SHIFT]
        ps = ps + (token_shift(ps) - ps) * mu_shift[l]
        y_rwkv = rwkv7_branch(ps, w0[l], w_decay_up[l], a0[l], w_iclr_up[l], w_glora_up[l],
                              k_k[l], k_a[l], r_k[l], lnx_g[l], lnx_b[l])
        o = N_SHIFT
        u_pool = p[..., o:o + POOL_WIDTH]
        o += POOL_WIDTH
        gate_a = jax.nn.sigmoid(p[..., o:o + D_MODEL])
        gate_b = jax.nn.sigmoid(p[..., o + D_MODEL:])
        branch_a = y_rwkv @ w_rwkv_out[l]
        branch_b = pool_branch(u_pool, w_pool[l], pool_scale[l])
        mix = (gate_a * branch_a + gate_b * branch_b) @ w_out[l]
        x = layer_norm(DEEPNORM_ALPHA * x + g1[:, None] * mix, ln1_g[l], ln1_b[l])
        h2 = x * (1.0 + sc2[:, None]) + sh2[:, None]
        f = moe_ffn(h2, w_router[l], b_router[l], w_gu[l], b_gu[l], w_down[l], b_down[l])
        x = layer_norm(DEEPNORM_ALPHA * x + g2[:, None] * f, ln2_g[l], ln2_b[l])
    return x
```

```cpp
#include <hip/hip_runtime.h>
#include <cstdio>
#include <cstdint>

#ifndef PROBE
#define PROBE 0
#endif
#define LAS __attribute__((address_space(3)))
typedef unsigned short bf16_t;
typedef short bf16x8 __attribute__((ext_vector_type(8)));
typedef float f32x4 __attribute__((ext_vector_type(4)));
typedef float f32x2 __attribute__((ext_vector_type(2)));
typedef unsigned u32x4 __attribute__((ext_vector_type(4)));
typedef unsigned u32x2 __attribute__((ext_vector_type(2)));
typedef int i32x4 __attribute__((ext_vector_type(4)));
typedef int i32x8 __attribute__((ext_vector_type(8)));
typedef unsigned char fp8_t;
constexpr float W8_SCALE = 64.0f, W8_INV = 1.0f / 64.0f;

constexpr int NB = 4, NT = 2048, NM = NB * NT, ND = 2048, NC = 1024, NH = 16, HS = 64;
constexpr int NSHIFT = 3360, NIN = 8480, NINP = 8704;
constexpr int OFF_R = 0, OFF_K = 1024, OFF_V = 2048, OFF_WD = 3072, OFF_AD = 3136, OFF_GD = 3200, OFF_POOL = 3360, OFF_GA = 4384, OFF_GB = 6432;
constexpr int NE = 32, TOPK = 4, DFF = 2048;
constexpr int LORA_K = 384, LORA_N = 3072;
constexpr int MAXTILES = 160, MP = MAXTILES * 256;
constexpr int NMOD = 6 * ND;
constexpr int KS_MOD = 32;
constexpr float LN_EPS = 1e-5f, GN_EPS = 64e-5f;
constexpr float DN_ALPHA = 1.189207115002721f;
constexpr float SW_LIMIT = 7.0f, SW_ALPHA = 1.702f;
constexpr int NWAVES = 8, NTHREADS = 512;
constexpr int LDS_BYTES = 147456;
constexpr int LDS_BARW = LDS_BYTES - 16;
constexpr int LDS_MISC = 131072;

constexpr int CW_CNT = 0;
constexpr int CW_CONV = 64 * 32;
constexpr int CW_CONV2 = 64 * 32 + 32;
constexpr int CW_NTILES = 64 * 33;
constexpr int CW_TILEE = 64 * 34;
constexpr int CTL_WORDS = 64 * 34 + 256;

#define XB_TMO      128
#define XB_XCNT(j)  (256  + 64 * (j))
#define XB_XSUB(j)  (1280 + 64 * (j))
#define XB_XGEN(j)  (2304 + 64 * (j))
#define XB_TOP      3328
#define XB_TOPGEN   3392
#define XCD_BAR_WORDS 3456
#define XB_SPIN_CAP (1u << 18)

__device__ __forceinline__ unsigned xb_ld(unsigned* p)              { return __hip_atomic_load(p, __ATOMIC_RELAXED, __HIP_MEMORY_SCOPE_AGENT); }
__device__ __forceinline__ unsigned xb_add(unsigned* p, unsigned v) { return __hip_atomic_fetch_add(p, v, __ATOMIC_RELAXED, __HIP_MEMORY_SCOPE_AGENT); }
__device__ __forceinline__ unsigned xb_xcc_id() { return (unsigned)__builtin_amdgcn_s_getreg((3 << 11) | 20) & 0xFu; }
#define XB_SPIN(cond, bar) do { unsigned _sp = 0; while (cond) { __builtin_amdgcn_s_sleep(1); \
    if ((++_sp & 255u) == 0u) { if (xb_ld(&(bar)[XB_TMO])) break; if (_sp > XB_SPIN_CAP) { atomicAdd(&(bar)[XB_TMO], 1u); break; } } } } while (0)

__device__ __forceinline__ int phase_tid(int wave);
struct XcdBarrier { unsigned* bar; unsigned x; volatile LAS unsigned* st; };

__device__ __forceinline__ XcdBarrier xcd_barrier_post(unsigned* bar, volatile LAS unsigned* st) {
    XcdBarrier b; b.bar = bar; b.x = xb_xcc_id(); b.st = st;
    if (threadIdx.x == 0) (void)xb_add(&bar[XB_XCNT(b.x)], 1u);
    return b;
}
__device__ __forceinline__ void xcd_barrier_complete(unsigned* bar, unsigned x, unsigned& nloc, unsigned& nx) {
    const unsigned G = gridDim.x * gridDim.y * gridDim.z;
    unsigned sum, cnt, mine, sp = 0u;
    for (;;) {
        sum = 0u; cnt = 0u; mine = 0u;
#pragma unroll
        for (unsigned j = 0; j < 16; ++j) { const unsigned c = xb_ld(&bar[XB_XCNT(j)]); sum += c; cnt += (c > 0u) ? 1u : 0u; mine = (j == x) ? c : mine; }
        if (sum == G) break;
        __builtin_amdgcn_s_sleep(1);
        if ((++sp & 255u) == 0u) { if (xb_ld(&bar[XB_TMO])) break; if (sp > XB_SPIN_CAP) { atomicAdd(&bar[XB_TMO], 1u); break; } }
    }
    nloc = mine > 0u ? mine : 1u; nx = cnt > 0u ? cnt : 1u;
}
__device__ __forceinline__ void xcd_barrier(const XcdBarrier& b, const int wave) {
    asm volatile("s_waitcnt vmcnt(0)" ::: "memory");
    __syncthreads();
    if (phase_tid(wave) == 0) {
        unsigned* bar = b.bar;
        __builtin_amdgcn_s_waitcnt(0);
        unsigned nloc = b.st[0], nx = b.st[1];
        if (nloc == 0u) { xcd_barrier_complete(bar, b.x, nloc, nx); b.st[0] = nloc; b.st[1] = nx; }
        const unsigned old = xb_add(&bar[XB_XSUB(b.x)], 1u);
        const unsigned gen = old / nloc;
        if (old + 1u == (gen + 1u) * nloc) {
            __builtin_amdgcn_fence(__ATOMIC_RELEASE, "agent");
            asm volatile("s_waitcnt vmcnt(0)" ::: "memory");
            const unsigned og = xb_add(&bar[XB_TOP], 1u);
            const unsigned tg = og / nx;
            if (og + 1u == (tg + 1u) * nx) xb_add(&bar[XB_TOPGEN], 1u);
            else XB_SPIN(xb_ld(&bar[XB_TOPGEN]) == tg, bar);
            __builtin_amdgcn_fence(__ATOMIC_ACQUIRE, "agent");
            xb_add(&bar[XB_XGEN(b.x)], 1u);
            asm volatile("s_waitcnt vmcnt(0)" ::: "memory");
        } else {
            XB_SPIN(xb_ld(&bar[XB_XGEN(b.x)]) == gen, bar);
            __builtin_amdgcn_fence(__ATOMIC_ACQUIRE, "agent");
            asm volatile("s_waitcnt vmcnt(0)" ::: "memory");
        }
    }
    __syncthreads();
}

__device__ __forceinline__ int phase_tid(int wave) {
    int lane; asm volatile("v_mbcnt_lo_u32_b32 %0, -1, 0\n\tv_mbcnt_hi_u32_b32 %0, -1, %0" : "=v"(lane));
    return wave * 64 + lane;
}
typedef __bf16 bf16x2_t __attribute__((ext_vector_type(2)));
__device__ __forceinline__ unsigned cvt_pk_bf16(float lo, float hi) { return __builtin_bit_cast(unsigned, __builtin_convertvector((f32x2){lo, hi}, bf16x2_t)); }
template <int CTRL> __device__ __forceinline__ float dpp_f(float x) {
    return __builtin_bit_cast(float, __builtin_amdgcn_update_dpp(0, __builtin_bit_cast(int, x), CTRL, 0xf, 0xf, false));
}
__device__ __forceinline__ float row16_allsum(float x) {
    x += dpp_f<0x128>(x); x += dpp_f<0x124>(x); x += dpp_f<0x122>(x); x += dpp_f<0x121>(x); return x;
}
__device__ __forceinline__ float wave_allsum(float x) {
    x = row16_allsum(x);
    const int xi = __builtin_bit_cast(int, x);
    return (__builtin_bit_cast(float, __builtin_amdgcn_readlane(xi, 0)) + __builtin_bit_cast(float, __builtin_amdgcn_readlane(xi, 16))) +
           (__builtin_bit_cast(float, __builtin_amdgcn_readlane(xi, 32)) + __builtin_bit_cast(float, __builtin_amdgcn_readlane(xi, 48)));
}
__device__ __forceinline__ unsigned pack4_fp8(float a, float b, float c, float d) { int r = 0; r = __builtin_amdgcn_cvt_pk_fp8_f32(a, b, r, false); r = __builtin_amdgcn_cvt_pk_fp8_f32(c, d, r, true); return (unsigned)r; }
__device__ __forceinline__ f32x2 bf2_unpack(unsigned u) { return (f32x2){__uint_as_float(u << 16), __uint_as_float(u & 0xffff0000u)}; }
__device__ __forceinline__ f32x4 bf4_unpack(u32x2 u) { const f32x2 a = bf2_unpack(u.x), b = bf2_unpack(u.y); return (f32x4){a[0], a[1], b[0], b[1]}; }
__device__ __forceinline__ float bf1(bf16_t h) { return __uint_as_float(((unsigned)h) << 16); }
__device__ __forceinline__ float sigmoidf_(float v) { return __builtin_amdgcn_rcpf(1.0f + __builtin_amdgcn_exp2f(v * -1.4426950408889634f)); }
__device__ __forceinline__ f32x4 ld4(const float* p) { return *(const f32x4*)p; }
__device__ __forceinline__ float dot4(f32x4 a, f32x4 b) { return (a[0] * b[0] + a[1] * b[1]) + (a[2] * b[2] + a[3] * b[3]); }

struct Params {
    const float *x, *c, *w_ada, *b_ada, *w_in, *mu_shift, *w0, *w_decay_up, *a0, *w_iclr_up, *w_glora_up, *k_k, *k_a, *r_k, *lnx_g, *lnx_b,
                *w_rwkv_out, *w_pool, *pool_scale, *w_out, *ln1_g, *ln1_b, *w_router, *b_router, *w_gu, *b_gu, *w_down, *b_down, *ln2_g, *ln2_b;
    float* out;
    unsigned* bar; unsigned* ctl;
    float* modp; float* mod;
    bf16_t* hb; bf16_t* wt_in; bf16_t* wt_rwkv; bf16_t* wt_pool; bf16_t* wt_out; bf16_t* bt_lora; fp8_t* wt_gu; fp8_t* wt_down;
    bf16_t* P; bf16_t* a_lora; bf16_t* dp; float* dec; bf16_t* iclr; bf16_t* gg; bf16_t* t1;
    bf16_t* yr; bf16_t* mx; float* z1; float* lnst; fp8_t* h2;
    int* sel; int* rnk; float* prob; int* dest;
    fp8_t* xb; fp8_t* act; bf16_t* yb;
};

namespace pg8 {
constexpr int BM = 256, BK = 64, HALF = 128, HTB = HALF * BK * 2, STAGE_BYTES = 8 * HTB, NXCD = 8, WGM = 8;
__host__ __device__ __forceinline__ int lds_byte(int r, int c) { const int st = (r >> 4) * 2 + (c >> 5), rr = r & 15, cc = c & 31, ob = rr * 64 + cc * 2; return st * 1024 + (ob ^ (((ob >> 9) & 1) << 5)); }
__host__ __device__ __forceinline__ void stage_rc(int b, int& R, int& C) { const int st = b / 1024, sb = b % 1024, swz = sb ^ (((sb >> 9) & 1) << 5); R = (st >> 1) * 16 + swz / 64; C = (st & 1) * 32 + (swz % 64) / 2; }
__host__ __device__ __forceinline__ int perm32(int rho) { const int n = rho >> 4, i = rho & 15; return 8 * (i >> 2) + 4 * n + (i & 3); }

struct Unit { int pm, pn, e; unsigned aoff, boff; };
struct Gemm { const bf16_t* A; const bf16_t* Bt; int lda, ldb, K; };

struct DenseOrder {
    int nM, nN, nwg, G, c, skip_from = 1 << 30, skip_n = 0; size_t a_tile, b_tile;
    __device__ void init(int nM_, int nN_, int G_, int c_, size_t a_tile_, size_t b_tile_) { nM = nM_; nN = nN_; nwg = nM * nN; G = G_; c = c_; a_tile = a_tile_; b_tile = b_tile_; }
    __device__ bool next(int i, Unit& u) const {
        const long L = (long)i * G + c; if (c < 0 || L >= nwg) return false;
        int wgid = (int)L; { const int q = nwg / NXCD, r = nwg % NXCD, xcd = wgid % NXCD, off = wgid / NXCD; wgid = (xcd < r ? xcd * (q + 1) : r * (q + 1) + (xcd - r) * q) + off; }
        const int nig = WGM * nN, gid = wgid / nig, fm = gid * WGM, gsz = (nM - fm) < WGM ? (nM - fm) : WGM;
        u.pm = fm + ((wgid % nig) % gsz); u.pn = (wgid % nig) / gsz; u.e = 0; if (u.pn >= skip_from) u.pn += skip_n;
        u.aoff = (unsigned)((size_t)u.pm * a_tile); u.boff = (unsigned)((size_t)u.pn * b_tile); return true;
    }
};

template <class Epi, class Sched, bool FP8 = false>
__device__ __forceinline__ void gemm_phase(LAS unsigned char* lds, const Gemm g, const Sched& S, const Epi& E, const int wave) {
    const int tid = phase_tid(wave);
    const int wid = __builtin_amdgcn_readfirstlane(tid >> 6), lane = tid & 63, wr = wid >> 2, wc = wid & 3, fr = lane & 15, fq = lane >> 4;
    const int K = g.K, nt = K / BK;
    unsigned voffA[2], voffB[2];
#pragma unroll
    for (int i = 0; i < 2; ++i) { int R, C; stage_rc(tid * 16 + i * 8192, R, C); const int Rb = Epi::PERM ? ((R & ~31) + perm32(R & 31)) : R;
        voffA[i] = (unsigned)(R * g.lda + C) * 2u; voffB[i] = (unsigned)(Rb * g.ldb + C) * 2u; }
    const unsigned kstep = (unsigned)(BK * 2);
    const unsigned hstepA = (unsigned)HALF * g.lda * 2u, hstepB = (unsigned)HALF * g.ldb * 2u;
    const __amdgpu_buffer_rsrc_t rsA = __builtin_amdgcn_make_buffer_rsrc((void*)g.A, (short)0, -1, 0x00020000), rsB = __builtin_amdgcn_make_buffer_rsrc((void*)g.Bt, (short)0, -1, 0x00020000);
    const unsigned ldsw = (unsigned)wid * 1024u;
    const int aoff = lds_byte(wr * 64 + fr, fq * 8), boff = lds_byte(wc * 32 + fr, fq * 8);
#define PG8_SA(b, h) (((b) * 2 + (h)) * HTB)
#define PG8_SB(b, h) ((4 + (b) * 2 + (h)) * HTB)
#define PG8_STAGE(bufoff, rs, soff, voff) do { _Pragma("unroll") for (int _i = 0; _i < 2; ++_i) \
        __builtin_amdgcn_raw_ptr_buffer_load_lds(rs, (LAS void*)(lds + (bufoff) + ldsw + _i * 8192), 16, (voff)[_i], (soff), 0, 0); } while (0)
#define PG8_LDA(dst, b, h) do { _Pragma("unroll") for (int m = 0; m < 4; ++m) _Pragma("unroll") for (int k = 0; k < 2; ++k) dst[m][k] = *(const LAS bf16x8*)(lds + PG8_SA(b, h) + aoff + m * 2048 + k * 1024); } while (0)
#define PG8_LDB(dst, b, h) do { _Pragma("unroll") for (int n = 0; n < 2; ++n) _Pragma("unroll") for (int k = 0; k < 2; ++k) dst[n][k] = *(const LAS bf16x8*)(lds + PG8_SB(b, h) + boff + n * 2048 + k * 1024); } while (0)
#define PG8_CAT(x) __builtin_shufflevector(__builtin_bit_cast(i32x4, (x)[0]), __builtin_bit_cast(i32x4, (x)[1]), 0, 1, 2, 3, 4, 5, 6, 7)
#define PG8_MMA(ai, bj, At, Bt) do { __builtin_amdgcn_s_setprio(1); \
        if constexpr (FP8) { _Pragma("unroll") for (int m = 0; m < 4; ++m) _Pragma("unroll") for (int n = 0; n < 2; ++n) \
            acc[ai][bj][m][n] = __builtin_amdgcn_mfma_scale_f32_16x16x128_f8f6f4(PG8_CAT(Bt[n]), PG8_CAT(At[m]), acc[ai][bj][m][n], 0, 0, 0, 0x7F7F7F7F, 0, 0x7F7F7F7F); } \
        else { _Pragma("unroll") for (int m = 0; m < 4; ++m) _Pragma("unroll") for (int n = 0; n < 2; ++n) _Pragma("unroll") for (int k = 0; k < 2; ++k) \
            acc[ai][bj][m][n] = __builtin_amdgcn_mfma_f32_16x16x32_bf16(Bt[n][k], At[m][k], acc[ai][bj][m][n], 0, 0, 0); } \
        __builtin_amdgcn_s_setprio(0); } while (0)
#define PG8_WAIT_V(n) asm volatile("s_waitcnt vmcnt(" #n ")" ::: "memory")
#define PG8_WAIT_L(n) asm volatile("s_waitcnt lgkmcnt(" #n ")" ::: "memory")
#define PG8_BAR __builtin_amdgcn_s_barrier()
#define PG8_SCHED __builtin_amdgcn_sched_barrier(0)
    Unit cur, nxt; int ui = 0;
    if (!S.next(0, cur)) return;
    f32x4 acc[2][2][4][2];
#pragma unroll
    for (int a = 0; a < 2; ++a)
#pragma unroll
        for (int b = 0; b < 2; ++b)
#pragma unroll
            for (int m = 0; m < 4; ++m)
#pragma unroll
                for (int n = 0; n < 2; ++n) acc[a][b][m][n] = (f32x4){0.f, 0.f, 0.f, 0.f};
    bf16x8 At[4][2], B0[2][2], B1[2][2];
    unsigned cA = cur.aoff, cB = cur.boff;
    PG8_STAGE(PG8_SB(0, 0), rsB, cB, voffB); PG8_STAGE(PG8_SA(0, 0), rsA, cA, voffA); PG8_STAGE(PG8_SB(0, 1), rsB, cB + hstepB, voffB); PG8_STAGE(PG8_SA(0, 1), rsA, cA + hstepA, voffA);
    if (wr == 1) PG8_BAR;
    PG8_WAIT_V(4); PG8_BAR;
    PG8_STAGE(PG8_SB(1, 0), rsB, cB + kstep, voffB); PG8_STAGE(PG8_SA(1, 0), rsA, cA + kstep, voffA); PG8_STAGE(PG8_SB(1, 1), rsB, cB + hstepB + kstep, voffB);
    PG8_WAIT_V(6); PG8_BAR;
    for (;;) {
        const bool has_next = S.next(ui + 1, nxt);
        const unsigned nA = has_next ? nxt.aoff : cA, nB = has_next ? nxt.boff : cB;
        for (int t = 0; t < nt; t += 2) {
            const bool last = (t == nt - 2);
            const unsigned a1 = cA + (unsigned)(t + 1) * kstep;
            const unsigned a2 = last ? nA : cA + (unsigned)(t + 2) * kstep, b2 = last ? nB : cB + (unsigned)(t + 2) * kstep;
            const unsigned a3 = a2 + kstep, b3 = b2 + kstep;
            PG8_LDB(B0, 0, 0); PG8_SCHED; PG8_LDA(At, 0, 0); PG8_STAGE(PG8_SA(1, 1), rsA, a1 + hstepA, voffA);
            PG8_WAIT_L(8); PG8_BAR; PG8_WAIT_L(0); PG8_MMA(0, 0, At, B0); PG8_BAR; PG8_SCHED;
            PG8_LDB(B1, 0, 1); PG8_STAGE(PG8_SB(0, 0), rsB, b2, voffB);
            PG8_BAR; PG8_WAIT_L(0); PG8_MMA(0, 1, At, B1); PG8_BAR;
            PG8_LDA(At, 0, 1); PG8_STAGE(PG8_SA(0, 0), rsA, a2, voffA);
            PG8_BAR; PG8_WAIT_L(0); PG8_MMA(1, 0, At, B0); PG8_BAR; PG8_SCHED;
            PG8_STAGE(PG8_SB(0, 1), rsB, b2 + hstepB, voffB);
            PG8_WAIT_V(6); PG8_BAR; PG8_MMA(1, 1, At, B1); PG8_BAR;
            PG8_LDB(B0, 1, 0); PG8_SCHED; PG8_LDA(At, 1, 0); PG8_STAGE(PG8_SA(0, 1), rsA, a2 + hstepA, voffA);
            PG8_WAIT_L(8); PG8_BAR; PG8_WAIT_L(0); PG8_MMA(0, 0, At, B0); PG8_BAR; PG8_SCHED;
            PG8_LDB(B1, 1, 1); PG8_STAGE(PG8_SB(1, 0), rsB, b3, voffB);
            PG8_BAR; PG8_WAIT_L(0); PG8_MMA(0, 1, At, B1); PG8_BAR;
            PG8_LDA(At, 1, 1); PG8_STAGE(PG8_SA(1, 0), rsA, a3, voffA);
            PG8_BAR; PG8_WAIT_L(0); PG8_MMA(1, 0, At, B0); PG8_BAR; PG8_SCHED;
            PG8_STAGE(PG8_SB(1, 1), rsB, b3 + hstepB, voffB);
            PG8_WAIT_V(6); PG8_BAR; PG8_MMA(1, 1, At, B1); PG8_BAR;
        }
        { const int l2 = phase_tid(wave) & 63; E(acc, cur, wr, wc, l2 & 15, l2 >> 4); }
        if (!has_next) break;
#pragma unroll
        for (int a = 0; a < 2; ++a)
#pragma unroll
            for (int b = 0; b < 2; ++b)
#pragma unroll
                for (int m = 0; m < 4; ++m)
#pragma unroll
                    for (int n = 0; n < 2; ++n) acc[a][b][m][n] = (f32x4){0.f, 0.f, 0.f, 0.f};
        cur = nxt; cA = nA; cB = nB; ++ui;
    }
    PG8_WAIT_V(0);
    if (wr == 0) PG8_BAR;
    PG8_BAR;
#undef PG8_SA
#undef PG8_SB
#undef PG8_STAGE
#undef PG8_LDA
#undef PG8_LDB
#undef PG8_MMA
#undef PG8_CAT
#undef PG8_WAIT_V
#undef PG8_WAIT_L
#undef PG8_BAR
#undef PG8_SCHED
}
}
using pg8::Unit;

#define EPI_LOOP_BEGIN \
    _Pragma("unroll") for (int ai = 0; ai < 2; ++ai) _Pragma("unroll") for (int m = 0; m < 4; ++m) { const int r = u.pm * 256 + ai * 128 + wr * 64 + m * 16 + fr; \
    _Pragma("unroll") for (int bj = 0; bj < 2; ++bj) _Pragma("unroll") for (int n = 0; n < 2; ++n) { const int cl = bj * 128 + wc * 32 + 16 * n + 4 * fq; const f32x4 a = acc[ai][bj][m][n];
#define EPI_LOOP_END } }

struct EpiP {
    static constexpr bool PERM = true; bf16_t* C;
    __device__ __forceinline__ void operator()(const f32x4 (&acc)[2][2][4][2], const Unit& u, int wr, int wc, int fr, int fq) const {
#pragma unroll
        for (int ai = 0; ai < 2; ++ai)
#pragma unroll
            for (int m = 0; m < 4; ++m) { const int r = u.pm * 256 + ai * 128 + wr * 64 + m * 16 + fr;
#pragma unroll
                for (int bj = 0; bj < 2; ++bj) { const int c0 = u.pn * 256 + bj * 128 + wc * 32 + 8 * fq; const f32x4 v0 = acc[ai][bj][m][0], v1 = acc[ai][bj][m][1];
                    u32x4 w; w.x = cvt_pk_bf16(v0[0], v0[1]); w.y = cvt_pk_bf16(v0[2], v0[3]); w.z = cvt_pk_bf16(v1[0], v1[1]); w.w = cvt_pk_bf16(v1[2], v1[3]);
                    *(u32x4*)(C + (size_t)r * NINP + c0) = w; } }
    }
};
#define EPI_COLS(ptr) f32x4 cv[2][2]; _Pragma("unroll") for (int bj = 0; bj < 2; ++bj) _Pragma("unroll") for (int n = 0; n < 2; ++n) cv[bj][n] = ld4((ptr) + bj * 128 + wc * 32 + 16 * n + 4 * fq);
#define EPI_COLS_PERM(ptr) f32x4 cv[2][2]; _Pragma("unroll") for (int bj = 0; bj < 2; ++bj) _Pragma("unroll") for (int n = 0; n < 2; ++n) cv[bj][n] = ld4((ptr) + bj * 128 + wc * 32 + 8 * fq + 4 * n);
struct EpiLora {
    static constexpr bool PERM = false; float* dec; bf16_t *iclr, *gg; const float *w0, *a0;
    __device__ __forceinline__ void operator()(const f32x4 (&acc)[2][2][4][2], const Unit& u, int wr, int wc, int fr, int fq) const {
        const int sect = u.pn >> 2, cb = (u.pn & 3) * 256;
        EPI_COLS((sect == 0 ? w0 : a0) + cb)
        EPI_LOOP_BEGIN
            const int c = cb + cl; f32x4 o;
            if (sect == 0) {
#pragma unroll
                for (int j = 0; j < 4; ++j) o[j] = __builtin_amdgcn_exp2f(-0.6065306597126334f * 1.4426950408889634f * sigmoidf_(cv[bj][n][j] + a[j]));
                *(f32x4*)(dec + (size_t)r * NC + c) = o; }
            else if (sect == 1) {
#pragma unroll
                for (int j = 0; j < 4; ++j) o[j] = sigmoidf_(cv[bj][n][j] + a[j]);
                u32x2 wv; wv.x = cvt_pk_bf16(o[0], o[1]); wv.y = cvt_pk_bf16(o[2], o[3]); *(u32x2*)(iclr + (size_t)r * NC + c) = wv; }
            else { u32x2 wv; wv.x = cvt_pk_bf16(a[0], a[1]); wv.y = cvt_pk_bf16(a[2], a[3]); *(u32x2*)(gg + (size_t)r * NC + c) = wv; }
        EPI_LOOP_END
    }
};
struct EpiPool {
    static constexpr bool PERM = true; bf16_t* t1; const bf16_t* P; const float* pscale;
    __device__ __forceinline__ void operator()(const f32x4 (&acc)[2][2][4][2], const Unit& u, int wr, int wc, int fr, int fq) const {
        EPI_COLS_PERM(pscale + u.pn * 256)
#pragma unroll
        for (int ai = 0; ai < 2; ++ai) { u32x4 gq[4][2];
#pragma unroll
            for (int m = 0; m < 4; ++m)
#pragma unroll
                for (int bj = 0; bj < 2; ++bj) gq[m][bj] = *(const u32x4*)(P + (size_t)(u.pm * 256 + ai * 128 + wr * 64 + m * 16 + fr) * NINP + OFF_GB + u.pn * 256 + bj * 128 + wc * 32 + 8 * fq);
#pragma unroll
            for (int m = 0; m < 4; ++m) { const int r = u.pm * 256 + ai * 128 + wr * 64 + m * 16 + fr;
#pragma unroll
                for (int bj = 0; bj < 2; ++bj) { const int c0 = u.pn * 256 + bj * 128 + wc * 32 + 8 * fq;
                    const f32x4 g0 = bf4_unpack((u32x2){gq[m][bj].x, gq[m][bj].y}), g1 = bf4_unpack((u32x2){gq[m][bj].z, gq[m][bj].w}), a0 = acc[ai][bj][m][0], a1 = acc[ai][bj][m][1]; f32x4 o0, o1;
#pragma unroll
                    for (int j = 0; j < 4; ++j) { o0[j] = sigmoidf_(g0[j]) * cv[bj][0][j] * a0[j]; o1[j] = sigmoidf_(g1[j]) * cv[bj][1][j] * a1[j]; }
                    u32x4 w; w.x = cvt_pk_bf16(o0[0], o0[1]); w.y = cvt_pk_bf16(o0[2], o0[3]); w.z = cvt_pk_bf16(o1[0], o1[1]); w.w = cvt_pk_bf16(o1[2], o1[3]);
                    *(u32x4*)(t1 + (size_t)r * ND + c0) = w; } } }
    }
};
struct EpiRwkv {
    static constexpr bool PERM = true; bf16_t* mx; const bf16_t* P; const bf16_t* t1;
    __device__ __forceinline__ void operator()(const f32x4 (&acc)[2][2][4][2], const Unit& u, int wr, int wc, int fr, int fq) const {
#pragma unroll
        for (int ai = 0; ai < 2; ++ai) { u32x4 gq[4][2], tq[4][2];
#pragma unroll
            for (int m = 0; m < 4; ++m)
#pragma unroll
                for (int bj = 0; bj < 2; ++bj) { const int r = u.pm * 256 + ai * 128 + wr * 64 + m * 16 + fr, c0 = u.pn * 256 + bj * 128 + wc * 32 + 8 * fq;
                    gq[m][bj] = *(const u32x4*)(P + (size_t)r * NINP + OFF_GA + c0); tq[m][bj] = *(const u32x4*)(t1 + (size_t)r * ND + c0); }
#pragma unroll
            for (int m = 0; m < 4; ++m) { const int r = u.pm * 256 + ai * 128 + wr * 64 + m * 16 + fr;
#pragma unroll
                for (int bj = 0; bj < 2; ++bj) { const int c0 = u.pn * 256 + bj * 128 + wc * 32 + 8 * fq;
                    const f32x4 g0 = bf4_unpack((u32x2){gq[m][bj].x, gq[m][bj].y}), g1 = bf4_unpack((u32x2){gq[m][bj].z, gq[m][bj].w});
                    const f32x4 t0 = bf4_unpack((u32x2){tq[m][bj].x, tq[m][bj].y}), t1v = bf4_unpack((u32x2){tq[m][bj].z, tq[m][bj].w}), a0 = acc[ai][bj][m][0], a1 = acc[ai][bj][m][1]; f32x4 o0, o1;
#pragma unroll
                    for (int j = 0; j < 4; ++j) { o0[j] = sigmoidf_(g0[j]) * a0[j] + t0[j]; o1[j] = sigmoidf_(g1[j]) * a1[j] + t1v[j]; }
                    u32x4 w; w.x = cvt_pk_bf16(o0[0], o0[1]); w.y = cvt_pk_bf16(o0[2], o0[3]); w.z = cvt_pk_bf16(o1[0], o1[1]); w.w = cvt_pk_bf16(o1[2], o1[3]);
                    *(u32x4*)(mx + (size_t)r * ND + c0) = w; } } }
    }
};
struct EpiWout {
    static constexpr bool PERM = true; float* z1; const float* x; const float* mod;
    __device__ __forceinline__ void operator()(const f32x4 (&acc)[2][2][4][2], const Unit& u, int wr, int wc, int fr, int fq) const {
        const int b = u.pm >> 3;
        EPI_COLS_PERM(mod + (size_t)b * NMOD + 2 * ND + u.pn * 256)
#pragma unroll
        for (int ai = 0; ai < 2; ++ai)
#pragma unroll
            for (int mh = 0; mh < 2; ++mh) { f32x4 xq[2][2][2];
#pragma unroll
                for (int m2 = 0; m2 < 2; ++m2)
#pragma unroll
                    for (int bj = 0; bj < 2; ++bj)
#pragma unroll
                        for (int n = 0; n < 2; ++n) xq[m2][bj][n] = ld4(x + (size_t)(u.pm * 256 + ai * 128 + wr * 64 + (mh * 2 + m2) * 16 + fr) * ND + u.pn * 256 + bj * 128 + wc * 32 + 8 * fq + 4 * n);
#pragma unroll
                for (int m2 = 0; m2 < 2; ++m2) { const int m = mh * 2 + m2, r = u.pm * 256 + ai * 128 + wr * 64 + m * 16 + fr;
#pragma unroll
                    for (int bj = 0; bj < 2; ++bj)
#pragma unroll
                        for (int n = 0; n < 2; ++n) { const int c = u.pn * 256 + bj * 128 + wc * 32 + 8 * fq + 4 * n;
                            *(f32x4*)(z1 + (size_t)r * ND + c) = xq[m2][bj][n] * DN_ALPHA + cv[bj][n] * acc[ai][bj][m][n]; } } }
    }
};
struct EpiGU {
    static constexpr bool PERM = true; fp8_t* act; const float* b_gu;
    __device__ __forceinline__ void operator()(const f32x4 (&acc)[2][2][4][2], const Unit& u, int wr, int wc, int fr, int fq) const {
        const float* bias = b_gu + (size_t)u.e * (2 * DFF) + u.pn * 256 + wc * 32 + 8 * fq;
#pragma unroll
        for (int bj = 0; bj < 2; ++bj) { const f32x4 c0v = ld4(bias + bj * 128), c1v = ld4(bias + bj * 128 + 4); const int c0 = u.pn * 256 + bj * 128 + wc * 32 + 8 * fq;
#pragma unroll
            for (int ai = 0; ai < 2; ++ai)
#pragma unroll
                for (int m = 0; m < 4; ++m) { const int r = u.pm * 256 + ai * 128 + wr * 64 + m * 16 + fr;
                    const f32x4 v0 = acc[ai][bj][m][0] * W8_INV + c0v, v1 = acc[ai][bj][m][1] * W8_INV + c1v;
                    float o[4];
#pragma unroll
                    for (int j = 0; j < 4; ++j) { const float gt = fminf(j < 2 ? v0[2 * j] : v1[2 * j - 4], SW_LIMIT); const float up = fminf(fmaxf(j < 2 ? v0[2 * j + 1] : v1[2 * j - 3], -SW_LIMIT), SW_LIMIT);
                        o[j] = (up + 1.0f) * (gt * __builtin_amdgcn_rcpf(1.0f + __builtin_amdgcn_exp2f(gt * (-SW_ALPHA * 1.4426950408889634f)))); }
                    *(unsigned*)(act + (size_t)r * DFF + (c0 >> 1)) = pack4_fp8(o[0], o[1], o[2], o[3]); } }
    }
};
struct EpiDown {
    static constexpr bool PERM = true; bf16_t* yb; const float* b_down;
    __device__ __forceinline__ void operator()(const f32x4 (&acc)[2][2][4][2], const Unit& u, int wr, int wc, int fr, int fq) const {
        const float* bias = b_down + (size_t)u.e * ND + u.pn * 256 + wc * 32 + 8 * fq;
#pragma unroll
        for (int bj = 0; bj < 2; ++bj) { const f32x4 c0v = ld4(bias + bj * 128), c1v = ld4(bias + bj * 128 + 4); const int c0 = u.pn * 256 + bj * 128 + wc * 32 + 8 * fq;
#pragma unroll
            for (int ai = 0; ai < 2; ++ai)
#pragma unroll
                for (int m = 0; m < 4; ++m) { const int r = u.pm * 256 + ai * 128 + wr * 64 + m * 16 + fr;
                    const f32x4 v0 = acc[ai][bj][m][0] * W8_INV + c0v, v1 = acc[ai][bj][m][1] * W8_INV + c1v;
                    u32x4 w; w.x = cvt_pk_bf16(v0[0], v0[1]); w.y = cvt_pk_bf16(v0[2], v0[3]); w.z = cvt_pk_bf16(v1[0], v1[1]); w.w = cvt_pk_bf16(v1[2], v1[3]);
                    *(u32x4*)(yb + (size_t)r * ND + c0) = w; } }
    }
};

struct WinRestOrder {
    int c; size_t a_tile, b_tile;
    __device__ bool next(int i, Unit& u) const {
        if (i > 0 || c < 0 || c >= 64) return false;
        u.pm = c >> 1; u.pn = 23 + (c & 1); u.e = 0; u.aoff = (unsigned)((size_t)u.pm * a_tile); u.boff = (unsigned)((size_t)u.pn * b_tile); return true;
    }
};
struct PoolOrder {
    int G, c;
    __device__ bool next(int i, Unit& u) const {
        const int L = i * G + c; if (c < 0 || L >= 256) return false;
        u.pm = L >> 3; u.pn = L & 7; u.e = 0;
        u.aoff = (unsigned)(((size_t)u.pm * 256 * NC + (size_t)(u.pn >> 1) * 256) * 2); u.boff = (unsigned)((size_t)u.pn * 256 * 256 * 2); return true;
    }
};
struct MoeOrder {
    int G, c, nN, ntiles; const LAS unsigned* tile_e; size_t a_tile, b_expert, b_tile;
    __device__ bool next(int i, Unit& u) const {
        const int L = i * G + c; if (L >= ntiles * nN) return false;
        u.pm = L / nN; u.pn = L % nN; u.e = __builtin_amdgcn_readfirstlane((int)tile_e[u.pm]);
        u.aoff = (unsigned)((size_t)u.pm * a_tile); u.boff = (unsigned)((size_t)u.e * b_expert + (size_t)u.pn * b_tile); return true;
    }
};

__device__ __forceinline__ void cvt_block_T(const float* src, int ld_src, bf16_t* dst, int ld_dst, int lane) {
    const int k8 = lane & 7, nq = lane >> 3;
    const float* s = src + (size_t)(k8 * 8) * ld_src + nq * 4;
    f32x4 v[8];
#pragma unroll
    for (int j = 0; j < 8; ++j) v[j] = ld4(s + (size_t)j * ld_src);
#pragma unroll
    for (int i = 0; i < 4; ++i) { u32x4 w; w.x = cvt_pk_bf16(v[0][i], v[1][i]); w.y = cvt_pk_bf16(v[2][i], v[3][i]); w.z = cvt_pk_bf16(v[4][i], v[5][i]); w.w = cvt_pk_bf16(v[6][i], v[7][i]);
        *(u32x4*)(dst + (size_t)(nq * 4 + i) * ld_dst + k8 * 8) = w; }
}
__device__ __forceinline__ void cvt_block_T2(const float* src, int ld_src, bf16_t* dst, int ld_dst, int lane) {
    const int k8 = lane & 7, nq = lane >> 3;
    const float* s = src + (size_t)(k8 * 8) * ld_src + nq * 4;
    f32x4 v[8], w2[8];
#pragma unroll
    for (int j = 0; j < 8; ++j) { v[j] = ld4(s + (size_t)j * ld_src); w2[j] = ld4(s + (size_t)j * ld_src + 32); }
#pragma unroll
    for (int i = 0; i < 4; ++i) { u32x4 w; w.x = cvt_pk_bf16(v[0][i], v[1][i]); w.y = cvt_pk_bf16(v[2][i], v[3][i]); w.z = cvt_pk_bf16(v[4][i], v[5][i]); w.w = cvt_pk_bf16(v[6][i], v[7][i]);
        *(u32x4*)(dst + (size_t)(nq * 4 + i) * ld_dst + k8 * 8) = w; }
#pragma unroll
    for (int i = 0; i < 4; ++i) { u32x4 w; w.x = cvt_pk_bf16(w2[0][i], w2[1][i]); w.y = cvt_pk_bf16(w2[2][i], w2[3][i]); w.z = cvt_pk_bf16(w2[4][i], w2[5][i]); w.w = cvt_pk_bf16(w2[6][i], w2[7][i]);
        *(u32x4*)(dst + (size_t)(32 + nq * 4 + i) * ld_dst + k8 * 8) = w; }
}

__device__ __forceinline__ void cvt8_load(f32x4 (&v)[16], const float* s, int ld_src) {
#pragma unroll
    for (int j = 0; j < 16; ++j) v[j] = __builtin_nontemporal_load((const f32x4*)(s + (size_t)j * ld_src));
}
__device__ __forceinline__ void cvt8_store(const f32x4 (&v)[16], fp8_t* d, int ld_dst) {
#pragma unroll
    for (int i = 0; i < 4; ++i) { u32x4 w; w.x = pack4_fp8(v[0][i] * W8_SCALE, v[1][i] * W8_SCALE, v[2][i] * W8_SCALE, v[3][i] * W8_SCALE); w.y = pack4_fp8(v[4][i] * W8_SCALE, v[5][i] * W8_SCALE, v[6][i] * W8_SCALE, v[7][i] * W8_SCALE);
        w.z = pack4_fp8(v[8][i] * W8_SCALE, v[9][i] * W8_SCALE, v[10][i] * W8_SCALE, v[11][i] * W8_SCALE); w.w = pack4_fp8(v[12][i] * W8_SCALE, v[13][i] * W8_SCALE, v[14][i] * W8_SCALE, v[15][i] * W8_SCALE);
        *(u32x4*)(d + (size_t)i * ld_dst) = w; }
}
__device__ __forceinline__ void cvt_wave_T8x8(const float* src, int ld_src, fp8_t* dst, int ld_dst, int lane) {
    const int k16 = lane & 7, nq = lane >> 3;
    const float* s = src + (size_t)(k16 * 16) * ld_src + nq * 4; fp8_t* d = dst + (size_t)(nq * 4) * ld_dst + k16 * 16;
    f32x4 va[16], vb[16];
    cvt8_load(va, s, ld_src);
#pragma unroll
    for (int i = 0; i < 8; i += 2) {
        cvt8_load(vb, s + (i + 1) * 32, ld_src);
        cvt8_store(va, d + (size_t)(i * 32) * ld_dst, ld_dst);
        if (i + 2 < 8) cvt8_load(va, s + (i + 2) * 32, ld_src);
        cvt8_store(vb, d + (size_t)((i + 1) * 32) * ld_dst, ld_dst);
    }
}

__device__ __forceinline__ void phase0(const Params& p, LAS unsigned char* lds, const int wave) {
    const int tid = phase_tid(wave);
    const int bid = blockIdx.x, lane = tid & 63, wv = tid >> 6;
    LAS float* cond = (LAS float*)lds;
    if (bid < 192) {
        for (int i = tid; i < NB * ND; i += NTHREADS) { const int b = i >> 11, k = i & 2047; const float cv = p.c[i]; cond[k * 4 + b] = cv / (1.0f + expf(-cv)); }
        __syncthreads();
        const int gid = bid * NTHREADS + tid, ks = gid / 3072, j4 = gid % 3072;
        f32x4 a0 = {0.f, 0.f, 0.f, 0.f}, a1 = a0, a2 = a0, a3 = a0;
        const float* wp = p.w_ada + (size_t)(ks * 64) * NMOD + j4 * 4;
#pragma unroll 8
        for (int kk = 0; kk < 64; ++kk) { const f32x4 w = ld4(wp + (size_t)kk * NMOD); const f32x4 cd = *(const LAS f32x4*)(cond + (ks * 64 + kk) * 4);
            a0 += w * cd[0]; a1 += w * cd[1]; a2 += w * cd[2]; a3 += w * cd[3]; }
        *(f32x4*)(p.modp + (size_t)(ks * 4 + 0) * NMOD + j4 * 4) = a0; *(f32x4*)(p.modp + (size_t)(ks * 4 + 1) * NMOD + j4 * 4) = a1;
        *(f32x4*)(p.modp + (size_t)(ks * 4 + 2) * NMOD + j4 * 4) = a2; *(f32x4*)(p.modp + (size_t)(ks * 4 + 3) * NMOD + j4 * 4) = a3;
    }
    const int gw = bid * NWAVES + wv, GW = gridDim.x * NWAVES;
    constexpr int I_IN = 32 * 265, I_RW = 16 * 64, I_PL = 4 * 4 * 16, I_OUT = 32 * 64, I_ALL = I_IN + I_RW + I_PL + I_OUT;
    for (int it = gw; it < I_ALL; it += GW) {
        if (it < I_IN) { const int kb = it / 265, nb = it % 265; cvt_block_T(p.w_in + (size_t)(kb * 64) * NIN + nb * 32, NIN, p.wt_in + (size_t)(nb * 32) * ND + kb * 64, ND, lane); }
        else if (it < I_IN + I_RW) { const int j = it - I_IN, kb = j / 64, nb = j % 64; cvt_block_T(p.w_rwkv_out + (size_t)(kb * 64) * ND + nb * 32, ND, p.wt_rwkv + (size_t)(nb * 32) * NC + kb * 64, NC, lane); }
        else if (it < I_IN + I_RW + I_PL) { const int j = it - I_IN - I_RW, g = j / 64, kb = (j % 64) / 16, nb = j % 16;
            cvt_block_T(p.w_pool + (size_t)g * 256 * 512 + (size_t)(kb * 64) * 512 + nb * 32, 512, p.wt_pool + (size_t)g * 512 * 256 + (size_t)(nb * 32) * 256 + kb * 64, 256, lane); }
        else { const int j = it - I_IN - I_RW - I_PL, kb = j / 64, nb = j % 64; cvt_block_T(p.w_out + (size_t)(kb * 64) * ND + nb * 32, ND, p.wt_out + (size_t)(nb * 32) * ND + kb * 64, ND, lane); }
    }
    for (int idx = bid * NTHREADS + tid; idx < LORA_N * (LORA_K / 8); idx += gridDim.x * NTHREADS) {
        const int n = idx / (LORA_K / 8), k0 = (idx % (LORA_K / 8)) * 8; float v[8];
#pragma unroll
        for (int j = 0; j < 8; ++j) { const int k = k0 + j; float x = 0.f;
            if (n < 1024) { if (k < 64) x = p.w_decay_up[k * NC + n]; }
            else if (n < 2048) { if (k >= 64 && k < 128) x = p.w_iclr_up[(k - 64) * NC + (n - 1024)]; }
            else { if (k >= 128 && k < 288) x = p.w_glora_up[(k - 128) * NC + (n - 2048)]; }
            v[j] = x; }
        u32x4 w; w.x = cvt_pk_bf16(v[0], v[1]); w.y = cvt_pk_bf16(v[2], v[3]); w.z = cvt_pk_bf16(v[4], v[5]); w.w = cvt_pk_bf16(v[6], v[7]);
        *(u32x4*)(p.bt_lora + (size_t)n * LORA_K + k0) = w;
    }
}

__device__ __forceinline__ void phase1(const Params& p, LAS unsigned char* lds, const int wave) {
    const int tid = phase_tid(wave);
    const int bid = blockIdx.x;
    if (tid < 192) { const int idx = bid * 192 + tid, b = idx / NMOD, j = idx % NMOD; float s = p.b_ada[j];
        for (int ks = 0; ks < KS_MOD; ++ks) s += p.modp[(size_t)(ks * 4 + b) * NMOD + j];
        p.mod[idx] = s; }
    LAS float* ss = (LAS float*)lds;
    const int m0 = bid * 32, b = m0 >> 11;
    {   const int j = tid * 8; f32x4 s0 = ld4(p.b_ada + j), s1 = ld4(p.b_ada + j + 4);
#pragma unroll 8
        for (int ks = 0; ks < KS_MOD; ++ks) { s0 += ld4(p.modp + (size_t)(ks * 4 + b) * NMOD + j); s1 += ld4(p.modp + (size_t)(ks * 4 + b) * NMOD + j + 4); }
        *(LAS f32x4*)(ss + j) = s0; *(LAS f32x4*)(ss + j + 4) = s1; }
    __syncthreads();
    const int k = (tid & 255) * 8, rh = tid >> 8;
    const f32x4 sh0 = *(const LAS f32x4*)(ss + k), sh1v = *(const LAS f32x4*)(ss + k + 4), sc0 = *(const LAS f32x4*)(ss + ND + k) + 1.0f, sc1v = *(const LAS f32x4*)(ss + ND + k + 4) + 1.0f;
#pragma unroll 4
    for (int i = 0; i < 16; ++i) { const size_t m = (size_t)(m0 + 2 * i + rh); const f32x4 x0 = ld4(p.x + m * ND + k), x1 = ld4(p.x + m * ND + k + 4); const f32x4 h0 = x0 * sc0 + sh0, h1 = x1 * sc1v + sh1v;
        u32x4 w; w.x = cvt_pk_bf16(h0[0], h0[1]); w.y = cvt_pk_bf16(h0[2], h0[3]); w.z = cvt_pk_bf16(h1[0], h1[1]); w.w = cvt_pk_bf16(h1[2], h1[3]); *(u32x4*)(p.hb + m * ND + k) = w; }
    __syncthreads();
}

__device__ __forceinline__ void phase3(const Params& p, LAS unsigned char* lds, const int wave) {
    const int tid = phase_tid(wave);
    const int bid = blockIdx.x, m0 = bid * 32, t0 = m0 & (NT - 1), hist = t0 > 0 ? 15 : 0;
    constexpr int TC = OFF_GA - OFF_WD, TCH = TC / 8;
    LAS bf16_t* T = (LAS bf16_t*)lds;
    for (int idx = tid; idx < 47 * TCH; idx += NTHREADS) { const int r = idx / TCH, ck = idx % TCH;
        if (r >= 15 - hist) *(LAS u32x4*)(T + r * TC + ck * 8) = *(const u32x4*)(p.P + (size_t)(m0 - 15 + r) * NINP + OFF_WD + ck * 8); }
    __syncthreads();
    for (int idx = tid; idx < 32 * (LORA_K / 8); idx += NTHREADS) { const int i = idx / (LORA_K / 8), j0 = (idx % (LORA_K / 8)) * 8; u32x4 w = {0u, 0u, 0u, 0u};
        if (j0 < 288) { const u32x4 cu = *(const LAS u32x4*)(T + (15 + i) * TC + j0); u32x4 pu = {0u, 0u, 0u, 0u}; if (t0 + i > 0) pu = *(const LAS u32x4*)(T + (14 + i) * TC + j0);
            const f32x4 c0 = bf4_unpack((u32x2){cu.x, cu.y}), c1 = bf4_unpack((u32x2){cu.z, cu.w}), q0 = bf4_unpack((u32x2){pu.x, pu.y}), q1 = bf4_unpack((u32x2){pu.z, pu.w});
            const f32x4 s0 = c0 + (q0 - c0) * ld4(p.mu_shift + OFF_WD + j0), s1 = c1 + (q1 - c1) * ld4(p.mu_shift + OFF_WD + j0 + 4); float v[8];
#pragma unroll
            for (int j = 0; j < 8; ++j) { const float x = j < 4 ? s0[j] : s1[j - 4];
                v[j] = j0 < 64 ? (1.0f - 2.0f * __builtin_amdgcn_rcpf(1.0f + __builtin_amdgcn_exp2f(x * 2.8853900817779268f))) : (j0 < 128 ? x : sigmoidf_(x)); }
            w.x = cvt_pk_bf16(v[0], v[1]); w.y = cvt_pk_bf16(v[2], v[3]); w.z = cvt_pk_bf16(v[4], v[5]); w.w = cvt_pk_bf16(v[6], v[7]); }
        *(u32x4*)(p.a_lora + (size_t)(m0 + i) * LORA_K + j0) = w; }
    for (int idx = tid; idx < 32 * (NC / 8); idx += NTHREADS) { const int i = idx >> 7, c = (idx & 127) * 8; const int win = 2 << (c >> 8), t = t0 + i, n = (t + 1) < win ? (t + 1) : win;
        const LAS bf16_t* up = T + (15 + i) * TC + (OFF_POOL - OFF_WD) + c; f32x4 a0 = {0.f, 0.f, 0.f, 0.f}, a1 = a0;
        for (int q = 0; q < n; ++q) { const u32x4 uu = *(const LAS u32x4*)(up - q * TC); a0 += bf4_unpack((u32x2){uu.x, uu.y}); a1 += bf4_unpack((u32x2){uu.z, uu.w}); }
        const u32x4 u0 = *(const LAS u32x4*)(up); const float rn = 1.0f / (float)n;
        const f32x4 d0 = a0 * rn - bf4_unpack((u32x2){u0.x, u0.y}), d1 = a1 * rn - bf4_unpack((u32x2){u0.z, u0.w});
        u32x4 w; w.x = cvt_pk_bf16(d0[0], d0[1]); w.y = cvt_pk_bf16(d0[2], d0[3]); w.z = cvt_pk_bf16(d1[0], d1[1]); w.w = cvt_pk_bf16(d1[2], d1[3]);
        *(u32x4*)(p.dp + (size_t)(m0 + i) * NC + c) = w; }
    __syncthreads();
}

__device__ __forceinline__ float row8_allsum(float x) {
    x += dpp_f<0x141>(x); x += dpp_f<0x1B>(x); x += dpp_f<0xB1>(x); return x;
}
__device__ __forceinline__ void scan_head(const Params& p, LAS unsigned char* lds, int bh, const int wave) {
    const int tid = phase_tid(wave);
    const int lane = tid & 63;
    const int b = bh >> 4, h = bh & 15;
    constexpr int L_AW = 0, L_W = 16384, L_BK = 32768, L_Y = 65536, L_V = 81920, L_G = 106496, L_SC = 131072, L_CS = 131840, L_Z = 132352, L_DUMMY = 132864, L_CST = 133888;
    constexpr int NCH = NT / 32;
    if (tid < 128) *(LAS unsigned*)(lds + L_Z + tid * 4) = 0u;
    {
        const int a8 = tid >> 6, cc = tid & 63, gch = h * HS + cc;
        const float* src = a8 == 0 ? p.mu_shift + OFF_R : a8 == 1 ? p.mu_shift + OFF_K : a8 == 2 ? p.mu_shift + OFF_V : a8 == 3 ? p.k_k : a8 == 4 ? p.k_a : a8 == 5 ? p.r_k : a8 == 6 ? p.lnx_g : p.lnx_b;
        *(LAS float*)(lds + L_CST + a8 * 256 + cc * 4) = src[gch]; }
    __syncthreads();
#define CST4(a8, u_) (*(const LAS f32x4*)(lds + L_CST + (a8) * 256 + (c8 + 4 * (u_)) * 4))
    const int ht = tid - 256, ls = (ht >> 3) & 31, c8 = (ht & 7) * 8, ch0 = h * HS + c8;
    f32x4 pr[2], pk[2], pv[2], qr[2], qk[2], qv[2], dc[2], ic[2], gt[2]; u32x4 pr8, pk8, pv8, qr8, qk8, qv8, ic8, gt8;
    const f32x4 zero4 = {0.f, 0.f, 0.f, 0.f};
#define SCAN_ISSUE(chunk) do { int ch = ch0; asm volatile("" : "+v"(ch)); const int t_ = (chunk) * 32 + ls; const size_t m_ = (size_t)b * NT + t_; const bf16_t* row_ = p.P + m_ * NINP + ch; \
        pr8 = *(const u32x4*)(row_ + OFF_R); pk8 = *(const u32x4*)(row_ + OFF_K); pv8 = *(const u32x4*)(row_ + OFF_V); \
        if (t_ > 0) { qr8 = *(const u32x4*)(row_ - NINP + OFF_R); qk8 = *(const u32x4*)(row_ - NINP + OFF_K); qv8 = *(const u32x4*)(row_ - NINP + OFF_V); } else { qr8 = (u32x4){0u, 0u, 0u, 0u}; qk8 = qr8; qv8 = qr8; } \
        ic8 = *(const u32x4*)(p.iclr + m_ * NC + ch); gt8 = *(const u32x4*)(p.gg + m_ * NC + ch); \
        _Pragma("unroll") for (int u_ = 0; u_ < 2; ++u_) dc[u_] = ld4(p.dec + m_ * NC + ch + 4 * u_); } while (0)
#define SCAN_UNPACK() do { ic[0] = bf4_unpack((u32x2){ic8.x, ic8.y}); ic[1] = bf4_unpack((u32x2){ic8.z, ic8.w}); gt[0] = bf4_unpack((u32x2){gt8.x, gt8.y}); gt[1] = bf4_unpack((u32x2){gt8.z, gt8.w}); pr[0] = bf4_unpack((u32x2){pr8.x, pr8.y}); pr[1] = bf4_unpack((u32x2){pr8.z, pr8.w}); pk[0] = bf4_unpack((u32x2){pk8.x, pk8.y}); pk[1] = bf4_unpack((u32x2){pk8.z, pk8.w}); \
        pv[0] = bf4_unpack((u32x2){pv8.x, pv8.y}); pv[1] = bf4_unpack((u32x2){pv8.z, pv8.w}); qr[0] = bf4_unpack((u32x2){qr8.x, qr8.y}); qr[1] = bf4_unpack((u32x2){qr8.z, qr8.w}); \
        qk[0] = bf4_unpack((u32x2){qk8.x, qk8.y}); qk[1] = bf4_unpack((u32x2){qk8.z, qk8.w}); qv[0] = bf4_unpack((u32x2){qv8.x, qv8.y}); qv[1] = bf4_unpack((u32x2){qv8.z, qv8.w}); } while (0)
#define SCAN_STAGE(chunk) do { SCAN_UNPACK(); int ch = ch0; asm volatile("" : "+v"(ch)); const int bp_ = (chunk) & 1, vb_ = (chunk) % 3; f32x4 r_[2], k_[2], v_[2], kk_[2], km_[2], bb_[2]; float ss_ = 0.f; \
        _Pragma("unroll") for (int u_ = 0; u_ < 2; ++u_) { const f32x4 mu_r = CST4(0, u_), mu_k = CST4(1, u_), mu_v = CST4(2, u_); \
            r_[u_] = pr[u_] + (qr[u_] - pr[u_]) * mu_r; k_[u_] = pk[u_] + (qk[u_] - pk[u_]) * mu_k; v_[u_] = pv[u_] + (qv[u_] - pv[u_]) * mu_v; \
            kk_[u_] = k_[u_] * CST4(3, u_); ss_ += dot4(kk_[u_], kk_[u_]); } \
        ss_ = row8_allsum(ss_); const float inv_ = 1.0f / fmaxf(sqrtf(ss_), 1e-12f); float br_ = 0.f, kr_ = 0.f, rk_ = 0.f; \
        _Pragma("unroll") for (int u_ = 0; u_ < 2; ++u_) { kk_[u_] = kk_[u_] * inv_; km_[u_] = k_[u_] * ((ic[u_] - 1.0f) * CST4(4, u_) + 1.0f); bb_[u_] = kk_[u_] * ic[u_]; \
            br_ += dot4(bb_[u_], r_[u_]); kr_ += dot4(km_[u_], r_[u_]); rk_ += dot4(r_[u_] * km_[u_], CST4(5, u_)); } \
        br_ = row8_allsum(br_); kr_ = row8_allsum(kr_); rk_ = row8_allsum(rk_); \
          \
        const int pp_ = ls >> 1, odd_ = ls & 1; float c1_ = 0.f, c2_ = 0.f, c3_ = 0.f, c4_ = 0.f; \
        _Pragma("unroll") for (int u_ = 0; u_ < 2; ++u_) { const int k0_ = c8 + 4 * u_; const int pos_ = (k0_ >> 5) * 32 + ((k0_ & 15) >> 2) * 8 + ((k0_ >> 4) & 1) * 4; \
            const f32x4 a_ = -kk_[u_], wr_ = dc[u_] * r_[u_] + a_ * br_; f32x4 pw_, pb_, pk_; \
            _Pragma("unroll") for (int j_ = 0; j_ < 4; ++j_) { pw_[j_] = dpp_f<0x118>(dc[u_][j_]); pb_[j_] = dpp_f<0x118>(bb_[u_][j_]); pk_[j_] = dpp_f<0x118>(km_[u_][j_]); } \
            const f32x4 x0_ = odd_ ? pw_ * a_ : a_, x1_ = odd_ ? pw_ * wr_ : wr_; \
            u32x2 wa_, ww_; wa_.x = cvt_pk_bf16(x0_[0], x0_[1]); wa_.y = cvt_pk_bf16(x0_[2], x0_[3]); ww_.x = cvt_pk_bf16(x1_[0], x1_[1]); ww_.y = cvt_pk_bf16(x1_[2], x1_[3]); \
            *(LAS u32x2*)(lds + L_AW + bp_ * 8192 + pp_ * 512 + odd_ * 256 + pos_ * 2) = wa_; *(LAS u32x2*)(lds + L_AW + bp_ * 8192 + pp_ * 512 + odd_ * 256 + 128 + pos_ * 2) = ww_; \
            if (odd_) { *(LAS f32x4*)(lds + L_W + bp_ * 8192 + pp_ * 256 + k0_ * 4) = pw_ * dc[u_]; \
                *(LAS f32x4*)(lds + L_BK + bp_ * 16384 + pp_ * 1024 + k0_ * 4) = pb_ * dc[u_]; *(LAS f32x4*)(lds + L_BK + bp_ * 16384 + pp_ * 1024 + 256 + k0_ * 4) = pk_ * dc[u_]; \
                *(LAS f32x4*)(lds + L_BK + bp_ * 16384 + pp_ * 1024 + 512 + k0_ * 4) = bb_[u_]; *(LAS f32x4*)(lds + L_BK + bp_ * 16384 + pp_ * 1024 + 768 + k0_ * 4) = km_[u_]; \
                c1_ += dot4(pb_, a_); c2_ += dot4(pk_, a_); c3_ += dot4(pb_, wr_); c4_ += dot4(pk_, wr_); } \
            *(LAS f32x4*)(lds + L_V + vb_ * 8192 + ls * 256 + k0_ * 4) = v_[u_]; *(LAS f32x4*)(lds + L_G + vb_ * 8192 + ls * 256 + k0_ * 4) = gt[u_]; } \
        c1_ = row8_allsum(c1_); c2_ = row8_allsum(c2_); c3_ = row8_allsum(c3_); c4_ = row8_allsum(c4_); \
        if ((ht & 7) == 0) { *(LAS f32x2*)(lds + L_SC + vb_ * 256 + ls * 8) = (f32x2){kr_, rk_}; if (odd_) *(LAS f32x4*)(lds + L_CS + bp_ * 256 + pp_ * 16) = (f32x4){c1_, c2_, c3_, c4_}; } } while (0)
#define SCAN_POST(chunk) do { int ch = ch0; asm volatile("" : "+v"(ch)); const int bp_ = (chunk) & 1, vb_ = (chunk) % 3; const f32x2 sc_ = *(const LAS f32x2*)(lds + L_SC + vb_ * 256 + ls * 8); f32x4 y_[2], v_[2]; float s_ = 0.f; \
        _Pragma("unroll") for (int u_ = 0; u_ < 2; ++u_) { v_[u_] = *(const LAS f32x4*)(lds + L_V + vb_ * 8192 + ls * 256 + (c8 + 4 * u_) * 4); \
            y_[u_] = *(const LAS f32x4*)(lds + L_Y + bp_ * 8192 + ls * 256 + (c8 + 4 * u_) * 4) + v_[u_] * sc_[0]; s_ += (y_[u_][0] + y_[u_][1]) + (y_[u_][2] + y_[u_][3]); } \
        const float mean_ = row8_allsum(s_) * (1.0f / 64.0f); float q_ = 0.f; \
        _Pragma("unroll") for (int u_ = 0; u_ < 2; ++u_) { y_[u_] = y_[u_] - mean_; q_ += dot4(y_[u_], y_[u_]); } \
        const float rstd_ = rsqrtf(row8_allsum(q_) * (1.0f / 64.0f) + GN_EPS); const size_t m_ = (size_t)b * NT + (chunk) * 32 + ls; u32x4 o_; \
        _Pragma("unroll") for (int u_ = 0; u_ < 2; ++u_) { const f32x4 g_ = *(const LAS f32x4*)(lds + L_G + vb_ * 8192 + ls * 256 + (c8 + 4 * u_) * 4); \
            const f32x4 yn_ = y_[u_] * rstd_ * CST4(6, u_) + CST4(7, u_); const f32x4 f_ = (yn_ + v_[u_] * sc_[1]) * g_; \
            if (u_ == 0) { o_.x = cvt_pk_bf16(f_[0], f_[1]); o_.y = cvt_pk_bf16(f_[2], f_[3]); } else { o_.z = cvt_pk_bf16(f_[0], f_[1]); o_.w = cvt_pk_bf16(f_[2], f_[3]); } } \
        *(u32x4*)(p.yr + m_ * NC + ch) = o_; } while (0)
    const int ri = lane & 15, rg = lane >> 4, sel = ri & 3;
    f32x4 X0 = zero4, X1 = zero4, X2 = zero4, X3 = zero4;
    if (wave >= 4) { SCAN_ISSUE(0); SCAN_STAGE(0); }
    __syncthreads();
    for (int chunk = 0; chunk < NCH; ++chunk) {
        if (wave < 4) {
            __builtin_amdgcn_s_setprio(3);
            const int bp = chunk & 1, vb = chunk % 3;
            const LAS unsigned char* awp = lds + L_AW + bp * 8192 + sel * 128 + rg * 16;
            const LAS unsigned char* wwp = lds + L_W + bp * 8192 + rg * 16;
            const LAS unsigned char* abp = lds + L_BK + bp * 16384 + rg * 256 + ri * 4;
            const LAS unsigned char* vp = lds + L_V + vb * 8192 + (16 * wave + ri) * 4;
            const LAS unsigned char* csp = lds + L_CS + bp * 256;
            LAS unsigned char* yp = (rg == 0) ? (lds + L_Y + bp * 8192 + (16 * wave + ri) * 4) : ((rg == 2) ? (lds + L_Y + bp * 8192 + 256 + (16 * wave + ri) * 4) : (lds + L_DUMMY + tid * 4));
            const int y_st = (rg & 1) ? 0 : 512;
#define SCAN_LD(S, pi) do { S##a0 = *(const LAS bf16x8*)(awp + (pi) * 512); S##a1 = *(const LAS bf16x8*)(awp + (pi) * 512 + 64); \
                S##w0 = *(const LAS f32x4*)(wwp + (pi) * 256); S##w1 = *(const LAS f32x4*)(wwp + (pi) * 256 + 64); S##w2 = *(const LAS f32x4*)(wwp + (pi) * 256 + 128); S##w3 = *(const LAS f32x4*)(wwp + (pi) * 256 + 192); \
                S##b0 = *(const LAS float*)(abp + (pi) * 1024); S##b1 = *(const LAS float*)(abp + (pi) * 1024 + 64); S##b2 = *(const LAS float*)(abp + (pi) * 1024 + 128); S##b3 = *(const LAS float*)(abp + (pi) * 1024 + 192); \
                S##vt = *(const LAS float*)(vp + (pi) * 512); S##vu = *(const LAS float*)(vp + (pi) * 512 + 256); S##cs = *(const LAS f32x4*)(csp + (pi) * 16); } while (0)
#define SCAN_STEP(S, pi) do { u32x4 xa, xc; \
                xa.x = cvt_pk_bf16(X0[0], X0[1]); xa.y = cvt_pk_bf16(X0[2], X0[3]); xa.z = cvt_pk_bf16(X1[0], X1[1]); xa.w = cvt_pk_bf16(X1[2], X1[3]); \
                xc.x = cvt_pk_bf16(X2[0], X2[1]); xc.y = cvt_pk_bf16(X2[2], X2[3]); xc.z = cvt_pk_bf16(X3[0], X3[1]); xc.w = cvt_pk_bf16(X3[2], X3[3]); \
                const f32x4 d0 = __builtin_amdgcn_mfma_f32_16x16x32_bf16(S##a0, __builtin_bit_cast(bf16x8, xa), zero4, 0, 0, 0); \
                const f32x4 d1 = __builtin_amdgcn_mfma_f32_16x16x32_bf16(S##a1, __builtin_bit_cast(bf16x8, xc), zero4, 0, 0, 0); \
                const f32x4 d = d0 + d1; const float sat = d[0]; \
                const float sau = d[2] + sat * S##cs[0] + S##vt * S##cs[1], yu = d[3] + sat * S##cs[2] + S##vt * S##cs[3]; \
                const float bsel = (rg == 0) ? sat : ((rg == 1) ? S##vt : ((rg == 2) ? sau : S##vu)); \
                X0 = __builtin_amdgcn_mfma_f32_16x16x4f32(S##b0, bsel, X0 * S##w0, 0, 0, 0); \
                X1 = __builtin_amdgcn_mfma_f32_16x16x4f32(S##b1, bsel, X1 * S##w1, 0, 0, 0); \
                X2 = __builtin_amdgcn_mfma_f32_16x16x4f32(S##b2, bsel, X2 * S##w2, 0, 0, 0); \
                X3 = __builtin_amdgcn_mfma_f32_16x16x4f32(S##b3, bsel, X3 * S##w3, 0, 0, 0); \
                *(LAS float*)(yp + (pi) * y_st) = (rg == 0) ? d[1] : yu; } while (0)
            bf16x8 Pa0, Pa1, Qa0, Qa1; f32x4 Pw0, Pw1, Pw2, Pw3, Qw0, Qw1, Qw2, Qw3, Pcs, Qcs; float Pb0, Pb1, Pb2, Pb3, Pvt, Pvu, Qb0, Qb1, Qb2, Qb3, Qvt, Qvu;
            SCAN_LD(P, 0);
#pragma unroll 1
            for (int pi = 0; pi < 16; pi += 2) {
                SCAN_LD(Q, pi + 1);
                SCAN_STEP(P, pi);
                if (pi + 2 < 16) SCAN_LD(P, pi + 2);
                SCAN_STEP(Q, pi + 1);
            }
#undef SCAN_LD
#undef SCAN_STEP
        } else {
            if (chunk + 1 < NCH) SCAN_ISSUE(chunk + 1);
            if (chunk > 0) SCAN_POST(chunk - 1);
            if (chunk + 1 < NCH) SCAN_STAGE(chunk + 1);
        }
        __syncthreads();
    }
    if (wave >= 4) SCAN_POST(NCH - 1);
    __syncthreads();
#undef SCAN_ISSUE
#undef CST4
#undef SCAN_STAGE
#undef SCAN_UNPACK
#undef SCAN_POST
}
__device__ __forceinline__ void conv_queue(const Params& p, LAS unsigned char* lds, const int wave, const int cw) {
    const int tid = phase_tid(wave);
    const int lane = tid & 63, wv = tid >> 6;
    LAS int* slot = (LAS int*)(lds + LDS_MISC);
    constexpr int N_GU = NE * 16 * 2, N_DN = NE * 16, N_ALL = N_GU + N_DN;
    for (;;) {
        __syncthreads();
        if (tid == 0) *slot = (int)atomicAdd(&p.ctl[cw], 1u);
        __syncthreads();
        const int it = *slot;
        if (it >= N_ALL) break;
        if (it < N_GU) { const int e = it >> 5, rem = it & 31, kb = rem >> 1, nh = rem & 1;
            const float* src = p.w_gu + (size_t)e * ND * (2 * DFF) + (size_t)(kb * 128) * (2 * DFF) + nh * 2048;
            fp8_t* dst = p.wt_gu + (size_t)e * (2 * DFF) * ND + (size_t)(nh * 2048) * ND + kb * 128;
            cvt_wave_T8x8(src + wv * 256, 2 * DFF, dst + (size_t)(wv * 256) * ND, ND, lane); }
        else { const int j = it - N_GU, e = j >> 4, kb = j & 15;
            const float* src = p.w_down + (size_t)e * DFF * ND + (size_t)(kb * 128) * ND;
            fp8_t* dst = p.wt_down + (size_t)e * ND * DFF + kb * 128;
            cvt_wave_T8x8(src + wv * 256, ND, dst + (size_t)(wv * 256) * DFF, DFF, lane); }
    }
}

__device__ __forceinline__ void phase8(const Params& p, LAS unsigned char* lds, const int wave) {
    const int tid = phase_tid(wave);
    const int bid = blockIdx.x, lane = tid & 63, wv = tid >> 6;
    constexpr int HP = ND + 4;
    LAS float* hs = (LAS float*)lds;
    LAS float* lg = hs + 16 * HP;
    LAS float* part = lg + 16 * 32;
    LAS float* topv = part + 4 * 16 * 32;
    LAS int* topi = (LAS int*)(topv + 64);
    const int b = (bid * 32) >> 11;
    const float* sh2 = p.mod + (size_t)b * NMOD + 3 * ND; const float* sc2 = p.mod + (size_t)b * NMOD + 4 * ND;
    for (int pass = 0; pass < 2; ++pass) {
        const int mb = bid * 32 + pass * 16;
        for (int rr = 0; rr < 2; ++rr) { const int r = wv * 2 + rr; const size_t m = (size_t)(mb + r);
            f32x4 z[8]; float s = 0.f;
#pragma unroll
            for (int j = 0; j < 4; ++j) { z[2 * j] = ld4(p.z1 + m * ND + j * 512 + lane * 8); z[2 * j + 1] = ld4(p.z1 + m * ND + j * 512 + lane * 8 + 4);
                s += ((z[2 * j][0] + z[2 * j][1]) + (z[2 * j][2] + z[2 * j][3])) + ((z[2 * j + 1][0] + z[2 * j + 1][1]) + (z[2 * j + 1][2] + z[2 * j + 1][3])); }
            const float mean = wave_allsum(s) * (1.0f / ND); float qv = 0.f;
#pragma unroll
            for (int j = 0; j < 8; ++j) { const f32x4 d = z[j] - mean; qv += dot4(d, d); }
            const float rstd = rsqrtf(wave_allsum(qv) * (1.0f / ND) + LN_EPS);
            if (lane == 0) *(f32x2*)(p.lnst + m * 2) = (f32x2){mean, rstd};
#pragma unroll
            for (int j = 0; j < 8; ++j) { const int k = (j >> 1) * 512 + lane * 8 + (j & 1) * 4;
                const f32x4 x1 = (z[j] - mean) * rstd * ld4(p.ln1_g + k) + ld4(p.ln1_b + k);
                const f32x4 h = x1 * (ld4(sc2 + k) + 1.0f) + ld4(sh2 + k);
                *(unsigned*)(p.h2 + m * ND + k) = pack4_fp8(h[0], h[1], h[2], h[3]);
                *(LAS f32x4*)(hs + r * HP + k) = h; } }
        __syncthreads();
        {
            const int kq = wv >> 1, ntl = wv & 1, ar = lane & 15, ak = lane >> 4;
            f32x4 acc = {0.f, 0.f, 0.f, 0.f};
            const LAS float* ap = hs + ar * HP + kq * 512 + ak; const float* bp = p.w_router + (size_t)(kq * 512 + ak) * NE + ntl * 16 + ar;
#pragma unroll 8
            for (int ks = 0; ks < 128; ++ks) acc = __builtin_amdgcn_mfma_f32_16x16x4f32(ap[ks * 4], bp[(size_t)ks * 4 * NE], acc, 0, 0, 0);
#pragma unroll
            for (int j = 0; j < 4; ++j) part[(kq * 16 + ak * 4 + j) * 32 + ntl * 16 + ar] = acc[j]; }
        __syncthreads();
        {   const int r = tid >> 5, e = tid & 31;
            lg[r * 32 + e] = p.b_router[e] + (part[(0 * 16 + r) * 32 + e] + part[(1 * 16 + r) * 32 + e]) + (part[(2 * 16 + r) * 32 + e] + part[(3 * 16 + r) * 32 + e]); }
        __syncthreads();
        {
            const int r = tid >> 5, e = tid & 31; const LAS float* l = lg + r * 32; const float mine = l[e]; int rank = 0;
#pragma unroll
            for (int q = 0; q < 8; ++q) { const f32x4 o = *(const LAS f32x4*)(l + q * 4);
#pragma unroll
                for (int j = 0; j < 4; ++j) rank += (o[j] > mine || (o[j] == mine && (q * 4 + j) < e)) ? 1 : 0; }
            if (rank < 4) { topv[r * 4 + rank] = mine; topi[r * 4 + rank] = e; } }
        __syncthreads();
        if (tid < 64) { const int r = tid >> 2, k = tid & 3, m = mb + r; const f32x4 tv = *(const LAS f32x4*)(topv + r * 4); const int ei = topi[r * 4 + k];
            const float e0 = 1.0f, e1 = expf(tv[1] - tv[0]), e2 = expf(tv[2] - tv[0]), e3 = expf(tv[3] - tv[0]); const float sum = (e0 + e1) + (e2 + e3);
            const float mineexp = k == 0 ? e0 : (k == 1 ? e1 : (k == 2 ? e2 : e3));
            const unsigned rk = atomicAdd(&p.ctl[CW_CNT + 64 * ei], 1u);
            p.sel[m * 4 + k] = ei; p.rnk[m * 4 + k] = (int)rk; p.prob[m * 4 + k] = mineexp / sum; }
        __syncthreads();
    }
}

__device__ __forceinline__ void phase9(const Params& p, LAS unsigned char* lds, const int wave) {
    const int tid = phase_tid(wave);
    const int bid = blockIdx.x, lane = tid & 63, wv = tid >> 6;
    LAS int* seg = (LAS int*)lds;
    if (tid == 0) { int s = 0;
        for (int e = 0; e < NE; ++e) { seg[e] = s; const int c = (int)xb_ld(&p.ctl[CW_CNT + 64 * e]); s += (c + 255) & ~255; }
        seg[NE] = s;
        if (bid == 0) { int t = 0;
            for (int e = 0; e < NE; ++e) { const int nt = (seg[e + 1] - seg[e]) >> 8; for (int i = 0; i < nt; ++i) p.ctl[CW_TILEE + t + i] = (unsigned)e; t += nt; }
            p.ctl[CW_NTILES] = (unsigned)t; } }
    __syncthreads();
    const int GW = gridDim.x * NWAVES;
    for (int it = bid * NWAVES + wv; it < NM * TOPK; it += GW) { const int m = it >> 2;
        const int e = p.sel[it], d = seg[e] + p.rnk[it];
        if (lane == 0) p.dest[it] = d;
        const u32x4* src = (const u32x4*)(p.h2 + (size_t)m * ND); u32x4* dst = (u32x4*)(p.xb + (size_t)d * ND);
#pragma unroll
        for (int i = 0; i < 2; ++i) dst[i * 64 + lane] = src[i * 64 + lane]; }
    __syncthreads();
}

__device__ __forceinline__ void phase13(const Params& p, const int wave) {
    const int tid = phase_tid(wave);
    const int bid = blockIdx.x, lane0 = tid & 63, wv = wave;
    const int GW = gridDim.x * NWAVES;
    for (int m = bid * NWAVES + wv; m < NM; m += GW) { const int b = m >> 11;
        int lane = lane0; asm volatile("" : "+v"(lane));
        const float* g2 = p.mod + (size_t)b * NMOD + 5 * ND;
        int d[4]; float pr[4]; const f32x2 st = *(const f32x2*)(p.lnst + (size_t)m * 2);
#pragma unroll
        for (int k = 0; k < 4; ++k) { d[k] = p.dest[m * 4 + k]; pr[k] = p.prob[m * 4 + k]; }
        f32x4 z[8]; float s = 0.f;
#pragma unroll
        for (int j = 0; j < 4; ++j) { const int c = j * 512 + lane * 8; f32x4 f0 = {0.f, 0.f, 0.f, 0.f}, f1 = f0;
#pragma unroll
            for (int k = 0; k < 4; ++k) { const u32x4 y8 = *(const u32x4*)(p.yb + (size_t)d[k] * ND + c);
                f0 += bf4_unpack((u32x2){y8.x, y8.y}) * pr[k]; f1 += bf4_unpack((u32x2){y8.z, y8.w}) * pr[k]; }
            const f32x4 xa = (ld4(p.z1 + (size_t)m * ND + c) - st[0]) * st[1] * ld4(p.ln1_g + c) + ld4(p.ln1_b + c), xb2 = (ld4(p.z1 + (size_t)m * ND + c + 4) - st[0]) * st[1] * ld4(p.ln1_g + c + 4) + ld4(p.ln1_b + c + 4);
            z[2 * j] = xa * DN_ALPHA + ld4(g2 + c) * f0; z[2 * j + 1] = xb2 * DN_ALPHA + ld4(g2 + c + 4) * f1;
            s += ((z[2 * j][0] + z[2 * j][1]) + (z[2 * j][2] + z[2 * j][3])) + ((z[2 * j + 1][0] + z[2 * j + 1][1]) + (z[2 * j + 1][2] + z[2 * j + 1][3])); }
        const float mean = wave_allsum(s) * (1.0f / ND); float qv = 0.f;
#pragma unroll
        for (int j = 0; j < 8; ++j) { const f32x4 dd = z[j] - mean; qv += dot4(dd, dd); }
        const float rstd = rsqrtf(wave_allsum(qv) * (1.0f / ND) + LN_EPS);
#pragma unroll
        for (int j = 0; j < 8; ++j) { const int c = (j >> 1) * 512 + lane * 8 + (j & 1) * 4;
            *(f32x4*)(p.out + (size_t)m * ND + c) = (z[j] - mean) * rstd * ld4(p.ln2_g + c) + ld4(p.ln2_b + c); } }
}

__global__ void __launch_bounds__(NTHREADS, 2) fwd(Params p) {
    extern __shared__ __attribute__((aligned(16))) unsigned char shm[];
    LAS unsigned char* lds = (LAS unsigned char*)shm;
    const int bid = blockIdx.x, G = gridDim.x;
    const int wave = __builtin_amdgcn_readfirstlane(threadIdx.x >> 6);
    if (threadIdx.x == 0) *(LAS u32x4*)(lds + LDS_BARW) = (u32x4){0u, 0u, 0u, 0u};
    __syncthreads();
    XcdBarrier bar = xcd_barrier_post(p.bar, (volatile LAS unsigned*)(lds + LDS_BARW));

    phase0(p, lds, wave);
    xcd_barrier(bar, wave);
    if (PROBE == 3) { phase0(p, lds, wave); xcd_barrier(bar, wave); }
    phase1(p, lds, wave);
    xcd_barrier(bar, wave);
    if (PROBE == 3) { phase1(p, lds, wave); xcd_barrier(bar, wave); }
    {
        pg8::Gemm g{p.hb, p.wt_in, ND, ND, ND}; pg8::DenseOrder S; S.init(NM / 256, NINP / 256 - 2, G, bid, (size_t)256 * ND * 2, (size_t)256 * ND * 2); S.skip_from = 23; S.skip_n = 2;
        EpiP E{p.P}; pg8::gemm_phase(lds, g, S, E, wave);
        if (PROBE == 1) { __syncthreads(); pg8::gemm_phase(lds, g, S, E, wave); } }
    xcd_barrier(bar, wave);
    phase3(p, lds, wave);
    xcd_barrier(bar, wave);
    if (PROBE == 3) { phase3(p, lds, wave); xcd_barrier(bar, wave); }
    {
        pg8::Gemm g{p.hb, p.wt_in, ND, ND, ND}; WinRestOrder S{bid, (size_t)256 * ND * 2, (size_t)256 * ND * 2};
        EpiP E{p.P}; pg8::gemm_phase(lds, g, S, E, wave); }
    __syncthreads();
    {
        pg8::Gemm g{p.a_lora, p.bt_lora, LORA_K, LORA_K, LORA_K}; pg8::DenseOrder S; S.init(NM / 256, LORA_N / 256, G - 64, bid - 64, (size_t)256 * LORA_K * 2, (size_t)256 * LORA_K * 2);
        EpiLora E{p.dec, p.iclr, p.gg, p.w0, p.a0}; pg8::gemm_phase(lds, g, S, E, wave);
        if (PROBE == 1) { __syncthreads(); pg8::gemm_phase(lds, g, S, E, wave); } }
    __syncthreads();
    {
        pg8::Gemm g{p.dp, p.wt_pool, NC, 256, 256}; PoolOrder S{1 << 20, bid >= 64 ? bid - 64 : 192 + bid};
        EpiPool E{p.t1, p.P, p.pool_scale}; pg8::gemm_phase(lds, g, S, E, wave);
        if (PROBE == 1) { __syncthreads(); pg8::gemm_phase(lds, g, S, E, wave); } }
    xcd_barrier(bar, wave);
    if (bid < NB * NH) { scan_head(p, lds, bid, wave); if (PROBE == 4) scan_head(p, lds, bid, wave); }
    conv_queue(p, lds, wave, CW_CONV);
    if (PROBE == 5) conv_queue(p, lds, wave, CW_CONV2);
    xcd_barrier(bar, wave);
    if (PROBE == 2) { if (bid < NB * NH) scan_head(p, lds, bid, wave); conv_queue(p, lds, wave, CW_CONV2); xcd_barrier(bar, wave); }
    {
        pg8::Gemm g{p.yr, p.wt_rwkv, NC, NC, NC}; pg8::DenseOrder S; S.init(NM / 256, ND / 256, G, bid, (size_t)256 * NC * 2, (size_t)256 * NC * 2);
        EpiRwkv E{p.mx, p.P, p.t1}; pg8::gemm_phase(lds, g, S, E, wave);
        if (PROBE == 1) { __syncthreads(); pg8::gemm_phase(lds, g, S, E, wave); } }
    xcd_barrier(bar, wave);
    {
        pg8::Gemm g{p.mx, p.wt_out, ND, ND, ND}; pg8::DenseOrder S; S.init(NM / 256, ND / 256, G, bid, (size_t)256 * ND * 2, (size_t)256 * ND * 2);
        EpiWout E{p.z1, p.x, p.mod}; pg8::gemm_phase(lds, g, S, E, wave);
        if (PROBE == 1) { __syncthreads(); pg8::gemm_phase(lds, g, S, E, wave); } }
    xcd_barrier(bar, wave);
    phase8(p, lds, wave);
    xcd_barrier(bar, wave);
    phase9(p, lds, wave);
    xcd_barrier(bar, wave);
    if (PROBE == 3) { phase9(p, lds, wave); xcd_barrier(bar, wave); }
    const int ntiles = (int)xb_ld(&p.ctl[CW_NTILES]);
    {   const int t_ = phase_tid(wave); if (t_ < MAXTILES) *(LAS unsigned*)(lds + LDS_MISC + 4 * t_) = p.ctl[CW_TILEE + t_]; }
    __syncthreads();
    {
        pg8::Gemm g{(const bf16_t*)p.xb, (const bf16_t*)p.wt_gu, ND / 2, ND / 2, ND / 2};
        MoeOrder S{G, bid, 2 * DFF / 256, ntiles, (const LAS unsigned*)(lds + LDS_MISC), (size_t)256 * ND, (size_t)(2 * DFF) * ND, (size_t)256 * ND};
        EpiGU E{p.act, p.b_gu}; pg8::gemm_phase<EpiGU, MoeOrder, true>(lds, g, S, E, wave);
        if (PROBE == 1) { __syncthreads(); pg8::gemm_phase<EpiGU, MoeOrder, true>(lds, g, S, E, wave); } }
    xcd_barrier(bar, wave);
    {
        pg8::Gemm g{(const bf16_t*)p.act, (const bf16_t*)p.wt_down, DFF / 2, DFF / 2, DFF / 2};
        MoeOrder S{G, bid, ND / 256, ntiles, (const LAS unsigned*)(lds + LDS_MISC), (size_t)256 * DFF, (size_t)ND * DFF, (size_t)256 * DFF};
        EpiDown E{p.yb, p.b_down}; pg8::gemm_phase<EpiDown, MoeOrder, true>(lds, g, S, E, wave);
        if (PROBE == 1) { __syncthreads(); pg8::gemm_phase<EpiDown, MoeOrder, true>(lds, g, S, E, wave); } }
    xcd_barrier(bar, wave);
    phase13(p, wave);
    if (PROBE == 3) { xcd_barrier(bar, wave); phase13(p, wave); }
}

static inline size_t align_up(size_t v, size_t a) { return (v + a - 1) / a * a; }

extern "C" void kernel_launch(void* const* d_in, const int* in_sizes, int n_in, void* d_out, int out_size, void* d_ws, size_t ws_size, hipStream_t stream) {
    (void)in_sizes; (void)n_in; (void)out_size;
    Params p{};
    const float** ins = (const float**)&p;
    for (int i = 0; i < 30; ++i) ins[i] = (const float*)d_in[i];
    p.out = (float*)d_out;
    char* ws = (char*)d_ws; size_t off = 0;
    auto take = [&](size_t bytes) { char* r = ws + off; off = align_up(off + bytes, 4096); return r; };
    const size_t ctl_bytes = (size_t)(XCD_BAR_WORDS + CTL_WORDS) * 4;
    p.bar = (unsigned*)take(ctl_bytes); p.ctl = p.bar + XCD_BAR_WORDS;
    p.modp = (float*)take((size_t)KS_MOD * 4 * NMOD * 4); p.mod = (float*)take((size_t)NB * NMOD * 4);
    p.hb = (bf16_t*)take((size_t)NM * ND * 2);
    p.wt_in = (bf16_t*)take((size_t)NINP * ND * 2); p.wt_rwkv = (bf16_t*)take((size_t)ND * NC * 2); p.wt_pool = (bf16_t*)take((size_t)ND * 256 * 2);
    p.wt_out = (bf16_t*)take((size_t)ND * ND * 2); p.bt_lora = (bf16_t*)take((size_t)LORA_N * LORA_K * 2);
    p.wt_gu = (fp8_t*)take((size_t)NE * 2 * DFF * ND); p.wt_down = (fp8_t*)take((size_t)NE * ND * DFF);
    p.P = (bf16_t*)take((size_t)NM * NINP * 2); p.a_lora = (bf16_t*)take((size_t)NM * LORA_K * 2); p.dp = (bf16_t*)take((size_t)NM * NC * 2);
    p.dec = (float*)take((size_t)NM * NC * 4); p.iclr = (bf16_t*)take((size_t)NM * NC * 2); p.gg = (bf16_t*)take((size_t)NM * NC * 2); p.t1 = (bf16_t*)take((size_t)NM * ND * 2);
    p.yr = (bf16_t*)take((size_t)NM * NC * 2); p.mx = (bf16_t*)take((size_t)NM * ND * 2); p.z1 = (float*)take((size_t)NM * ND * 4); p.lnst = (float*)take((size_t)NM * 2 * 4);
    p.h2 = (fp8_t*)take((size_t)NM * ND);
    p.sel = (int*)take((size_t)NM * TOPK * 4); p.rnk = (int*)take((size_t)NM * TOPK * 4); p.prob = (float*)take((size_t)NM * TOPK * 4); p.dest = (int*)take((size_t)NM * TOPK * 4);
    p.xb = (fp8_t*)take((size_t)MP * ND); p.act = (fp8_t*)take((size_t)MP * DFF); p.yb = (bf16_t*)take((size_t)MP * ND * 2);
    if (off > ws_size) { fprintf(stderr, "kernel_launch: workspace too small (%zu > %zu)\n", off, ws_size); return; }

    static int grid = 0;
    if (!grid) {
        int dev = 0, cus = 0, per_cu = 0;
        hipGetDevice(&dev); hipDeviceGetAttribute(&cus, hipDeviceAttributeMultiprocessorCount, dev);
        hipFuncSetAttribute((const void*)fwd, hipFuncAttributeMaxDynamicSharedMemorySize, LDS_BYTES);
        hipOccupancyMaxActiveBlocksPerMultiprocessor(&per_cu, (const void*)fwd, NTHREADS, LDS_BYTES);
        if (per_cu < 1) fprintf(stderr, "kernel_launch: occupancy query reports %d workgroups per CU\n", per_cu);
        if (cus != 256) fprintf(stderr, "kernel_launch: %d CUs; this kernel is laid out for 256\n", cus);
        grid = 256;
    }
    hipMemsetAsync(p.bar, 0, ctl_bytes, stream);
    hipLaunchKernelGGL(fwd, dim3(grid), dim3(NTHREADS), LDS_BYTES, stream, p);
}
```

```cpp
#include <hip/hip_runtime.h>
#include <cstdio>
#include <cstdint>

#ifndef PROBE
#define PROBE 0
#endif
#define LAS __attribute__((address_space(3)))
typedef unsigned short bf16_t;
typedef short bf16x8 __attribute__((ext_vector_type(8)));
typedef float f32x4 __attribute__((ext_vector_type(4)));
typedef float f32x2 __attribute__((ext_vector_type(2)));
typedef unsigned u32x4 __attribute__((ext_vector_type(4)));
typedef unsigned u32x2 __attribute__((ext_vector_type(2)));
typedef int i32x4 __attribute__((ext_vector_type(4)));
typedef int i32x8 __attribute__((ext_vector_type(8)));
typedef unsigned char fp8_t;
constexpr float W8_SCALE = 64.0f, W8_INV = 1.0f / 64.0f;

constexpr int NB = 4, NT = 2048, NM = NB * NT, ND = 2048, NC = 1024, NH = 16, HS = 64;
constexpr int NSHIFT = 3360, NIN = 8480, NINP = 8704;
constexpr int OFF_R = 0, OFF_K = 1024, OFF_V = 2048, OFF_WD = 3072, OFF_AD = 3136, OFF_GD = 3200, OFF_POOL = 3360, OFF_GA = 4384, OFF_GB = 6432;
constexpr int NE = 32, TOPK = 4, DFF = 2048;
constexpr int LORA_K = 384, LORA_N = 3072;
constexpr int MAXTILES = 160, MP = MAXTILES * 256;
constexpr int NMOD = 6 * ND;
constexpr int KS_MOD = 32;
constexpr float LN_EPS = 1e-5f, GN_EPS = 64e-5f;
constexpr float DN_ALPHA = 1.189207115002721f;
constexpr float SW_LIMIT = 7.0f, SW_ALPHA = 1.702f;
constexpr int NWAVES = 8, NTHREADS = 512;
constexpr int LDS_BYTES = 147456;
constexpr int LDS_BARW = LDS_BYTES - 16;
constexpr int LDS_MISC = 131072;

constexpr int CW_CNT = 0;
constexpr int CW_CONV = 64 * 32;
constexpr int CW_CONV2 = 64 * 32 + 32;
constexpr int CW_NTILES = 64 * 33;
constexpr int CW_TILEE = 64 * 34;
constexpr int CTL_WORDS = 64 * 34 + 256;

#define XB_TMO      128
#define XB_XCNT(j)  (256  + 64 * (j))
#define XB_XSUB(j)  (1280 + 64 * (j))
#define XB_XGEN(j)  (2304 + 64 * (j))
#define XB_TOP      3328
#define XB_TOPGEN   3392
#define XCD_BAR_WORDS 3456
#define XB_SPIN_CAP (1u << 18)

__device__ __forceinline__ unsigned xb_ld(unsigned* p)              { return __hip_atomic_load(p, __ATOMIC_RELAXED, __HIP_MEMORY_SCOPE_AGENT); }
__device__ __forceinline__ unsigned xb_add(unsigned* p, unsigned v) { return __hip_atomic_fetch_add(p, v, __ATOMIC_RELAXED, __HIP_MEMORY_SCOPE_AGENT); }
__device__ __forceinline__ unsigned xb_xcc_id() { return (unsigned)__builtin_amdgcn_s_getreg((3 << 11) | 20) & 0xFu; }
#define XB_SPIN(cond, bar) do { unsigned _sp = 0; while (cond) { __builtin_amdgcn_s_sleep(1); \
    if ((++_sp & 255u) == 0u) { if (xb_ld(&(bar)[XB_TMO])) break; if (_sp > XB_SPIN_CAP) { atomicAdd(&(bar)[XB_TMO], 1u); break; } } } } while (0)

__device__ __forceinline__ int phase_tid(int wave);
struct XcdBarrier { unsigned* bar; unsigned x; volatile LAS unsigned* st; };

__device__ __forceinline__ XcdBarrier xcd_barrier_post(unsigned* bar, volatile LAS unsigned* st) {
    XcdBarrier b; b.bar = bar; b.x = xb_xcc_id(); b.st = st;
    if (threadIdx.x == 0) (void)xb_add(&bar[XB_XCNT(b.x)], 1u);
    return b;
}
__device__ __forceinline__ void xcd_barrier_complete(unsigned* bar, unsigned x, unsigned& nloc, unsigned& nx) {
    const unsigned G = gridDim.x * gridDim.y * gridDim.z;
    unsigned sum, cnt, mine, sp = 0u;
    for (;;) {
        sum = 0u; cnt = 0u; mine = 0u;
#pragma unroll
        for (unsigned j = 0; j < 16; ++j) { const unsigned c = xb_ld(&bar[XB_XCNT(j)]); sum += c; cnt += (c > 0u) ? 1u : 0u; mine = (j == x) ? c : mine; }
        if (sum == G) break;
        __builtin_amdgcn_s_sleep(1);
        if ((++sp & 255u) == 0u) { if (xb_ld(&bar[XB_TMO])) break; if (sp > XB_SPIN_CAP) { atomicAdd(&bar[XB_TMO], 1u); break; } }
    }
    nloc = mine > 0u ? mine : 1u; nx = cnt > 0u ? cnt : 1u;
}
__device__ __forceinline__ void xcd_barrier(const XcdBarrier& b, const int wave) {
    asm volatile("s_waitcnt vmcnt(0)" ::: "memory");
    __syncthreads();
    if (phase_tid(wave) == 0) {
        unsigned* bar = b.bar;
        __builtin_amdgcn_s_waitcnt(0);
        unsigned nloc = b.st[0], nx = b.st[1];
        if (nloc == 0u) { xcd_barrier_complete(bar, b.x, nloc, nx); b.st[0] = nloc; b.st[1] = nx; }
        const unsigned old = xb_add(&bar[XB_XSUB(b.x)], 1u);
        const unsigned gen = old / nloc;
        if (old + 1u == (gen + 1u) * nloc) {
            __builtin_amdgcn_fence(__ATOMIC_RELEASE, "agent");
            asm volatile("s_waitcnt vmcnt(0)" ::: "memory");
            const unsigned og = xb_add(&bar[XB_TOP], 1u);
            const unsigned tg = og / nx;
            if (og + 1u == (tg + 1u) * nx) xb_add(&bar[XB_TOPGEN], 1u);
            else XB_SPIN(xb_ld(&bar[XB_TOPGEN]) == tg, bar);
            __builtin_amdgcn_fence(__ATOMIC_ACQUIRE, "agent");
            xb_add(&bar[XB_XGEN(b.x)], 1u);
            asm volatile("s_waitcnt vmcnt(0)" ::: "memory");
        } else {
            XB_SPIN(xb_ld(&bar[XB_XGEN(b.x)]) == gen, bar);
            __builtin_amdgcn_fence(__ATOMIC_ACQUIRE, "agent");
            asm volatile("s_waitcnt vmcnt(0)" ::: "memory");
        }
    }
    __syncthreads();
}

__device__ __forceinline__ int phase_tid(int wave) {
    int lane; asm volatile("v_mbcnt_lo_u32_b32 %0, -1, 0\n\tv_mbcnt_hi_u32_b32 %0, -1, %0" : "=v"(lane));
    return wave * 64 + lane;
}
typedef __bf16 bf16x2_t __attribute__((ext_vector_type(2)));
__device__ __forceinline__ unsigned cvt_pk_bf16(float lo, float hi) { return __builtin_bit_cast(unsigned, __builtin_convertvector((f32x2){lo, hi}, bf16x2_t)); }
template <int CTRL> __device__ __forceinline__ float dpp_f(float x) {
    return __builtin_bit_cast(float, __builtin_amdgcn_update_dpp(0, __builtin_bit_cast(int, x), CTRL, 0xf, 0xf, false));
}
__device__ __forceinline__ float row16_allsum(float x) {
    x += dpp_f<0x128>(x); x += dpp_f<0x124>(x); x += dpp_f<0x122>(x); x += dpp_f<0x121>(x); return x;
}
__device__ __forceinline__ float wave_allsum(float x) {
    x = row16_allsum(x);
    const int xi = __builtin_bit_cast(int, x);
    return (__builtin_bit_cast(float, __builtin_amdgcn_readlane(xi, 0)) + __builtin_bit_cast(float, __builtin_amdgcn_readlane(xi, 16))) +
           (__builtin_bit_cast(float, __builtin_amdgcn_readlane(xi, 32)) + __builtin_bit_cast(float, __builtin_amdgcn_readlane(xi, 48)));
}
__device__ __forceinline__ unsigned pack4_fp8(float a, float b, float c, float d) { int r = 0; r = __builtin_amdgcn_cvt_pk_fp8_f32(a, b, r, false); r = __builtin_amdgcn_cvt_pk_fp8_f32(c, d, r, true); return (unsigned)r; }
__device__ __forceinline__ f32x2 bf2_unpack(unsigned u) { return (f32x2){__uint_as_float(u << 16), __uint_as_float(u & 0xffff0000u)}; }
__device__ __forceinline__ f32x4 bf4_unpack(u32x2 u) { const f32x2 a = bf2_unpack(u.x), b = bf2_unpack(u.y); return (f32x4){a[0], a[1], b[0], b[1]}; }
__device__ __forceinline__ float bf1(bf16_t h) { return __uint_as_float(((unsigned)h) << 16); }
__device__ __forceinline__ float sigmoidf_(float v) { return __builtin_amdgcn_rcpf(1.0f + __builtin_amdgcn_exp2f(v * -1.4426950408889634f)); }
__device__ __forceinline__ f32x4 ld4(const float* p) { return *(const f32x4*)p; }
__device__ __forceinline__ float dot4(f32x4 a, f32x4 b) { return (a[0] * b[0] + a[1] * b[1]) + (a[2] * b[2] + a[3] * b[3]); }

struct Params {
    const float *x, *c, *w_ada, *b_ada, *w_in, *mu_shift, *w0, *w_decay_up, *a0, *w_iclr_up, *w_glora_up, *k_k, *k_a, *r_k, *lnx_g, *lnx_b,
                *w_rwkv_out, *w_pool, *pool_scale, *w_out, *ln1_g, *ln1_b, *w_router, *b_router, *w_gu, *b_gu, *w_down, *b_down, *ln2_g, *ln2_b;
    float* out;
    unsigned* bar; unsigned* ctl;
    float* modp; float* mod;
    bf16_t* hb; bf16_t* wt_in; bf16_t* wt_rwkv; bf16_t* wt_pool; bf16_t* wt_out; bf16_t* bt_lora; fp8_t* wt_gu; fp8_t* wt_down;
    bf16_t* P; bf16_t* a_lora; bf16_t* dp; float* dec; bf16_t* iclr; bf16_t* gg; bf16_t* t1;
    bf16_t* yr; bf16_t* mx; float* z1; float* lnst; fp8_t* h2;
    int* sel; int* rnk; float* prob; int* dest;
    fp8_t* xb; fp8_t* act; bf16_t* yb;
};

namespace pg8 {
constexpr int BM = 256, BK = 64, HALF = 128, HTB = HALF * BK * 2, STAGE_BYTES = 8 * HTB, NXCD = 8, WGM = 8;
__host__ __device__ __forceinline__ int lds_byte(int r, int c) { const int st = (r >> 4) * 2 + (c >> 5), rr = r & 15, cc = c & 31, ob = rr * 64 + cc * 2; return st * 1024 + (ob ^ (((ob >> 9) & 1) << 5)); }
__host__ __device__ __forceinline__ void stage_rc(int b, int& R, int& C) { const int st = b / 1024, sb = b % 1024, swz = sb ^ (((sb >> 9) & 1) << 5); R = (st >> 1) * 16 + swz / 64; C = (st & 1) * 32 + (swz % 64) / 2; }
__host__ __device__ __forceinline__ int perm32(int rho) { const int n = rho >> 4, i = rho & 15; return 8 * (i >> 2) + 4 * n + (i & 3); }

struct Unit { int pm, pn, e; unsigned aoff, boff; };
struct Gemm { const bf16_t* A; const bf16_t* Bt; int lda, ldb, K; };

struct DenseOrder {
    int nM, nN, nwg, G, c, skip_from = 1 << 30, skip_n = 0; size_t a_tile, b_tile;
    __device__ void init(int nM_, int nN_, int G_, int c_, size_t a_tile_, size_t b_tile_) { nM = nM_; nN = nN_; nwg = nM * nN; G = G_; c = c_; a_tile = a_tile_; b_tile = b_tile_; }
    __device__ bool next(int i, Unit& u) const {
        const long L = (long)i * G + c; if (c < 0 || L >= nwg) return false;
        int wgid = (int)L; { const int q = nwg / NXCD, r = nwg % NXCD, xcd = wgid % NXCD, off = wgid / NXCD; wgid = (xcd < r ? xcd * (q + 1) : r * (q + 1) + (xcd - r) * q) + off; }
        const int nig = WGM * nN, gid = wgid / nig, fm = gid * WGM, gsz = (nM - fm) < WGM ? (nM - fm) : WGM;
        u.pm = fm + ((wgid % nig) % gsz); u.pn = (wgid % nig) / gsz; u.e = 0; if (u.pn >= skip_from) u.pn += skip_n;
        u.aoff = (unsigned)((size_t)u.pm * a_tile); u.boff = (unsigned)((size_t)u.pn * b_tile); return true;
    }
};

template <class Epi, class Sched, bool FP8 = false>
__device__ __forceinline__ void gemm_phase(LAS unsigned char* lds, const Gemm g, const Sched& S, const Epi& E, const int wave) {
    const int tid = phase_tid(wave);
    const int wid = __builtin_amdgcn_readfirstlane(tid >> 6), lane = tid & 63, wr = wid >> 2, wc = wid & 3, fr = lane & 15, fq = lane >> 4;
    const int K = g.K, nt = K / BK;
    unsigned voffA[2], voffB[2];
#pragma unroll
    for (int i = 0; i < 2; ++i) { int R, C; stage_rc(tid * 16 + i * 8192, R, C); const int Rb = Epi::PERM ? ((R & ~31) + perm32(R & 31)) : R;
        voffA[i] = (unsigned)(R * g.lda + C) * 2u; voffB[i] = (unsigned)(Rb * g.ldb + C) * 2u; }
    const unsigned kstep = (unsigned)(BK * 2);
    const unsigned hstepA = (unsigned)HALF * g.lda * 2u, hstepB = (unsigned)HALF * g.ldb * 2u;
    const __amdgpu_buffer_rsrc_t rsA = __builtin_amdgcn_make_buffer_rsrc((void*)g.A, (short)0, -1, 0x00020000), rsB = __builtin_amdgcn_make_buffer_rsrc((void*)g.Bt, (short)0, -1, 0x00020000);
    const unsigned ldsw = (unsigned)wid * 1024u;
    const int aoff = lds_byte(wr * 64 + fr, fq * 8), boff = lds_byte(wc * 32 + fr, fq * 8);
#define PG8_SA(b, h) (((b) * 2 + (h)) * HTB)
#define PG8_SB(b, h) ((4 + (b) * 2 + (h)) * HTB)
#define PG8_STAGE(bufoff, rs, soff, voff) do { _Pragma("unroll") for (int _i = 0; _i < 2; ++_i) \
        __builtin_amdgcn_raw_ptr_buffer_load_lds(rs, (LAS void*)(lds + (bufoff) + ldsw + _i * 8192), 16, (voff)[_i], (soff), 0, 0); } while (0)
#define PG8_LDA(dst, b, h) do { _Pragma("unroll") for (int m = 0; m < 4; ++m) _Pragma("unroll") for (int k = 0; k < 2; ++k) dst[m][k] = *(const LAS bf16x8*)(lds + PG8_SA(b, h) + aoff + m * 2048 + k * 1024); } while (0)
#define PG8_LDB(dst, b, h) do { _Pragma("unroll") for (int n = 0; n < 2; ++n) _Pragma("unroll") for (int k = 0; k < 2; ++k) dst[n][k] = *(const LAS bf16x8*)(lds + PG8_SB(b, h) + boff + n * 2048 + k * 1024); } while (0)
#define PG8_CAT(x) __builtin_shufflevector(__builtin_bit_cast(i32x4, (x)[0]), __builtin_bit_cast(i32x4, (x)[1]), 0, 1, 2, 3, 4, 5, 6, 7)
#define PG8_MMA(ai, bj, At, Bt) do { __builtin_amdgcn_s_setprio(1); \
        if constexpr (FP8) { _Pragma("unroll") for (int m = 0; m < 4; ++m) _Pragma("unroll") for (int n = 0; n < 2; ++n) \
            acc[ai][bj][m][n] = __builtin_amdgcn_mfma_scale_f32_16x16x128_f8f6f4(PG8_CAT(Bt[n]), PG8_CAT(At[m]), acc[ai][bj][m][n], 0, 0, 0, 0x7F7F7F7F, 0, 0x7F7F7F7F); } \
        else { _Pragma("unroll") for (int m = 0; m < 4; ++m) _Pragma("unroll") for (int n = 0; n < 2; ++n) _Pragma("unroll") for (int k = 0; k < 2; ++k) \
            acc[ai][bj][m][n] = __builtin_amdgcn_mfma_f32_16x16x32_bf16(Bt[n][k], At[m][k], acc[ai][bj][m][n], 0, 0, 0); } \
        __builtin_amdgcn_s_setprio(0); } while (0)
#define PG8_WAIT_V(n) asm volatile("s_waitcnt vmcnt(" #n ")" ::: "memory")
#define PG8_WAIT_L(n) asm volatile("s_waitcnt lgkmcnt(" #n ")" ::: "memory")
#define PG8_BAR __builtin_amdgcn_s_barrier()
#define PG8_SCHED __builtin_amdgcn_sched_barrier(0)
    Unit cur, nxt; int ui = 0;
    if (!S.next(0, cur)) return;
    f32x4 acc[2][2][4][2];
#pragma unroll
    for (int a = 0; a < 2; ++a)
#pragma unroll
        for (int b = 0; b < 2; ++b)
#pragma unroll
            for (int m = 0; m < 4; ++m)
#pragma unroll
                for (int n = 0; n < 2; ++n) acc[a][b][m][n] = (f32x4){0.f, 0.f, 0.f, 0.f};
    bf16x8 At[4][2], B0[2][2], B1[2][2];
    unsigned cA = cur.aoff, cB = cur.boff;
    PG8_STAGE(PG8_SB(0, 0), rsB, cB, voffB); PG8_STAGE(PG8_SA(0, 0), rsA, cA, voffA); PG8_STAGE(PG8_SB(0, 1), rsB, cB + hstepB, voffB); PG8_STAGE(PG8_SA(0, 1), rsA, cA + hstepA, voffA);
    if (wr == 1) PG8_BAR;
    PG8_WAIT_V(4); PG8_BAR;
    PG8_STAGE(PG8_SB(1, 0), rsB, cB + kstep, voffB); PG8_STAGE(PG8_SA(1, 0), rsA, cA + kstep, voffA); PG8_STAGE(PG8_SB(1, 1), rsB, cB + hstepB + kstep, voffB);
    PG8_WAIT_V(6); PG8_BAR;
    for (;;) {
        const bool has_next = S.next(ui + 1, nxt);
        const unsigned nA = has_next ? nxt.aoff : cA, nB = has_next ? nxt.boff : cB;
        for (int t = 0; t < nt; t += 2) {
            const bool last = (t == nt - 2);
            const unsigned a1 = cA + (unsigned)(t + 1) * kstep;
            const unsigned a2 = last ? nA : cA + (unsigned)(t + 2) * kstep, b2 = last ? nB : cB + (unsigned)(t + 2) * kstep;
            const unsigned a3 = a2 + kstep, b3 = b2 + kstep;
            PG8_LDB(B0, 0, 0); PG8_SCHED; PG8_LDA(At, 0, 0); PG8_STAGE(PG8_SA(1, 1), rsA, a1 + hstepA, voffA);
            PG8_WAIT_L(8); PG8_BAR; PG8_WAIT_L(0); PG8_MMA(0, 0, At, B0); PG8_BAR; PG8_SCHED;
            PG8_LDB(B1, 0, 1); PG8_STAGE(PG8_SB(0, 0), rsB, b2, voffB);
            PG8_BAR; PG8_WAIT_L(0); PG8_MMA(0, 1, At, B1); PG8_BAR;
            PG8_LDA(At, 0, 1); PG8_STAGE(PG8_SA(0, 0), rsA, a2, voffA);
            PG8_BAR; PG8_WAIT_L(0); PG8_MMA(1, 0, At, B0); PG8_BAR; PG8_SCHED;
            PG8_STAGE(PG8_SB(0, 1), rsB, b2 + hstepB, voffB);
            PG8_WAIT_V(6); PG8_BAR; PG8_MMA(1, 1, At, B1); PG8_BAR;
            PG8_LDB(B0, 1, 0); PG8_SCHED; PG8_LDA(At, 1, 0); PG8_STAGE(PG8_SA(0, 1), rsA, a2 + hstepA, voffA);
            PG8_WAIT_L(8); PG8_BAR; PG8_WAIT_L(0); PG8_MMA(0, 0, At, B0); PG8_BAR; PG8_SCHED;
            PG8_LDB(B1, 1, 1); PG8_STAGE(PG8_SB(1, 0), rsB, b3, voffB);
            PG8_BAR; PG8_WAIT_L(0); PG8_MMA(0, 1, At, B1); PG8_BAR;
            PG8_LDA(At, 1, 1); PG8_STAGE(PG8_SA(1, 0), rsA, a3, voffA);
            PG8_BAR; PG8_WAIT_L(0); PG8_MMA(1, 0, At, B0); PG8_BAR; PG8_SCHED;
            PG8_STAGE(PG8_SB(1, 1), rsB, b3 + hstepB, voffB);
            PG8_WAIT_V(6); PG8_BAR; PG8_MMA(1, 1, At, B1); PG8_BAR;
        }
        { const int l2 = phase_tid(wave) & 63; E(acc, cur, wr, wc, l2 & 15, l2 >> 4); }
        if (!has_next) break;
#pragma unroll
        for (int a = 0; a < 2; ++a)
#pragma unroll
            for (int b = 0; b < 2; ++b)
#pragma unroll
                for (int m = 0; m < 4; ++m)
#pragma unroll
                    for (int n = 0; n < 2; ++n) acc[a][b][m][n] = (f32x4){0.f, 0.f, 0.f, 0.f};
        cur = nxt; cA = nA; cB = nB; ++ui;
    }
    PG8_WAIT_V(0);
    if (wr == 0) PG8_BAR;
    PG8_BAR;
#undef PG8_SA
#undef PG8_SB
#undef PG8_STAGE
#undef PG8_LDA
#undef PG8_LDB
#undef PG8_MMA
#undef PG8_CAT
#undef PG8_WAIT_V
#undef PG8_WAIT_L
#undef PG8_BAR
#undef PG8_SCHED
}
}
using pg8::Unit;

#define EPI_LOOP_BEGIN \
    _Pragma("unroll") for (int ai = 0; ai < 2; ++ai) _Pragma("unroll") for (int m = 0; m < 4; ++m) { const int r = u.pm * 256 + ai * 128 + wr * 64 + m * 16 + fr; \
    _Pragma("unroll") for (int bj = 0; bj < 2; ++bj) _Pragma("unroll") for (int n = 0; n < 2; ++n) { const int cl = bj * 128 + wc * 32 + 16 * n + 4 * fq; const f32x4 a = acc[ai][bj][m][n];
#define EPI_LOOP_END } }

struct EpiP {
    static constexpr bool PERM = true; bf16_t* C;
    __device__ __forceinline__ void operator()(const f32x4 (&acc)[2][2][4][2], const Unit& u, int wr, int wc, int fr, int fq) const {
#pragma unroll
        for (int ai = 0; ai < 2; ++ai)
#pragma unroll
            for (int m = 0; m < 4; ++m) { const int r = u.pm * 256 + ai * 128 + wr * 64 + m * 16 + fr;
#pragma unroll
                for (int bj = 0; bj < 2; ++bj) { const int c0 = u.pn * 256 + bj * 128 + wc * 32 + 8 * fq; const f32x4 v0 = acc[ai][bj][m][0], v1 = acc[ai][bj][m][1];
                    u32x4 w; w.x = cvt_pk_bf16(v0[0], v0[1]); w.y = cvt_pk_bf16(v0[2], v0[3]); w.z = cvt_pk_bf16(v1[0], v1[1]); w.w = cvt_pk_bf16(v1[2], v1[3]);
                    *(u32x4*)(C + (size_t)r * NINP + c0) = w; } }
    }
};
#define EPI_COLS(ptr) f32x4 cv[2][2]; _Pragma("unroll") for (int bj = 0; bj < 2; ++bj) _Pragma("unroll") for (int n = 0; n < 2; ++n) cv[bj][n] = ld4((ptr) + bj * 128 + wc * 32 + 16 * n + 4 * fq);
#define EPI_COLS_PERM(ptr) f32x4 cv[2][2]; _Pragma("unroll") for (int bj = 0; bj < 2; ++bj) _Pragma("unroll") for (int n = 0; n < 2; ++n) cv[bj][n] = ld4((ptr) + bj * 128 + wc * 32 + 8 * fq + 4 * n);
struct EpiLora {
    static constexpr bool PERM = false; float* dec; bf16_t *iclr, *gg; const float *w0, *a0;
    __device__ __forceinline__ void operator()(const f32x4 (&acc)[2][2][4][2], const Unit& u, int wr, int wc, int fr, int fq) const {
        const int sect = u.pn >> 2, cb = (u.pn & 3) * 256;
        EPI_COLS((sect == 0 ? w0 : a0) + cb)
        EPI_LOOP_BEGIN
            const int c = cb + cl; f32x4 o;
            if (sect == 0) {
#pragma unroll
                for (int j = 0; j < 4; ++j) o[j] = __builtin_amdgcn_exp2f(-0.6065306597126334f * 1.4426950408889634f * sigmoidf_(cv[bj][n][j] + a[j]));
                *(f32x4*)(dec + (size_t)r * NC + c) = o; }
            else if (sect == 1) {
#pragma unroll
                for (int j = 0; j < 4; ++j) o[j] = sigmoidf_(cv[bj][n][j] + a[j]);
                u32x2 wv; wv.x = cvt_pk_bf16(o[0], o[1]); wv.y = cvt_pk_bf16(o[2], o[3]); *(u32x2*)(iclr + (size_t)r * NC + c) = wv; }
            else { u32x2 wv; wv.x = cvt_pk_bf16(a[0], a[1]); wv.y = cvt_pk_bf16(a[2], a[3]); *(u32x2*)(gg + (size_t)r * NC + c) = wv; }
        EPI_LOOP_END
    }
};
struct EpiPool {
    static constexpr bool PERM = true; bf16_t* t1; const bf16_t* P; const float* pscale;
    __device__ __forceinline__ void operator()(const f32x4 (&acc)[2][2][4][2], const Unit& u, int wr, int wc, int fr, int fq) const {
        EPI_COLS_PERM(pscale + u.pn * 256)
#pragma unroll
        for (int ai = 0; ai < 2; ++ai) { u32x4 gq[4][2];
#pragma unroll
            for (int m = 0; m < 4; ++m)
#pragma unroll
                for (int bj = 0; bj < 2; ++bj) gq[m][bj] = *(const u32x4*)(P + (size_t)(u.pm * 256 + ai * 128 + wr * 64 + m * 16 + fr) * NINP + OFF_GB + u.pn * 256 + bj * 128 + wc * 32 + 8 * fq);
#pragma unroll
            for (int m = 0; m < 4; ++m) { const int r = u.pm * 256 + ai * 128 + wr * 64 + m * 16 + fr;
#pragma unroll
                for (int bj = 0; bj < 2; ++bj) { const int c0 = u.pn * 256 + bj * 128 + wc * 32 + 8 * fq;
                    const f32x4 g0 = bf4_unpack((u32x2){gq[m][bj].x, gq[m][bj].y}), g1 = bf4_unpack((u32x2){gq[m][bj].z, gq[m][bj].w}), a0 = acc[ai][bj][m][0], a1 = acc[ai][bj][m][1]; f32x4 o0, o1;
#pragma unroll
                    for (int j = 0; j < 4; ++j) { o0[j] = sigmoidf_(g0[j]) * cv[bj][0][j] * a0[j]; o1[j] = sigmoidf_(g1[j]) * cv[bj][1][j] * a1[j]; }
                    u32x4 w; w.x = cvt_pk_bf16(o0[0], o0[1]); w.y = cvt_pk_bf16(o0[2], o0[3]); w.z = cvt_pk_bf16(o1[0], o1[1]); w.w = cvt_pk_bf16(o1[2], o1[3]);
                    *(u32x4*)(t1 + (size_t)r * ND + c0) = w; } } }
    }
};
struct EpiRwkv {
    static constexpr bool PERM = true; bf16_t* mx; const bf16_t* P; const bf16_t* t1;
    __device__ __forceinline__ void operator()(const f32x4 (&acc)[2][2][4][2], const Unit& u, int wr, int wc, int fr, int fq) const {
#pragma unroll
        for (int ai = 0; ai < 2; ++ai) { u32x4 gq[4][2], tq[4][2];
#pragma unroll
            for (int m = 0; m < 4; ++m)
#pragma unroll
                for (int bj = 0; bj < 2; ++bj) { const int r = u.pm * 256 + ai * 128 + wr * 64 + m * 16 + fr, c0 = u.pn * 256 + bj * 128 + wc * 32 + 8 * fq;
                    gq[m][bj] = *(const u32x4*)(P + (size_t)r * NINP + OFF_GA + c0); tq[m][bj] = *(const u32x4*)(t1 + (size_t)r * ND + c0); }
#pragma unroll
            for (int m = 0; m < 4; ++m) { const int r = u.pm * 256 + ai * 128 + wr * 64 + m * 16 + fr;
#pragma unroll
                for (int bj = 0; bj < 2; ++bj) { const int c0 = u.pn * 256 + bj * 128 + wc * 32 + 8 * fq;
                    const f32x4 g0 = bf4_unpack((u32x2){gq[m][bj].x, gq[m][bj].y}), g1 = bf4_unpack((u32x2){gq[m][bj].z, gq[m][bj].w});
                    const f32x4 t0 = bf4_unpack((u32x2){tq[m][bj].x, tq[m][bj].y}), t1v = bf4_unpack((u32x2){tq[m][bj].z, tq[m][bj].w}), a0 = acc[ai][bj][m][0], a1 = acc[ai][bj][m][1]; f32x4 o0, o1;
#pragma unroll
                    for (int j = 0; j < 4; ++j) { o0[j] = sigmoidf_(g0[j]) * a0[j] + t0[j]; o1[j] = sigmoidf_(g1[j]) * a1[j] + t1v[j]; }
                    u32x4 w; w.x = cvt_pk_bf16(o0[0], o0[1]); w.y = cvt_pk_bf16(o0[2], o0[3]); w.z = cvt_pk_bf16(o1[0], o1[1]); w.w = cvt_pk_bf16(o1[2], o1[3]);
                    *(u32x4*)(mx + (size_t)r * ND + c0) = w; } } }
    }
};
struct EpiWout {
    static constexpr bool PERM = true; float* z1; const float* x; const float* mod;
    __device__ __forceinline__ void operator()(const f32x4 (&acc)[2][2][4][2], const Unit& u, int wr, int wc, int fr, int fq) const {
        const int b = u.pm >> 3;
        EPI_COLS_PERM(mod + (size_t)b * NMOD + 2 * ND + u.pn * 256)
#pragma unroll
        for (int ai = 0; ai < 2; ++ai)
#pragma unroll
            for (int mh = 0; mh < 2; ++mh) { f32x4 xq[2][2][2];
#pragma unroll
                for (int m2 = 0; m2 < 2; ++m2)
#pragma unroll
                    for (int bj = 0; bj < 2; ++bj)
#pragma unroll
                        for (int n = 0; n < 2; ++n) xq[m2][bj][n] = ld4(x + (size_t)(u.pm * 256 + ai * 128 + wr * 64 + (mh * 2 + m2) * 16 + fr) * ND + u.pn * 256 + bj * 128 + wc * 32 + 8 * fq + 4 * n);
#pragma unroll
                for (int m2 = 0; m2 < 2; ++m2) { const int m = mh * 2 + m2, r = u.pm * 256 + ai * 128 + wr * 64 + m * 16 + fr;
#pragma unroll
                    for (int bj = 0; bj < 2; ++bj)
#pragma unroll
                        for (int n = 0; n < 2; ++n) { const int c = u.pn * 256 + bj * 128 + wc * 32 + 8 * fq + 4 * n;
                            *(f32x4*)(z1 + (size_t)r * ND + c) = xq[m2][bj][n] * DN_ALPHA + cv[bj][n] * acc[ai][bj][m][n]; } } }
    }
};
struct EpiGU {
    static constexpr bool PERM = true; fp8_t* act; const float* b_gu;
    __device__ __forceinline__ void operator()(const f32x4 (&acc)[2][2][4][2], const Unit& u, int wr, int wc, int fr, int fq) const {
        const float* bias = b_gu + (size_t)u.e * (2 * DFF) + u.pn * 256 + wc * 32 + 8 * fq;
#pragma unroll
        for (int bj = 0; bj < 2; ++bj) { const f32x4 c0v = ld4(bias + bj * 128), c1v = ld4(bias + bj * 128 + 4); const int c0 = u.pn * 256 + bj * 128 + wc * 32 + 8 * fq;
#pragma unroll
            for (int ai = 0; ai < 2; ++ai)
#pragma unroll
                for (int m = 0; m < 4; ++m) { const int r = u.pm * 256 + ai * 128 + wr * 64 + m * 16 + fr;
                    const f32x4 v0 = acc[ai][bj][m][0] * W8_INV + c0v, v1 = acc[ai][bj][m][1] * W8_INV + c1v;
                    float o[4];
#pragma unroll
                    for (int j = 0; j < 4; ++j) { const float gt = fminf(j < 2 ? v0[2 * j] : v1[2 * j - 4], SW_LIMIT); const float up = fminf(fmaxf(j < 2 ? v0[2 * j + 1] : v1[2 * j - 3], -SW_LIMIT), SW_LIMIT);
                        o[j] = (up + 1.0f) * (gt * __builtin_amdgcn_rcpf(1.0f + __builtin_amdgcn_exp2f(gt * (-SW_ALPHA * 1.4426950408889634f)))); }
                    *(unsigned*)(act + (size_t)r * DFF + (c0 >> 1)) = pack4_fp8(o[0], o[1], o[2], o[3]); } }
    }
};
struct EpiDown {
    static constexpr bool PERM = true; bf16_t* yb; const float* b_down;
    __device__ __forceinline__ void operator()(const f32x4 (&acc)[2][2][4][2], const Unit& u, int wr, int wc, int fr, int fq) const {
        const float* bias = b_down + (size_t)u.e * ND + u.pn * 256 + wc * 32 + 8 * fq;
#pragma unroll
        for (int bj = 0; bj < 2; ++bj) { const f32x4 c0v = ld4(bias + bj * 128), c1v = ld4(bias + bj * 128 + 4); const int c0 = u.pn * 256 + bj * 128 + wc * 32 + 8 * fq;
#pragma unroll
            for (int ai = 0; ai < 2; ++ai)
#pragma unroll
                for (int m = 0; m < 4; ++m) { const int r = u.pm * 256 + ai * 128 + wr * 64 + m * 16 + fr;
                    const f32x4 v0 = acc[ai][bj][m][0] * W8_INV + c0v, v1 = acc[ai][bj][m][1] * W8_INV + c1v;
                    u32x4 w; w.x = cvt_pk_bf16(v0[0], v0[1]); w.y = cvt_pk_bf16(v0[2], v0[3]); w.z = cvt_pk_bf16(v1[0], v1[1]); w.w = cvt_pk_bf16(v1[2], v1[3]);
                    *(u32x4*)(yb + (size_t)r * ND + c0) = w; } }
    }
};

struct WinRestOrder {
    int c; size_t a_tile, b_tile;
    __device__ bool next(int i, Unit& u) const {
        if (i > 0 || c < 0 || c >= 64) return false;
        u.pm = c >> 1; u.pn = 23 + (c & 1); u.e = 0; u.aoff = (unsigned)((size_t)u.pm * a_tile); u.boff = (unsigned)((size_t)u.pn * b_tile); return true;
    }
};
struct PoolOrder {
    int G, c;
    __device__ bool next(int i, Unit& u) const {
        const int L = i * G + c; if (c < 0 || L >= 256) return false;
        u.pm = L >> 3; u.pn = L & 7; u.e = 0;
        u.aoff = (unsigned)(((size_t)u.pm * 256 * NC + (size_t)(u.pn >> 1) * 256) * 2); u.boff = (unsigned)((size_t)u.pn * 256 * 256 * 2); return true;
    }
};
struct MoeOrder {
    int G, c, nN, ntiles; const LAS unsigned* tile_e; size_t a_tile, b_expert, b_tile;
    __device__ bool next(int i, Unit& u) const {
        const int L = i * G + c; if (L >= ntiles * nN) return false;
        u.pm = L / nN; u.pn = L % nN; u.e = __builtin_amdgcn_readfirstlane((int)tile_e[u.pm]);
        u.aoff = (unsigned)((size_t)u.pm * a_tile); u.boff = (unsigned)((size_t)u.e * b_expert + (size_t)u.pn * b_tile); return true;
    }
};

__device__ __forceinline__ void cvt_block_T(const float* src, int ld_src, bf16_t* dst, int ld_dst, int lane) {
    const int k8 = lane & 7, nq = lane >> 3;
    const float* s = src + (size_t)(k8 * 8) * ld_src + nq * 4;
    f32x4 v[8];
#pragma unroll
    for (int j = 0; j < 8; ++j) v[j] = ld4(s + (size_t)j * ld_src);
#pragma unroll
    for (int i = 0; i < 4; ++i) { u32x4 w; w.x = cvt_pk_bf16(v[0][i], v[1][i]); w.y = cvt_pk_bf16(v[2][i], v[3][i]); w.z = cvt_pk_bf16(v[4][i], v[5][i]); w.w = cvt_pk_bf16(v[6][i], v[7][i]);
        *(u32x4*)(dst + (size_t)(nq * 4 + i) * ld_dst + k8 * 8) = w; }
}
__device__ __forceinline__ void cvt_block_T2(const float* src, int ld_src, bf16_t* dst, int ld_dst, int lane) {
    const int k8 = lane & 7, nq = lane >> 3;
    const float* s = src + (size_t)(k8 * 8) * ld_src + nq * 4;
    f32x4 v[8], w2[8];
#pragma unroll
    for (int j = 0; j < 8; ++j) { v[j] = ld4(s + (size_t)j * ld_src); w2[j] = ld4(s + (size_t)j * ld_src + 32); }
#pragma unroll
    for (int i = 0; i < 4; ++i) { u32x4 w; w.x = cvt_pk_bf16(v[0][i], v[1][i]); w.y = cvt_pk_bf16(v[2][i], v[3][i]); w.z = cvt_pk_bf16(v[4][i], v[5][i]); w.w = cvt_pk_bf16(v[6][i], v[7][i]);
        *(u32x4*)(dst + (size_t)(nq * 4 + i) * ld_dst + k8 * 8) = w; }
#pragma unroll
    for (int i = 0; i < 4; ++i) { u32x4 w; w.x = cvt_pk_bf16(w2[0][i], w2[1][i]); w.y = cvt_pk_bf16(w2[2][i], w2[3][i]); w.z = cvt_pk_bf16(w2[4][i], w2[5][i]); w.w = cvt_pk_bf16(w2[6][i], w2[7][i]);
        *(u32x4*)(dst + (size_t)(32 + nq * 4 + i) * ld_dst + k8 * 8) = w; }
}

__device__ __forceinline__ void cvt8_load(f32x4 (&v)[16], const float* s, int ld_src) {
#pragma unroll
    for (int j = 0; j < 16; ++j) v[j] = __builtin_nontemporal_load((const f32x4*)(s + (size_t)j * ld_src));
}
__device__ __forceinline__ void cvt8_store(const f32x4 (&v)[16], fp8_t* d, int ld_dst) {
#pragma unroll
    for (int i = 0; i < 4; ++i) { u32x4 w; w.x = pack4_fp8(v[0][i] * W8_SCALE, v[1][i] * W8_SCALE, v[2][i] * W8_SCALE, v[3][i] * W8_SCALE); w.y = pack4_fp8(v[4][i] * W8_SCALE, v[5][i] * W8_SCALE, v[6][i] * W8_SCALE, v[7][i] * W8_SCALE);
        w.z = pack4_fp8(v[8][i] * W8_SCALE, v[9][i] * W8_SCALE, v[10][i] * W8_SCALE, v[11][i] * W8_SCALE); w.w = pack4_fp8(v[12][i] * W8_SCALE, v[13][i] * W8_SCALE, v[14][i] * W8_SCALE, v[15][i] * W8_SCALE);
        __builtin_nontemporal_store(w, (u32x4*)(d + (size_t)i * ld_dst)); }
}
__device__ __forceinline__ void cvt_wave_T8x8(const float* src, int ld_src, fp8_t* dst, int ld_dst, int lane) {
    const int k16 = lane & 7, nq = lane >> 3;
    const float* s = src + (size_t)(k16 * 16) * ld_src + nq * 4; fp8_t* d = dst + (size_t)(nq * 4) * ld_dst + k16 * 16;
    f32x4 va[16], vb[16];
    cvt8_load(va, s, ld_src);
#pragma unroll
    for (int i = 0; i < 8; i += 2) {
        cvt8_load(vb, s + (i + 1) * 32, ld_src);
        cvt8_store(va, d + (size_t)(i * 32) * ld_dst, ld_dst);
        if (i + 2 < 8) cvt8_load(va, s + (i + 2) * 32, ld_src);
        cvt8_store(vb, d + (size_t)((i + 1) * 32) * ld_dst, ld_dst);
    }
}

__device__ __forceinline__ void phase0(const Params& p, LAS unsigned char* lds, const int wave) {
    const int tid = phase_tid(wave);
    const int bid = blockIdx.x, lane = tid & 63, wv = tid >> 6;
    LAS float* cond = (LAS float*)lds;
    if (bid < 192) {
        for (int i = tid; i < NB * ND; i += NTHREADS) { const int b = i >> 11, k = i & 2047; const float cv = p.c[i]; cond[k * 4 + b] = cv / (1.0f + expf(-cv)); }
        __syncthreads();
        const int gid = bid * NTHREADS + tid, ks = gid / 3072, j4 = gid % 3072;
        f32x4 a0 = {0.f, 0.f, 0.f, 0.f}, a1 = a0, a2 = a0, a3 = a0;
        const float* wp = p.w_ada + (size_t)(ks * 64) * NMOD + j4 * 4;
#pragma unroll 8
        for (int kk = 0; kk < 64; ++kk) { const f32x4 w = ld4(wp + (size_t)kk * NMOD); const f32x4 cd = *(const LAS f32x4*)(cond + (ks * 64 + kk) * 4);
            a0 += w * cd[0]; a1 += w * cd[1]; a2 += w * cd[2]; a3 += w * cd[3]; }
        *(f32x4*)(p.modp + (size_t)(ks * 4 + 0) * NMOD + j4 * 4) = a0; *(f32x4*)(p.modp + (size_t)(ks * 4 + 1) * NMOD + j4 * 4) = a1;
        *(f32x4*)(p.modp + (size_t)(ks * 4 + 2) * NMOD + j4 * 4) = a2; *(f32x4*)(p.modp + (size_t)(ks * 4 + 3) * NMOD + j4 * 4) = a3;
    }
    const int gw = bid * NWAVES + wv, GW = gridDim.x * NWAVES;
    constexpr int I_IN = 32 * 265, I_RW = 16 * 64, I_PL = 4 * 4 * 16, I_OUT = 32 * 64, I_ALL = I_IN + I_RW + I_PL + I_OUT;
    for (int it = gw; it < I_ALL; it += GW) {
        if (it < I_IN) { const int kb = it / 265, nb = it % 265; cvt_block_T(p.w_in + (size_t)(kb * 64) * NIN + nb * 32, NIN, p.wt_in + (size_t)(nb * 32) * ND + kb * 64, ND, lane); }
        else if (it < I_IN + I_RW) { const int j = it - I_IN, kb = j / 64, nb = j % 64; cvt_block_T(p.w_rwkv_out + (size_t)(kb * 64) * ND + nb * 32, ND, p.wt_rwkv + (size_t)(nb * 32) * NC + kb * 64, NC, lane); }
        else if (it < I_IN + I_RW + I_PL) { const int j = it - I_IN - I_RW, g = j / 64, kb = (j % 64) / 16, nb = j % 16;
            cvt_block_T(p.w_pool + (size_t)g * 256 * 512 + (size_t)(kb * 64) * 512 + nb * 32, 512, p.wt_pool + (size_t)g * 512 * 256 + (size_t)(nb * 32) * 256 + kb * 64, 256, lane); }
        else { const int j = it - I_IN - I_RW - I_PL, kb = j / 64, nb = j % 64; cvt_block_T(p.w_out + (size_t)(kb * 64) * ND + nb * 32, ND, p.wt_out + (size_t)(nb * 32) * ND + kb * 64, ND, lane); }
    }
    for (int idx = bid * NTHREADS + tid; idx < LORA_N * (LORA_K / 8); idx += gridDim.x * NTHREADS) {
        const int n = idx / (LORA_K / 8), k0 = (idx % (LORA_K / 8)) * 8; float v[8];
#pragma unroll
        for (int j = 0; j < 8; ++j) { const int k = k0 + j; float x = 0.f;
            if (n < 1024) { if (k < 64) x = p.w_decay_up[k * NC + n]; }
            else if (n < 2048) { if (k >= 64 && k < 128) x = p.w_iclr_up[(k - 64) * NC + (n - 1024)]; }
            else { if (k >= 128 && k < 288) x = p.w_glora_up[(k - 128) * NC + (n - 2048)]; }
            v[j] = x; }
        u32x4 w; w.x = cvt_pk_bf16(v[0], v[1]); w.y = cvt_pk_bf16(v[2], v[3]); w.z = cvt_pk_bf16(v[4], v[5]); w.w = cvt_pk_bf16(v[6], v[7]);
        *(u32x4*)(p.bt_lora + (size_t)n * LORA_K + k0) = w;
    }
}

__device__ __forceinline__ void phase1(const Params& p, LAS unsigned char* lds, const int wave) {
    const int tid = phase_tid(wave);
    const int bid = blockIdx.x;
    if (tid < 192) { const int idx = bid * 192 + tid, b = idx / NMOD, j = idx % NMOD; float s = p.b_ada[j];
        for (int ks = 0; ks < KS_MOD; ++ks) s += p.modp[(size_t)(ks * 4 + b) * NMOD + j];
        p.mod[idx] = s; }
    LAS float* ss = (LAS float*)lds;
    const int m0 = bid * 32, b = m0 >> 11;
    {   const int j = tid * 8; f32x4 s0 = ld4(p.b_ada + j), s1 = ld4(p.b_ada + j + 4);
#pragma unroll 8
        for (int ks = 0; ks < KS_MOD; ++ks) { s0 += ld4(p.modp + (size_t)(ks * 4 + b) * NMOD + j); s1 += ld4(p.modp + (size_t)(ks * 4 + b) * NMOD + j + 4); }
        *(LAS f32x4*)(ss + j) = s0; *(LAS f32x4*)(ss + j + 4) = s1; }
    __syncthreads();
    const int k = (tid & 255) * 8, rh = tid >> 8;
    const f32x4 sh0 = *(const LAS f32x4*)(ss + k), sh1v = *(const LAS f32x4*)(ss + k + 4), sc0 = *(const LAS f32x4*)(ss + ND + k) + 1.0f, sc1v = *(const LAS f32x4*)(ss + ND + k + 4) + 1.0f;
#pragma unroll 4
    for (int i = 0; i < 16; ++i) { const size_t m = (size_t)(m0 + 2 * i + rh); const f32x4 x0 = ld4(p.x + m * ND + k), x1 = ld4(p.x + m * ND + k + 4); const f32x4 h0 = x0 * sc0 + sh0, h1 = x1 * sc1v + sh1v;
        u32x4 w; w.x = cvt_pk_bf16(h0[0], h0[1]); w.y = cvt_pk_bf16(h0[2], h0[3]); w.z = cvt_pk_bf16(h1[0], h1[1]); w.w = cvt_pk_bf16(h1[2], h1[3]); *(u32x4*)(p.hb + m * ND + k) = w; }
    __syncthreads();
}

__device__ __forceinline__ void phase3(const Params& p, LAS unsigned char* lds, const int wave) {
    const int tid = phase_tid(wave);
    const int bid = blockIdx.x, m0 = bid * 32, t0 = m0 & (NT - 1), hist = t0 > 0 ? 15 : 0;
    constexpr int TC = OFF_GA - OFF_WD, TCH = TC / 8;
    LAS bf16_t* T = (LAS bf16_t*)lds;
    for (int idx = tid; idx < 47 * TCH; idx += NTHREADS) { const int r = idx / TCH, ck = idx % TCH;
        if (r >= 15 - hist) *(LAS u32x4*)(T + r * TC + ck * 8) = *(const u32x4*)(p.P + (size_t)(m0 - 15 + r) * NINP + OFF_WD + ck * 8); }
    __syncthreads();
    for (int idx = tid; idx < 32 * (LORA_K / 8); idx += NTHREADS) { const int i = idx / (LORA_K / 8), j0 = (idx % (LORA_K / 8)) * 8; u32x4 w = {0u, 0u, 0u, 0u};
        if (j0 < 288) { const u32x4 cu = *(const LAS u32x4*)(T + (15 + i) * TC + j0); u32x4 pu = {0u, 0u, 0u, 0u}; if (t0 + i > 0) pu = *(const LAS u32x4*)(T + (14 + i) * TC + j0);
            const f32x4 c0 = bf4_unpack((u32x2){cu.x, cu.y}), c1 = bf4_unpack((u32x2){cu.z, cu.w}), q0 = bf4_unpack((u32x2){pu.x, pu.y}), q1 = bf4_unpack((u32x2){pu.z, pu.w});
            const f32x4 s0 = c0 + (q0 - c0) * ld4(p.mu_shift + OFF_WD + j0), s1 = c1 + (q1 - c1) * ld4(p.mu_shift + OFF_WD + j0 + 4); float v[8];
#pragma unroll
            for (int j = 0; j < 8; ++j) { const float x = j < 4 ? s0[j] : s1[j - 4];
                v[j] = j0 < 64 ? (1.0f - 2.0f * __builtin_amdgcn_rcpf(1.0f + __builtin_amdgcn_exp2f(x * 2.8853900817779268f))) : (j0 < 128 ? x : sigmoidf_(x)); }
            w.x = cvt_pk_bf16(v[0], v[1]); w.y = cvt_pk_bf16(v[2], v[3]); w.z = cvt_pk_bf16(v[4], v[5]); w.w = cvt_pk_bf16(v[6], v[7]); }
        *(u32x4*)(p.a_lora + (size_t)(m0 + i) * LORA_K + j0) = w; }
    for (int idx = tid; idx < 32 * (NC / 8); idx += NTHREADS) { const int i = idx >> 7, c = (idx & 127) * 8; const int win = 2 << (c >> 8), t = t0 + i, n = (t + 1) < win ? (t + 1) : win;
        const LAS bf16_t* up = T + (15 + i) * TC + (OFF_POOL - OFF_WD) + c; f32x4 a0 = {0.f, 0.f, 0.f, 0.f}, a1 = a0;
        for (int q = 0; q < n; ++q) { const u32x4 uu = *(const LAS u32x4*)(up - q * TC); a0 += bf4_unpack((u32x2){uu.x, uu.y}); a1 += bf4_unpack((u32x2){uu.z, uu.w}); }
        const u32x4 u0 = *(const LAS u32x4*)(up); const float rn = 1.0f / (float)n;
        const f32x4 d0 = a0 * rn - bf4_unpack((u32x2){u0.x, u0.y}), d1 = a1 * rn - bf4_unpack((u32x2){u0.z, u0.w});
        u32x4 w; w.x = cvt_pk_bf16(d0[0], d0[1]); w.y = cvt_pk_bf16(d0[2], d0[3]); w.z = cvt_pk_bf16(d1[0], d1[1]); w.w = cvt_pk_bf16(d1[2], d1[3]);
        *(u32x4*)(p.dp + (size_t)(m0 + i) * NC + c) = w; }
    __syncthreads();
}

__device__ __forceinline__ float row8_allsum(float x) {
    x += dpp_f<0x141>(x); x += dpp_f<0x1B>(x); x += dpp_f<0xB1>(x); return x;
}
__device__ __forceinline__ void scan_head(const Params& p, LAS unsigned char* lds, int bh, const int wave) {
    const int tid = phase_tid(wave);
    const int lane = tid & 63;
    const int b = bh >> 4, h = bh & 15;
    constexpr int L_AW = 0, L_W = 16384, L_BK = 32768, L_Y = 65536, L_V = 81920, L_G = 106496, L_SC = 131072, L_CS = 131840, L_Z = 132352, L_DUMMY = 132864, L_CST = 133888;
    constexpr int NCH = NT / 32;
    if (tid < 128) *(LAS unsigned*)(lds + L_Z + tid * 4) = 0u;
    {
        const int a8 = tid >> 6, cc = tid & 63, gch = h * HS + cc;
        const float* src = a8 == 0 ? p.mu_shift + OFF_R : a8 == 1 ? p.mu_shift + OFF_K : a8 == 2 ? p.mu_shift + OFF_V : a8 == 3 ? p.k_k : a8 == 4 ? p.k_a : a8 == 5 ? p.r_k : a8 == 6 ? p.lnx_g : p.lnx_b;
        *(LAS float*)(lds + L_CST + a8 * 256 + cc * 4) = src[gch]; }
    __syncthreads();
#define CST4(a8, u_) (*(const LAS f32x4*)(lds + L_CST + (a8) * 256 + (c8 + 4 * (u_)) * 4))
    const int ht = tid - 256, ls = (ht >> 3) & 31, c8 = (ht & 7) * 8, ch0 = h * HS + c8;
    f32x4 pr[2], pk[2], pv[2], qr[2], qk[2], qv[2], dc[2], ic[2], gt[2]; u32x4 pr8, pk8, pv8, qr8, qk8, qv8, ic8, gt8;
    const f32x4 zero4 = {0.f, 0.f, 0.f, 0.f};
#define SCAN_ISSUE(chunk) do { int ch = ch0; asm volatile("" : "+v"(ch)); const int t_ = (chunk) * 32 + ls; const size_t m_ = (size_t)b * NT + t_; const bf16_t* row_ = p.P + m_ * NINP + ch; \
        pr8 = *(const u32x4*)(row_ + OFF_R); pk8 = *(const u32x4*)(row_ + OFF_K); pv8 = *(const u32x4*)(row_ + OFF_V); \
        if (t_ > 0) { qr8 = *(const u32x4*)(row_ - NINP + OFF_R); qk8 = *(const u32x4*)(row_ - NINP + OFF_K); qv8 = *(const u32x4*)(row_ - NINP + OFF_V); } else { qr8 = (u32x4){0u, 0u, 0u, 0u}; qk8 = qr8; qv8 = qr8; } \
        ic8 = *(const u32x4*)(p.iclr + m_ * NC + ch); gt8 = *(const u32x4*)(p.gg + m_ * NC + ch); \
        _Pragma("unroll") for (int u_ = 0; u_ < 2; ++u_) dc[u_] = ld4(p.dec + m_ * NC + ch + 4 * u_); } while (0)
#define SCAN_UNPACK() do { ic[0] = bf4_unpack((u32x2){ic8.x, ic8.y}); ic[1] = bf4_unpack((u32x2){ic8.z, ic8.w}); gt[0] = bf4_unpack((u32x2){gt8.x, gt8.y}); gt[1] = bf4_unpack((u32x2){gt8.z, gt8.w}); pr[0] = bf4_unpack((u32x2){pr8.x, pr8.y}); pr[1] = bf4_unpack((u32x2){pr8.z, pr8.w}); pk[0] = bf4_unpack((u32x2){pk8.x, pk8.y}); pk[1] = bf4_unpack((u32x2){pk8.z, pk8.w}); \
        pv[0] = bf4_unpack((u32x2){pv8.x, pv8.y}); pv[1] = bf4_unpack((u32x2){pv8.z, pv8.w}); qr[0] = bf4_unpack((u32x2){qr8.x, qr8.y}); qr[1] = bf4_unpack((u32x2){qr8.z, qr8.w}); \
        qk[0] = bf4_unpack((u32x2){qk8.x, qk8.y}); qk[1] = bf4_unpack((u32x2){qk8.z, qk8.w}); qv[0] = bf4_unpack((u32x2){qv8.x, qv8.y}); qv[1] = bf4_unpack((u32x2){qv8.z, qv8.w}); } while (0)
#define SCAN_STAGE(chunk) do { SCAN_UNPACK(); int ch = ch0; asm volatile("" : "+v"(ch)); const int bp_ = (chunk) & 1, vb_ = (chunk) % 3; f32x4 r_[2], k_[2], v_[2], kk_[2], km_[2], bb_[2]; float ss_ = 0.f; \
        _Pragma("unroll") for (int u_ = 0; u_ < 2; ++u_) { const f32x4 mu_r = CST4(0, u_), mu_k = CST4(1, u_), mu_v = CST4(2, u_); \
            r_[u_] = pr[u_] + (qr[u_] - pr[u_]) * mu_r; k_[u_] = pk[u_] + (qk[u_] - pk[u_]) * mu_k; v_[u_] = pv[u_] + (qv[u_] - pv[u_]) * mu_v; \
            kk_[u_] = k_[u_] * CST4(3, u_); ss_ += dot4(kk_[u_], kk_[u_]); } \
        ss_ = row8_allsum(ss_); const float inv_ = 1.0f / fmaxf(sqrtf(ss_), 1e-12f); float br_ = 0.f, kr_ = 0.f, rk_ = 0.f; \
        _Pragma("unroll") for (int u_ = 0; u_ < 2; ++u_) { kk_[u_] = kk_[u_] * inv_; km_[u_] = k_[u_] * ((ic[u_] - 1.0f) * CST4(4, u_) + 1.0f); bb_[u_] = kk_[u_] * ic[u_]; \
            br_ += dot4(bb_[u_], r_[u_]); kr_ += dot4(km_[u_], r_[u_]); rk_ += dot4(r_[u_] * km_[u_], CST4(5, u_)); } \
        br_ = row8_allsum(br_); kr_ = row8_allsum(kr_); rk_ = row8_allsum(rk_); \
          \
        const int pp_ = ls >> 1, odd_ = ls & 1; float c1_ = 0.f, c2_ = 0.f, c3_ = 0.f, c4_ = 0.f; \
        _Pragma("unroll") for (int u_ = 0; u_ < 2; ++u_) { const int k0_ = c8 + 4 * u_; const int pos_ = (k0_ >> 5) * 32 + ((k0_ & 15) >> 2) * 8 + ((k0_ >> 4) & 1) * 4; \
            const f32x4 a_ = -kk_[u_], wr_ = dc[u_] * r_[u_] + a_ * br_; f32x4 pw_, pb_, pk_; \
            _Pragma("unroll") for (int j_ = 0; j_ < 4; ++j_) { pw_[j_] = dpp_f<0x118>(dc[u_][j_]); pb_[j_] = dpp_f<0x118>(bb_[u_][j_]); pk_[j_] = dpp_f<0x118>(km_[u_][j_]); } \
            const f32x4 x0_ = odd_ ? pw_ * a_ : a_, x1_ = odd_ ? pw_ * wr_ : wr_; \
            u32x2 wa_, ww_; wa_.x = cvt_pk_bf16(x0_[0], x0_[1]); wa_.y = cvt_pk_bf16(x0_[2], x0_[3]); ww_.x = cvt_pk_bf16(x1_[0], x1_[1]); ww_.y = cvt_pk_bf16(x1_[2], x1_[3]); \
            *(LAS u32x2*)(lds + L_AW + bp_ * 8192 + pp_ * 512 + odd_ * 256 + pos_ * 2) = wa_; *(LAS u32x2*)(lds + L_AW + bp_ * 8192 + pp_ * 512 + odd_ * 256 + 128 + pos_ * 2) = ww_; \
            if (odd_) { *(LAS f32x4*)(lds + L_W + bp_ * 8192 + pp_ * 256 + k0_ * 4) = pw_ * dc[u_]; \
                *(LAS f32x4*)(lds + L_BK + bp_ * 16384 + pp_ * 1024 + k0_ * 4) = pb_ * dc[u_]; *(LAS f32x4*)(lds + L_BK + bp_ * 16384 + pp_ * 1024 + 256 + k0_ * 4) = pk_ * dc[u_]; \
                *(LAS f32x4*)(lds + L_BK + bp_ * 16384 + pp_ * 1024 + 512 + k0_ * 4) = bb_[u_]; *(LAS f32x4*)(lds + L_BK + bp_ * 16384 + pp_ * 1024 + 768 + k0_ * 4) = km_[u_]; \
                c1_ += dot4(pb_, a_); c2_ += dot4(pk_, a_); c3_ += dot4(pb_, wr_); c4_ += dot4(pk_, wr_); } \
            *(LAS f32x4*)(lds + L_V + vb_ * 8192 + ls * 256 + k0_ * 4) = v_[u_]; *(LAS f32x4*)(lds + L_G + vb_ * 8192 + ls * 256 + k0_ * 4) = gt[u_]; } \
        c1_ = row8_allsum(c1_); c2_ = row8_allsum(c2_); c3_ = row8_allsum(c3_); c4_ = row8_allsum(c4_); \
        if ((ht & 7) == 0) { *(LAS f32x2*)(lds + L_SC + vb_ * 256 + ls * 8) = (f32x2){kr_, rk_}; if (odd_) *(LAS f32x4*)(lds + L_CS + bp_ * 256 + pp_ * 16) = (f32x4){c1_, c2_, c3_, c4_}; } } while (0)
#define SCAN_POST(chunk) do { int ch = ch0; asm volatile("" : "+v"(ch)); const int bp_ = (chunk) & 1, vb_ = (chunk) % 3; const f32x2 sc_ = *(const LAS f32x2*)(lds + L_SC + vb_ * 256 + ls * 8); f32x4 y_[2], v_[2]; float s_ = 0.f; \
        _Pragma("unroll") for (int u_ = 0; u_ < 2; ++u_) { v_[u_] = *(const LAS f32x4*)(lds + L_V + vb_ * 8192 + ls * 256 + (c8 + 4 * u_) * 4); \
            y_[u_] = *(const LAS f32x4*)(lds + L_Y + bp_ * 8192 + ls * 256 + (c8 + 4 * u_) * 4) + v_[u_] * sc_[0]; s_ += (y_[u_][0] + y_[u_][1]) + (y_[u_][2] + y_[u_][3]); } \
        const float mean_ = row8_allsum(s_) * (1.0f / 64.0f); float q_ = 0.f; \
        _Pragma("unroll") for (int u_ = 0; u_ < 2; ++u_) { y_[u_] = y_[u_] - mean_; q_ += dot4(y_[u_], y_[u_]); } \
        const float rstd_ = rsqrtf(row8_allsum(q_) * (1.0f / 64.0f) + GN_EPS); const size_t m_ = (size_t)b * NT + (chunk) * 32 + ls; u32x4 o_; \
        _Pragma("unroll") for (int u_ = 0; u_ < 2; ++u_) { const f32x4 g_ = *(const LAS f32x4*)(lds + L_G + vb_ * 8192 + ls * 256 + (c8 + 4 * u_) * 4); \
            const f32x4 yn_ = y_[u_] * rstd_ * CST4(6, u_) + CST4(7, u_); const f32x4 f_ = (yn_ + v_[u_] * sc_[1]) * g_; \
            if (u_ == 0) { o_.x = cvt_pk_bf16(f_[0], f_[1]); o_.y = cvt_pk_bf16(f_[2], f_[3]); } else { o_.z = cvt_pk_bf16(f_[0], f_[1]); o_.w = cvt_pk_bf16(f_[2], f_[3]); } } \
        *(u32x4*)(p.yr + m_ * NC + ch) = o_; } while (0)
    const int ri = lane & 15, rg = lane >> 4, sel = ri & 3;
    f32x4 X0 = zero4, X1 = zero4, X2 = zero4, X3 = zero4;
    if (wave >= 4) { SCAN_ISSUE(0); SCAN_STAGE(0); }
    __syncthreads();
    for (int chunk = 0; chunk < NCH; ++chunk) {
        if (wave < 4) {
            __builtin_amdgcn_s_setprio(3);
            const int bp = chunk & 1, vb = chunk % 3;
            const LAS unsigned char* awp = lds + L_AW + bp * 8192 + sel * 128 + rg * 16;
            const LAS unsigned char* wwp = lds + L_W + bp * 8192 + rg * 16;
            const LAS unsigned char* abp = lds + L_BK + bp * 16384 + rg * 256 + ri * 4;
            const LAS unsigned char* vp = lds + L_V + vb * 8192 + (16 * wave + ri) * 4;
            const LAS unsigned char* csp = lds + L_CS + bp * 256;
            LAS unsigned char* yp = (rg == 0) ? (lds + L_Y + bp * 8192 + (16 * wave + ri) * 4) : ((rg == 2) ? (lds + L_Y + bp * 8192 + 256 + (16 * wave + ri) * 4) : (lds + L_DUMMY + tid * 4));
            const int y_st = (rg & 1) ? 0 : 512;
#define SCAN_LD(S, pi) do { S##a0 = *(const LAS bf16x8*)(awp + (pi) * 512); S##a1 = *(const LAS bf16x8*)(awp + (pi) * 512 + 64); \
                S##w0 = *(const LAS f32x4*)(wwp + (pi) * 256); S##w1 = *(const LAS f32x4*)(wwp + (pi) * 256 + 64); S##w2 = *(const LAS f32x4*)(wwp + (pi) * 256 + 128); S##w3 = *(const LAS f32x4*)(wwp + (pi) * 256 + 192); \
                S##b0 = *(const LAS float*)(abp + (pi) * 1024); S##b1 = *(const LAS float*)(abp + (pi) * 1024 + 64); S##b2 = *(const LAS float*)(abp + (pi) * 1024 + 128); S##b3 = *(const LAS float*)(abp + (pi) * 1024 + 192); \
                S##vt = *(const LAS float*)(vp + (pi) * 512); S##vu = *(const LAS float*)(vp + (pi) * 512 + 256); S##cs = *(const LAS f32x4*)(csp + (pi) * 16); } while (0)
#define SCAN_STEP(S, pi) do { u32x4 xa, xc; \
                xa.x = cvt_pk_bf16(X0[0], X0[1]); xa.y = cvt_pk_bf16(X0[2], X0[3]); xa.z = cvt_pk_bf16(X1[0], X1[1]); xa.w = cvt_pk_bf16(X1[2], X1[3]); \
                xc.x = cvt_pk_bf16(X2[0], X2[1]); xc.y = cvt_pk_bf16(X2[2], X2[3]); xc.z = cvt_pk_bf16(X3[0], X3[1]); xc.w = cvt_pk_bf16(X3[2], X3[3]); \
                const f32x4 d0 = __builtin_amdgcn_mfma_f32_16x16x32_bf16(S##a0, __builtin_bit_cast(bf16x8, xa), zero4, 0, 0, 0); \
                const f32x4 d1 = __builtin_amdgcn_mfma_f32_16x16x32_bf16(S##a1, __builtin_bit_cast(bf16x8, xc), zero4, 0, 0, 0); \
                const f32x4 d = d0 + d1; const float sat = d[0]; \
                const float sau = d[2] + sat * S##cs[0] + S##vt * S##cs[1], yu = d[3] + sat * S##cs[2] + S##vt * S##cs[3]; \
                const float bsel = (rg == 0) ? sat : ((rg == 1) ? S##vt : ((rg == 2) ? sau : S##vu)); \
                X0 = __builtin_amdgcn_mfma_f32_16x16x4f32(S##b0, bsel, X0 * S##w0, 0, 0, 0); \
                X1 = __builtin_amdgcn_mfma_f32_16x16x4f32(S##b1, bsel, X1 * S##w1, 0, 0, 0); \
                X2 = __builtin_amdgcn_mfma_f32_16x16x4f32(S##b2, bsel, X2 * S##w2, 0, 0, 0); \
                X3 = __builtin_amdgcn_mfma_f32_16x16x4f32(S##b3, bsel, X3 * S##w3, 0, 0, 0); \
                *(LAS float*)(yp + (pi) * y_st) = (rg == 0) ? d[1] : yu; } while (0)
            bf16x8 Pa0, Pa1, Qa0, Qa1; f32x4 Pw0, Pw1, Pw2, Pw3, Qw0, Qw1, Qw2, Qw3, Pcs, Qcs; float Pb0, Pb1, Pb2, Pb3, Pvt, Pvu, Qb0, Qb1, Qb2, Qb3, Qvt, Qvu;
            SCAN_LD(P, 0);
#pragma unroll 1
            for (int pi = 0; pi < 16; pi += 2) {
                SCAN_LD(Q, pi + 1);
                SCAN_STEP(P, pi);
                if (pi + 2 < 16) SCAN_LD(P, pi + 2);
                SCAN_STEP(Q, pi + 1);
            }
#undef SCAN_LD
#undef SCAN_STEP
        } else {
            if (chunk + 1 < NCH) SCAN_ISSUE(chunk + 1);
            if (chunk > 0) SCAN_POST(chunk - 1);
            if (chunk + 1 < NCH) SCAN_STAGE(chunk + 1);
        }
        __syncthreads();
    }
    if (wave >= 4) SCAN_POST(NCH - 1);
    __syncthreads();
#undef SCAN_ISSUE
#undef CST4
#undef SCAN_STAGE
#undef SCAN_UNPACK
#undef SCAN_POST
}
__device__ __forceinline__ void conv_queue(const Params& p, LAS unsigned char* lds, const int wave, const int cw) {
    const int tid = phase_tid(wave);
    const int lane = tid & 63, wv = tid >> 6;
    LAS int* slot = (LAS int*)(lds + LDS_MISC);
    constexpr int N_GU = NE * 16 * 2, N_DN = NE * 16, N_ALL = N_GU + N_DN;
    for (;;) {
        __syncthreads();
        if (tid == 0) *slot = (int)atomicAdd(&p.ctl[cw], 1u);
        __syncthreads();
        const int it = *slot;
        if (it >= N_ALL) break;
        if (it < N_GU) { const int e = it >> 5, rem = it & 31, kb = rem >> 1, nh = rem & 1;
            const float* src = p.w_gu + (size_t)e * ND * (2 * DFF) + (size_t)(kb * 128) * (2 * DFF) + nh * 2048;
            fp8_t* dst = p.wt_gu + (size_t)e * (2 * DFF) * ND + (size_t)(nh * 2048) * ND + kb * 128;
            cvt_wave_T8x8(src + wv * 256, 2 * DFF, dst + (size_t)(wv * 256) * ND, ND, lane); }
        else { const int j = it - N_GU, e = j >> 4, kb = j & 15;
            const float* src = p.w_down + (size_t)e * DFF * ND + (size_t)(kb * 128) * ND;
            fp8_t* dst = p.wt_down + (size_t)e * ND * DFF + kb * 128;
            cvt_wave_T8x8(src + wv * 256, ND, dst + (size_t)(wv * 256) * DFF, DFF, lane); }
    }
}

__device__ __forceinline__ void phase8(const Params& p, LAS unsigned char* lds, const int wave) {
    const int tid = phase_tid(wave);
    const int bid = blockIdx.x, lane = tid & 63, wv = tid >> 6;
    constexpr int HP = ND + 4;
    LAS float* hs = (LAS float*)lds;
    LAS float* lg = hs + 16 * HP;
    LAS float* part = lg + 16 * 32;
    LAS float* topv = part + 4 * 16 * 32;
    LAS int* topi = (LAS int*)(topv + 64);
    const int b = (bid * 32) >> 11;
    const float* sh2 = p.mod + (size_t)b * NMOD + 3 * ND; const float* sc2 = p.mod + (size_t)b * NMOD + 4 * ND;
    for (int pass = 0; pass < 2; ++pass) {
        const int mb = bid * 32 + pass * 16;
        for (int rr = 0; rr < 2; ++rr) { const int r = wv * 2 + rr; const size_t m = (size_t)(mb + r);
            f32x4 z[8]; float s = 0.f;
#pragma unroll
            for (int j = 0; j < 4; ++j) { z[2 * j] = ld4(p.z1 + m * ND + j * 512 + lane * 8); z[2 * j + 1] = ld4(p.z1 + m * ND + j * 512 + lane * 8 + 4);
                s += ((z[2 * j][0] + z[2 * j][1]) + (z[2 * j][2] + z[2 * j][3])) + ((z[2 * j + 1][0] + z[2 * j + 1][1]) + (z[2 * j + 1][2] + z[2 * j + 1][3])); }
            const float mean = wave_allsum(s) * (1.0f / ND); float qv = 0.f;
#pragma unroll
            for (int j = 0; j < 8; ++j) { const f32x4 d = z[j] - mean; qv += dot4(d, d); }
            const float rstd = rsqrtf(wave_allsum(qv) * (1.0f / ND) + LN_EPS);
            if (lane == 0) *(f32x2*)(p.lnst + m * 2) = (f32x2){mean, rstd};
#pragma unroll
            for (int j = 0; j < 8; ++j) { const int k = (j >> 1) * 512 + lane * 8 + (j & 1) * 4;
                const f32x4 x1 = (z[j] - mean) * rstd * ld4(p.ln1_g + k) + ld4(p.ln1_b + k);
                const f32x4 h = x1 * (ld4(sc2 + k) + 1.0f) + ld4(sh2 + k);
                *(unsigned*)(p.h2 + m * ND + k) = pack4_fp8(h[0], h[1], h[2], h[3]);
                *(LAS f32x4*)(hs + r * HP + k) = h; } }
        __syncthreads();
        {
            const int kq = wv >> 1, ntl = wv & 1, ar = lane & 15, ak = lane >> 4;
            f32x4 acc = {0.f, 0.f, 0.f, 0.f};
            const LAS float* ap = hs + ar * HP + kq * 512 + ak; const float* bp = p.w_router + (size_t)(kq * 512 + ak) * NE + ntl * 16 + ar;
#pragma unroll 8
            for (int ks = 0; ks < 128; ++ks) acc = __builtin_amdgcn_mfma_f32_16x16x4f32(ap[ks * 4], bp[(size_t)ks * 4 * NE], acc, 0, 0, 0);
#pragma unroll
            for (int j = 0; j < 4; ++j) part[(kq * 16 + ak * 4 + j) * 32 + ntl * 16 + ar] = acc[j]; }
        __syncthreads();
        {   const int r = tid >> 5, e = tid & 31;
            lg[r * 32 + e] = p.b_router[e] + (part[(0 * 16 + r) * 32 + e] + part[(1 * 16 + r) * 32 + e]) + (part[(2 * 16 + r) * 32 + e] + part[(3 * 16 + r) * 32 + e]); }
        __syncthreads();
        {
            const int r = tid >> 5, e = tid & 31; const LAS float* l = lg + r * 32; const float mine = l[e]; int rank = 0;
#pragma unroll
            for (int q = 0; q < 8; ++q) { const f32x4 o = *(const LAS f32x4*)(l + q * 4);
#pragma unroll
                for (int j = 0; j < 4; ++j) rank += (o[j] > mine || (o[j] == mine && (q * 4 + j) < e)) ? 1 : 0; }
            if (rank < 4) { topv[r * 4 + rank] = mine; topi[r * 4 + rank] = e; } }
        __syncthreads();
        if (tid < 64) { const int r = tid >> 2, k = tid & 3, m = mb + r; const f32x4 tv = *(const LAS f32x4*)(topv + r * 4); const int ei = topi[r * 4 + k];
            const float e0 = 1.0f, e1 = expf(tv[1] - tv[0]), e2 = expf(tv[2] - tv[0]), e3 = expf(tv[3] - tv[0]); const float sum = (e0 + e1) + (e2 + e3);
            const float mineexp = k == 0 ? e0 : (k == 1 ? e1 : (k == 2 ? e2 : e3));
            const unsigned rk = atomicAdd(&p.ctl[CW_CNT + 64 * ei], 1u);
            p.sel[m * 4 + k] = ei; p.rnk[m * 4 + k] = (int)rk; p.prob[m * 4 + k] = mineexp / sum; }
        __syncthreads();
    }
}

__device__ __forceinline__ void phase9(const Params& p, LAS unsigned char* lds, const int wave) {
    const int tid = phase_tid(wave);
    const int bid = blockIdx.x, lane = tid & 63, wv = tid >> 6;
    LAS int* seg = (LAS int*)lds;
    if (tid == 0) { int s = 0;
        for (int e = 0; e < NE; ++e) { seg[e] = s; const int c = (int)xb_ld(&p.ctl[CW_CNT + 64 * e]); s += (c + 255) & ~255; }
        seg[NE] = s;
        if (bid == 0) { int t = 0;
            for (int e = 0; e < NE; ++e) { const int nt = (seg[e + 1] - seg[e]) >> 8; for (int i = 0; i < nt; ++i) p.ctl[CW_TILEE + t + i] = (unsigned)e; t += nt; }
            p.ctl[CW_NTILES] = (unsigned)t; } }
    __syncthreads();
    const int GW = gridDim.x * NWAVES;
    for (int it = bid * NWAVES + wv; it < NM * TOPK; it += GW) { const int m = it >> 2;
        const int e = p.sel[it], d = seg[e] + p.rnk[it];
        if (lane == 0) p.dest[it] = d;
        const u32x4* src = (const u32x4*)(p.h2 + (size_t)m * ND); u32x4* dst = (u32x4*)(p.xb + (size_t)d * ND);
#pragma unroll
        for (int i = 0; i < 2; ++i) dst[i * 64 + lane] = src[i * 64 + lane]; }
    __syncthreads();
}

__device__ __forceinline__ void phase13(const Params& p, const int wave) {
    const int tid = phase_tid(wave);
    const int bid = blockIdx.x, lane0 = tid & 63, wv = wave;
    const int GW = gridDim.x * NWAVES;
    for (int m = bid * NWAVES + wv; m < NM; m += GW) { const int b = m >> 11;
        int lane = lane0; asm volatile("" : "+v"(lane));
        const float* g2 = p.mod + (size_t)b * NMOD + 5 * ND;
        int d[4]; float pr[4]; const f32x2 st = *(const f32x2*)(p.lnst + (size_t)m * 2);
#pragma unroll
        for (int k = 0; k < 4; ++k) { d[k] = p.dest[m * 4 + k]; pr[k] = p.prob[m * 4 + k]; }
        f32x4 z[8]; float s = 0.f;
#pragma unroll
        for (int j = 0; j < 4; ++j) { const int c = j * 512 + lane * 8; f32x4 f0 = {0.f, 0.f, 0.f, 0.f}, f1 = f0;
#pragma unroll
            for (int k = 0; k < 4; ++k) { const u32x4 y8 = *(const u32x4*)(p.yb + (size_t)d[k] * ND + c);
                f0 += bf4_unpack((u32x2){y8.x, y8.y}) * pr[k]; f1 += bf4_unpack((u32x2){y8.z, y8.w}) * pr[k]; }
            const f32x4 xa = (ld4(p.z1 + (size_t)m * ND + c) - st[0]) * st[1] * ld4(p.ln1_g + c) + ld4(p.ln1_b + c), xb2 = (ld4(p.z1 + (size_t)m * ND + c + 4) - st[0]) * st[1] * ld4(p.ln1_g + c + 4) + ld4(p.ln1_b + c + 4);
            z[2 * j] = xa * DN_ALPHA + ld4(g2 + c) * f0; z[2 * j + 1] = xb2 * DN_ALPHA + ld4(g2 + c + 4) * f1;
            s += ((z[2 * j][0] + z[2 * j][1]) + (z[2 * j][2] + z[2 * j][3])) + ((z[2 * j + 1][0] + z[2 * j + 1][1]) + (z[2 * j + 1][2] + z[2 * j + 1][3])); }
        const float mean = wave_allsum(s) * (1.0f / ND); float qv = 0.f;
#pragma unroll
        for (int j = 0; j < 8; ++j) { const f32x4 dd = z[j] - mean; qv += dot4(dd, dd); }
        const float rstd = rsqrtf(wave_allsum(qv) * (1.0f / ND) + LN_EPS);
#pragma unroll
        for (int j = 0; j < 8; ++j) { const int c = (j >> 1) * 512 + lane * 8 + (j & 1) * 4;
            *(f32x4*)(p.out + (size_t)m * ND + c) = (z[j] - mean) * rstd * ld4(p.ln2_g + c) + ld4(p.ln2_b + c); } }
}

__global__ void __launch_bounds__(NTHREADS, 2) fwd(Params p) {
    extern __shared__ __attribute__((aligned(16))) unsigned char shm[];
    LAS unsigned char* lds = (LAS unsigned char*)shm;
    const int bid = blockIdx.x, G = gridDim.x;
    const int wave = __builtin_amdgcn_readfirstlane(threadIdx.x >> 6);
    if (threadIdx.x == 0) *(LAS u32x4*)(lds + LDS_BARW) = (u32x4){0u, 0u, 0u, 0u};
    __syncthreads();
    XcdBarrier bar = xcd_barrier_post(p.bar, (volatile LAS unsigned*)(lds + LDS_BARW));

    phase0(p, lds, wave);
    xcd_barrier(bar, wave);
    if (PROBE == 3) { phase0(p, lds, wave); xcd_barrier(bar, wave); }
    phase1(p, lds, wave);
    xcd_barrier(bar, wave);
    if (PROBE == 3) { phase1(p, lds, wave); xcd_barrier(bar, wave); }
    {
        pg8::Gemm g{p.hb, p.wt_in, ND, ND, ND}; pg8::DenseOrder S; S.init(NM / 256, NINP / 256 - 2, G, bid, (size_t)256 * ND * 2, (size_t)256 * ND * 2); S.skip_from = 23; S.skip_n = 2;
        EpiP E{p.P}; pg8::gemm_phase(lds, g, S, E, wave);
        if (PROBE == 1) { __syncthreads(); pg8::gemm_phase(lds, g, S, E, wave); } }
    xcd_barrier(bar, wave);
    phase3(p, lds, wave);
    xcd_barrier(bar, wave);
    if (PROBE == 3) { phase3(p, lds, wave); xcd_barrier(bar, wave); }
    {
        pg8::Gemm g{p.hb, p.wt_in, ND, ND, ND}; WinRestOrder S{bid, (size_t)256 * ND * 2, (size_t)256 * ND * 2};
        EpiP E{p.P}; pg8::gemm_phase(lds, g, S, E, wave); }
    __syncthreads();
    {
        pg8::Gemm g{p.a_lora, p.bt_lora, LORA_K, LORA_K, LORA_K}; pg8::DenseOrder S; S.init(NM / 256, LORA_N / 256, G - 64, bid - 64, (size_t)256 * LORA_K * 2, (size_t)256 * LORA_K * 2);
        EpiLora E{p.dec, p.iclr, p.gg, p.w0, p.a0}; pg8::gemm_phase(lds, g, S, E, wave);
        if (PROBE == 1) { __syncthreads(); pg8::gemm_phase(lds, g, S, E, wave); } }
    __syncthreads();
    {
        pg8::Gemm g{p.dp, p.wt_pool, NC, 256, 256}; PoolOrder S{1 << 20, bid >= 64 ? bid - 64 : 192 + bid};
        EpiPool E{p.t1, p.P, p.pool_scale}; pg8::gemm_phase(lds, g, S, E, wave);
        if (PROBE == 1) { __syncthreads(); pg8::gemm_phase(lds, g, S, E, wave); } }
    xcd_barrier(bar, wave);
    if (bid < NB * NH) { scan_head(p, lds, bid, wave); if (PROBE == 4) scan_head(p, lds, bid, wave); }
    conv_queue(p, lds, wave, CW_CONV);
    if (PROBE == 5) conv_queue(p, lds, wave, CW_CONV2);
    xcd_barrier(bar, wave);
    if (PROBE == 2) { if (bid < NB * NH) scan_head(p, lds, bid, wave); conv_queue(p, lds, wave, CW_CONV2); xcd_barrier(bar, wave); }
    {
        pg8::Gemm g{p.yr, p.wt_rwkv, NC, NC, NC}; pg8::DenseOrder S; S.init(NM / 256, ND / 256, G, bid, (size_t)256 * NC * 2, (size_t)256 * NC * 2);
        EpiRwkv E{p.mx, p.P, p.t1}; pg8::gemm_phase(lds, g, S, E, wave);
        if (PROBE == 1) { __syncthreads(); pg8::gemm_phase(lds, g, S, E, wave); } }
    xcd_barrier(bar, wave);
    {
        pg8::Gemm g{p.mx, p.wt_out, ND, ND, ND}; pg8::DenseOrder S; S.init(NM / 256, ND / 256, G, bid, (size_t)256 * ND * 2, (size_t)256 * ND * 2);
        EpiWout E{p.z1, p.x, p.mod}; pg8::gemm_phase(lds, g, S, E, wave);
        if (PROBE == 1) { __syncthreads(); pg8::gemm_phase(lds, g, S, E, wave); } }
    xcd_barrier(bar, wave);
    phase8(p, lds, wave);
    xcd_barrier(bar, wave);
    phase9(p, lds, wave);
    xcd_barrier(bar, wave);
    if (PROBE == 3) { phase9(p, lds, wave); xcd_barrier(bar, wave); }
    const int ntiles = (int)xb_ld(&p.ctl[CW_NTILES]);
    {   const int t_ = phase_tid(wave); if (t_ < MAXTILES) *(LAS unsigned*)(lds + LDS_MISC + 4 * t_) = p.ctl[CW_TILEE + t_]; }
    __syncthreads();
    {
        pg8::Gemm g{(const bf16_t*)p.xb, (const bf16_t*)p.wt_gu, ND / 2, ND / 2, ND / 2};
        MoeOrder S{G, bid, 2 * DFF / 256, ntiles, (const LAS unsigned*)(lds + LDS_MISC), (size_t)256 * ND, (size_t)(2 * DFF) * ND, (size_t)256 * ND};
        EpiGU E{p.act, p.b_gu}; pg8::gemm_phase<EpiGU, MoeOrder, true>(lds, g, S, E, wave);
        if (PROBE == 1) { __syncthreads(); pg8::gemm_phase<EpiGU, MoeOrder, true>(lds, g, S, E, wave); } }
    xcd_barrier(bar, wave);
    {
        pg8::Gemm g{(const bf16_t*)p.act, (const bf16_t*)p.wt_down, DFF / 2, DFF / 2, DFF / 2};
        MoeOrder S{G, bid, ND / 256, ntiles, (const LAS unsigned*)(lds + LDS_MISC), (size_t)256 * DFF, (size_t)ND * DFF, (size_t)256 * DFF};
        EpiDown E{p.yb, p.b_down}; pg8::gemm_phase<EpiDown, MoeOrder, true>(lds, g, S, E, wave);
        if (PROBE == 1) { __syncthreads(); pg8::gemm_phase<EpiDown, MoeOrder, true>(lds, g, S, E, wave); } }
    xcd_barrier(bar, wave);
    phase13(p, wave);
    if (PROBE == 3) { xcd_barrier(bar, wave); phase13(p, wave); }
}

static inline size_t align_up(size_t v, size_t a) { return (v + a - 1) / a * a; }

extern "C" void kernel_launch(void* const* d_in, const int* in_sizes, int n_in, void* d_out, int out_size, void* d_ws, size_t ws_size, hipStream_t stream) {
    (void)in_sizes; (void)n_in; (void)out_size;
    Params p{};
    const float** ins = (const float**)&p;
    for (int i = 0; i < 30; ++i) ins[i] = (const float*)d_in[i];
    p.out = (float*)d_out;
    char* ws = (char*)d_ws; size_t off = 0;
    auto take = [&](size_t bytes) { char* r = ws + off; off = align_up(off + bytes, 4096); return r; };
    const size_t ctl_bytes = (size_t)(XCD_BAR_WORDS + CTL_WORDS) * 4;
    p.bar = (unsigned*)take(ctl_bytes); p.ctl = p.bar + XCD_BAR_WORDS;
    p.modp = (float*)take((size_t)KS_MOD * 4 * NMOD * 4); p.mod = (float*)take((size_t)NB * NMOD * 4);
    p.hb = (bf16_t*)take((size_t)NM * ND * 2);
    p.wt_in = (bf16_t*)take((size_t)NINP * ND * 2); p.wt_rwkv = (bf16_t*)take((size_t)ND * NC * 2); p.wt_pool = (bf16_t*)take((size_t)ND * 256 * 2);
    p.wt_out = (bf16_t*)take((size_t)ND * ND * 2); p.bt_lora = (bf16_t*)take((size_t)LORA_N * LORA_K * 2);
    p.wt_gu = (fp8_t*)take((size_t)NE * 2 * DFF * ND); p.wt_down = (fp8_t*)take((size_t)NE * ND * DFF);
    p.P = (bf16_t*)take((size_t)NM * NINP * 2); p.a_lora = (bf16_t*)take((size_t)NM * LORA_K * 2); p.dp = (bf16_t*)take((size_t)NM * NC * 2);
    p.dec = (float*)take((size_t)NM * NC * 4); p.iclr = (bf16_t*)take((size_t)NM * NC * 2); p.gg = (bf16_t*)take((size_t)NM * NC * 2); p.t1 = (bf16_t*)take((size_t)NM * ND * 2);
    p.yr = (bf16_t*)take((size_t)NM * NC * 2); p.mx = (bf16_t*)take((size_t)NM * ND * 2); p.z1 = (float*)take((size_t)NM * ND * 4); p.lnst = (float*)take((size_t)NM * 2 * 4);
    p.h2 = (fp8_t*)take((size_t)NM * ND);
    p.sel = (int*)take((size_t)NM * TOPK * 4); p.rnk = (int*)take((size_t)NM * TOPK * 4); p.prob = (float*)take((size_t)NM * TOPK * 4); p.dest = (int*)take((size_t)NM * TOPK * 4);
    p.xb = (fp8_t*)take((size_t)MP * ND); p.act = (fp8_t*)take((size_t)MP * DFF); p.yb = (bf16_t*)take((size_t)MP * ND * 2);
    if (off > ws_size) { fprintf(stderr, "kernel_launch: workspace too small (%zu > %zu)\n", off, ws_size); return; }

    static int grid = 0;
    if (!grid) {
        int dev = 0, cus = 0, per_cu = 0;
        hipGetDevice(&dev); hipDeviceGetAttribute(&cus, hipDeviceAttributeMultiprocessorCount, dev);
        hipFuncSetAttribute((const void*)fwd, hipFuncAttributeMaxDynamicSharedMemorySize, LDS_BYTES);
        hipOccupancyMaxActiveBlocksPerMultiprocessor(&per_cu, (const void*)fwd, NTHREADS, LDS_BYTES);
        if (per_cu < 1) fprintf(stderr, "kernel_launch: occupancy query reports %d workgroups per CU\n", per_cu);
        if (cus != 256) fprintf(stderr, "kernel_launch: %d CUs; this kernel is laid out for 256\n", cus);
        grid = 256;
    }
    hipMemsetAsync(p.bar, 0, ctl_bytes, stream);
    hipLaunchKernelGGL(fwd, dim3(grid), dim3(NTHREADS), LDS_BYTES, stream, p);
}
```

```cpp
#include <hip/hip_runtime.h>
#include <cstdio>
#include <cstdint>

#ifndef PROBE
#define PROBE 0
#endif
#define LAS __attribute__((address_space(3)))
typedef unsigned short bf16_t;
typedef short bf16x8 __attribute__((ext_vector_type(8)));
typedef float f32x4 __attribute__((ext_vector_type(4)));
typedef float f32x2 __attribute__((ext_vector_type(2)));
typedef unsigned u32x4 __attribute__((ext_vector_type(4)));
typedef unsigned u32x2 __attribute__((ext_vector_type(2)));
typedef int i32x4 __attribute__((ext_vector_type(4)));
typedef int i32x8 __attribute__((ext_vector_type(8)));
typedef unsigned char fp8_t;
constexpr float W8_SCALE = 64.0f, W8_INV = 1.0f / 64.0f;

constexpr int NB = 4, NT = 2048, NM = NB * NT, ND = 2048, NC = 1024, NH = 16, HS = 64;
constexpr int NSHIFT = 3360, NIN = 8480, NINP = 8704;
constexpr int OFF_R = 0, OFF_K = 1024, OFF_V = 2048, OFF_WD = 3072, OFF_AD = 3136, OFF_GD = 3200, OFF_POOL = 3360, OFF_GA = 4384, OFF_GB = 6432;
constexpr int NE = 32, TOPK = 4, DFF = 2048;
constexpr int LORA_K = 384, LORA_N = 3072;
constexpr int MAXTILES = 160, MP = MAXTILES * 256;
constexpr int NMOD = 6 * ND;
constexpr int KS_MOD = 32;
constexpr float LN_EPS = 1e-5f, GN_EPS = 64e-5f;
constexpr float DN_ALPHA = 1.189207115002721f;
constexpr float SW_LIMIT = 7.0f, SW_ALPHA = 1.702f;
constexpr int NWAVES = 8, NTHREADS = 512;
constexpr int LDS_BYTES = 147456;
constexpr int LDS_BARW = LDS_BYTES - 16;
constexpr int LDS_MISC = 131072;

constexpr int CW_CNT = 0;
constexpr int CW_CONV = 64 * 32;
constexpr int CW_CONV2 = 64 * 32 + 32;
constexpr int CW_NTILES = 64 * 33;
constexpr int CW_TILEE = 64 * 34;
constexpr int CTL_WORDS = 64 * 34 + 256;

#define XB_TMO      128
#define XB_XCNT(j)  (256  + 64 * (j))
#define XB_XSUB(j)  (1280 + 64 * (j))
#define XB_XGEN(j)  (2304 + 64 * (j))
#define XB_TOP      3328
#define XB_TOPGEN   3392
#define XCD_BAR_WORDS 3456
#define XB_SPIN_CAP (1u << 18)

__device__ __forceinline__ unsigned xb_ld(unsigned* p)              { return __hip_atomic_load(p, __ATOMIC_RELAXED, __HIP_MEMORY_SCOPE_AGENT); }
__device__ __forceinline__ unsigned xb_add(unsigned* p, unsigned v) { return __hip_atomic_fetch_add(p, v, __ATOMIC_RELAXED, __HIP_MEMORY_SCOPE_AGENT); }
__device__ __forceinline__ unsigned xb_xcc_id() { return (unsigned)__builtin_amdgcn_s_getreg((3 << 11) | 20) & 0xFu; }
#define XB_SPIN(cond, bar) do { unsigned _sp = 0; while (cond) { __builtin_amdgcn_s_sleep(1); \
    if ((++_sp & 255u) == 0u) { if (xb_ld(&(bar)[XB_TMO])) break; if (_sp > XB_SPIN_CAP) { atomicAdd(&(bar)[XB_TMO], 1u); break; } } } } while (0)

__device__ __forceinline__ int phase_tid(int wave);
struct XcdBarrier { unsigned* bar; unsigned x; volatile LAS unsigned* st; };

__device__ __forceinline__ XcdBarrier xcd_barrier_post(unsigned* bar, volatile LAS unsigned* st) {
    XcdBarrier b; b.bar = bar; b.x = xb_xcc_id(); b.st = st;
    if (threadIdx.x == 0) (void)xb_add(&bar[XB_XCNT(b.x)], 1u);
    return b;
}
__device__ __forceinline__ void xcd_barrier_complete(unsigned* bar, unsigned x, unsigned& nloc, unsigned& nx) {
    const unsigned G = gridDim.x * gridDim.y * gridDim.z;
    unsigned sum, cnt, mine, sp = 0u;
    for (;;) {
        sum = 0u; cnt = 0u; mine = 0u;
#pragma unroll
        for (unsigned j = 0; j < 16; ++j) { const unsigned c = xb_ld(&bar[XB_XCNT(j)]); sum += c; cnt += (c > 0u) ? 1u : 0u; mine = (j == x) ? c : mine; }
        if (sum == G) break;
        __builtin_amdgcn_s_sleep(1);
        if ((++sp & 255u) == 0u) { if (xb_ld(&bar[XB_TMO])) break; if (sp > XB_SPIN_CAP) { atomicAdd(&bar[XB_TMO], 1u); break; } }
    }
    nloc = mine > 0u ? mine : 1u; nx = cnt > 0u ? cnt : 1u;
}
__device__ __forceinline__ void xcd_barrier(const XcdBarrier& b, const int wave) {
    asm volatile("s_waitcnt vmcnt(0)" ::: "memory");
    __syncthreads();
    if (phase_tid(wave) == 0) {
        unsigned* bar = b.bar;
        __builtin_amdgcn_s_waitcnt(0);
        unsigned nloc = b.st[0], nx = b.st[1];
        if (nloc == 0u) { xcd_barrier_complete(bar, b.x, nloc, nx); b.st[0] = nloc; b.st[1] = nx; }
        const unsigned old = xb_add(&bar[XB_XSUB(b.x)], 1u);
        const unsigned gen = old / nloc;
        if (old + 1u == (gen + 1u) * nloc) {
            __builtin_amdgcn_fence(__ATOMIC_RELEASE, "agent");
            asm volatile("s_waitcnt vmcnt(0)" ::: "memory");
            const unsigned og = xb_add(&bar[XB_TOP], 1u);
            const unsigned tg = og / nx;
            if (og + 1u == (tg + 1u) * nx) xb_add(&bar[XB_TOPGEN], 1u);
            else XB_SPIN(xb_ld(&bar[XB_TOPGEN]) == tg, bar);
            __builtin_amdgcn_fence(__ATOMIC_ACQUIRE, "agent");
            xb_add(&bar[XB_XGEN(b.x)], 1u);
            asm volatile("s_waitcnt vmcnt(0)" ::: "memory");
        } else {
            XB_SPIN(xb_ld(&bar[XB_XGEN(b.x)]) == gen, bar);
            __builtin_amdgcn_fence(__ATOMIC_ACQUIRE, "agent");
            asm volatile("s_waitcnt vmcnt(0)" ::: "memory");
        }
    }
    __syncthreads();
}

__device__ __forceinline__ int phase_tid(int wave) {
    int lane; asm volatile("v_mbcnt_lo_u32_b32 %0, -1, 0\n\tv_mbcnt_hi_u32_b32 %0, -1, %0" : "=v"(lane));
    return wave * 64 + lane;
}
typedef __bf16 bf16x2_t __attribute__((ext_vector_type(2)));
__device__ __forceinline__ unsigned cvt_pk_bf16(float lo, float hi) { return __builtin_bit_cast(unsigned, __builtin_convertvector((f32x2){lo, hi}, bf16x2_t)); }
template <int CTRL> __device__ __forceinline__ float dpp_f(float x) {
    return __builtin_bit_cast(float, __builtin_amdgcn_update_dpp(0, __builtin_bit_cast(int, x), CTRL, 0xf, 0xf, false));
}
__device__ __forceinline__ float row16_allsum(float x) {
    x += dpp_f<0x128>(x); x += dpp_f<0x124>(x); x += dpp_f<0x122>(x); x += dpp_f<0x121>(x); return x;
}
__device__ __forceinline__ float wave_allsum(float x) {
    x = row16_allsum(x);
    const int xi = __builtin_bit_cast(int, x);
    return (__builtin_bit_cast(float, __builtin_amdgcn_readlane(xi, 0)) + __builtin_bit_cast(float, __builtin_amdgcn_readlane(xi, 16))) +
           (__builtin_bit_cast(float, __builtin_amdgcn_readlane(xi, 32)) + __builtin_bit_cast(float, __builtin_amdgcn_readlane(xi, 48)));
}
__device__ __forceinline__ unsigned pack4_fp8(float a, float b, float c, float d) { int r = 0; r = __builtin_amdgcn_cvt_pk_fp8_f32(a, b, r, false); r = __builtin_amdgcn_cvt_pk_fp8_f32(c, d, r, true); return (unsigned)r; }
__device__ __forceinline__ f32x2 bf2_unpack(unsigned u) { return (f32x2){__uint_as_float(u << 16), __uint_as_float(u & 0xffff0000u)}; }
__device__ __forceinline__ f32x4 bf4_unpack(u32x2 u) { const f32x2 a = bf2_unpack(u.x), b = bf2_unpack(u.y); return (f32x4){a[0], a[1], b[0], b[1]}; }
__device__ __forceinline__ float bf1(bf16_t h) { return __uint_as_float(((unsigned)h) << 16); }
__device__ __forceinline__ float sigmoidf_(float v) { return __builtin_amdgcn_rcpf(1.0f + __builtin_amdgcn_exp2f(v * -1.4426950408889634f)); }
__device__ __forceinline__ f32x4 ld4(const float* p) { return *(const f32x4*)p; }
__device__ __forceinline__ f32x4 ld4nt(const float* p) { return __builtin_nontemporal_load((const f32x4*)p); }
__device__ __forceinline__ u32x4 ldu4nt(const void* p) { return __builtin_nontemporal_load((const u32x4*)p); }
__device__ __forceinline__ float dot4(f32x4 a, f32x4 b) { return (a[0] * b[0] + a[1] * b[1]) + (a[2] * b[2] + a[3] * b[3]); }

struct Params {
    const float *x, *c, *w_ada, *b_ada, *w_in, *mu_shift, *w0, *w_decay_up, *a0, *w_iclr_up, *w_glora_up, *k_k, *k_a, *r_k, *lnx_g, *lnx_b,
                *w_rwkv_out, *w_pool, *pool_scale, *w_out, *ln1_g, *ln1_b, *w_router, *b_router, *w_gu, *b_gu, *w_down, *b_down, *ln2_g, *ln2_b;
    float* out;
    unsigned* bar; unsigned* ctl;
    float* modp; float* mod;
    bf16_t* hb; bf16_t* wt_in; bf16_t* wt_rwkv; bf16_t* wt_pool; bf16_t* wt_out; bf16_t* bt_lora; fp8_t* wt_gu; fp8_t* wt_down;
    bf16_t* P; bf16_t* a_lora; bf16_t* dp; float* dec; bf16_t* iclr; bf16_t* gg; bf16_t* t1;
    bf16_t* yr; bf16_t* mx; float* z1; float* lnst; fp8_t* h2;
    int* sel; int* rnk; float* prob; int* dest;
    fp8_t* xb; fp8_t* act; bf16_t* yb;
};

namespace pg8 {
constexpr int BM = 256, BK = 64, HALF = 128, HTB = HALF * BK * 2, STAGE_BYTES = 8 * HTB, NXCD = 8, WGM = 8;
__host__ __device__ __forceinline__ int lds_byte(int r, int c) { const int st = (r >> 4) * 2 + (c >> 5), rr = r & 15, cc = c & 31, ob = rr * 64 + cc * 2; return st * 1024 + (ob ^ (((ob >> 9) & 1) << 5)); }
__host__ __device__ __forceinline__ void stage_rc(int b, int& R, int& C) { const int st = b / 1024, sb = b % 1024, swz = sb ^ (((sb >> 9) & 1) << 5); R = (st >> 1) * 16 + swz / 64; C = (st & 1) * 32 + (swz % 64) / 2; }
__host__ __device__ __forceinline__ int perm32(int rho) { const int n = rho >> 4, i = rho & 15; return 8 * (i >> 2) + 4 * n + (i & 3); }

struct Unit { int pm, pn, e; unsigned aoff, boff; };
struct Gemm { const bf16_t* A; const bf16_t* Bt; int lda, ldb, K; };

struct DenseOrder {
    int nM, nN, nwg, G, c, skip_from = 1 << 30, skip_n = 0; size_t a_tile, b_tile;
    __device__ void init(int nM_, int nN_, int G_, int c_, size_t a_tile_, size_t b_tile_) { nM = nM_; nN = nN_; nwg = nM * nN; G = G_; c = c_; a_tile = a_tile_; b_tile = b_tile_; }
    __device__ bool next(int i, Unit& u) const {
        const long L = (long)i * G + c; if (c < 0 || L >= nwg) return false;
        int wgid = (int)L; { const int q = nwg / NXCD, r = nwg % NXCD, xcd = wgid % NXCD, off = wgid / NXCD; wgid = (xcd < r ? xcd * (q + 1) : r * (q + 1) + (xcd - r) * q) + off; }
        const int nig = WGM * nN, gid = wgid / nig, fm = gid * WGM, gsz = (nM - fm) < WGM ? (nM - fm) : WGM;
        u.pm = fm + ((wgid % nig) % gsz); u.pn = (wgid % nig) / gsz; u.e = 0; if (u.pn >= skip_from) u.pn += skip_n;
        u.aoff = (unsigned)((size_t)u.pm * a_tile); u.boff = (unsigned)((size_t)u.pn * b_tile); return true;
    }
};

template <class Epi, class Sched, bool FP8 = false>
__device__ __forceinline__ void gemm_phase(LAS unsigned char* lds, const Gemm g, const Sched& S, const Epi& E, const int wave) {
    const int tid = phase_tid(wave);
    const int wid = __builtin_amdgcn_readfirstlane(tid >> 6), lane = tid & 63, wr = wid >> 2, wc = wid & 3, fr = lane & 15, fq = lane >> 4;
    const int K = g.K, nt = K / BK;
    unsigned voffA[2], voffB[2];
#pragma unroll
    for (int i = 0; i < 2; ++i) { int R, C; stage_rc(tid * 16 + i * 8192, R, C); const int Rb = Epi::PERM ? ((R & ~31) + perm32(R & 31)) : R;
        voffA[i] = (unsigned)(R * g.lda + C) * 2u; voffB[i] = (unsigned)(Rb * g.ldb + C) * 2u; }
    const unsigned kstep = (unsigned)(BK * 2);
    const unsigned hstepA = (unsigned)HALF * g.lda * 2u, hstepB = (unsigned)HALF * g.ldb * 2u;
    const __amdgpu_buffer_rsrc_t rsA = __builtin_amdgcn_make_buffer_rsrc((void*)g.A, (short)0, -1, 0x00020000), rsB = __builtin_amdgcn_make_buffer_rsrc((void*)g.Bt, (short)0, -1, 0x00020000);
    const unsigned ldsw = (unsigned)wid * 1024u;
    const int aoff = lds_byte(wr * 64 + fr, fq * 8), boff = lds_byte(wc * 32 + fr, fq * 8);
#define PG8_SA(b, h) (((b) * 2 + (h)) * HTB)
#define PG8_SB(b, h) ((4 + (b) * 2 + (h)) * HTB)
#define PG8_STAGE(bufoff, rs, soff, voff) do { _Pragma("unroll") for (int _i = 0; _i < 2; ++_i) \
        __builtin_amdgcn_raw_ptr_buffer_load_lds(rs, (LAS void*)(lds + (bufoff) + ldsw + _i * 8192), 16, (voff)[_i], (soff), 0, 0); } while (0)
#define PG8_LDA(dst, b, h) do { _Pragma("unroll") for (int m = 0; m < 4; ++m) _Pragma("unroll") for (int k = 0; k < 2; ++k) dst[m][k] = *(const LAS bf16x8*)(lds + PG8_SA(b, h) + aoff + m * 2048 + k * 1024); } while (0)
#define PG8_LDB(dst, b, h) do { _Pragma("unroll") for (int n = 0; n < 2; ++n) _Pragma("unroll") for (int k = 0; k < 2; ++k) dst[n][k] = *(const LAS bf16x8*)(lds + PG8_SB(b, h) + boff + n * 2048 + k * 1024); } while (0)
#define PG8_CAT(x) __builtin_shufflevector(__builtin_bit_cast(i32x4, (x)[0]), __builtin_bit_cast(i32x4, (x)[1]), 0, 1, 2, 3, 4, 5, 6, 7)
#define PG8_MMA(ai, bj, At, Bt) do { __builtin_amdgcn_s_setprio(1); \
        if constexpr (FP8) { _Pragma("unroll") for (int m = 0; m < 4; ++m) _Pragma("unroll") for (int n = 0; n < 2; ++n) \
            acc[ai][bj][m][n] = __builtin_amdgcn_mfma_scale_f32_16x16x128_f8f6f4(PG8_CAT(Bt[n]), PG8_CAT(At[m]), acc[ai][bj][m][n], 0, 0, 0, 0x7F7F7F7F, 0, 0x7F7F7F7F); } \
        else { _Pragma("unroll") for (int m = 0; m < 4; ++m) _Pragma("unroll") for (int n = 0; n < 2; ++n) _Pragma("unroll") for (int k = 0; k < 2; ++k) \
            acc[ai][bj][m][n] = __builtin_amdgcn_mfma_f32_16x16x32_bf16(Bt[n][k], At[m][k], acc[ai][bj][m][n], 0, 0, 0); } \
        __builtin_amdgcn_s_setprio(0); } while (0)
#define PG8_WAIT_V(n) asm volatile("s_waitcnt vmcnt(" #n ")" ::: "memory")
#define PG8_WAIT_L(n) asm volatile("s_waitcnt lgkmcnt(" #n ")" ::: "memory")
#define PG8_BAR __builtin_amdgcn_s_barrier()
#define PG8_SCHED __builtin_amdgcn_sched_barrier(0)
    Unit cur, nxt; int ui = 0;
    if (!S.next(0, cur)) return;
    f32x4 acc[2][2][4][2];
#pragma unroll
    for (int a = 0; a < 2; ++a)
#pragma unroll
        for (int b = 0; b < 2; ++b)
#pragma unroll
            for (int m = 0; m < 4; ++m)
#pragma unroll
                for (int n = 0; n < 2; ++n) acc[a][b][m][n] = (f32x4){0.f, 0.f, 0.f, 0.f};
    bf16x8 At[4][2], B0[2][2], B1[2][2];
    unsigned cA = cur.aoff, cB = cur.boff;
    PG8_STAGE(PG8_SB(0, 0), rsB, cB, voffB); PG8_STAGE(PG8_SA(0, 0), rsA, cA, voffA); PG8_STAGE(PG8_SB(0, 1), rsB, cB + hstepB, voffB); PG8_STAGE(PG8_SA(0, 1), rsA, cA + hstepA, voffA);
    if (wr == 1) PG8_BAR;
    PG8_WAIT_V(4); PG8_BAR;
    PG8_STAGE(PG8_SB(1, 0), rsB, cB + kstep, voffB); PG8_STAGE(PG8_SA(1, 0), rsA, cA + kstep, voffA); PG8_STAGE(PG8_SB(1, 1), rsB, cB + hstepB + kstep, voffB);
    PG8_WAIT_V(6); PG8_BAR;
    for (;;) {
        const bool has_next = S.next(ui + 1, nxt);
        const unsigned nA = has_next ? nxt.aoff : cA, nB = has_next ? nxt.boff : cB;
        for (int t = 0; t < nt; t += 2) {
            const bool last = (t == nt - 2);
            const unsigned a1 = cA + (unsigned)(t + 1) * kstep;
            const unsigned a2 = last ? nA : cA + (unsigned)(t + 2) * kstep, b2 = last ? nB : cB + (unsigned)(t + 2) * kstep;
            const unsigned a3 = a2 + kstep, b3 = b2 + kstep;
            PG8_LDB(B0, 0, 0); PG8_SCHED; PG8_LDA(At, 0, 0); PG8_STAGE(PG8_SA(1, 1), rsA, a1 + hstepA, voffA);
            PG8_WAIT_L(8); PG8_BAR; PG8_WAIT_L(0); PG8_MMA(0, 0, At, B0); PG8_BAR; PG8_SCHED;
            PG8_LDB(B1, 0, 1); PG8_STAGE(PG8_SB(0, 0), rsB, b2, voffB);
            PG8_BAR; PG8_WAIT_L(0); PG8_MMA(0, 1, At, B1); PG8_BAR;
            PG8_LDA(At, 0, 1); PG8_STAGE(PG8_SA(0, 0), rsA, a2, voffA);
            PG8_BAR; PG8_WAIT_L(0); PG8_MMA(1, 0, At, B0); PG8_BAR; PG8_SCHED;
            PG8_STAGE(PG8_SB(0, 1), rsB, b2 + hstepB, voffB);
            PG8_WAIT_V(6); PG8_BAR; PG8_MMA(1, 1, At, B1); PG8_BAR;
            PG8_LDB(B0, 1, 0); PG8_SCHED; PG8_LDA(At, 1, 0); PG8_STAGE(PG8_SA(0, 1), rsA, a2 + hstepA, voffA);
            PG8_WAIT_L(8); PG8_BAR; PG8_WAIT_L(0); PG8_MMA(0, 0, At, B0); PG8_BAR; PG8_SCHED;
            PG8_LDB(B1, 1, 1); PG8_STAGE(PG8_SB(1, 0), rsB, b3, voffB);
            PG8_BAR; PG8_WAIT_L(0); PG8_MMA(0, 1, At, B1); PG8_BAR;
            PG8_LDA(At, 1, 1); PG8_STAGE(PG8_SA(1, 0), rsA, a3, voffA);
            PG8_BAR; PG8_WAIT_L(0); PG8_MMA(1, 0, At, B0); PG8_BAR; PG8_SCHED;
            PG8_STAGE(PG8_SB(1, 1), rsB, b3 + hstepB, voffB);
            PG8_WAIT_V(6); PG8_BAR; PG8_MMA(1, 1, At, B1); PG8_BAR;
        }
        { const int l2 = phase_tid(wave) & 63; E(acc, cur, wr, wc, l2 & 15, l2 >> 4); }
        if (!has_next) break;
#pragma unroll
        for (int a = 0; a < 2; ++a)
#pragma unroll
            for (int b = 0; b < 2; ++b)
#pragma unroll
                for (int m = 0; m < 4; ++m)
#pragma unroll
                    for (int n = 0; n < 2; ++n) acc[a][b][m][n] = (f32x4){0.f, 0.f, 0.f, 0.f};
        cur = nxt; cA = nA; cB = nB; ++ui;
    }
    PG8_WAIT_V(0);
    if (wr == 0) PG8_BAR;
    PG8_BAR;
#undef PG8_SA
#undef PG8_SB
#undef PG8_STAGE
#undef PG8_LDA
#undef PG8_LDB
#undef PG8_MMA
#undef PG8_CAT
#undef PG8_WAIT_V
#undef PG8_WAIT_L
#undef PG8_BAR
#undef PG8_SCHED
}
}
using pg8::Unit;

#define EPI_LOOP_BEGIN \
    _Pragma("unroll") for (int ai = 0; ai < 2; ++ai) _Pragma("unroll") for (int m = 0; m < 4; ++m) { const int r = u.pm * 256 + ai * 128 + wr * 64 + m * 16 + fr; \
    _Pragma("unroll") for (int bj = 0; bj < 2; ++bj) _Pragma("unroll") for (int n = 0; n < 2; ++n) { const int cl = bj * 128 + wc * 32 + 16 * n + 4 * fq; const f32x4 a = acc[ai][bj][m][n];
#define EPI_LOOP_END } }

struct EpiP {
    static constexpr bool PERM = true; bf16_t* C;
    __device__ __forceinline__ void operator()(const f32x4 (&acc)[2][2][4][2], const Unit& u, int wr, int wc, int fr, int fq) const {
#pragma unroll
        for (int ai = 0; ai < 2; ++ai)
#pragma unroll
            for (int m = 0; m < 4; ++m) { const int r = u.pm * 256 + ai * 128 + wr * 64 + m * 16 + fr;
#pragma unroll
                for (int bj = 0; bj < 2; ++bj) { const int c0 = u.pn * 256 + bj * 128 + wc * 32 + 8 * fq; const f32x4 v0 = acc[ai][bj][m][0], v1 = acc[ai][bj][m][1];
                    u32x4 w; w.x = cvt_pk_bf16(v0[0], v0[1]); w.y = cvt_pk_bf16(v0[2], v0[3]); w.z = cvt_pk_bf16(v1[0], v1[1]); w.w = cvt_pk_bf16(v1[2], v1[3]);
                    *(u32x4*)(C + (size_t)r * NINP + c0) = w; } }
    }
};
#define EPI_COLS(ptr) f32x4 cv[2][2]; _Pragma("unroll") for (int bj = 0; bj < 2; ++bj) _Pragma("unroll") for (int n = 0; n < 2; ++n) cv[bj][n] = ld4((ptr) + bj * 128 + wc * 32 + 16 * n + 4 * fq);
#define EPI_COLS_PERM(ptr) f32x4 cv[2][2]; _Pragma("unroll") for (int bj = 0; bj < 2; ++bj) _Pragma("unroll") for (int n = 0; n < 2; ++n) cv[bj][n] = ld4((ptr) + bj * 128 + wc * 32 + 8 * fq + 4 * n);
struct EpiLora {
    static constexpr bool PERM = false; float* dec; bf16_t *iclr, *gg; const float *w0, *a0;
    __device__ __forceinline__ void operator()(const f32x4 (&acc)[2][2][4][2], const Unit& u, int wr, int wc, int fr, int fq) const {
        const int sect = u.pn >> 2, cb = (u.pn & 3) * 256;
        EPI_COLS((sect == 0 ? w0 : a0) + cb)
        EPI_LOOP_BEGIN
            const int c = cb + cl; f32x4 o;
            if (sect == 0) {
#pragma unroll
                for (int j = 0; j < 4; ++j) o[j] = __builtin_amdgcn_exp2f(-0.6065306597126334f * 1.4426950408889634f * sigmoidf_(cv[bj][n][j] + a[j]));
                *(f32x4*)(dec + (size_t)r * NC + c) = o; }
            else if (sect == 1) {
#pragma unroll
                for (int j = 0; j < 4; ++j) o[j] = sigmoidf_(cv[bj][n][j] + a[j]);
                u32x2 wv; wv.x = cvt_pk_bf16(o[0], o[1]); wv.y = cvt_pk_bf16(o[2], o[3]); *(u32x2*)(iclr + (size_t)r * NC + c) = wv; }
            else { u32x2 wv; wv.x = cvt_pk_bf16(a[0], a[1]); wv.y = cvt_pk_bf16(a[2], a[3]); *(u32x2*)(gg + (size_t)r * NC + c) = wv; }
        EPI_LOOP_END
    }
};
struct EpiPool {
    static constexpr bool PERM = true; bf16_t* t1; const bf16_t* P; const float* pscale;
    __device__ __forceinline__ void operator()(const f32x4 (&acc)[2][2][4][2], const Unit& u, int wr, int wc, int fr, int fq) const {
        EPI_COLS_PERM(pscale + u.pn * 256)
#pragma unroll
        for (int ai = 0; ai < 2; ++ai) { u32x4 gq[4][2];
#pragma unroll
            for (int m = 0; m < 4; ++m)
#pragma unroll
                for (int bj = 0; bj < 2; ++bj) gq[m][bj] = ldu4nt(P + (size_t)(u.pm * 256 + ai * 128 + wr * 64 + m * 16 + fr) * NINP + OFF_GB + u.pn * 256 + bj * 128 + wc * 32 + 8 * fq);
#pragma unroll
            for (int m = 0; m < 4; ++m) { const int r = u.pm * 256 + ai * 128 + wr * 64 + m * 16 + fr;
#pragma unroll
                for (int bj = 0; bj < 2; ++bj) { const int c0 = u.pn * 256 + bj * 128 + wc * 32 + 8 * fq;
                    const f32x4 g0 = bf4_unpack((u32x2){gq[m][bj].x, gq[m][bj].y}), g1 = bf4_unpack((u32x2){gq[m][bj].z, gq[m][bj].w}), a0 = acc[ai][bj][m][0], a1 = acc[ai][bj][m][1]; f32x4 o0, o1;
#pragma unroll
                    for (int j = 0; j < 4; ++j) { o0[j] = sigmoidf_(g0[j]) * cv[bj][0][j] * a0[j]; o1[j] = sigmoidf_(g1[j]) * cv[bj][1][j] * a1[j]; }
                    u32x4 w; w.x = cvt_pk_bf16(o0[0], o0[1]); w.y = cvt_pk_bf16(o0[2], o0[3]); w.z = cvt_pk_bf16(o1[0], o1[1]); w.w = cvt_pk_bf16(o1[2], o1[3]);
                    *(u32x4*)(t1 + (size_t)r * ND + c0) = w; } } }
    }
};
struct EpiRwkv {
    static constexpr bool PERM = true; bf16_t* mx; const bf16_t* P; const bf16_t* t1;
    __device__ __forceinline__ void operator()(const f32x4 (&acc)[2][2][4][2], const Unit& u, int wr, int wc, int fr, int fq) const {
#pragma unroll
        for (int ai = 0; ai < 2; ++ai) { u32x4 gq[4][2], tq[4][2];
#pragma unroll
            for (int m = 0; m < 4; ++m)
#pragma unroll
                for (int bj = 0; bj < 2; ++bj) { const int r = u.pm * 256 + ai * 128 + wr * 64 + m * 16 + fr, c0 = u.pn * 256 + bj * 128 + wc * 32 + 8 * fq;
                    gq[m][bj] = ldu4nt(P + (size_t)r * NINP + OFF_GA + c0); tq[m][bj] = ldu4nt(t1 + (size_t)r * ND + c0); }
#pragma unroll
            for (int m = 0; m < 4; ++m) { const int r = u.pm * 256 + ai * 128 + wr * 64 + m * 16 + fr;
#pragma unroll
                for (int bj = 0; bj < 2; ++bj) { const int c0 = u.pn * 256 + bj * 128 + wc * 32 + 8 * fq;
                    const f32x4 g0 = bf4_unpack((u32x2){gq[m][bj].x, gq[m][bj].y}), g1 = bf4_unpack((u32x2){gq[m][bj].z, gq[m][bj].w});
                    const f32x4 t0 = bf4_unpack((u32x2){tq[m][bj].x, tq[m][bj].y}), t1v = bf4_unpack((u32x2){tq[m][bj].z, tq[m][bj].w}), a0 = acc[ai][bj][m][0], a1 = acc[ai][bj][m][1]; f32x4 o0, o1;
#pragma unroll
                    for (int j = 0; j < 4; ++j) { o0[j] = sigmoidf_(g0[j]) * a0[j] + t0[j]; o1[j] = sigmoidf_(g1[j]) * a1[j] + t1v[j]; }
                    u32x4 w; w.x = cvt_pk_bf16(o0[0], o0[1]); w.y = cvt_pk_bf16(o0[2], o0[3]); w.z = cvt_pk_bf16(o1[0], o1[1]); w.w = cvt_pk_bf16(o1[2], o1[3]);
                    *(u32x4*)(mx + (size_t)r * ND + c0) = w; } } }
    }
};
struct EpiWout {
    static constexpr bool PERM = true; float* z1; const float* x; const float* mod;
    __device__ __forceinline__ void operator()(const f32x4 (&acc)[2][2][4][2], const Unit& u, int wr, int wc, int fr, int fq) const {
        const int b = u.pm >> 3;
        EPI_COLS_PERM(mod + (size_t)b * NMOD + 2 * ND + u.pn * 256)
#pragma unroll
        for (int ai = 0; ai < 2; ++ai)
#pragma unroll
            for (int mh = 0; mh < 2; ++mh) { f32x4 xq[2][2][2];
#pragma unroll
                for (int m2 = 0; m2 < 2; ++m2)
#pragma unroll
                    for (int bj = 0; bj < 2; ++bj)
#pragma unroll
                        for (int n = 0; n < 2; ++n) xq[m2][bj][n] = ld4nt(x + (size_t)(u.pm * 256 + ai * 128 + wr * 64 + (mh * 2 + m2) * 16 + fr) * ND + u.pn * 256 + bj * 128 + wc * 32 + 8 * fq + 4 * n);
#pragma unroll
                for (int m2 = 0; m2 < 2; ++m2) { const int m = mh * 2 + m2, r = u.pm * 256 + ai * 128 + wr * 64 + m * 16 + fr;
#pragma unroll
                    for (int bj = 0; bj < 2; ++bj)
#pragma unroll
                        for (int n = 0; n < 2; ++n) { const int c = u.pn * 256 + bj * 128 + wc * 32 + 8 * fq + 4 * n;
                            *(f32x4*)(z1 + (size_t)r * ND + c) = xq[m2][bj][n] * DN_ALPHA + cv[bj][n] * acc[ai][bj][m][n]; } } }
    }
};
struct EpiGU {
    static constexpr bool PERM = true; fp8_t* act; const float* b_gu;
    __device__ __forceinline__ void operator()(const f32x4 (&acc)[2][2][4][2], const Unit& u, int wr, int wc, int fr, int fq) const {
        const float* bias = b_gu + (size_t)u.e * (2 * DFF) + u.pn * 256 + wc * 32 + 8 * fq;
#pragma unroll
        for (int bj = 0; bj < 2; ++bj) { const f32x4 c0v = ld4(bias + bj * 128), c1v = ld4(bias + bj * 128 + 4); const int c0 = u.pn * 256 + bj * 128 + wc * 32 + 8 * fq;
#pragma unroll
            for (int ai = 0; ai < 2; ++ai)
#pragma unroll
                for (int m = 0; m < 4; ++m) { const int r = u.pm * 256 + ai * 128 + wr * 64 + m * 16 + fr;
                    const f32x4 v0 = acc[ai][bj][m][0] * W8_INV + c0v, v1 = acc[ai][bj][m][1] * W8_INV + c1v;
                    float o[4];
#pragma unroll
                    for (int j = 0; j < 4; ++j) { const float gt = fminf(j < 2 ? v0[2 * j] : v1[2 * j - 4], SW_LIMIT); const float up = fminf(fmaxf(j < 2 ? v0[2 * j + 1] : v1[2 * j - 3], -SW_LIMIT), SW_LIMIT);
                        o[j] = (up + 1.0f) * (gt * __builtin_amdgcn_rcpf(1.0f + __builtin_amdgcn_exp2f(gt * (-SW_ALPHA * 1.4426950408889634f)))); }
                    *(unsigned*)(act + (size_t)r * DFF + (c0 >> 1)) = pack4_fp8(o[0], o[1], o[2], o[3]); } }
    }
};
struct EpiDown {
    static constexpr bool PERM = true; bf16_t* yb; const float* b_down;
    __device__ __forceinline__ void operator()(const f32x4 (&acc)[2][2][4][2], const Unit& u, int wr, int wc, int fr, int fq) const {
        const float* bias = b_down + (size_t)u.e * ND + u.pn * 256 + wc * 32 + 8 * fq;
#pragma unroll
        for (int bj = 0; bj < 2; ++bj) { const f32x4 c0v = ld4(bias + bj * 128), c1v = ld4(bias + bj * 128 + 4); const int c0 = u.pn * 256 + bj * 128 + wc * 32 + 8 * fq;
#pragma unroll
            for (int ai = 0; ai < 2; ++ai)
#pragma unroll
                for (int m = 0; m < 4; ++m) { const int r = u.pm * 256 + ai * 128 + wr * 64 + m * 16 + fr;
                    const f32x4 v0 = acc[ai][bj][m][0] * W8_INV + c0v, v1 = acc[ai][bj][m][1] * W8_INV + c1v;
                    u32x4 w; w.x = cvt_pk_bf16(v0[0], v0[1]); w.y = cvt_pk_bf16(v0[2], v0[3]); w.z = cvt_pk_bf16(v1[0], v1[1]); w.w = cvt_pk_bf16(v1[2], v1[3]);
                    *(u32x4*)(yb + (size_t)r * ND + c0) = w; } }
    }
};

struct WinRestOrder {
    int c; size_t a_tile, b_tile;
    __device__ bool next(int i, Unit& u) const {
        if (i > 0 || c < 0 || c >= 64) return false;
        u.pm = c >> 1; u.pn = 23 + (c & 1); u.e = 0; u.aoff = (unsigned)((size_t)u.pm * a_tile); u.boff = (unsigned)((size_t)u.pn * b_tile); return true;
    }
};
struct PoolOrder {
    int G, c;
    __device__ bool next(int i, Unit& u) const {
        const int L = i * G + c; if (c < 0 || L >= 256) return false;
        u.pm = L >> 3; u.pn = L & 7; u.e = 0;
        u.aoff = (unsigned)(((size_t)u.pm * 256 * NC + (size_t)(u.pn >> 1) * 256) * 2); u.boff = (unsigned)((size_t)u.pn * 256 * 256 * 2); return true;
    }
};
struct MoeOrder {
    int G, c, nN, ntiles; const LAS unsigned* tile_e; size_t a_tile, b_expert, b_tile;
    __device__ bool next(int i, Unit& u) const {
        const int L = i * G + c; if (L >= ntiles * nN) return false;
        u.pm = L / nN; u.pn = L % nN; u.e = __builtin_amdgcn_readfirstlane((int)tile_e[u.pm]);
        u.aoff = (unsigned)((size_t)u.pm * a_tile); u.boff = (unsigned)((size_t)u.e * b_expert + (size_t)u.pn * b_tile); return true;
    }
};

__device__ __forceinline__ void cvt_block_T(const float* src, int ld_src, bf16_t* dst, int ld_dst, int lane) {
    const int k8 = lane & 7, nq = lane >> 3;
    const float* s = src + (size_t)(k8 * 8) * ld_src + nq * 4;
    f32x4 v[8];
#pragma unroll
    for (int j = 0; j < 8; ++j) v[j] = __builtin_nontemporal_load((const f32x4*)(s + (size_t)j * ld_src));
#pragma unroll
    for (int i = 0; i < 4; ++i) { u32x4 w; w.x = cvt_pk_bf16(v[0][i], v[1][i]); w.y = cvt_pk_bf16(v[2][i], v[3][i]); w.z = cvt_pk_bf16(v[4][i], v[5][i]); w.w = cvt_pk_bf16(v[6][i], v[7][i]);
        *(u32x4*)(dst + (size_t)(nq * 4 + i) * ld_dst + k8 * 8) = w; }
}
__device__ __forceinline__ void cvt_block_T2(const float* src, int ld_src, bf16_t* dst, int ld_dst, int lane) {
    const int k8 = lane & 7, nq = lane >> 3;
    const float* s = src + (size_t)(k8 * 8) * ld_src + nq * 4;
    f32x4 v[8], w2[8];
#pragma unroll
    for (int j = 0; j < 8; ++j) { v[j] = ld4(s + (size_t)j * ld_src); w2[j] = ld4(s + (size_t)j * ld_src + 32); }
#pragma unroll
    for (int i = 0; i < 4; ++i) { u32x4 w; w.x = cvt_pk_bf16(v[0][i], v[1][i]); w.y = cvt_pk_bf16(v[2][i], v[3][i]); w.z = cvt_pk_bf16(v[4][i], v[5][i]); w.w = cvt_pk_bf16(v[6][i], v[7][i]);
        *(u32x4*)(dst + (size_t)(nq * 4 + i) * ld_dst + k8 * 8) = w; }
#pragma unroll
    for (int i = 0; i < 4; ++i) { u32x4 w; w.x = cvt_pk_bf16(w2[0][i], w2[1][i]); w.y = cvt_pk_bf16(w2[2][i], w2[3][i]); w.z = cvt_pk_bf16(w2[4][i], w2[5][i]); w.w = cvt_pk_bf16(w2[6][i], w2[7][i]);
        *(u32x4*)(dst + (size_t)(32 + nq * 4 + i) * ld_dst + k8 * 8) = w; }
}

__device__ __forceinline__ void cvt8_load(f32x4 (&v)[16], const float* s, int ld_src) {
#pragma unroll
    for (int j = 0; j < 16; ++j) v[j] = __builtin_nontemporal_load((const f32x4*)(s + (size_t)j * ld_src));
}
__device__ __forceinline__ void cvt8_store(const f32x4 (&v)[16], fp8_t* d, int ld_dst) {
#pragma unroll
    for (int i = 0; i < 4; ++i) { u32x4 w; w.x = pack4_fp8(v[0][i] * W8_SCALE, v[1][i] * W8_SCALE, v[2][i] * W8_SCALE, v[3][i] * W8_SCALE); w.y = pack4_fp8(v[4][i] * W8_SCALE, v[5][i] * W8_SCALE, v[6][i] * W8_SCALE, v[7][i] * W8_SCALE);
        w.z = pack4_fp8(v[8][i] * W8_SCALE, v[9][i] * W8_SCALE, v[10][i] * W8_SCALE, v[11][i] * W8_SCALE); w.w = pack4_fp8(v[12][i] * W8_SCALE, v[13][i] * W8_SCALE, v[14][i] * W8_SCALE, v[15][i] * W8_SCALE);
        __builtin_nontemporal_store(w, (u32x4*)(d + (size_t)i * ld_dst)); }
}
__device__ __forceinline__ void cvt_wave_T8x8(const float* src, int ld_src, fp8_t* dst, int ld_dst, int lane) {
    const int k16 = lane & 7, nq = lane >> 3;
    const float* s = src + (size_t)(k16 * 16) * ld_src + nq * 4; fp8_t* d = dst + (size_t)(nq * 4) * ld_dst + k16 * 16;
    f32x4 va[16], vb[16];
    cvt8_load(va, s, ld_src);
#pragma unroll
    for (int i = 0; i < 8; i += 2) {
        cvt8_load(vb, s + (i + 1) * 32, ld_src);
        cvt8_store(va, d + (size_t)(i * 32) * ld_dst, ld_dst);
        if (i + 2 < 8) cvt8_load(va, s + (i + 2) * 32, ld_src);
        cvt8_store(vb, d + (size_t)((i + 1) * 32) * ld_dst, ld_dst);
    }
}

__device__ __forceinline__ void phase0(const Params& p, LAS unsigned char* lds, const int wave) {
    const int tid = phase_tid(wave);
    const int bid = blockIdx.x, lane = tid & 63, wv = tid >> 6;
    LAS float* cond = (LAS float*)lds;
    if (bid < 192) {
        for (int i = tid; i < NB * ND; i += NTHREADS) { const int b = i >> 11, k = i & 2047; const float cv = p.c[i]; cond[k * 4 + b] = cv / (1.0f + expf(-cv)); }
        __syncthreads();
        const int gid = bid * NTHREADS + tid, ks = gid / 3072, j4 = gid % 3072;
        f32x4 a0 = {0.f, 0.f, 0.f, 0.f}, a1 = a0, a2 = a0, a3 = a0;
        const float* wp = p.w_ada + (size_t)(ks * 64) * NMOD + j4 * 4;
#pragma unroll 8
        for (int kk = 0; kk < 64; ++kk) { const f32x4 w = __builtin_nontemporal_load((const f32x4*)(wp + (size_t)kk * NMOD)); const f32x4 cd = *(const LAS f32x4*)(cond + (ks * 64 + kk) * 4);
            a0 += w * cd[0]; a1 += w * cd[1]; a2 += w * cd[2]; a3 += w * cd[3]; }
        *(f32x4*)(p.modp + (size_t)(ks * 4 + 0) * NMOD + j4 * 4) = a0; *(f32x4*)(p.modp + (size_t)(ks * 4 + 1) * NMOD + j4 * 4) = a1;
        *(f32x4*)(p.modp + (size_t)(ks * 4 + 2) * NMOD + j4 * 4) = a2; *(f32x4*)(p.modp + (size_t)(ks * 4 + 3) * NMOD + j4 * 4) = a3;
    }
    const int gw = bid * NWAVES + wv, GW = gridDim.x * NWAVES;
    constexpr int I_IN = 32 * 265, I_RW = 16 * 64, I_PL = 4 * 4 * 16, I_OUT = 32 * 64, I_ALL = I_IN + I_RW + I_PL + I_OUT;
    for (int it = gw; it < I_ALL; it += GW) {
        if (it < I_IN) { const int kb = it / 265, nb = it % 265; cvt_block_T(p.w_in + (size_t)(kb * 64) * NIN + nb * 32, NIN, p.wt_in + (size_t)(nb * 32) * ND + kb * 64, ND, lane); }
        else if (it < I_IN + I_RW) { const int j = it - I_IN, kb = j / 64, nb = j % 64; cvt_block_T(p.w_rwkv_out + (size_t)(kb * 64) * ND + nb * 32, ND, p.wt_rwkv + (size_t)(nb * 32) * NC + kb * 64, NC, lane); }
        else if (it < I_IN + I_RW + I_PL) { const int j = it - I_IN - I_RW, g = j / 64, kb = (j % 64) / 16, nb = j % 16;
            cvt_block_T(p.w_pool + (size_t)g * 256 * 512 + (size_t)(kb * 64) * 512 + nb * 32, 512, p.wt_pool + (size_t)g * 512 * 256 + (size_t)(nb * 32) * 256 + kb * 64, 256, lane); }
        else { const int j = it - I_IN - I_RW - I_PL, kb = j / 64, nb = j % 64; cvt_block_T(p.w_out + (size_t)(kb * 64) * ND + nb * 32, ND, p.wt_out + (size_t)(nb * 32) * ND + kb * 64, ND, lane); }
    }
    for (int idx = bid * NTHREADS + tid; idx < LORA_N * (LORA_K / 8); idx += gridDim.x * NTHREADS) {
        const int n = idx / (LORA_K / 8), k0 = (idx % (LORA_K / 8)) * 8; float v[8];
#pragma unroll
        for (int j = 0; j < 8; ++j) { const int k = k0 + j; float x = 0.f;
            if (n < 1024) { if (k < 64) x = p.w_decay_up[k * NC + n]; }
            else if (n < 2048) { if (k >= 64 && k < 128) x = p.w_iclr_up[(k - 64) * NC + (n - 1024)]; }
            else { if (k >= 128 && k < 288) x = p.w_glora_up[(k - 128) * NC + (n - 2048)]; }
            v[j] = x; }
        u32x4 w; w.x = cvt_pk_bf16(v[0], v[1]); w.y = cvt_pk_bf16(v[2], v[3]); w.z = cvt_pk_bf16(v[4], v[5]); w.w = cvt_pk_bf16(v[6], v[7]);
        *(u32x4*)(p.bt_lora + (size_t)n * LORA_K + k0) = w;
    }
}

__device__ __forceinline__ void phase1(const Params& p, LAS unsigned char* lds, const int wave) {
    const int tid = phase_tid(wave);
    const int bid = blockIdx.x;
    if (tid < 192) { const int idx = bid * 192 + tid, b = idx / NMOD, j = idx % NMOD; float s = p.b_ada[j];
        for (int ks = 0; ks < KS_MOD; ++ks) s += p.modp[(size_t)(ks * 4 + b) * NMOD + j];
        p.mod[idx] = s; }
    LAS float* ss = (LAS float*)lds;
    const int m0 = bid * 32, b = m0 >> 11;
    {   const int j = tid * 8; f32x4 s0 = ld4(p.b_ada + j), s1 = ld4(p.b_ada + j + 4);
#pragma unroll 8
        for (int ks = 0; ks < KS_MOD; ++ks) { s0 += ld4(p.modp + (size_t)(ks * 4 + b) * NMOD + j); s1 += ld4(p.modp + (size_t)(ks * 4 + b) * NMOD + j + 4); }
        *(LAS f32x4*)(ss + j) = s0; *(LAS f32x4*)(ss + j + 4) = s1; }
    __syncthreads();
    const int k = (tid & 255) * 8, rh = tid >> 8;
    const f32x4 sh0 = *(const LAS f32x4*)(ss + k), sh1v = *(const LAS f32x4*)(ss + k + 4), sc0 = *(const LAS f32x4*)(ss + ND + k) + 1.0f, sc1v = *(const LAS f32x4*)(ss + ND + k + 4) + 1.0f;
#pragma unroll 4
    for (int i = 0; i < 16; ++i) { const size_t m = (size_t)(m0 + 2 * i + rh); const f32x4 x0 = ld4(p.x + m * ND + k), x1 = ld4(p.x + m * ND + k + 4); const f32x4 h0 = x0 * sc0 + sh0, h1 = x1 * sc1v + sh1v;
        u32x4 w; w.x = cvt_pk_bf16(h0[0], h0[1]); w.y = cvt_pk_bf16(h0[2], h0[3]); w.z = cvt_pk_bf16(h1[0], h1[1]); w.w = cvt_pk_bf16(h1[2], h1[3]); *(u32x4*)(p.hb + m * ND + k) = w; }
    __syncthreads();
}

__device__ __forceinline__ void phase3(const Params& p, LAS unsigned char* lds, const int wave) {
    const int tid = phase_tid(wave);
    const int bid = blockIdx.x, m0 = bid * 32, t0 = m0 & (NT - 1), hist = t0 > 0 ? 15 : 0;
    constexpr int TC = OFF_GA - OFF_WD, TCH = TC / 8;
    LAS bf16_t* T = (LAS bf16_t*)lds;
    for (int idx = tid; idx < 47 * TCH; idx += NTHREADS) { const int r = idx / TCH, ck = idx % TCH;
        if (r >= 15 - hist) *(LAS u32x4*)(T + r * TC + ck * 8) = ldu4nt(p.P + (size_t)(m0 - 15 + r) * NINP + OFF_WD + ck * 8); }
    __syncthreads();
    for (int idx = tid; idx < 32 * (LORA_K / 8); idx += NTHREADS) { const int i = idx / (LORA_K / 8), j0 = (idx % (LORA_K / 8)) * 8; u32x4 w = {0u, 0u, 0u, 0u};
        if (j0 < 288) { const u32x4 cu = *(const LAS u32x4*)(T + (15 + i) * TC + j0); u32x4 pu = {0u, 0u, 0u, 0u}; if (t0 + i > 0) pu = *(const LAS u32x4*)(T + (14 + i) * TC + j0);
            const f32x4 c0 = bf4_unpack((u32x2){cu.x, cu.y}), c1 = bf4_unpack((u32x2){cu.z, cu.w}), q0 = bf4_unpack((u32x2){pu.x, pu.y}), q1 = bf4_unpack((u32x2){pu.z, pu.w});
            const f32x4 s0 = c0 + (q0 - c0) * ld4(p.mu_shift + OFF_WD + j0), s1 = c1 + (q1 - c1) * ld4(p.mu_shift + OFF_WD + j0 + 4); float v[8];
#pragma unroll
            for (int j = 0; j < 8; ++j) { const float x = j < 4 ? s0[j] : s1[j - 4];
                v[j] = j0 < 64 ? (1.0f - 2.0f * __builtin_amdgcn_rcpf(1.0f + __builtin_amdgcn_exp2f(x * 2.8853900817779268f))) : (j0 < 128 ? x : sigmoidf_(x)); }
            w.x = cvt_pk_bf16(v[0], v[1]); w.y = cvt_pk_bf16(v[2], v[3]); w.z = cvt_pk_bf16(v[4], v[5]); w.w = cvt_pk_bf16(v[6], v[7]); }
        *(u32x4*)(p.a_lora + (size_t)(m0 + i) * LORA_K + j0) = w; }
    for (int idx = tid; idx < 32 * (NC / 8); idx += NTHREADS) { const int i = idx >> 7, c = (idx & 127) * 8; const int win = 2 << (c >> 8), t = t0 + i, n = (t + 1) < win ? (t + 1) : win;
        const LAS bf16_t* up = T + (15 + i) * TC + (OFF_POOL - OFF_WD) + c; f32x4 a0 = {0.f, 0.f, 0.f, 0.f}, a1 = a0;
        for (int q = 0; q < n; ++q) { const u32x4 uu = *(const LAS u32x4*)(up - q * TC); a0 += bf4_unpack((u32x2){uu.x, uu.y}); a1 += bf4_unpack((u32x2){uu.z, uu.w}); }
        const u32x4 u0 = *(const LAS u32x4*)(up); const float rn = 1.0f / (float)n;
        const f32x4 d0 = a0 * rn - bf4_unpack((u32x2){u0.x, u0.y}), d1 = a1 * rn - bf4_unpack((u32x2){u0.z, u0.w});
        u32x4 w; w.x = cvt_pk_bf16(d0[0], d0[1]); w.y = cvt_pk_bf16(d0[2], d0[3]); w.z = cvt_pk_bf16(d1[0], d1[1]); w.w = cvt_pk_bf16(d1[2], d1[3]);
        *(u32x4*)(p.dp + (size_t)(m0 + i) * NC + c) = w; }
    __syncthreads();
}

__device__ __forceinline__ float row8_allsum(float x) {
    x += dpp_f<0x141>(x); x += dpp_f<0x1B>(x); x += dpp_f<0xB1>(x); return x;
}
__device__ __forceinline__ void scan_head(const Params& p, LAS unsigned char* lds, int bh, const int wave) {
    const int tid = phase_tid(wave);
    const int lane = tid & 63;
    const int b = bh >> 4, h = bh & 15;
    constexpr int L_AW = 0, L_W = 16384, L_BK = 32768, L_Y = 65536, L_V = 81920, L_G = 106496, L_SC = 131072, L_CS = 131840, L_Z = 132352, L_DUMMY = 132864, L_CST = 133888;
    constexpr int NCH = NT / 32;
    if (tid < 128) *(LAS unsigned*)(lds + L_Z + tid * 4) = 0u;
    {
        const int a8 = tid >> 6, cc = tid & 63, gch = h * HS + cc;
        const float* src = a8 == 0 ? p.mu_shift + OFF_R : a8 == 1 ? p.mu_shift + OFF_K : a8 == 2 ? p.mu_shift + OFF_V : a8 == 3 ? p.k_k : a8 == 4 ? p.k_a : a8 == 5 ? p.r_k : a8 == 6 ? p.lnx_g : p.lnx_b;
        *(LAS float*)(lds + L_CST + a8 * 256 + cc * 4) = src[gch]; }
    __syncthreads();
#define CST4(a8, u_) (*(const LAS f32x4*)(lds + L_CST + (a8) * 256 + (c8 + 4 * (u_)) * 4))
    const int ht = tid - 256, ls = (ht >> 3) & 31, c8 = (ht & 7) * 8, ch0 = h * HS + c8;
    f32x4 pr[2], pk[2], pv[2], qr[2], qk[2], qv[2], dc[2], ic[2], gt[2]; u32x4 pr8, pk8, pv8, qr8, qk8, qv8, ic8, gt8;
    const f32x4 zero4 = {0.f, 0.f, 0.f, 0.f};
#define SCAN_ISSUE(chunk) do { int ch = ch0; asm volatile("" : "+v"(ch)); const int t_ = (chunk) * 32 + ls; const size_t m_ = (size_t)b * NT + t_; const bf16_t* row_ = p.P + m_ * NINP + ch; \
        pr8 = *(const u32x4*)(row_ + OFF_R); pk8 = *(const u32x4*)(row_ + OFF_K); pv8 = *(const u32x4*)(row_ + OFF_V); \
        if (t_ > 0) { qr8 = *(const u32x4*)(row_ - NINP + OFF_R); qk8 = *(const u32x4*)(row_ - NINP + OFF_K); qv8 = *(const u32x4*)(row_ - NINP + OFF_V); } else { qr8 = (u32x4){0u, 0u, 0u, 0u}; qk8 = qr8; qv8 = qr8; } \
        ic8 = ldu4nt(p.iclr + m_ * NC + ch); gt8 = ldu4nt(p.gg + m_ * NC + ch); \
        _Pragma("unroll") for (int u_ = 0; u_ < 2; ++u_) dc[u_] = ld4nt(p.dec + m_ * NC + ch + 4 * u_); } while (0)
#define SCAN_UNPACK() do { ic[0] = bf4_unpack((u32x2){ic8.x, ic8.y}); ic[1] = bf4_unpack((u32x2){ic8.z, ic8.w}); gt[0] = bf4_unpack((u32x2){gt8.x, gt8.y}); gt[1] = bf4_unpack((u32x2){gt8.z, gt8.w}); pr[0] = bf4_unpack((u32x2){pr8.x, pr8.y}); pr[1] = bf4_unpack((u32x2){pr8.z, pr8.w}); pk[0] = bf4_unpack((u32x2){pk8.x, pk8.y}); pk[1] = bf4_unpack((u32x2){pk8.z, pk8.w}); \
        pv[0] = bf4_unpack((u32x2){pv8.x, pv8.y}); pv[1] = bf4_unpack((u32x2){pv8.z, pv8.w}); qr[0] = bf4_unpack((u32x2){qr8.x, qr8.y}); qr[1] = bf4_unpack((u32x2){qr8.z, qr8.w}); \
        qk[0] = bf4_unpack((u32x2){qk8.x, qk8.y}); qk[1] = bf4_unpack((u32x2){qk8.z, qk8.w}); qv[0] = bf4_unpack((u32x2){qv8.x, qv8.y}); qv[1] = bf4_unpack((u32x2){qv8.z, qv8.w}); } while (0)
#define SCAN_STAGE(chunk) do { SCAN_UNPACK(); int ch = ch0; asm volatile("" : "+v"(ch)); const int bp_ = (chunk) & 1, vb_ = (chunk) % 3; f32x4 r_[2], k_[2], v_[2], kk_[2], km_[2], bb_[2]; float ss_ = 0.f; \
        _Pragma("unroll") for (int u_ = 0; u_ < 2; ++u_) { const f32x4 mu_r = CST4(0, u_), mu_k = CST4(1, u_), mu_v = CST4(2, u_); \
            r_[u_] = pr[u_] + (qr[u_] - pr[u_]) * mu_r; k_[u_] = pk[u_] + (qk[u_] - pk[u_]) * mu_k; v_[u_] = pv[u_] + (qv[u_] - pv[u_]) * mu_v; \
            kk_[u_] = k_[u_] * CST4(3, u_); ss_ += dot4(kk_[u_], kk_[u_]); } \
        ss_ = row8_allsum(ss_); const float inv_ = 1.0f / fmaxf(sqrtf(ss_), 1e-12f); float br_ = 0.f, kr_ = 0.f, rk_ = 0.f; \
        _Pragma("unroll") for (int u_ = 0; u_ < 2; ++u_) { kk_[u_] = kk_[u_] * inv_; km_[u_] = k_[u_] * ((ic[u_] - 1.0f) * CST4(4, u_) + 1.0f); bb_[u_] = kk_[u_] * ic[u_]; \
            br_ += dot4(bb_[u_], r_[u_]); kr_ += dot4(km_[u_], r_[u_]); rk_ += dot4(r_[u_] * km_[u_], CST4(5, u_)); } \
        br_ = row8_allsum(br_); kr_ = row8_allsum(kr_); rk_ = row8_allsum(rk_); \
          \
        const int pp_ = ls >> 1, odd_ = ls & 1; float c1_ = 0.f, c2_ = 0.f, c3_ = 0.f, c4_ = 0.f; \
        _Pragma("unroll") for (int u_ = 0; u_ < 2; ++u_) { const int k0_ = c8 + 4 * u_; const int pos_ = (k0_ >> 5) * 32 + ((k0_ & 15) >> 2) * 8 + ((k0_ >> 4) & 1) * 4; \
            const f32x4 a_ = -kk_[u_], wr_ = dc[u_] * r_[u_] + a_ * br_; f32x4 pw_, pb_, pk_; \
            _Pragma("unroll") for (int j_ = 0; j_ < 4; ++j_) { pw_[j_] = dpp_f<0x118>(dc[u_][j_]); pb_[j_] = dpp_f<0x118>(bb_[u_][j_]); pk_[j_] = dpp_f<0x118>(km_[u_][j_]); } \
            const f32x4 x0_ = odd_ ? pw_ * a_ : a_, x1_ = odd_ ? pw_ * wr_ : wr_; \
            u32x2 wa_, ww_; wa_.x = cvt_pk_bf16(x0_[0], x0_[1]); wa_.y = cvt_pk_bf16(x0_[2], x0_[3]); ww_.x = cvt_pk_bf16(x1_[0], x1_[1]); ww_.y = cvt_pk_bf16(x1_[2], x1_[3]); \
            *(LAS u32x2*)(lds + L_AW + bp_ * 8192 + pp_ * 512 + odd_ * 256 + pos_ * 2) = wa_; *(LAS u32x2*)(lds + L_AW + bp_ * 8192 + pp_ * 512 + odd_ * 256 + 128 + pos_ * 2) = ww_; \
            if (odd_) { *(LAS f32x4*)(lds + L_W + bp_ * 8192 + pp_ * 256 + k0_ * 4) = pw_ * dc[u_]; \
                *(LAS f32x4*)(lds + L_BK + bp_ * 16384 + pp_ * 1024 + k0_ * 4) = pb_ * dc[u_]; *(LAS f32x4*)(lds + L_BK + bp_ * 16384 + pp_ * 1024 + 256 + k0_ * 4) = pk_ * dc[u_]; \
                *(LAS f32x4*)(lds + L_BK + bp_ * 16384 + pp_ * 1024 + 512 + k0_ * 4) = bb_[u_]; *(LAS f32x4*)(lds + L_BK + bp_ * 16384 + pp_ * 1024 + 768 + k0_ * 4) = km_[u_]; \
                c1_ += dot4(pb_, a_); c2_ += dot4(pk_, a_); c3_ += dot4(pb_, wr_); c4_ += dot4(pk_, wr_); } \
            *(LAS f32x4*)(lds + L_V + vb_ * 8192 + ls * 256 + k0_ * 4) = v_[u_]; *(LAS f32x4*)(lds + L_G + vb_ * 8192 + ls * 256 + k0_ * 4) = gt[u_]; } \
        c1_ = row8_allsum(c1_); c2_ = row8_allsum(c2_); c3_ = row8_allsum(c3_); c4_ = row8_allsum(c4_); \
        if ((ht & 7) == 0) { *(LAS f32x2*)(lds + L_SC + vb_ * 256 + ls * 8) = (f32x2){kr_, rk_}; if (odd_) *(LAS f32x4*)(lds + L_CS + bp_ * 256 + pp_ * 16) = (f32x4){c1_, c2_, c3_, c4_}; } } while (0)
#define SCAN_POST(chunk) do { int ch = ch0; asm volatile("" : "+v"(ch)); const int bp_ = (chunk) & 1, vb_ = (chunk) % 3; const f32x2 sc_ = *(const LAS f32x2*)(lds + L_SC + vb_ * 256 + ls * 8); f32x4 y_[2], v_[2]; float s_ = 0.f; \
        _Pragma("unroll") for (int u_ = 0; u_ < 2; ++u_) { v_[u_] = *(const LAS f32x4*)(lds + L_V + vb_ * 8192 + ls * 256 + (c8 + 4 * u_) * 4); \
            y_[u_] = *(const LAS f32x4*)(lds + L_Y + bp_ * 8192 + ls * 256 + (c8 + 4 * u_) * 4) + v_[u_] * sc_[0]; s_ += (y_[u_][0] + y_[u_][1]) + (y_[u_][2] + y_[u_][3]); } \
        const float mean_ = row8_allsum(s_) * (1.0f / 64.0f); float q_ = 0.f; \
        _Pragma("unroll") for (int u_ = 0; u_ < 2; ++u_) { y_[u_] = y_[u_] - mean_; q_ += dot4(y_[u_], y_[u_]); } \
        const float rstd_ = rsqrtf(row8_allsum(q_) * (1.0f / 64.0f) + GN_EPS); const size_t m_ = (size_t)b * NT + (chunk) * 32 + ls; u32x4 o_; \
        _Pragma("unroll") for (int u_ = 0; u_ < 2; ++u_) { const f32x4 g_ = *(const LAS f32x4*)(lds + L_G + vb_ * 8192 + ls * 256 + (c8 + 4 * u_) * 4); \
            const f32x4 yn_ = y_[u_] * rstd_ * CST4(6, u_) + CST4(7, u_); const f32x4 f_ = (yn_ + v_[u_] * sc_[1]) * g_; \
            if (u_ == 0) { o_.x = cvt_pk_bf16(f_[0], f_[1]); o_.y = cvt_pk_bf16(f_[2], f_[3]); } else { o_.z = cvt_pk_bf16(f_[0], f_[1]); o_.w = cvt_pk_bf16(f_[2], f_[3]); } } \
        *(u32x4*)(p.yr + m_ * NC + ch) = o_; } while (0)
    const int ri = lane & 15, rg = lane >> 4, sel = ri & 3;
    f32x4 X0 = zero4, X1 = zero4, X2 = zero4, X3 = zero4;
    if (wave >= 4) { SCAN_ISSUE(0); SCAN_STAGE(0); }
    __syncthreads();
    for (int chunk = 0; chunk < NCH; ++chunk) {
        if (wave < 4) {
            __builtin_amdgcn_s_setprio(3);
            const int bp = chunk & 1, vb = chunk % 3;
            const LAS unsigned char* awp = lds + L_AW + bp * 8192 + sel * 128 + rg * 16;
            const LAS unsigned char* wwp = lds + L_W + bp * 8192 + rg * 16;
            const LAS unsigned char* abp = lds + L_BK + bp * 16384 + rg * 256 + ri * 4;
            const LAS unsigned char* vp = lds + L_V + vb * 8192 + (16 * wave + ri) * 4;
            const LAS unsigned char* csp = lds + L_CS + bp * 256;
            LAS unsigned char* yp = (rg == 0) ? (lds + L_Y + bp * 8192 + (16 * wave + ri) * 4) : ((rg == 2) ? (lds + L_Y + bp * 8192 + 256 + (16 * wave + ri) * 4) : (lds + L_DUMMY + tid * 4));
            const int y_st = (rg & 1) ? 0 : 512;
#define SCAN_LD(S, pi) do { S##a0 = *(const LAS bf16x8*)(awp + (pi) * 512); S##a1 = *(const LAS bf16x8*)(awp + (pi) * 512 + 64); \
                S##w0 = *(const LAS f32x4*)(wwp + (pi) * 256); S##w1 = *(const LAS f32x4*)(wwp + (pi) * 256 + 64); S##w2 = *(const LAS f32x4*)(wwp + (pi) * 256 + 128); S##w3 = *(const LAS f32x4*)(wwp + (pi) * 256 + 192); \
                S##b0 = *(const LAS float*)(abp + (pi) * 1024); S##b1 = *(const LAS float*)(abp + (pi) * 1024 + 64); S##b2 = *(const LAS float*)(abp + (pi) * 1024 + 128); S##b3 = *(const LAS float*)(abp + (pi) * 1024 + 192); \
                S##vt = *(const LAS float*)(vp + (pi) * 512); S##vu = *(const LAS float*)(vp + (pi) * 512 + 256); S##cs = *(const LAS f32x4*)(csp + (pi) * 16); } while (0)
#define SCAN_STEP(S, pi) do { u32x4 xa, xc; \
                xa.x = cvt_pk_bf16(X0[0], X0[1]); xa.y = cvt_pk_bf16(X0[2], X0[3]); xa.z = cvt_pk_bf16(X1[0], X1[1]); xa.w = cvt_pk_bf16(X1[2], X1[3]); \
                xc.x = cvt_pk_bf16(X2[0], X2[1]); xc.y = cvt_pk_bf16(X2[2], X2[3]); xc.z = cvt_pk_bf16(X3[0], X3[1]); xc.w = cvt_pk_bf16(X3[2], X3[3]); \
                const f32x4 d0 = __builtin_amdgcn_mfma_f32_16x16x32_bf16(S##a0, __builtin_bit_cast(bf16x8, xa), zero4, 0, 0, 0); \
                const f32x4 d1 = __builtin_amdgcn_mfma_f32_16x16x32_bf16(S##a1, __builtin_bit_cast(bf16x8, xc), zero4, 0, 0, 0); \
                const f32x4 d = d0 + d1; const float sat = d[0]; \
                const float sau = d[2] + sat * S##cs[0] + S##vt * S##cs[1], yu = d[3] + sat * S##cs[2] + S##vt * S##cs[3]; \
                const float bsel = (rg == 0) ? sat : ((rg == 1) ? S##vt : ((rg == 2) ? sau : S##vu)); \
                X0 = __builtin_amdgcn_mfma_f32_16x16x4f32(S##b0, bsel, X0 * S##w0, 0, 0, 0); \
                X1 = __builtin_amdgcn_mfma_f32_16x16x4f32(S##b1, bsel, X1 * S##w1, 0, 0, 0); \
                X2 = __builtin_amdgcn_mfma_f32_16x16x4f32(S##b2, bsel, X2 * S##w2, 0, 0, 0); \
                X3 = __builtin_amdgcn_mfma_f32_16x16x4f32(S##b3, bsel, X3 * S##w3, 0, 0, 0); \
                *(LAS float*)(yp + (pi) * y_st) = (rg == 0) ? d[1] : yu; } while (0)
            bf16x8 Pa0, Pa1, Qa0, Qa1; f32x4 Pw0, Pw1, Pw2, Pw3, Qw0, Qw1, Qw2, Qw3, Pcs, Qcs; float Pb0, Pb1, Pb2, Pb3, Pvt, Pvu, Qb0, Qb1, Qb2, Qb3, Qvt, Qvu;
            SCAN_LD(P, 0);
#pragma unroll 1
            for (int pi = 0; pi < 16; pi += 2) {
                SCAN_LD(Q, pi + 1);
                SCAN_STEP(P, pi);
                if (pi + 2 < 16) SCAN_LD(P, pi + 2);
                SCAN_STEP(Q, pi + 1);
            }
#undef SCAN_LD
#undef SCAN_STEP
        } else {
            if (chunk + 1 < NCH) SCAN_ISSUE(chunk + 1);
            if (chunk > 0) SCAN_POST(chunk - 1);
            if (chunk + 1 < NCH) SCAN_STAGE(chunk + 1);
        }
        __syncthreads();
    }
    if (wave >= 4) SCAN_POST(NCH - 1);
    __syncthreads();
#undef SCAN_ISSUE
#undef CST4
#undef SCAN_STAGE
#undef SCAN_UNPACK
#undef SCAN_POST
}
__device__ __forceinline__ void conv_queue(const Params& p, LAS unsigned char* lds, const int wave, const int cw) {
    const int tid = phase_tid(wave);
    const int lane = tid & 63, wv = tid >> 6;
    LAS int* slot = (LAS int*)(lds + LDS_MISC);
    constexpr int N_GU = NE * 16 * 2, N_DN = NE * 16, N_ALL = N_GU + N_DN;
    for (;;) {
        __syncthreads();
        if (tid == 0) *slot = (int)atomicAdd(&p.ctl[cw], 1u);
        __syncthreads();
        const int it = *slot;
        if (it >= N_ALL) break;
        if (it < N_GU) { const int e = it >> 5, rem = it & 31, kb = rem >> 1, nh = rem & 1;
            const float* src = p.w_gu + (size_t)e * ND * (2 * DFF) + (size_t)(kb * 128) * (2 * DFF) + nh * 2048;
            fp8_t* dst = p.wt_gu + (size_t)e * (2 * DFF) * ND + (size_t)(nh * 2048) * ND + kb * 128;
            cvt_wave_T8x8(src + wv * 256, 2 * DFF, dst + (size_t)(wv * 256) * ND, ND, lane); }
        else { const int j = it - N_GU, e = j >> 4, kb = j & 15;
            const float* src = p.w_down + (size_t)e * DFF * ND + (size_t)(kb * 128) * ND;
            fp8_t* dst = p.wt_down + (size_t)e * ND * DFF + kb * 128;
            cvt_wave_T8x8(src + wv * 256, ND, dst + (size_t)(wv * 256) * DFF, DFF, lane); }
    }
}

__device__ __forceinline__ void phase8(const Params& p, LAS unsigned char* lds, const int wave) {
    const int tid = phase_tid(wave);
    const int bid = blockIdx.x, lane = tid & 63, wv = tid >> 6;
    constexpr int HP = ND + 4;
    LAS float* hs = (LAS float*)lds;
    LAS float* lg = hs + 16 * HP;
    LAS float* part = lg + 16 * 32;
    LAS float* topv = part + 4 * 16 * 32;
    LAS int* topi = (LAS int*)(topv + 64);
    const int b = (bid * 32) >> 11;
    const float* sh2 = p.mod + (size_t)b * NMOD + 3 * ND; const float* sc2 = p.mod + (size_t)b * NMOD + 4 * ND;
    for (int pass = 0; pass < 2; ++pass) {
        const int mb = bid * 32 + pass * 16;
        for (int rr = 0; rr < 2; ++rr) { const int r = wv * 2 + rr; const size_t m = (size_t)(mb + r);
            f32x4 z[8]; float s = 0.f;
#pragma unroll
            for (int j = 0; j < 4; ++j) { z[2 * j] = ld4(p.z1 + m * ND + j * 512 + lane * 8); z[2 * j + 1] = ld4(p.z1 + m * ND + j * 512 + lane * 8 + 4);
                s += ((z[2 * j][0] + z[2 * j][1]) + (z[2 * j][2] + z[2 * j][3])) + ((z[2 * j + 1][0] + z[2 * j + 1][1]) + (z[2 * j + 1][2] + z[2 * j + 1][3])); }
            const float mean = wave_allsum(s) * (1.0f / ND); float qv = 0.f;
#pragma unroll
            for (int j = 0; j < 8; ++j) { const f32x4 d = z[j] - mean; qv += dot4(d, d); }
            const float rstd = rsqrtf(wave_allsum(qv) * (1.0f / ND) + LN_EPS);
            if (lane == 0) *(f32x2*)(p.lnst + m * 2) = (f32x2){mean, rstd};
#pragma unroll
            for (int j = 0; j < 8; ++j) { const int k = (j >> 1) * 512 + lane * 8 + (j & 1) * 4;
                const f32x4 x1 = (z[j] - mean) * rstd * ld4(p.ln1_g + k) + ld4(p.ln1_b + k);
                const f32x4 h = x1 * (ld4(sc2 + k) + 1.0f) + ld4(sh2 + k);
                *(unsigned*)(p.h2 + m * ND + k) = pack4_fp8(h[0], h[1], h[2], h[3]);
                *(LAS f32x4*)(hs + r * HP + k) = h; } }
        __syncthreads();
        {
            const int kq = wv >> 1, ntl = wv & 1, ar = lane & 15, ak = lane >> 4;
            f32x4 acc = {0.f, 0.f, 0.f, 0.f};
            const LAS float* ap = hs + ar * HP + kq * 512 + ak; const float* bp = p.w_router + (size_t)(kq * 512 + ak) * NE + ntl * 16 + ar;
#pragma unroll 8
            for (int ks = 0; ks < 128; ++ks) acc = __builtin_amdgcn_mfma_f32_16x16x4f32(ap[ks * 4], bp[(size_t)ks * 4 * NE], acc, 0, 0, 0);
#pragma unroll
            for (int j = 0; j < 4; ++j) part[(kq * 16 + ak * 4 + j) * 32 + ntl * 16 + ar] = acc[j]; }
        __syncthreads();
        {   const int r = tid >> 5, e = tid & 31;
            lg[r * 32 + e] = p.b_router[e] + (part[(0 * 16 + r) * 32 + e] + part[(1 * 16 + r) * 32 + e]) + (part[(2 * 16 + r) * 32 + e] + part[(3 * 16 + r) * 32 + e]); }
        __syncthreads();
        {
            const int r = tid >> 5, e = tid & 31; const LAS float* l = lg + r * 32; const float mine = l[e]; int rank = 0;
#pragma unroll
            for (int q = 0; q < 8; ++q) { const f32x4 o = *(const LAS f32x4*)(l + q * 4);
#pragma unroll
                for (int j = 0; j < 4; ++j) rank += (o[j] > mine || (o[j] == mine && (q * 4 + j) < e)) ? 1 : 0; }
            if (rank < 4) { topv[r * 4 + rank] = mine; topi[r * 4 + rank] = e; } }
        __syncthreads();
        if (tid < 64) { const int r = tid >> 2, k = tid & 3, m = mb + r; const f32x4 tv = *(const LAS f32x4*)(topv + r * 4); const int ei = topi[r * 4 + k];
            const float e0 = 1.0f, e1 = expf(tv[1] - tv[0]), e2 = expf(tv[2] - tv[0]), e3 = expf(tv[3] - tv[0]); const float sum = (e0 + e1) + (e2 + e3);
            const float mineexp = k == 0 ? e0 : (k == 1 ? e1 : (k == 2 ? e2 : e3));
            const unsigned rk = atomicAdd(&p.ctl[CW_CNT + 64 * ei], 1u);
            p.sel[m * 4 + k] = ei; p.rnk[m * 4 + k] = (int)rk; p.prob[m * 4 + k] = mineexp / sum; }
        __syncthreads();
    }
}

__device__ __forceinline__ void phase9(const Params& p, LAS unsigned char* lds, const int wave) {
    const int tid = phase_tid(wave);
    const int bid = blockIdx.x, lane = tid & 63, wv = tid >> 6;
    LAS int* seg = (LAS int*)lds;
    if (tid == 0) { int s = 0;
        for (int e = 0; e < NE; ++e) { seg[e] = s; const int c = (int)xb_ld(&p.ctl[CW_CNT + 64 * e]); s += (c + 255) & ~255; }
        seg[NE] = s;
        if (bid == 0) { int t = 0;
            for (int e = 0; e < NE; ++e) { const int nt = (seg[e + 1] - seg[e]) >> 8; for (int i = 0; i < nt; ++i) p.ctl[CW_TILEE + t + i] = (unsigned)e; t += nt; }
            p.ctl[CW_NTILES] = (unsigned)t; } }
    __syncthreads();
    const int GW = gridDim.x * NWAVES;
    for (int it = bid * NWAVES + wv; it < NM * TOPK; it += GW) { const int m = it >> 2;
        const int e = p.sel[it], d = seg[e] + p.rnk[it];
        if (lane == 0) p.dest[it] = d;
        const u32x4* src = (const u32x4*)(p.h2 + (size_t)m * ND); u32x4* dst = (u32x4*)(p.xb + (size_t)d * ND);
#pragma unroll
        for (int i = 0; i < 2; ++i) dst[i * 64 + lane] = src[i * 64 + lane]; }
    __syncthreads();
}

__device__ __forceinline__ void phase13(const Params& p, const int wave) {
    const int tid = phase_tid(wave);
    const int bid = blockIdx.x, lane0 = tid & 63, wv = wave;
    const int GW = gridDim.x * NWAVES;
    for (int m = bid * NWAVES + wv; m < NM; m += GW) { const int b = m >> 11;
        int lane = lane0; asm volatile("" : "+v"(lane));
        const float* g2 = p.mod + (size_t)b * NMOD + 5 * ND;
        int d[4]; float pr[4]; const f32x2 st = *(const f32x2*)(p.lnst + (size_t)m * 2);
#pragma unroll
        for (int k = 0; k < 4; ++k) { d[k] = p.dest[m * 4 + k]; pr[k] = p.prob[m * 4 + k]; }
        f32x4 z[8]; float s = 0.f;
#pragma unroll
        for (int j = 0; j < 4; ++j) { const int c = j * 512 + lane * 8; f32x4 f0 = {0.f, 0.f, 0.f, 0.f}, f1 = f0;
#pragma unroll
            for (int k = 0; k < 4; ++k) { const u32x4 y8 = ldu4nt(p.yb + (size_t)d[k] * ND + c);
                f0 += bf4_unpack((u32x2){y8.x, y8.y}) * pr[k]; f1 += bf4_unpack((u32x2){y8.z, y8.w}) * pr[k]; }
            const f32x4 xa = (ld4nt(p.z1 + (size_t)m * ND + c) - st[0]) * st[1] * ld4(p.ln1_g + c) + ld4(p.ln1_b + c), xb2 = (ld4nt(p.z1 + (size_t)m * ND + c + 4) - st[0]) * st[1] * ld4(p.ln1_g + c + 4) + ld4(p.ln1_b + c + 4);
            z[2 * j] = xa * DN_ALPHA + ld4(g2 + c) * f0; z[2 * j + 1] = xb2 * DN_ALPHA + ld4(g2 + c + 4) * f1;
            s += ((z[2 * j][0] + z[2 * j][1]) + (z[2 * j][2] + z[2 * j][3])) + ((z[2 * j + 1][0] + z[2 * j + 1][1]) + (z[2 * j + 1][2] + z[2 * j + 1][3])); }
        const float mean = wave_allsum(s) * (1.0f / ND); float qv = 0.f;
#pragma unroll
        for (int j = 0; j < 8; ++j) { const f32x4 dd = z[j] - mean; qv += dot4(dd, dd); }
        const float rstd = rsqrtf(wave_allsum(qv) * (1.0f / ND) + LN_EPS);
#pragma unroll
        for (int j = 0; j < 8; ++j) { const int c = (j >> 1) * 512 + lane * 8 + (j & 1) * 4;
            *(f32x4*)(p.out + (size_t)m * ND + c) = (z[j] - mean) * rstd * ld4(p.ln2_g + c) + ld4(p.ln2_b + c); } }
}

__global__ void __launch_bounds__(NTHREADS, 2) fwd(Params p) {
    extern __shared__ __attribute__((aligned(16))) unsigned char shm[];
    LAS unsigned char* lds = (LAS unsigned char*)shm;
    const int bid = blockIdx.x, G = gridDim.x;
    const int wave = __builtin_amdgcn_readfirstlane(threadIdx.x >> 6);
    if (threadIdx.x == 0) *(LAS u32x4*)(lds + LDS_BARW) = (u32x4){0u, 0u, 0u, 0u};
    __syncthreads();
    XcdBarrier bar = xcd_barrier_post(p.bar, (volatile LAS unsigned*)(lds + LDS_BARW));

    phase0(p, lds, wave);
    xcd_barrier(bar, wave);
    if (PROBE == 3) { phase0(p, lds, wave); xcd_barrier(bar, wave); }
    phase1(p, lds, wave);
    xcd_barrier(bar, wave);
    if (PROBE == 3) { phase1(p, lds, wave); xcd_barrier(bar, wave); }
    {
        pg8::Gemm g{p.hb, p.wt_in, ND, ND, ND}; pg8::DenseOrder S; S.init(NM / 256, NINP / 256 - 2, G, bid, (size_t)256 * ND * 2, (size_t)256 * ND * 2); S.skip_from = 23; S.skip_n = 2;
        EpiP E{p.P}; pg8::gemm_phase(lds, g, S, E, wave);
        if (PROBE == 1) { __syncthreads(); pg8::gemm_phase(lds, g, S, E, wave); } }
    xcd_barrier(bar, wave);
    phase3(p, lds, wave);
    xcd_barrier(bar, wave);
    if (PROBE == 3) { phase3(p, lds, wave); xcd_barrier(bar, wave); }
    {
        pg8::Gemm g{p.hb, p.wt_in, ND, ND, ND}; WinRestOrder S{bid, (size_t)256 * ND * 2, (size_t)256 * ND * 2};
        EpiP E{p.P}; pg8::gemm_phase(lds, g, S, E, wave); }
    __syncthreads();
    {
        pg8::Gemm g{p.a_lora, p.bt_lora, LORA_K, LORA_K, LORA_K}; pg8::DenseOrder S; S.init(NM / 256, LORA_N / 256, G - 64, bid - 64, (size_t)256 * LORA_K * 2, (size_t)256 * LORA_K * 2);
        EpiLora E{p.dec, p.iclr, p.gg, p.w0, p.a0}; pg8::gemm_phase(lds, g, S, E, wave);
        if (PROBE == 1) { __syncthreads(); pg8::gemm_phase(lds, g, S, E, wave); } }
    __syncthreads();
    {
        pg8::Gemm g{p.dp, p.wt_pool, NC, 256, 256}; PoolOrder S{1 << 20, bid >= 64 ? bid - 64 : 192 + bid};
        EpiPool E{p.t1, p.P, p.pool_scale}; pg8::gemm_phase(lds, g, S, E, wave);
        if (PROBE == 1) { __syncthreads(); pg8::gemm_phase(lds, g, S, E, wave); } }
    xcd_barrier(bar, wave);
    if (bid < NB * NH) { scan_head(p, lds, bid, wave); if (PROBE == 4) scan_head(p, lds, bid, wave); }
    conv_queue(p, lds, wave, CW_CONV);
    if (PROBE == 5) conv_queue(p, lds, wave, CW_CONV2);
    xcd_barrier(bar, wave);
    if (PROBE == 2) { if (bid < NB * NH) scan_head(p, lds, bid, wave); conv_queue(p, lds, wave, CW_CONV2); xcd_barrier(bar, wave); }
    {
        pg8::Gemm g{p.yr, p.wt_rwkv, NC, NC, NC}; pg8::DenseOrder S; S.init(NM / 256, ND / 256, G, bid, (size_t)256 * NC * 2, (size_t)256 * NC * 2);
        EpiRwkv E{p.mx, p.P, p.t1}; pg8::gemm_phase(lds, g, S, E, wave);
        if (PROBE == 1) { __syncthreads(); pg8::gemm_phase(lds, g, S, E, wave); } }
    xcd_barrier(bar, wave);
    {
        pg8::Gemm g{p.mx, p.wt_out, ND, ND, ND}; pg8::DenseOrder S; S.init(NM / 256, ND / 256, G, bid, (size_t)256 * ND * 2, (size_t)256 * ND * 2);
        EpiWout E{p.z1, p.x, p.mod}; pg8::gemm_phase(lds, g, S, E, wave);
        if (PROBE == 1) { __syncthreads(); pg8::gemm_phase(lds, g, S, E, wave); } }
    xcd_barrier(bar, wave);
    phase8(p, lds, wave);
    xcd_barrier(bar, wave);
    phase9(p, lds, wave);
    xcd_barrier(bar, wave);
    if (PROBE == 3) { phase9(p, lds, wave); xcd_barrier(bar, wave); }
    const int ntiles = (int)xb_ld(&p.ctl[CW_NTILES]);
    {   const int t_ = phase_tid(wave); if (t_ < MAXTILES) *(LAS unsigned*)(lds + LDS_MISC + 4 * t_) = p.ctl[CW_TILEE + t_]; }
    __syncthreads();
    {
        pg8::Gemm g{(const bf16_t*)p.xb, (const bf16_t*)p.wt_gu, ND / 2, ND / 2, ND / 2};
        MoeOrder S{G, bid, 2 * DFF / 256, ntiles, (const LAS unsigned*)(lds + LDS_MISC), (size_t)256 * ND, (size_t)(2 * DFF) * ND, (size_t)256 * ND};
        EpiGU E{p.act, p.b_gu}; pg8::gemm_phase<EpiGU, MoeOrder, true>(lds, g, S, E, wave);
        if (PROBE == 1) { __syncthreads(); pg8::gemm_phase<EpiGU, MoeOrder, true>(lds, g, S, E, wave); } }
    xcd_barrier(bar, wave);
    {
        pg8::Gemm g{(const bf16_t*)p.act, (const bf16_t*)p.wt_down, DFF / 2, DFF / 2, DFF / 2};
        MoeOrder S{G, bid, ND / 256, ntiles, (const LAS unsigned*)(lds + LDS_MISC), (size_t)256 * DFF, (size_t)ND * DFF, (size_t)256 * DFF};
        EpiDown E{p.yb, p.b_down}; pg8::gemm_phase<EpiDown, MoeOrder, true>(lds, g, S, E, wave);
        if (PROBE == 1) { __syncthreads(); pg8::gemm_phase<EpiDown, MoeOrder, true>(lds, g, S, E, wave); } }
    xcd_barrier(bar, wave);
    phase13(p, wave);
    if (PROBE == 3) { xcd_barrier(bar, wave); phase13(p, wave); }
}

static inline size_t align_up(size_t v, size_t a) { return (v + a - 1) / a * a; }

extern "C" void kernel_launch(void* const* d_in, const int* in_sizes, int n_in, void* d_out, int out_size, void* d_ws, size_t ws_size, hipStream_t stream) {
    (void)in_sizes; (void)n_in; (void)out_size;
    Params p{};
    const float** ins = (const float**)&p;
    for (int i = 0; i < 30; ++i) ins[i] = (const float*)d_in[i];
    p.out = (float*)d_out;
    char* ws = (char*)d_ws; size_t off = 0;
    auto take = [&](size_t bytes) { char* r = ws + off; off = align_up(off + bytes, 4096); return r; };
    const size_t ctl_bytes = (size_t)(XCD_BAR_WORDS + CTL_WORDS) * 4;
    p.bar = (unsigned*)take(ctl_bytes); p.ctl = p.bar + XCD_BAR_WORDS;
    p.modp = (float*)take((size_t)KS_MOD * 4 * NMOD * 4); p.mod = (float*)take((size_t)NB * NMOD * 4);
    p.hb = (bf16_t*)take((size_t)NM * ND * 2);
    p.wt_in = (bf16_t*)take((size_t)NINP * ND * 2); p.wt_rwkv = (bf16_t*)take((size_t)ND * NC * 2); p.wt_pool = (bf16_t*)take((size_t)ND * 256 * 2);
    p.wt_out = (bf16_t*)take((size_t)ND * ND * 2); p.bt_lora = (bf16_t*)take((size_t)LORA_N * LORA_K * 2);
    p.wt_gu = (fp8_t*)take((size_t)NE * 2 * DFF * ND); p.wt_down = (fp8_t*)take((size_t)NE * ND * DFF);
    p.P = (bf16_t*)take((size_t)NM * NINP * 2); p.a_lora = (bf16_t*)take((size_t)NM * LORA_K * 2); p.dp = (bf16_t*)take((size_t)NM * NC * 2);
    p.dec = (float*)take((size_t)NM * NC * 4); p.iclr = (bf16_t*)take((size_t)NM * NC * 2); p.gg = (bf16_t*)take((size_t)NM * NC * 2); p.t1 = (bf16_t*)take((size_t)NM * ND * 2);
    p.yr = (bf16_t*)take((size_t)NM * NC * 2); p.mx = (bf16_t*)take((size_t)NM * ND * 2); p.z1 = (float*)take((size_t)NM * ND * 4); p.lnst = (float*)take((size_t)NM * 2 * 4);
    p.h2 = (fp8_t*)take((size_t)NM * ND);
    p.sel = (int*)take((size_t)NM * TOPK * 4); p.rnk = (int*)take((size_t)NM * TOPK * 4); p.prob = (float*)take((size_t)NM * TOPK * 4); p.dest = (int*)take((size_t)NM * TOPK * 4);
    p.xb = (fp8_t*)take((size_t)MP * ND); p.act = (fp8_t*)take((size_t)MP * DFF); p.yb = (bf16_t*)take((size_t)MP * ND * 2);
    if (off > ws_size) { fprintf(stderr, "kernel_launch: workspace too small (%zu > %zu)\n", off, ws_size); return; }

    static int grid = 0;
    if (!grid) {
        int dev = 0, cus = 0, per_cu = 0;
        hipGetDevice(&dev); hipDeviceGetAttribute(&cus, hipDeviceAttributeMultiprocessorCount, dev);
        hipFuncSetAttribute((const void*)fwd, hipFuncAttributeMaxDynamicSharedMemorySize, LDS_BYTES);
        hipOccupancyMaxActiveBlocksPerMultiprocessor(&per_cu, (const void*)fwd, NTHREADS, LDS_BYTES);
        if (per_cu < 1) fprintf(stderr, "kernel_launch: occupancy query reports %d workgroups per CU\n", per_cu);
        if (cus != 256) fprintf(stderr, "kernel_launch: %d CUs; this kernel is laid out for 256\n", cus);
        grid = 256;
    }
    hipMemsetAsync(p.bar, 0, ctl_bytes, stream);
    hipLaunchKernelGGL(fwd, dim3(grid), dim3(NTHREADS), LDS_BYTES, stream, p);
}
```

```cpp
#include <hip/hip_runtime.h>
#include <cstdio>
#include <cstdint>

#ifndef PROBE
#define PROBE 0
#endif
#define LAS __attribute__((address_space(3)))
typedef unsigned short bf16_t;
typedef short bf16x8 __attribute__((ext_vector_type(8)));
typedef float f32x4 __attribute__((ext_vector_type(4)));
typedef float f32x2 __attribute__((ext_vector_type(2)));
typedef unsigned u32x4 __attribute__((ext_vector_type(4)));
typedef unsigned u32x2 __attribute__((ext_vector_type(2)));
typedef int i32x4 __attribute__((ext_vector_type(4)));
typedef int i32x8 __attribute__((ext_vector_type(8)));
typedef unsigned char fp8_t;
constexpr float W8_SCALE = 64.0f, W8_INV = 1.0f / 64.0f;

constexpr int NB = 4, NT = 2048, NM = NB * NT, ND = 2048, NC = 1024, NH = 16, HS = 64;
constexpr int NSHIFT = 3360, NIN = 8480, NINP = 8704;
constexpr int OFF_R = 0, OFF_K = 1024, OFF_V = 2048, OFF_WD = 3072, OFF_AD = 3136, OFF_GD = 3200, OFF_POOL = 3360, OFF_GA = 4384, OFF_GB = 6432;
constexpr int NE = 32, TOPK = 4, DFF = 2048;
constexpr int LORA_K = 384, LORA_N = 3072;
constexpr int MAXTILES = 160, MP = MAXTILES * 256;
constexpr int NMOD = 6 * ND;
constexpr int KS_MOD = 32;
constexpr float LN_EPS = 1e-5f, GN_EPS = 64e-5f;
constexpr float DN_ALPHA = 1.189207115002721f;
constexpr float SW_LIMIT = 7.0f, SW_ALPHA = 1.702f;
constexpr int NWAVES = 8, NTHREADS = 512;
constexpr int LDS_BYTES = 147456;
constexpr int LDS_BARW = LDS_BYTES - 16;
constexpr int LDS_MISC = 131072;

constexpr int CW_CNT = 0;
constexpr int CW_CONV = 64 * 32;
constexpr int CW_CONV2 = 64 * 32 + 32;
constexpr int CW_NTILES = 64 * 33;
constexpr int CW_TILEE = 64 * 34;
constexpr int CTL_WORDS = 64 * 34 + 256;

#define XB_TMO      128
#define XB_XCNT(j)  (256  + 64 * (j))
#define XB_XSUB(j)  (1280 + 64 * (j))
#define XB_XGEN(j)  (2304 + 64 * (j))
#define XB_TOP      3328
#define XB_TOPGEN   3392
#define XCD_BAR_WORDS 3456
#define XB_SPIN_CAP (1u << 18)

__device__ __forceinline__ unsigned xb_ld(unsigned* p)              { return __hip_atomic_load(p, __ATOMIC_RELAXED, __HIP_MEMORY_SCOPE_AGENT); }
__device__ __forceinline__ unsigned xb_add(unsigned* p, unsigned v) { return __hip_atomic_fetch_add(p, v, __ATOMIC_RELAXED, __HIP_MEMORY_SCOPE_AGENT); }
__device__ __forceinline__ unsigned xb_xcc_id() { return (unsigned)__builtin_amdgcn_s_getreg((3 << 11) | 20) & 0xFu; }
#define XB_SPIN(cond, bar) do { unsigned _sp = 0; while (cond) { __builtin_amdgcn_s_sleep(1); \
    if ((++_sp & 255u) == 0u) { if (xb_ld(&(bar)[XB_TMO])) break; if (_sp > XB_SPIN_CAP) { atomicAdd(&(bar)[XB_TMO], 1u); break; } } } } while (0)

__device__ __forceinline__ int phase_tid(int wave);
struct XcdBarrier { unsigned* bar; unsigned x; volatile LAS unsigned* st; };

__device__ __forceinline__ XcdBarrier xcd_barrier_post(unsigned* bar, volatile LAS unsigned* st) {
    XcdBarrier b; b.bar = bar; b.x = xb_xcc_id(); b.st = st;
    if (threadIdx.x == 0) (void)xb_add(&bar[XB_XCNT(b.x)], 1u);
    return b;
}
__device__ __forceinline__ void xcd_barrier_complete(unsigned* bar, unsigned x, unsigned& nloc, unsigned& nx) {
    const unsigned G = gridDim.x * gridDim.y * gridDim.z;
    unsigned sum, cnt, mine, sp = 0u;
    for (;;) {
        sum = 0u; cnt = 0u; mine = 0u;
#pragma unroll
        for (unsigned j = 0; j < 16; ++j) { const unsigned c = xb_ld(&bar[XB_XCNT(j)]); sum += c; cnt += (c > 0u) ? 1u : 0u; mine = (j == x) ? c : mine; }
        if (sum == G) break;
        __builtin_amdgcn_s_sleep(1);
        if ((++sp & 255u) == 0u) { if (xb_ld(&bar[XB_TMO])) break; if (sp > XB_SPIN_CAP) { atomicAdd(&bar[XB_TMO], 1u); break; } }
    }
    nloc = mine > 0u ? mine : 1u; nx = cnt > 0u ? cnt : 1u;
}
__device__ __forceinline__ void xcd_barrier(const XcdBarrier& b, const int wave) {
    asm volatile("s_waitcnt vmcnt(0)" ::: "memory");
    __syncthreads();
    if (phase_tid(wave) == 0) {
        unsigned* bar = b.bar;
        __builtin_amdgcn_s_waitcnt(0);
        unsigned nloc = b.st[0], nx = b.st[1];
        if (nloc == 0u) { xcd_barrier_complete(bar, b.x, nloc, nx); b.st[0] = nloc; b.st[1] = nx; }
        const unsigned old = xb_add(&bar[XB_XSUB(b.x)], 1u);
        const unsigned gen = old / nloc;
        if (old + 1u == (gen + 1u) * nloc) {
            __builtin_amdgcn_fence(__ATOMIC_RELEASE, "agent");
            asm volatile("s_waitcnt vmcnt(0)" ::: "memory");
            const unsigned og = xb_add(&bar[XB_TOP], 1u);
            const unsigned tg = og / nx;
            if (og + 1u == (tg + 1u) * nx) xb_add(&bar[XB_TOPGEN], 1u);
            else XB_SPIN(xb_ld(&bar[XB_TOPGEN]) == tg, bar);
            __builtin_amdgcn_fence(__ATOMIC_ACQUIRE, "agent");
            xb_add(&bar[XB_XGEN(b.x)], 1u);
            asm volatile("s_waitcnt vmcnt(0)" ::: "memory");
        } else {
            XB_SPIN(xb_ld(&bar[XB_XGEN(b.x)]) == gen, bar);
            __builtin_amdgcn_fence(__ATOMIC_ACQUIRE, "agent");
            asm volatile("s_waitcnt vmcnt(0)" ::: "memory");
        }
    }
    __syncthreads();
}

__device__ __forceinline__ int phase_tid(int wave) {
    int lane; asm volatile("v_mbcnt_lo_u32_b32 %0, -1, 0\n\tv_mbcnt_hi_u32_b32 %0, -1, %0" : "=v"(lane));
    return wave * 64 + lane;
}
typedef __bf16 bf16x2_t __attribute__((ext_vector_type(2)));
__device__ __forceinline__ unsigned cvt_pk_bf16(float lo, float hi) { return __builtin_bit_cast(unsigned, __builtin_convertvector((f32x2){lo, hi}, bf16x2_t)); }
template <int CTRL> __device__ __forceinline__ float dpp_f(float x) {
    return __builtin_bit_cast(float, __builtin_amdgcn_update_dpp(0, __builtin_bit_cast(int, x), CTRL, 0xf, 0xf, false));
}
__device__ __forceinline__ float row16_allsum(float x) {
    x += dpp_f<0x128>(x); x += dpp_f<0x124>(x); x += dpp_f<0x122>(x); x += dpp_f<0x121>(x); return x;
}
__device__ __forceinline__ float wave_allsum(float x) {
    x = row16_allsum(x);
    const int xi = __builtin_bit_cast(int, x);
    return (__builtin_bit_cast(float, __builtin_amdgcn_readlane(xi, 0)) + __builtin_bit_cast(float, __builtin_amdgcn_readlane(xi, 16))) +
           (__builtin_bit_cast(float, __builtin_amdgcn_readlane(xi, 32)) + __builtin_bit_cast(float, __builtin_amdgcn_readlane(xi, 48)));
}
__device__ __forceinline__ unsigned pack4_fp8(float a, float b, float c, float d) { int r = 0; r = __builtin_amdgcn_cvt_pk_fp8_f32(a, b, r, false); r = __builtin_amdgcn_cvt_pk_fp8_f32(c, d, r, true); return (unsigned)r; }
__device__ __forceinline__ f32x2 bf2_unpack(unsigned u) { return (f32x2){__uint_as_float(u << 16), __uint_as_float(u & 0xffff0000u)}; }
__device__ __forceinline__ f32x4 bf4_unpack(u32x2 u) { const f32x2 a = bf2_unpack(u.x), b = bf2_unpack(u.y); return (f32x4){a[0], a[1], b[0], b[1]}; }
__device__ __forceinline__ float bf1(bf16_t h) { return __uint_as_float(((unsigned)h) << 16); }
__device__ __forceinline__ float sigmoidf_(float v) { return __builtin_amdgcn_rcpf(1.0f + __builtin_amdgcn_exp2f(v * -1.4426950408889634f)); }
__device__ __forceinline__ f32x4 ld4(const float* p) { return *(const f32x4*)p; }
__device__ __forceinline__ f32x4 ld4nt(const float* p) { return __builtin_nontemporal_load((const f32x4*)p); }
__device__ __forceinline__ u32x4 ldu4nt(const void* p) { return __builtin_nontemporal_load((const u32x4*)p); }
__device__ __forceinline__ float dot4(f32x4 a, f32x4 b) { return (a[0] * b[0] + a[1] * b[1]) + (a[2] * b[2] + a[3] * b[3]); }

struct Params {
    const float *x, *c, *w_ada, *b_ada, *w_in, *mu_shift, *w0, *w_decay_up, *a0, *w_iclr_up, *w_glora_up, *k_k, *k_a, *r_k, *lnx_g, *lnx_b,
                *w_rwkv_out, *w_pool, *pool_scale, *w_out, *ln1_g, *ln1_b, *w_router, *b_router, *w_gu, *b_gu, *w_down, *b_down, *ln2_g, *ln2_b;
    float* out;
    unsigned* bar; unsigned* ctl;
    float* modp; float* mod;
    bf16_t* hb; bf16_t* wt_in; bf16_t* wt_rwkv; bf16_t* wt_pool; bf16_t* wt_out; bf16_t* bt_lora; fp8_t* wt_gu; fp8_t* wt_down;
    bf16_t* P; bf16_t* a_lora; bf16_t* dp; float* dec; bf16_t* iclr; bf16_t* gg; bf16_t* t1;
    bf16_t* yr; bf16_t* mx; float* z1; float* lnst; fp8_t* h2;
    int* sel; int* rnk; float* prob; int* dest;
    fp8_t* xb; fp8_t* act; bf16_t* yb;
};

namespace pg8 {
constexpr int BM = 256, BK = 64, HALF = 128, HTB = HALF * BK * 2, STAGE_BYTES = 8 * HTB, NXCD = 8, WGM = 8;
__host__ __device__ __forceinline__ int lds_byte(int r, int c) { const int st = (r >> 4) * 2 + (c >> 5), rr = r & 15, cc = c & 31, ob = rr * 64 + cc * 2; return st * 1024 + (ob ^ (((ob >> 9) & 1) << 5)); }
__host__ __device__ __forceinline__ void stage_rc(int b, int& R, int& C) { const int st = b / 1024, sb = b % 1024, swz = sb ^ (((sb >> 9) & 1) << 5); R = (st >> 1) * 16 + swz / 64; C = (st & 1) * 32 + (swz % 64) / 2; }
__host__ __device__ __forceinline__ int perm32(int rho) { const int n = rho >> 4, i = rho & 15; return 8 * (i >> 2) + 4 * n + (i & 3); }

struct Unit { int pm, pn, e; unsigned aoff, boff; };
struct Gemm { const bf16_t* A; const bf16_t* Bt; int lda, ldb, K; };

struct DenseOrder {
    int nM, nN, nwg, G, c, skip_from = 1 << 30, skip_n = 0; size_t a_tile, b_tile;
    __device__ void init(int nM_, int nN_, int G_, int c_, size_t a_tile_, size_t b_tile_) { nM = nM_; nN = nN_; nwg = nM * nN; G = G_; c = c_; a_tile = a_tile_; b_tile = b_tile_; }
    __device__ bool next(int i, Unit& u) const {
        const long L = (long)i * G + c; if (c < 0 || L >= nwg) return false;
        int wgid = (int)L; { const int q = nwg / NXCD, r = nwg % NXCD, xcd = wgid % NXCD, off = wgid / NXCD; wgid = (xcd < r ? xcd * (q + 1) : r * (q + 1) + (xcd - r) * q) + off; }
        const int nig = WGM * nN, gid = wgid / nig, fm = gid * WGM, gsz = (nM - fm) < WGM ? (nM - fm) : WGM;
        u.pm = fm + ((wgid % nig) % gsz); u.pn = (wgid % nig) / gsz; u.e = 0; if (u.pn >= skip_from) u.pn += skip_n;
        u.aoff = (unsigned)((size_t)u.pm * a_tile); u.boff = (unsigned)((size_t)u.pn * b_tile); return true;
    }
};

template <class Epi, class Sched, bool FP8 = false>
__device__ __forceinline__ void gemm_phase(LAS unsigned char* lds, const Gemm g, const Sched& S, const Epi& E, const int wave) {
    const int tid = phase_tid(wave);
    const int wid = __builtin_amdgcn_readfirstlane(tid >> 6), lane = tid & 63, wr = wid >> 2, wc = wid & 3, fr = lane & 15, fq = lane >> 4;
    const int K = g.K, nt = K / BK;
    unsigned voffA[2], voffB[2];
#pragma unroll
    for (int i = 0; i < 2; ++i) { int R, C; stage_rc(tid * 16 + i * 8192, R, C); const int Rb = Epi::PERM ? ((R & ~31) + perm32(R & 31)) : R;
        voffA[i] = (unsigned)(R * g.lda + C) * 2u; voffB[i] = (unsigned)(Rb * g.ldb + C) * 2u; }
    const unsigned kstep = (unsigned)(BK * 2);
    const unsigned hstepA = (unsigned)HALF * g.lda * 2u, hstepB = (unsigned)HALF * g.ldb * 2u;
    const __amdgpu_buffer_rsrc_t rsA = __builtin_amdgcn_make_buffer_rsrc((void*)g.A, (short)0, -1, 0x00020000), rsB = __builtin_amdgcn_make_buffer_rsrc((void*)g.Bt, (short)0, -1, 0x00020000);
    const unsigned ldsw = (unsigned)wid * 1024u;
    const int aoff = lds_byte(wr * 64 + fr, fq * 8), boff = lds_byte(wc * 32 + fr, fq * 8);
#define PG8_SA(b, h) (((b) * 2 + (h)) * HTB)
#define PG8_SB(b, h) ((4 + (b) * 2 + (h)) * HTB)
#define PG8_STAGE(bufoff, rs, soff, voff) do { _Pragma("unroll") for (int _i = 0; _i < 2; ++_i) \
        __builtin_amdgcn_raw_ptr_buffer_load_lds(rs, (LAS void*)(lds + (bufoff) + ldsw + _i * 8192), 16, (voff)[_i], (soff), 0, 0); } while (0)
#define PG8_LDA(dst, b, h) do { _Pragma("unroll") for (int m = 0; m < 4; ++m) _Pragma("unroll") for (int k = 0; k < 2; ++k) dst[m][k] = *(const LAS bf16x8*)(lds + PG8_SA(b, h) + aoff + m * 2048 + k * 1024); } while (0)
#define PG8_LDB(dst, b, h) do { _Pragma("unroll") for (int n = 0; n < 2; ++n) _Pragma("unroll") for (int k = 0; k < 2; ++k) dst[n][k] = *(const LAS bf16x8*)(lds + PG8_SB(b, h) + boff + n * 2048 + k * 1024); } while (0)
#define PG8_CAT(x) __builtin_shufflevector(__builtin_bit_cast(i32x4, (x)[0]), __builtin_bit_cast(i32x4, (x)[1]), 0, 1, 2, 3, 4, 5, 6, 7)
#define PG8_MMA(ai, bj, At, Bt) do { __builtin_amdgcn_s_setprio(1); \
        if constexpr (FP8) { _Pragma("unroll") for (int m = 0; m < 4; ++m) _Pragma("unroll") for (int n = 0; n < 2; ++n) \
            acc[ai][bj][m][n] = __builtin_amdgcn_mfma_scale_f32_16x16x128_f8f6f4(PG8_CAT(Bt[n]), PG8_CAT(At[m]), acc[ai][bj][m][n], 0, 0, 0, 0x7F7F7F7F, 0, 0x7F7F7F7F); } \
        else { _Pragma("unroll") for (int m = 0; m < 4; ++m) _Pragma("unroll") for (int n = 0; n < 2; ++n) _Pragma("unroll") for (int k = 0; k < 2; ++k) \
            acc[ai][bj][m][n] = __builtin_amdgcn_mfma_f32_16x16x32_bf16(Bt[n][k], At[m][k], acc[ai][bj][m][n], 0, 0, 0); } \
        __builtin_amdgcn_s_setprio(0); } while (0)
#define PG8_WAIT_V(n) asm volatile("s_waitcnt vmcnt(" #n ")" ::: "memory")
#define PG8_WAIT_L(n) asm volatile("s_waitcnt lgkmcnt(" #n ")" ::: "memory")
#define PG8_BAR __builtin_amdgcn_s_barrier()
#define PG8_SCHED __builtin_amdgcn_sched_barrier(0)
    Unit cur, nxt; int ui = 0;
    if (!S.next(0, cur)) return;
    f32x4 acc[2][2][4][2];
#pragma unroll
    for (int a = 0; a < 2; ++a)
#pragma unroll
        for (int b = 0; b < 2; ++b)
#pragma unroll
            for (int m = 0; m < 4; ++m)
#pragma unroll
                for (int n = 0; n < 2; ++n) acc[a][b][m][n] = (f32x4){0.f, 0.f, 0.f, 0.f};
    bf16x8 At[4][2], B0[2][2], B1[2][2];
    unsigned cA = cur.aoff, cB = cur.boff;
    PG8_STAGE(PG8_SB(0, 0), rsB, cB, voffB); PG8_STAGE(PG8_SA(0, 0), rsA, cA, voffA); PG8_STAGE(PG8_SB(0, 1), rsB, cB + hstepB, voffB); PG8_STAGE(PG8_SA(0, 1), rsA, cA + hstepA, voffA);
    if (wr == 1) PG8_BAR;
    PG8_WAIT_V(4); PG8_BAR;
    PG8_STAGE(PG8_SB(1, 0), rsB, cB + kstep, voffB); PG8_STAGE(PG8_SA(1, 0), rsA, cA + kstep, voffA); PG8_STAGE(PG8_SB(1, 1), rsB, cB + hstepB + kstep, voffB);
    PG8_WAIT_V(6); PG8_BAR;
    for (;;) {
        const bool has_next = S.next(ui + 1, nxt);
        const unsigned nA = has_next ? nxt.aoff : cA, nB = has_next ? nxt.boff : cB;
        for (int t = 0; t < nt; t += 2) {
            const bool last = (t == nt - 2);
            const unsigned a1 = cA + (unsigned)(t + 1) * kstep;
            const unsigned a2 = last ? nA : cA + (unsigned)(t + 2) * kstep, b2 = last ? nB : cB + (unsigned)(t + 2) * kstep;
            const unsigned a3 = a2 + kstep, b3 = b2 + kstep;
            PG8_LDB(B0, 0, 0); PG8_SCHED; PG8_LDA(At, 0, 0); PG8_STAGE(PG8_SA(1, 1), rsA, a1 + hstepA, voffA);
            PG8_WAIT_L(8); PG8_BAR; PG8_WAIT_L(0); PG8_MMA(0, 0, At, B0); PG8_BAR; PG8_SCHED;
            PG8_LDB(B1, 0, 1); PG8_STAGE(PG8_SB(0, 0), rsB, b2, voffB);
            PG8_BAR; PG8_WAIT_L(0); PG8_MMA(0, 1, At, B1); PG8_BAR;
            PG8_LDA(At, 0, 1); PG8_STAGE(PG8_SA(0, 0), rsA, a2, voffA);
            PG8_BAR; PG8_WAIT_L(0); PG8_MMA(1, 0, At, B0); PG8_BAR; PG8_SCHED;
            PG8_STAGE(PG8_SB(0, 1), rsB, b2 + hstepB, voffB);
            PG8_WAIT_V(6); PG8_BAR; PG8_MMA(1, 1, At, B1); PG8_BAR;
            PG8_LDB(B0, 1, 0); PG8_SCHED; PG8_LDA(At, 1, 0); PG8_STAGE(PG8_SA(0, 1), rsA, a2 + hstepA, voffA);
            PG8_WAIT_L(8); PG8_BAR; PG8_WAIT_L(0); PG8_MMA(0, 0, At, B0); PG8_BAR; PG8_SCHED;
            PG8_LDB(B1, 1, 1); PG8_STAGE(PG8_SB(1, 0), rsB, b3, voffB);
            PG8_BAR; PG8_WAIT_L(0); PG8_MMA(0, 1, At, B1); PG8_BAR;
            PG8_LDA(At, 1, 1); PG8_STAGE(PG8_SA(1, 0), rsA, a3, voffA);
            PG8_BAR; PG8_WAIT_L(0); PG8_MMA(1, 0, At, B0); PG8_BAR; PG8_SCHED;
            PG8_STAGE(PG8_SB(1, 1), rsB, b3 + hstepB, voffB);
            PG8_WAIT_V(6); PG8_BAR; PG8_MMA(1, 1, At, B1); PG8_BAR;
        }
        { const int l2 = phase_tid(wave) & 63; E(acc, cur, wr, wc, l2 & 15, l2 >> 4); }
        if (!has_next) break;
#pragma unroll
        for (int a = 0; a < 2; ++a)
#pragma unroll
            for (int b = 0; b < 2; ++b)
#pragma unroll
                for (int m = 0; m < 4; ++m)
#pragma unroll
                    for (int n = 0; n < 2; ++n) acc[a][b][m][n] = (f32x4){0.f, 0.f, 0.f, 0.f};
        cur = nxt; cA = nA; cB = nB; ++ui;
    }
    PG8_WAIT_V(0);
    if (wr == 0) PG8_BAR;
    PG8_BAR;
#undef PG8_SA
#undef PG8_SB
#undef PG8_STAGE
#undef PG8_LDA
#undef PG8_LDB
#undef PG8_MMA
#undef PG8_CAT
#undef PG8_WAIT_V
#undef PG8_WAIT_L
#undef PG8_BAR
#undef PG8_SCHED
}
}
using pg8::Unit;

#define EPI_LOOP_BEGIN \
    _Pragma("unroll") for (int ai = 0; ai < 2; ++ai) _Pragma("unroll") for (int m = 0; m < 4; ++m) { const int r = u.pm * 256 + ai * 128 + wr * 64 + m * 16 + fr; \
    _Pragma("unroll") for (int bj = 0; bj < 2; ++bj) _Pragma("unroll") for (int n = 0; n < 2; ++n) { const int cl = bj * 128 + wc * 32 + 16 * n + 4 * fq; const f32x4 a = acc[ai][bj][m][n];
#define EPI_LOOP_END } }

struct EpiP {
    static constexpr bool PERM = true; bf16_t* C;
    __device__ __forceinline__ void operator()(const f32x4 (&acc)[2][2][4][2], const Unit& u, int wr, int wc, int fr, int fq) const {
#pragma unroll
        for (int ai = 0; ai < 2; ++ai)
#pragma unroll
            for (int m = 0; m < 4; ++m) { const int r = u.pm * 256 + ai * 128 + wr * 64 + m * 16 + fr;
#pragma unroll
                for (int bj = 0; bj < 2; ++bj) { const int c0 = u.pn * 256 + bj * 128 + wc * 32 + 8 * fq; const f32x4 v0 = acc[ai][bj][m][0], v1 = acc[ai][bj][m][1];
                    u32x4 w; w.x = cvt_pk_bf16(v0[0], v0[1]); w.y = cvt_pk_bf16(v0[2], v0[3]); w.z = cvt_pk_bf16(v1[0], v1[1]); w.w = cvt_pk_bf16(v1[2], v1[3]);
                    *(u32x4*)(C + (size_t)r * NINP + c0) = w; } }
    }
};
#define EPI_COLS(ptr) f32x4 cv[2][2]; _Pragma("unroll") for (int bj = 0; bj < 2; ++bj) _Pragma("unroll") for (int n = 0; n < 2; ++n) cv[bj][n] = ld4((ptr) + bj * 128 + wc * 32 + 16 * n + 4 * fq);
#define EPI_COLS_PERM(ptr) f32x4 cv[2][2]; _Pragma("unroll") for (int bj = 0; bj < 2; ++bj) _Pragma("unroll") for (int n = 0; n < 2; ++n) cv[bj][n] = ld4((ptr) + bj * 128 + wc * 32 + 8 * fq + 4 * n);
struct EpiLora {
    static constexpr bool PERM = false; float* dec; bf16_t *iclr, *gg; const float *w0, *a0;
    __device__ __forceinline__ void operator()(const f32x4 (&acc)[2][2][4][2], const Unit& u, int wr, int wc, int fr, int fq) const {
        const int sect = u.pn >> 2, cb = (u.pn & 3) * 256;
        EPI_COLS((sect == 0 ? w0 : a0) + cb)
        EPI_LOOP_BEGIN
            const int c = cb + cl; f32x4 o;
            if (sect == 0) {
#pragma unroll
                for (int j = 0; j < 4; ++j) o[j] = __builtin_amdgcn_exp2f(-0.6065306597126334f * 1.4426950408889634f * sigmoidf_(cv[bj][n][j] + a[j]));
                *(f32x4*)(dec + (size_t)r * NC + c) = o; }
            else if (sect == 1) {
#pragma unroll
                for (int j = 0; j < 4; ++j) o[j] = sigmoidf_(cv[bj][n][j] + a[j]);
                u32x2 wv; wv.x = cvt_pk_bf16(o[0], o[1]); wv.y = cvt_pk_bf16(o[2], o[3]); *(u32x2*)(iclr + (size_t)r * NC + c) = wv; }
            else { u32x2 wv; wv.x = cvt_pk_bf16(a[0], a[1]); wv.y = cvt_pk_bf16(a[2], a[3]); *(u32x2*)(gg + (size_t)r * NC + c) = wv; }
        EPI_LOOP_END
    }
};
struct EpiPool {
    static constexpr bool PERM = true; bf16_t* t1; const bf16_t* P; const float* pscale;
    __device__ __forceinline__ void operator()(const f32x4 (&acc)[2][2][4][2], const Unit& u, int wr, int wc, int fr, int fq) const {
        EPI_COLS_PERM(pscale + u.pn * 256)
#pragma unroll
        for (int ai = 0; ai < 2; ++ai) { u32x4 gq[4][2];
#pragma unroll
            for (int m = 0; m < 4; ++m)
#pragma unroll
                for (int bj = 0; bj < 2; ++bj) gq[m][bj] = ldu4nt(P + (size_t)(u.pm * 256 + ai * 128 + wr * 64 + m * 16 + fr) * NINP + OFF_GB + u.pn * 256 + bj * 128 + wc * 32 + 8 * fq);
#pragma unroll
            for (int m = 0; m < 4; ++m) { const int r = u.pm * 256 + ai * 128 + wr * 64 + m * 16 + fr;
#pragma unroll
                for (int bj = 0; bj < 2; ++bj) { const int c0 = u.pn * 256 + bj * 128 + wc * 32 + 8 * fq;
                    const f32x4 g0 = bf4_unpack((u32x2){gq[m][bj].x, gq[m][bj].y}), g1 = bf4_unpack((u32x2){gq[m][bj].z, gq[m][bj].w}), a0 = acc[ai][bj][m][0], a1 = acc[ai][bj][m][1]; f32x4 o0, o1;
#pragma unroll
                    for (int j = 0; j < 4; ++j) { o0[j] = sigmoidf_(g0[j]) * cv[bj][0][j] * a0[j]; o1[j] = sigmoidf_(g1[j]) * cv[bj][1][j] * a1[j]; }
                    u32x4 w; w.x = cvt_pk_bf16(o0[0], o0[1]); w.y = cvt_pk_bf16(o0[2], o0[3]); w.z = cvt_pk_bf16(o1[0], o1[1]); w.w = cvt_pk_bf16(o1[2], o1[3]);
                    *(u32x4*)(t1 + (size_t)r * ND + c0) = w; } } }
    }
};
struct EpiRwkv {
    static constexpr bool PERM = true; bf16_t* mx; const bf16_t* P; const bf16_t* t1;
    __device__ __forceinline__ void operator()(const f32x4 (&acc)[2][2][4][2], const Unit& u, int wr, int wc, int fr, int fq) const {
#pragma unroll
        for (int ai = 0; ai < 2; ++ai) { u32x4 gq[4][2], tq[4][2];
#pragma unroll
            for (int m = 0; m < 4; ++m)
#pragma unroll
                for (int bj = 0; bj < 2; ++bj) { const int r = u.pm * 256 + ai * 128 + wr * 64 + m * 16 + fr, c0 = u.pn * 256 + bj * 128 + wc * 32 + 8 * fq;
                    gq[m][bj] = ldu4nt(P + (size_t)r * NINP + OFF_GA + c0); tq[m][bj] = ldu4nt(t1 + (size_t)r * ND + c0); }
#pragma unroll
            for (int m = 0; m < 4; ++m) { const int r = u.pm * 256 + ai * 128 + wr * 64 + m * 16 + fr;
#pragma unroll
                for (int bj = 0; bj < 2; ++bj) { const int c0 = u.pn * 256 + bj * 128 + wc * 32 + 8 * fq;
                    const f32x4 g0 = bf4_unpack((u32x2){gq[m][bj].x, gq[m][bj].y}), g1 = bf4_unpack((u32x2){gq[m][bj].z, gq[m][bj].w});
                    const f32x4 t0 = bf4_unpack((u32x2){tq[m][bj].x, tq[m][bj].y}), t1v = bf4_unpack((u32x2){tq[m][bj].z, tq[m][bj].w}), a0 = acc[ai][bj][m][0], a1 = acc[ai][bj][m][1]; f32x4 o0, o1;
#pragma unroll
                    for (int j = 0; j < 4; ++j) { o0[j] = sigmoidf_(g0[j]) * a0[j] + t0[j]; o1[j] = sigmoidf_(g1[j]) * a1[j] + t1v[j]; }
                    u32x4 w; w.x = cvt_pk_bf16(o0[0], o0[1]); w.y = cvt_pk_bf16(o0[2], o0[3]); w.z = cvt_pk_bf16(o1[0], o1[1]); w.w = cvt_pk_bf16(o1[2], o1[3]);
                    *(u32x4*)(mx + (size_t)r * ND + c0) = w; } } }
    }
};
struct EpiWout {
    static constexpr bool PERM = true; float* z1; const float* x; const float* mod;
    __device__ __forceinline__ void operator()(const f32x4 (&acc)[2][2][4][2], const Unit& u, int wr, int wc, int fr, int fq) const {
        const int b = u.pm >> 3;
        EPI_COLS_PERM(mod + (size_t)b * NMOD + 2 * ND + u.pn * 256)
#pragma unroll
        for (int ai = 0; ai < 2; ++ai)
#pragma unroll
            for (int mh = 0; mh < 2; ++mh) { f32x4 xq[2][2][2];
#pragma unroll
                for (int m2 = 0; m2 < 2; ++m2)
#pragma unroll
                    for (int bj = 0; bj < 2; ++bj)
#pragma unroll
                        for (int n = 0; n < 2; ++n) xq[m2][bj][n] = ld4nt(x + (size_t)(u.pm * 256 + ai * 128 + wr * 64 + (mh * 2 + m2) * 16 + fr) * ND + u.pn * 256 + bj * 128 + wc * 32 + 8 * fq + 4 * n);
#pragma unroll
                for (int m2 = 0; m2 < 2; ++m2) { const int m = mh * 2 + m2, r = u.pm * 256 + ai * 128 + wr * 64 + m * 16 + fr;
#pragma unroll
                    for (int bj = 0; bj < 2; ++bj)
#pragma unroll
                        for (int n = 0; n < 2; ++n) { const int c = u.pn * 256 + bj * 128 + wc * 32 + 8 * fq + 4 * n;
                            *(f32x4*)(z1 + (size_t)r * ND + c) = xq[m2][bj][n] * DN_ALPHA + cv[bj][n] * acc[ai][bj][m][n]; } } }
    }
};
struct EpiGU {
    static constexpr bool PERM = true; fp8_t* act; const float* b_gu;
    __device__ __forceinline__ void operator()(const f32x4 (&acc)[2][2][4][2], const Unit& u, int wr, int wc, int fr, int fq) const {
        const float* bias = b_gu + (size_t)u.e * (2 * DFF) + u.pn * 256 + wc * 32 + 8 * fq;
#pragma unroll
        for (int bj = 0; bj < 2; ++bj) { const f32x4 c0v = ld4(bias + bj * 128), c1v = ld4(bias + bj * 128 + 4); const int c0 = u.pn * 256 + bj * 128 + wc * 32 + 8 * fq;
#pragma unroll
            for (int ai = 0; ai < 2; ++ai)
#pragma unroll
                for (int m = 0; m < 4; ++m) { const int r = u.pm * 256 + ai * 128 + wr * 64 + m * 16 + fr;
                    const f32x4 v0 = acc[ai][bj][m][0] * W8_INV + c0v, v1 = acc[ai][bj][m][1] * W8_INV + c1v;
                    float o[4];
#pragma unroll
                    for (int j = 0; j < 4; ++j) { const float gt = fminf(j < 2 ? v0[2 * j] : v1[2 * j - 4], SW_LIMIT); const float up = fminf(fmaxf(j < 2 ? v0[2 * j + 1] : v1[2 * j - 3], -SW_LIMIT), SW_LIMIT);
                        o[j] = (up + 1.0f) * (gt * __builtin_amdgcn_rcpf(1.0f + __builtin_amdgcn_exp2f(gt * (-SW_ALPHA * 1.4426950408889634f)))); }
                    *(unsigned*)(act + (size_t)r * DFF + (c0 >> 1)) = pack4_fp8(o[0], o[1], o[2], o[3]); } }
    }
};
struct EpiDown {
    static constexpr bool PERM = true; bf16_t* yb; const float* b_down;
    __device__ __forceinline__ void operator()(const f32x4 (&acc)[2][2][4][2], const Unit& u, int wr, int wc, int fr, int fq) const {
        const float* bias = b_down + (size_t)u.e * ND + u.pn * 256 + wc * 32 + 8 * fq;
#pragma unroll
        for (int bj = 0; bj < 2; ++bj) { const f32x4 c0v = ld4(bias + bj * 128), c1v = ld4(bias + bj * 128 + 4); const int c0 = u.pn * 256 + bj * 128 + wc * 32 + 8 * fq;
#pragma unroll
            for (int ai = 0; ai < 2; ++ai)
#pragma unroll
                for (int m = 0; m < 4; ++m) { const int r = u.pm * 256 + ai * 128 + wr * 64 + m * 16 + fr;
                    const f32x4 v0 = acc[ai][bj][m][0] * W8_INV + c0v, v1 = acc[ai][bj][m][1] * W8_INV + c1v;
                    u32x4 w; w.x = cvt_pk_bf16(v0[0], v0[1]); w.y = cvt_pk_bf16(v0[2], v0[3]); w.z = cvt_pk_bf16(v1[0], v1[1]); w.w = cvt_pk_bf16(v1[2], v1[3]);
                    *(u32x4*)(yb + (size_t)r * ND + c0) = w; } }
    }
};

struct WinRestOrder {
    int c; size_t a_tile, b_tile;
    __device__ bool next(int i, Unit& u) const {
        if (i > 0 || c < 0 || c >= 64) return false;
        u.pm = c >> 1; u.pn = 23 + (c & 1); u.e = 0; u.aoff = (unsigned)((size_t)u.pm * a_tile); u.boff = (unsigned)((size_t)u.pn * b_tile); return true;
    }
};
struct PoolOrder {
    int G, c;
    __device__ bool next(int i, Unit& u) const {
        const int L = i * G + c; if (c < 0 || L >= 256) return false;
        u.pm = L >> 3; u.pn = L & 7; u.e = 0;
        u.aoff = (unsigned)(((size_t)u.pm * 256 * NC + (size_t)(u.pn >> 1) * 256) * 2); u.boff = (unsigned)((size_t)u.pn * 256 * 256 * 2); return true;
    }
};
struct MoeOrder {
    int G, c, nN, ntiles; const LAS unsigned* tile_e; size_t a_tile, b_expert, b_tile;
    __device__ bool next(int i, Unit& u) const {
        const int L = i * G + c; if (L >= ntiles * nN) return false;
        u.pm = L / nN; u.pn = L % nN; u.e = __builtin_amdgcn_readfirstlane((int)tile_e[u.pm]);
        u.aoff = (unsigned)((size_t)u.pm * a_tile); u.boff = (unsigned)((size_t)u.e * b_expert + (size_t)u.pn * b_tile); return true;
    }
};

__device__ __forceinline__ void cvt_block_T(const float* src, int ld_src, bf16_t* dst, int ld_dst, int lane) {
    const int k8 = lane & 7, nq = lane >> 3;
    const float* s = src + (size_t)(k8 * 8) * ld_src + nq * 4;
    f32x4 v[8];
#pragma unroll
    for (int j = 0; j < 8; ++j) v[j] = __builtin_nontemporal_load((const f32x4*)(s + (size_t)j * ld_src));
#pragma unroll
    for (int i = 0; i < 4; ++i) { u32x4 w; w.x = cvt_pk_bf16(v[0][i], v[1][i]); w.y = cvt_pk_bf16(v[2][i], v[3][i]); w.z = cvt_pk_bf16(v[4][i], v[5][i]); w.w = cvt_pk_bf16(v[6][i], v[7][i]);
        *(u32x4*)(dst + (size_t)(nq * 4 + i) * ld_dst + k8 * 8) = w; }
}
__device__ __forceinline__ void cvt_block_T2(const float* src, int ld_src, bf16_t* dst, int ld_dst, int lane) {
    const int k8 = lane & 7, nq = lane >> 3;
    const float* s = src + (size_t)(k8 * 8) * ld_src + nq * 4;
    f32x4 v[8], w2[8];
#pragma unroll
    for (int j = 0; j < 8; ++j) { v[j] = ld4(s + (size_t)j * ld_src); w2[j] = ld4(s + (size_t)j * ld_src + 32); }
#pragma unroll
    for (int i = 0; i < 4; ++i) { u32x4 w; w.x = cvt_pk_bf16(v[0][i], v[1][i]); w.y = cvt_pk_bf16(v[2][i], v[3][i]); w.z = cvt_pk_bf16(v[4][i], v[5][i]); w.w = cvt_pk_bf16(v[6][i], v[7][i]);
        *(u32x4*)(dst + (size_t)(nq * 4 + i) * ld_dst + k8 * 8) = w; }
#pragma unroll
    for (int i = 0; i < 4; ++i) { u32x4 w; w.x = cvt_pk_bf16(w2[0][i], w2[1][i]); w.y = cvt_pk_bf16(w2[2][i], w2[3][i]); w.z = cvt_pk_bf16(w2[4][i], w2[5][i]); w.w = cvt_pk_bf16(w2[6][i], w2[7][i]);
        *(u32x4*)(dst + (size_t)(32 + nq * 4 + i) * ld_dst + k8 * 8) = w; }
}

__device__ __forceinline__ void cvt8_load(f32x4 (&v)[16], const float* s, int ld_src) {
#pragma unroll
    for (int j = 0; j < 16; ++j) v[j] = __builtin_nontemporal_load((const f32x4*)(s + (size_t)j * ld_src));
}
__device__ __forceinline__ void cvt8_store(const f32x4 (&v)[16], fp8_t* d, int ld_dst) {
#pragma unroll
    for (int i = 0; i < 4; ++i) { u32x4 w; w.x = pack4_fp8(v[0][i] * W8_SCALE, v[1][i] * W8_SCALE, v[2][i] * W8_SCALE, v[3][i] * W8_SCALE); w.y = pack4_fp8(v[4][i] * W8_SCALE, v[5][i] * W8_SCALE, v[6][i] * W8_SCALE, v[7][i] * W8_SCALE);
        w.z = pack4_fp8(v[8][i] * W8_SCALE, v[9][i] * W8_SCALE, v[10][i] * W8_SCALE, v[11][i] * W8_SCALE); w.w = pack4_fp8(v[12][i] * W8_SCALE, v[13][i] * W8_SCALE, v[14][i] * W8_SCALE, v[15][i] * W8_SCALE);
        __builtin_nontemporal_store(w, (u32x4*)(d + (size_t)i * ld_dst)); }
}
__device__ __forceinline__ void cvt_wave_T8x8(const float* src, int ld_src, fp8_t* dst, int ld_dst, int lane) {
    const int k16 = lane & 7, nq = lane >> 3;
    const float* s = src + (size_t)(k16 * 16) * ld_src + nq * 4; fp8_t* d = dst + (size_t)(nq * 4) * ld_dst + k16 * 16;
    f32x4 va[16], vb[16];
    cvt8_load(va, s, ld_src);
#pragma unroll
    for (int i = 0; i < 8; i += 2) {
        cvt8_load(vb, s + (i + 1) * 32, ld_src);
        cvt8_store(va, d + (size_t)(i * 32) * ld_dst, ld_dst);
        if (i + 2 < 8) cvt8_load(va, s + (i + 2) * 32, ld_src);
        cvt8_store(vb, d + (size_t)((i + 1) * 32) * ld_dst, ld_dst);
    }
}

__device__ __forceinline__ void phase0(const Params& p, LAS unsigned char* lds, const int wave) {
    const int tid = phase_tid(wave);
    const int bid = blockIdx.x, lane = tid & 63, wv = tid >> 6;
    LAS float* cond = (LAS float*)lds;
    if (bid < 192) {
        for (int i = tid; i < NB * ND; i += NTHREADS) { const int b = i >> 11, k = i & 2047; const float cv = p.c[i]; cond[k * 4 + b] = cv / (1.0f + expf(-cv)); }
        __syncthreads();
        const int gid = bid * NTHREADS + tid, ks = gid / 3072, j4 = gid % 3072;
        f32x4 a0 = {0.f, 0.f, 0.f, 0.f}, a1 = a0, a2 = a0, a3 = a0;
        const float* wp = p.w_ada + (size_t)(ks * 64) * NMOD + j4 * 4;
#pragma unroll 8
        for (int kk = 0; kk < 64; ++kk) { const f32x4 w = __builtin_nontemporal_load((const f32x4*)(wp + (size_t)kk * NMOD)); const f32x4 cd = *(const LAS f32x4*)(cond + (ks * 64 + kk) * 4);
            a0 += w * cd[0]; a1 += w * cd[1]; a2 += w * cd[2]; a3 += w * cd[3]; }
        *(f32x4*)(p.modp + (size_t)(ks * 4 + 0) * NMOD + j4 * 4) = a0; *(f32x4*)(p.modp + (size_t)(ks * 4 + 1) * NMOD + j4 * 4) = a1;
        *(f32x4*)(p.modp + (size_t)(ks * 4 + 2) * NMOD + j4 * 4) = a2; *(f32x4*)(p.modp + (size_t)(ks * 4 + 3) * NMOD + j4 * 4) = a3;
    }
    const int gw = bid * NWAVES + wv, GW = gridDim.x * NWAVES;
    constexpr int I_IN = 32 * 265, I_RW = 16 * 64, I_PL = 4 * 4 * 16, I_OUT = 32 * 64, I_ALL = I_IN + I_RW + I_PL + I_OUT;
    for (int it = gw; it < I_ALL; it += GW) {
        if (it < I_IN) { const int kb = it / 265, nb = it % 265; cvt_block_T(p.w_in + (size_t)(kb * 64) * NIN + nb * 32, NIN, p.wt_in + (size_t)(nb * 32) * ND + kb * 64, ND, lane); }
        else if (it < I_IN + I_RW) { const int j = it - I_IN, kb = j / 64, nb = j % 64; cvt_block_T(p.w_rwkv_out + (size_t)(kb * 64) * ND + nb * 32, ND, p.wt_rwkv + (size_t)(nb * 32) * NC + kb * 64, NC, lane); }
        else if (it < I_IN + I_RW + I_PL) { const int j = it - I_IN - I_RW, g = j / 64, kb = (j % 64) / 16, nb = j % 16;
            cvt_block_T(p.w_pool + (size_t)g * 256 * 512 + (size_t)(kb * 64) * 512 + nb * 32, 512, p.wt_pool + (size_t)g * 512 * 256 + (size_t)(nb * 32) * 256 + kb * 64, 256, lane); }
        else { const int j = it - I_IN - I_RW - I_PL, kb = j / 64, nb = j % 64; cvt_block_T(p.w_out + (size_t)(kb * 64) * ND + nb * 32, ND, p.wt_out + (size_t)(nb * 32) * ND + kb * 64, ND, lane); }
    }
    for (int idx = bid * NTHREADS + tid; idx < LORA_N * (LORA_K / 8); idx += gridDim.x * NTHREADS) {
        const int n = idx / (LORA_K / 8), k0 = (idx % (LORA_K / 8)) * 8; float v[8];
#pragma unroll
        for (int j = 0; j < 8; ++j) { const int k = k0 + j; float x = 0.f;
            if (n < 1024) { if (k < 64) x = p.w_decay_up[k * NC + n]; }
            else if (n < 2048) { if (k >= 64 && k < 128) x = p.w_iclr_up[(k - 64) * NC + (n - 1024)]; }
            else { if (k >= 128 && k < 288) x = p.w_glora_up[(k - 128) * NC + (n - 2048)]; }
            v[j] = x; }
        u32x4 w; w.x = cvt_pk_bf16(v[0], v[1]); w.y = cvt_pk_bf16(v[2], v[3]); w.z = cvt_pk_bf16(v[4], v[5]); w.w = cvt_pk_bf16(v[6], v[7]);
        *(u32x4*)(p.bt_lora + (size_t)n * LORA_K + k0) = w;
    }
}

__device__ __forceinline__ void phase1(const Params& p, LAS unsigned char* lds, const int wave) {
    const int tid = phase_tid(wave);
    const int bid = blockIdx.x;
    if (tid < 192) { const int idx = bid * 192 + tid, b = idx / NMOD, j = idx % NMOD; float s = p.b_ada[j];
        for (int ks = 0; ks < KS_MOD; ++ks) s += p.modp[(size_t)(ks * 4 + b) * NMOD + j];
        p.mod[idx] = s; }
    LAS float* ss = (LAS float*)lds;
    const int m0 = bid * 32, b = m0 >> 11;
    {   const int j = tid * 8; f32x4 s0 = ld4(p.b_ada + j), s1 = ld4(p.b_ada + j + 4);
#pragma unroll 8
        for (int ks = 0; ks < KS_MOD; ++ks) { s0 += ld4(p.modp + (size_t)(ks * 4 + b) * NMOD + j); s1 += ld4(p.modp + (size_t)(ks * 4 + b) * NMOD + j + 4); }
        *(LAS f32x4*)(ss + j) = s0; *(LAS f32x4*)(ss + j + 4) = s1; }
    __syncthreads();
    const int k = (tid & 255) * 8, rh = tid >> 8;
    const f32x4 sh0 = *(const LAS f32x4*)(ss + k), sh1v = *(const LAS f32x4*)(ss + k + 4), sc0 = *(const LAS f32x4*)(ss + ND + k) + 1.0f, sc1v = *(const LAS f32x4*)(ss + ND + k + 4) + 1.0f;
#pragma unroll 4
    for (int i = 0; i < 16; ++i) { const size_t m = (size_t)(m0 + 2 * i + rh); const f32x4 x0 = ld4nt(p.x + m * ND + k), x1 = ld4nt(p.x + m * ND + k + 4); const f32x4 h0 = x0 * sc0 + sh0, h1 = x1 * sc1v + sh1v;
        u32x4 w; w.x = cvt_pk_bf16(h0[0], h0[1]); w.y = cvt_pk_bf16(h0[2], h0[3]); w.z = cvt_pk_bf16(h1[0], h1[1]); w.w = cvt_pk_bf16(h1[2], h1[3]); *(u32x4*)(p.hb + m * ND + k) = w; }
    __syncthreads();
}

__device__ __forceinline__ void phase3(const Params& p, LAS unsigned char* lds, const int wave) {
    const int tid = phase_tid(wave);
    const int bid = blockIdx.x, m0 = bid * 32, t0 = m0 & (NT - 1), hist = t0 > 0 ? 15 : 0;
    constexpr int TC = OFF_GA - OFF_WD, TCH = TC / 8;
    LAS bf16_t* T = (LAS bf16_t*)lds;
    for (int idx = tid; idx < 47 * TCH; idx += NTHREADS) { const int r = idx / TCH, ck = idx % TCH;
        if (r >= 15 - hist) *(LAS u32x4*)(T + r * TC + ck * 8) = ldu4nt(p.P + (size_t)(m0 - 15 + r) * NINP + OFF_WD + ck * 8); }
    __syncthreads();
    for (int idx = tid; idx < 32 * (LORA_K / 8); idx += NTHREADS) { const int i = idx / (LORA_K / 8), j0 = (idx % (LORA_K / 8)) * 8; u32x4 w = {0u, 0u, 0u, 0u};
        if (j0 < 288) { const u32x4 cu = *(const LAS u32x4*)(T + (15 + i) * TC + j0); u32x4 pu = {0u, 0u, 0u, 0u}; if (t0 + i > 0) pu = *(const LAS u32x4*)(T + (14 + i) * TC + j0);
            const f32x4 c0 = bf4_unpack((u32x2){cu.x, cu.y}), c1 = bf4_unpack((u32x2){cu.z, cu.w}), q0 = bf4_unpack((u32x2){pu.x, pu.y}), q1 = bf4_unpack((u32x2){pu.z, pu.w});
            const f32x4 s0 = c0 + (q0 - c0) * ld4(p.mu_shift + OFF_WD + j0), s1 = c1 + (q1 - c1) * ld4(p.mu_shift + OFF_WD + j0 + 4); float v[8];
#pragma unroll
            for (int j = 0; j < 8; ++j) { const float x = j < 4 ? s0[j] : s1[j - 4];
                v[j] = j0 < 64 ? (1.0f - 2.0f * __builtin_amdgcn_rcpf(1.0f + __builtin_amdgcn_exp2f(x * 2.8853900817779268f))) : (j0 < 128 ? x : sigmoidf_(x)); }
            w.x = cvt_pk_bf16(v[0], v[1]); w.y = cvt_pk_bf16(v[2], v[3]); w.z = cvt_pk_bf16(v[4], v[5]); w.w = cvt_pk_bf16(v[6], v[7]); }
        *(u32x4*)(p.a_lora + (size_t)(m0 + i) * LORA_K + j0) = w; }
    for (int idx = tid; idx < 32 * (NC / 8); idx += NTHREADS) { const int i = idx >> 7, c = (idx & 127) * 8; const int win = 2 << (c >> 8), t = t0 + i, n = (t + 1) < win ? (t + 1) : win;
        const LAS bf16_t* up = T + (15 + i) * TC + (OFF_POOL - OFF_WD) + c; f32x4 a0 = {0.f, 0.f, 0.f, 0.f}, a1 = a0;
        for (int q = 0; q < n; ++q) { const u32x4 uu = *(const LAS u32x4*)(up - q * TC); a0 += bf4_unpack((u32x2){uu.x, uu.y}); a1 += bf4_unpack((u32x2){uu.z, uu.w}); }
        const u32x4 u0 = *(const LAS u32x4*)(up); const float rn = 1.0f / (float)n;
        const f32x4 d0 = a0 * rn - bf4_unpack((u32x2){u0.x, u0.y}), d1 = a1 * rn - bf4_unpack((u32x2){u0.z, u0.w});
        u32x4 w; w.x = cvt_pk_bf16(d0[0], d0[1]); w.y = cvt_pk_bf16(d0[2], d0[3]); w.z = cvt_pk_bf16(d1[0], d1[1]); w.w = cvt_pk_bf16(d1[2], d1[3]);
        *(u32x4*)(p.dp + (size_t)(m0 + i) * NC + c) = w; }
    __syncthreads();
}

__device__ __forceinline__ float row8_allsum(float x) {
    x += dpp_f<0x141>(x); x += dpp_f<0x1B>(x); x += dpp_f<0xB1>(x); return x;
}
__device__ __forceinline__ void scan_head(const Params& p, LAS unsigned char* lds, int bh, const int wave) {
    const int tid = phase_tid(wave);
    const int lane = tid & 63;
    const int b = bh >> 4, h = bh & 15;
    constexpr int L_AW = 0, L_W = 16384, L_BK = 32768, L_Y = 65536, L_V = 81920, L_G = 106496, L_SC = 131072, L_CS = 131840, L_Z = 132352, L_DUMMY = 132864, L_CST = 133888;
    constexpr int NCH = NT / 32;
    if (tid < 128) *(LAS unsigned*)(lds + L_Z + tid * 4) = 0u;
    {
        const int a8 = tid >> 6, cc = tid & 63, gch = h * HS + cc;
        const float* src = a8 == 0 ? p.mu_shift + OFF_R : a8 == 1 ? p.mu_shift + OFF_K : a8 == 2 ? p.mu_shift + OFF_V : a8 == 3 ? p.k_k : a8 == 4 ? p.k_a : a8 == 5 ? p.r_k : a8 == 6 ? p.lnx_g : p.lnx_b;
        *(LAS float*)(lds + L_CST + a8 * 256 + cc * 4) = src[gch]; }
    __syncthreads();
#define CST4(a8, u_) (*(const LAS f32x4*)(lds + L_CST + (a8) * 256 + (c8 + 4 * (u_)) * 4))
    const int ht = tid - 256, ls = (ht >> 3) & 31, c8 = (ht & 7) * 8, ch0 = h * HS + c8;
    f32x4 pr[2], pk[2], pv[2], qr[2], qk[2], qv[2], dc[2], ic[2], gt[2]; u32x4 pr8, pk8, pv8, qr8, qk8, qv8, ic8, gt8;
    const f32x4 zero4 = {0.f, 0.f, 0.f, 0.f};
#define SCAN_ISSUE(chunk) do { int ch = ch0; asm volatile("" : "+v"(ch)); const int t_ = (chunk) * 32 + ls; const size_t m_ = (size_t)b * NT + t_; const bf16_t* row_ = p.P + m_ * NINP + ch; \
        pr8 = *(const u32x4*)(row_ + OFF_R); pk8 = *(const u32x4*)(row_ + OFF_K); pv8 = *(const u32x4*)(row_ + OFF_V); \
        if (t_ > 0) { qr8 = *(const u32x4*)(row_ - NINP + OFF_R); qk8 = *(const u32x4*)(row_ - NINP + OFF_K); qv8 = *(const u32x4*)(row_ - NINP + OFF_V); } else { qr8 = (u32x4){0u, 0u, 0u, 0u}; qk8 = qr8; qv8 = qr8; } \
        ic8 = ldu4nt(p.iclr + m_ * NC + ch); gt8 = ldu4nt(p.gg + m_ * NC + ch); \
        _Pragma("unroll") for (int u_ = 0; u_ < 2; ++u_) dc[u_] = ld4nt(p.dec + m_ * NC + ch + 4 * u_); } while (0)
#define SCAN_UNPACK() do { ic[0] = bf4_unpack((u32x2){ic8.x, ic8.y}); ic[1] = bf4_unpack((u32x2){ic8.z, ic8.w}); gt[0] = bf4_unpack((u32x2){gt8.x, gt8.y}); gt[1] = bf4_unpack((u32x2){gt8.z, gt8.w}); pr[0] = bf4_unpack((u32x2){pr8.x, pr8.y}); pr[1] = bf4_unpack((u32x2){pr8.z, pr8.w}); pk[0] = bf4_unpack((u32x2){pk8.x, pk8.y}); pk[1] = bf4_unpack((u32x2){pk8.z, pk8.w}); \
        pv[0] = bf4_unpack((u32x2){pv8.x, pv8.y}); pv[1] = bf4_unpack((u32x2){pv8.z, pv8.w}); qr[0] = bf4_unpack((u32x2){qr8.x, qr8.y}); qr[1] = bf4_unpack((u32x2){qr8.z, qr8.w}); \
        qk[0] = bf4_unpack((u32x2){qk8.x, qk8.y}); qk[1] = bf4_unpack((u32x2){qk8.z, qk8.w}); qv[0] = bf4_unpack((u32x2){qv8.x, qv8.y}); qv[1] = bf4_unpack((u32x2){qv8.z, qv8.w}); } while (0)
#define SCAN_STAGE(chunk) do { SCAN_UNPACK(); int ch = ch0; asm volatile("" : "+v"(ch)); const int bp_ = (chunk) & 1, vb_ = (chunk) % 3; f32x4 r_[2], k_[2], v_[2], kk_[2], km_[2], bb_[2]; float ss_ = 0.f; \
        _Pragma("unroll") for (int u_ = 0; u_ < 2; ++u_) { const f32x4 mu_r = CST4(0, u_), mu_k = CST4(1, u_), mu_v = CST4(2, u_); \
            r_[u_] = pr[u_] + (qr[u_] - pr[u_]) * mu_r; k_[u_] = pk[u_] + (qk[u_] - pk[u_]) * mu_k; v_[u_] = pv[u_] + (qv[u_] - pv[u_]) * mu_v; \
            kk_[u_] = k_[u_] * CST4(3, u_); ss_ += dot4(kk_[u_], kk_[u_]); } \
        ss_ = row8_allsum(ss_); const float inv_ = 1.0f / fmaxf(sqrtf(ss_), 1e-12f); float br_ = 0.f, kr_ = 0.f, rk_ = 0.f; \
        _Pragma("unroll") for (int u_ = 0; u_ < 2; ++u_) { kk_[u_] = kk_[u_] * inv_; km_[u_] = k_[u_] * ((ic[u_] - 1.0f) * CST4(4, u_) + 1.0f); bb_[u_] = kk_[u_] * ic[u_]; \
            br_ += dot4(bb_[u_], r_[u_]); kr_ += dot4(km_[u_], r_[u_]); rk_ += dot4(r_[u_] * km_[u_], CST4(5, u_)); } \
        br_ = row8_allsum(br_); kr_ = row8_allsum(kr_); rk_ = row8_allsum(rk_); \
          \
        const int pp_ = ls >> 1, odd_ = ls & 1; float c1_ = 0.f, c2_ = 0.f, c3_ = 0.f, c4_ = 0.f; \
        _Pragma("unroll") for (int u_ = 0; u_ < 2; ++u_) { const int k0_ = c8 + 4 * u_; const int pos_ = (k0_ >> 5) * 32 + ((k0_ & 15) >> 2) * 8 + ((k0_ >> 4) & 1) * 4; \
            const f32x4 a_ = -kk_[u_], wr_ = dc[u_] * r_[u_] + a_ * br_; f32x4 pw_, pb_, pk_; \
            _Pragma("unroll") for (int j_ = 0; j_ < 4; ++j_) { pw_[j_] = dpp_f<0x118>(dc[u_][j_]); pb_[j_] = dpp_f<0x118>(bb_[u_][j_]); pk_[j_] = dpp_f<0x118>(km_[u_][j_]); } \
            const f32x4 x0_ = odd_ ? pw_ * a_ : a_, x1_ = odd_ ? pw_ * wr_ : wr_; \
            u32x2 wa_, ww_; wa_.x = cvt_pk_bf16(x0_[0], x0_[1]); wa_.y = cvt_pk_bf16(x0_[2], x0_[3]); ww_.x = cvt_pk_bf16(x1_[0], x1_[1]); ww_.y = cvt_pk_bf16(x1_[2], x1_[3]); \
            *(LAS u32x2*)(lds + L_AW + bp_ * 8192 + pp_ * 512 + odd_ * 256 + pos_ * 2) = wa_; *(LAS u32x2*)(lds + L_AW + bp_ * 8192 + pp_ * 512 + odd_ * 256 + 128 + pos_ * 2) = ww_; \
            if (odd_) { *(LAS f32x4*)(lds + L_W + bp_ * 8192 + pp_ * 256 + k0_ * 4) = pw_ * dc[u_]; \
                *(LAS f32x4*)(lds + L_BK + bp_ * 16384 + pp_ * 1024 + k0_ * 4) = pb_ * dc[u_]; *(LAS f32x4*)(lds + L_BK + bp_ * 16384 + pp_ * 1024 + 256 + k0_ * 4) = pk_ * dc[u_]; \
                *(LAS f32x4*)(lds + L_BK + bp_ * 16384 + pp_ * 1024 + 512 + k0_ * 4) = bb_[u_]; *(LAS f32x4*)(lds + L_BK + bp_ * 16384 + pp_ * 1024 + 768 + k0_ * 4) = km_[u_]; \
                c1_ += dot4(pb_, a_); c2_ += dot4(pk_, a_); c3_ += dot4(pb_, wr_); c4_ += dot4(pk_, wr_); } \
            *(LAS f32x4*)(lds + L_V + vb_ * 8192 + ls * 256 + k0_ * 4) = v_[u_]; *(LAS f32x4*)(lds + L_G + vb_ * 8192 + ls * 256 + k0_ * 4) = gt[u_]; } \
        c1_ = row8_allsum(c1_); c2_ = row8_allsum(c2_); c3_ = row8_allsum(c3_); c4_ = row8_allsum(c4_); \
        if ((ht & 7) == 0) { *(LAS f32x2*)(lds + L_SC + vb_ * 256 + ls * 8) = (f32x2){kr_, rk_}; if (odd_) *(LAS f32x4*)(lds + L_CS + bp_ * 256 + pp_ * 16) = (f32x4){c1_, c2_, c3_, c4_}; } } while (0)
#define SCAN_POST(chunk) do { int ch = ch0; asm volatile("" : "+v"(ch)); const int bp_ = (chunk) & 1, vb_ = (chunk) % 3; const f32x2 sc_ = *(const LAS f32x2*)(lds + L_SC + vb_ * 256 + ls * 8); f32x4 y_[2], v_[2]; float s_ = 0.f; \
        _Pragma("unroll") for (int u_ = 0; u_ < 2; ++u_) { v_[u_] = *(const LAS f32x4*)(lds + L_V + vb_ * 8192 + ls * 256 + (c8 + 4 * u_) * 4); \
            y_[u_] = *(const LAS f32x4*)(lds + L_Y + bp_ * 8192 + ls * 256 + (c8 + 4 * u_) * 4) + v_[u_] * sc_[0]; s_ += (y_[u_][0] + y_[u_][1]) + (y_[u_][2] + y_[u_][3]); } \
        const float mean_ = row8_allsum(s_) * (1.0f / 64.0f); float q_ = 0.f; \
        _Pragma("unroll") for (int u_ = 0; u_ < 2; ++u_) { y_[u_] = y_[u_] - mean_; q_ += dot4(y_[u_], y_[u_]); } \
        const float rstd_ = rsqrtf(row8_allsum(q_) * (1.0f / 64.0f) + GN_EPS); const size_t m_ = (size_t)b * NT + (chunk) * 32 + ls; u32x4 o_; \
        _Pragma("unroll") for (int u_ = 0; u_ < 2; ++u_) { const f32x4 g_ = *(const LAS f32x4*)(lds + L_G + vb_ * 8192 + ls * 256 + (c8 + 4 * u_) * 4); \
            const f32x4 yn_ = y_[u_] * rstd_ * CST4(6, u_) + CST4(7, u_); const f32x4 f_ = (yn_ + v_[u_] * sc_[1]) * g_; \
            if (u_ == 0) { o_.x = cvt_pk_bf16(f_[0], f_[1]); o_.y = cvt_pk_bf16(f_[2], f_[3]); } else { o_.z = cvt_pk_bf16(f_[0], f_[1]); o_.w = cvt_pk_bf16(f_[2], f_[3]); } } \
        *(u32x4*)(p.yr + m_ * NC + ch) = o_; } while (0)
    const int ri = lane & 15, rg = lane >> 4, sel = ri & 3;
    f32x4 X0 = zero4, X1 = zero4, X2 = zero4, X3 = zero4;
    if (wave >= 4) { SCAN_ISSUE(0); SCAN_STAGE(0); }
    __syncthreads();
    for (int chunk = 0; chunk < NCH; ++chunk) {
        if (wave < 4) {
            __builtin_amdgcn_s_setprio(3);
            const int bp = chunk & 1, vb = chunk % 3;
            const LAS unsigned char* awp = lds + L_AW + bp * 8192 + sel * 128 + rg * 16;
            const LAS unsigned char* wwp = lds + L_W + bp * 8192 + rg * 16;
            const LAS unsigned char* abp = lds + L_BK + bp * 16384 + rg * 256 + ri * 4;
            const LAS unsigned char* vp = lds + L_V + vb * 8192 + (16 * wave + ri) * 4;
            const LAS unsigned char* csp = lds + L_CS + bp * 256;
            LAS unsigned char* yp = (rg == 0) ? (lds + L_Y + bp * 8192 + (16 * wave + ri) * 4) : ((rg == 2) ? (lds + L_Y + bp * 8192 + 256 + (16 * wave + ri) * 4) : (lds + L_DUMMY + tid * 4));
            const int y_st = (rg & 1) ? 0 : 512;
#define SCAN_LD(S, pi) do { S##a0 = *(const LAS bf16x8*)(awp + (pi) * 512); S##a1 = *(const LAS bf16x8*)(awp + (pi) * 512 + 64); \
                S##w0 = *(const LAS f32x4*)(wwp + (pi) * 256); S##w1 = *(const LAS f32x4*)(wwp + (pi) * 256 + 64); S##w2 = *(const LAS f32x4*)(wwp + (pi) * 256 + 128); S##w3 = *(const LAS f32x4*)(wwp + (pi) * 256 + 192); \
                S##b0 = *(const LAS float*)(abp + (pi) * 1024); S##b1 = *(const LAS float*)(abp + (pi) * 1024 + 64); S##b2 = *(const LAS float*)(abp + (pi) * 1024 + 128); S##b3 = *(const LAS float*)(abp + (pi) * 1024 + 192); \
                S##vt = *(const LAS float*)(vp + (pi) * 512); S##vu = *(const LAS float*)(vp + (pi) * 512 + 256); S##cs = *(const LAS f32x4*)(csp + (pi) * 16); } while (0)
#define SCAN_STEP(S, pi) do { u32x4 xa, xc; \
                xa.x = cvt_pk_bf16(X0[0], X0[1]); xa.y = cvt_pk_bf16(X0[2], X0[3]); xa.z = cvt_pk_bf16(X1[0], X1[1]); xa.w = cvt_pk_bf16(X1[2], X1[3]); \
                xc.x = cvt_pk_bf16(X2[0], X2[1]); xc.y = cvt_pk_bf16(X2[2], X2[3]); xc.z = cvt_pk_bf16(X3[0], X3[1]); xc.w = cvt_pk_bf16(X3[2], X3[3]); \
                const f32x4 d0 = __builtin_amdgcn_mfma_f32_16x16x32_bf16(S##a0, __builtin_bit_cast(bf16x8, xa), zero4, 0, 0, 0); \
                const f32x4 d1 = __builtin_amdgcn_mfma_f32_16x16x32_bf16(S##a1, __builtin_bit_cast(bf16x8, xc), zero4, 0, 0, 0); \
                const f32x4 d = d0 + d1; const float sat = d[0]; \
                const float sau = d[2] + sat * S##cs[0] + S##vt * S##cs[1], yu = d[3] + sat * S##cs[2] + S##vt * S##cs[3]; \
                const float bsel = (rg == 0) ? sat : ((rg == 1) ? S##vt : ((rg == 2) ? sau : S##vu)); \
                X0 = __builtin_amdgcn_mfma_f32_16x16x4f32(S##b0, bsel, X0 * S##w0, 0, 0, 0); \
                X1 = __builtin_amdgcn_mfma_f32_16x16x4f32(S##b1, bsel, X1 * S##w1, 0, 0, 0); \
                X2 = __builtin_amdgcn_mfma_f32_16x16x4f32(S##b2, bsel, X2 * S##w2, 0, 0, 0); \
                X3 = __builtin_amdgcn_mfma_f32_16x16x4f32(S##b3, bsel, X3 * S##w3, 0, 0, 0); \
                *(LAS float*)(yp + (pi) * y_st) = (rg == 0) ? d[1] : yu; } while (0)
            bf16x8 Pa0, Pa1, Qa0, Qa1; f32x4 Pw0, Pw1, Pw2, Pw3, Qw0, Qw1, Qw2, Qw3, Pcs, Qcs; float Pb0, Pb1, Pb2, Pb3, Pvt, Pvu, Qb0, Qb1, Qb2, Qb3, Qvt, Qvu;
            SCAN_LD(P, 0);
#pragma unroll 1
            for (int pi = 0; pi < 16; pi += 2) {
                SCAN_LD(Q, pi + 1);
                SCAN_STEP(P, pi);
                if (pi + 2 < 16) SCAN_LD(P, pi + 2);
                SCAN_STEP(Q, pi + 1);
            }
#undef SCAN_LD
#undef SCAN_STEP
        } else {
            if (chunk + 1 < NCH) SCAN_ISSUE(chunk + 1);
            if (chunk > 0) SCAN_POST(chunk - 1);
            if (chunk + 1 < NCH) SCAN_STAGE(chunk + 1);
        }
        __syncthreads();
    }
    if (wave >= 4) SCAN_POST(NCH - 1);
    __syncthreads();
#undef SCAN_ISSUE
#undef CST4
#undef SCAN_STAGE
#undef SCAN_UNPACK
#undef SCAN_POST
}
__device__ __forceinline__ void conv_queue(const Params& p, LAS unsigned char* lds, const int wave, const int cw) {
    const int tid = phase_tid(wave);
    const int lane = tid & 63, wv = tid >> 6;
    LAS int* slot = (LAS int*)(lds + LDS_MISC);
    constexpr int N_GU = NE * 16 * 2, N_DN = NE * 16, N_ALL = N_GU + N_DN;
    for (;;) {
        __syncthreads();
        if (tid == 0) *slot = (int)atomicAdd(&p.ctl[cw], 1u);
        __syncthreads();
        const int it = *slot;
        if (it >= N_ALL) break;
        if (it < N_GU) { const int e = it >> 5, rem = it & 31, kb = rem >> 1, nh = rem & 1;
            const float* src = p.w_gu + (size_t)e * ND * (2 * DFF) + (size_t)(kb * 128) * (2 * DFF) + nh * 2048;
            fp8_t* dst = p.wt_gu + (size_t)e * (2 * DFF) * ND + (size_t)(nh * 2048) * ND + kb * 128;
            cvt_wave_T8x8(src + wv * 256, 2 * DFF, dst + (size_t)(wv * 256) * ND, ND, lane); }
        else { const int j = it - N_GU, e = j >> 4, kb = j & 15;
            const float* src = p.w_down + (size_t)e * DFF * ND + (size_t)(kb * 128) * ND;
            fp8_t* dst = p.wt_down + (size_t)e * ND * DFF + kb * 128;
            cvt_wave_T8x8(src + wv * 256, ND, dst + (size_t)(wv * 256) * DFF, DFF, lane); }
    }
}

__device__ __forceinline__ void phase8(const Params& p, LAS unsigned char* lds, const int wave) {
    const int tid = phase_tid(wave);
    const int bid = blockIdx.x, lane = tid & 63, wv = tid >> 6;
    constexpr int HP = ND + 4;
    LAS float* hs = (LAS float*)lds;
    LAS float* lg = hs + 16 * HP;
    LAS float* part = lg + 16 * 32;
    LAS float* topv = part + 4 * 16 * 32;
    LAS int* topi = (LAS int*)(topv + 64);
    const int b = (bid * 32) >> 11;
    const float* sh2 = p.mod + (size_t)b * NMOD + 3 * ND; const float* sc2 = p.mod + (size_t)b * NMOD + 4 * ND;
    for (int pass = 0; pass < 2; ++pass) {
        const int mb = bid * 32 + pass * 16;
        for (int rr = 0; rr < 2; ++rr) { const int r = wv * 2 + rr; const size_t m = (size_t)(mb + r);
            f32x4 z[8]; float s = 0.f;
#pragma unroll
            for (int j = 0; j < 4; ++j) { z[2 * j] = ld4nt(p.z1 + m * ND + j * 512 + lane * 8); z[2 * j + 1] = ld4nt(p.z1 + m * ND + j * 512 + lane * 8 + 4);
                s += ((z[2 * j][0] + z[2 * j][1]) + (z[2 * j][2] + z[2 * j][3])) + ((z[2 * j + 1][0] + z[2 * j + 1][1]) + (z[2 * j + 1][2] + z[2 * j + 1][3])); }
            const float mean = wave_allsum(s) * (1.0f / ND); float qv = 0.f;
#pragma unroll
            for (int j = 0; j < 8; ++j) { const f32x4 d = z[j] - mean; qv += dot4(d, d); }
            const float rstd = rsqrtf(wave_allsum(qv) * (1.0f / ND) + LN_EPS);
            if (lane == 0) *(f32x2*)(p.lnst + m * 2) = (f32x2){mean, rstd};
#pragma unroll
            for (int j = 0; j < 8; ++j) { const int k = (j >> 1) * 512 + lane * 8 + (j & 1) * 4;
                const f32x4 x1 = (z[j] - mean) * rstd * ld4(p.ln1_g + k) + ld4(p.ln1_b + k);
                const f32x4 h = x1 * (ld4(sc2 + k) + 1.0f) + ld4(sh2 + k);
                *(unsigned*)(p.h2 + m * ND + k) = pack4_fp8(h[0], h[1], h[2], h[3]);
                *(LAS f32x4*)(hs + r * HP + k) = h; } }
        __syncthreads();
        {
            const int kq = wv >> 1, ntl = wv & 1, ar = lane & 15, ak = lane >> 4;
            f32x4 acc = {0.f, 0.f, 0.f, 0.f};
            const LAS float* ap = hs + ar * HP + kq * 512 + ak; const float* bp = p.w_router + (size_t)(kq * 512 + ak) * NE + ntl * 16 + ar;
#pragma unroll 8
            for (int ks = 0; ks < 128; ++ks) acc = __builtin_amdgcn_mfma_f32_16x16x4f32(ap[ks * 4], bp[(size_t)ks * 4 * NE], acc, 0, 0, 0);
#pragma unroll
            for (int j = 0; j < 4; ++j) part[(kq * 16 + ak * 4 + j) * 32 + ntl * 16 + ar] = acc[j]; }
        __syncthreads();
        {   const int r = tid >> 5, e = tid & 31;
            lg[r * 32 + e] = p.b_router[e] + (part[(0 * 16 + r) * 32 + e] + part[(1 * 16 + r) * 32 + e]) + (part[(2 * 16 + r) * 32 + e] + part[(3 * 16 + r) * 32 + e]); }
        __syncthreads();
        {
            const int r = tid >> 5, e = tid & 31; const LAS float* l = lg + r * 32; const float mine = l[e]; int rank = 0;
#pragma unroll
            for (int q = 0; q < 8; ++q) { const f32x4 o = *(const LAS f32x4*)(l + q * 4);
#pragma unroll
                for (int j = 0; j < 4; ++j) rank += (o[j] > mine || (o[j] == mine && (q * 4 + j) < e)) ? 1 : 0; }
            if (rank < 4) { topv[r * 4 + rank] = mine; topi[r * 4 + rank] = e; } }
        __syncthreads();
        if (tid < 64) { const int r = tid >> 2, k = tid & 3, m = mb + r; const f32x4 tv = *(const LAS f32x4*)(topv + r * 4); const int ei = topi[r * 4 + k];
            const float e0 = 1.0f, e1 = expf(tv[1] - tv[0]), e2 = expf(tv[2] - tv[0]), e3 = expf(tv[3] - tv[0]); const float sum = (e0 + e1) + (e2 + e3);
            const float mineexp = k == 0 ? e0 : (k == 1 ? e1 : (k == 2 ? e2 : e3));
            const unsigned rk = atomicAdd(&p.ctl[CW_CNT + 64 * ei], 1u);
            p.sel[m * 4 + k] = ei; p.rnk[m * 4 + k] = (int)rk; p.prob[m * 4 + k] = mineexp / sum; }
        __syncthreads();
    }
}

__device__ __forceinline__ void phase9(const Params& p, LAS unsigned char* lds, const int wave) {
    const int tid = phase_tid(wave);
    const int bid = blockIdx.x, lane = tid & 63, wv = tid >> 6;
    LAS int* seg = (LAS int*)lds;
    if (tid == 0) { int s = 0;
        for (int e = 0; e < NE; ++e) { seg[e] = s; const int c = (int)xb_ld(&p.ctl[CW_CNT + 64 * e]); s += (c + 255) & ~255; }
        seg[NE] = s;
        if (bid == 0) { int t = 0;
            for (int e = 0; e < NE; ++e) { const int nt = (seg[e + 1] - seg[e]) >> 8; for (int i = 0; i < nt; ++i) p.ctl[CW_TILEE + t + i] = (unsigned)e; t += nt; }
            p.ctl[CW_NTILES] = (unsigned)t; } }
    __syncthreads();
    const int GW = gridDim.x * NWAVES;
    for (int it = bid * NWAVES + wv; it < NM * TOPK; it += GW) { const int m = it >> 2;
        const int e = p.sel[it], d = seg[e] + p.rnk[it];
        if (lane == 0) p.dest[it] = d;
        const u32x4* src = (const u32x4*)(p.h2 + (size_t)m * ND); u32x4* dst = (u32x4*)(p.xb + (size_t)d * ND);
#pragma unroll
        for (int i = 0; i < 2; ++i) dst[i * 64 + lane] = src[i * 64 + lane]; }
    __syncthreads();
}

__device__ __forceinline__ void phase13(const Params& p, const int wave) {
    const int tid = phase_tid(wave);
    const int bid = blockIdx.x, lane0 = tid & 63, wv = wave;
    const int GW = gridDim.x * NWAVES;
    for (int m = bid * NWAVES + wv; m < NM; m += GW) { const int b = m >> 11;
        int lane = lane0; asm volatile("" : "+v"(lane));
        const float* g2 = p.mod + (size_t)b * NMOD + 5 * ND;
        int d[4]; float pr[4]; const f32x2 st = *(const f32x2*)(p.lnst + (size_t)m * 2);
#pragma unroll
        for (int k = 0; k < 4; ++k) { d[k] = p.dest[m * 4 + k]; pr[k] = p.prob[m * 4 + k]; }
        f32x4 z[8]; float s = 0.f;
#pragma unroll
        for (int j = 0; j < 4; ++j) { const int c = j * 512 + lane * 8; f32x4 f0 = {0.f, 0.f, 0.f, 0.f}, f1 = f0;
#pragma unroll
            for (int k = 0; k < 4; ++k) { const u32x4 y8 = ldu4nt(p.yb + (size_t)d[k] * ND + c);
                f0 += bf4_unpack((u32x2){y8.x, y8.y}) * pr[k]; f1 += bf4_unpack((u32x2){y8.z, y8.w}) * pr[k]; }
            const f32x4 xa = (ld4nt(p.z1 + (size_t)m * ND + c) - st[0]) * st[1] * ld4(p.ln1_g + c) + ld4(p.ln1_b + c), xb2 = (ld4nt(p.z1 + (size_t)m * ND + c + 4) - st[0]) * st[1] * ld4(p.ln1_g + c + 4) + ld4(p.ln1_b + c + 4);
            z[2 * j] = xa * DN_ALPHA + ld4(g2 + c) * f0; z[2 * j + 1] = xb2 * DN_ALPHA + ld4(g2 + c + 4) * f1;
            s += ((z[2 * j][0] + z[2 * j][1]) + (z[2 * j][2] + z[2 * j][3])) + ((z[2 * j + 1][0] + z[2 * j + 1][1]) + (z[2 * j + 1][2] + z[2 * j + 1][3])); }
        const float mean = wave_allsum(s) * (1.0f / ND); float qv = 0.f;
#pragma unroll
        for (int j = 0; j < 8; ++j) { const f32x4 dd = z[j] - mean; qv += dot4(dd, dd); }
        const float rstd = rsqrtf(wave_allsum(qv) * (1.0f / ND) + LN_EPS);
#pragma unroll
        for (int j = 0; j < 8; ++j) { const int c = (j >> 1) * 512 + lane * 8 + (j & 1) * 4;
            *(f32x4*)(p.out + (size_t)m * ND + c) = (z[j] - mean) * rstd * ld4(p.ln2_g + c) + ld4(p.ln2_b + c); } }
}

__global__ void __launch_bounds__(NTHREADS, 2) fwd(Params p) {
    extern __shared__ __attribute__((aligned(16))) unsigned char shm[];
    LAS unsigned char* lds = (LAS unsigned char*)shm;
    const int bid = blockIdx.x, G = gridDim.x;
    const int wave = __builtin_amdgcn_readfirstlane(threadIdx.x >> 6);
    if (threadIdx.x == 0) *(LAS u32x4*)(lds + LDS_BARW) = (u32x4){0u, 0u, 0u, 0u};
    __syncthreads();
    XcdBarrier bar = xcd_barrier_post(p.bar, (volatile LAS unsigned*)(lds + LDS_BARW));

    phase0(p, lds, wave);
    xcd_barrier(bar, wave);
    if (PROBE == 3) { phase0(p, lds, wave); xcd_barrier(bar, wave); }
    phase1(p, lds, wave);
    xcd_barrier(bar, wave);
    if (PROBE == 3) { phase1(p, lds, wave); xcd_barrier(bar, wave); }
    {
        pg8::Gemm g{p.hb, p.wt_in, ND, ND, ND}; pg8::DenseOrder S; S.init(NM / 256, NINP / 256 - 2, G, bid, (size_t)256 * ND * 2, (size_t)256 * ND * 2); S.skip_from = 23; S.skip_n = 2;
        EpiP E{p.P}; pg8::gemm_phase(lds, g, S, E, wave);
        if (PROBE == 1) { __syncthreads(); pg8::gemm_phase(lds, g, S, E, wave); } }
    xcd_barrier(bar, wave);
    phase3(p, lds, wave);
    xcd_barrier(bar, wave);
    if (PROBE == 3) { phase3(p, lds, wave); xcd_barrier(bar, wave); }
    {
        pg8::Gemm g{p.hb, p.wt_in, ND, ND, ND}; WinRestOrder S{bid, (size_t)256 * ND * 2, (size_t)256 * ND * 2};
        EpiP E{p.P}; pg8::gemm_phase(lds, g, S, E, wave); }
    __syncthreads();
    {
        pg8::Gemm g{p.a_lora, p.bt_lora, LORA_K, LORA_K, LORA_K}; pg8::DenseOrder S; S.init(NM / 256, LORA_N / 256, G - 64, bid - 64, (size_t)256 * LORA_K * 2, (size_t)256 * LORA_K * 2);
        EpiLora E{p.dec, p.iclr, p.gg, p.w0, p.a0}; pg8::gemm_phase(lds, g, S, E, wave);
        if (PROBE == 1) { __syncthreads(); pg8::gemm_phase(lds, g, S, E, wave); } }
    __syncthreads();
    {
        pg8::Gemm g{p.dp, p.wt_pool, NC, 256, 256}; PoolOrder S{1 << 20, bid >= 64 ? bid - 64 : 192 + bid};
        EpiPool E{p.t1, p.P, p.pool_scale}; pg8::gemm_phase(lds, g, S, E, wave);
        if (PROBE == 1) { __syncthreads(); pg8::gemm_phase(lds, g, S, E, wave); } }
    xcd_barrier(bar, wave);
    if (bid < NB * NH) { scan_head(p, lds, bid, wave); if (PROBE == 4) scan_head(p, lds, bid, wave); }
    conv_queue(p, lds, wave, CW_CONV);
    if (PROBE == 5) conv_queue(p, lds, wave, CW_CONV2);
    xcd_barrier(bar, wave);
    if (PROBE == 2) { if (bid < NB * NH) scan_head(p, lds, bid, wave); conv_queue(p, lds, wave, CW_CONV2); xcd_barrier(bar, wave); }
    {
        pg8::Gemm g{p.yr, p.wt_rwkv, NC, NC, NC}; pg8::DenseOrder S; S.init(NM / 256, ND / 256, G, bid, (size_t)256 * NC * 2, (size_t)256 * NC * 2);
        EpiRwkv E{p.mx, p.P, p.t1}; pg8::gemm_phase(lds, g, S, E, wave);
        if (PROBE == 1) { __syncthreads(); pg8::gemm_phase(lds, g, S, E, wave); } }
    xcd_barrier(bar, wave);
    {
        pg8::Gemm g{p.mx, p.wt_out, ND, ND, ND}; pg8::DenseOrder S; S.init(NM / 256, ND / 256, G, bid, (size_t)256 * ND * 2, (size_t)256 * ND * 2);
        EpiWout E{p.z1, p.x, p.mod}; pg8::gemm_phase(lds, g, S, E, wave);
        if (PROBE == 1) { __syncthreads(); pg8::gemm_phase(lds, g, S, E, wave); } }
    xcd_barrier(bar, wave);
    phase8(p, lds, wave);
    xcd_barrier(bar, wave);
    phase9(p, lds, wave);
    xcd_barrier(bar, wave);
    if (PROBE == 3) { phase9(p, lds, wave); xcd_barrier(bar, wave); }
    const int ntiles = (int)xb_ld(&p.ctl[CW_NTILES]);
    {   const int t_ = phase_tid(wave); if (t_ < MAXTILES) *(LAS unsigned*)(lds + LDS_MISC + 4 * t_) = p.ctl[CW_TILEE + t_]; }
    __syncthreads();
    {
        pg8::Gemm g{(const bf16_t*)p.xb, (const bf16_t*)p.wt_gu, ND / 2, ND / 2, ND / 2};
        MoeOrder S{G, bid, 2 * DFF / 256, ntiles, (const LAS unsigned*)(lds + LDS_MISC), (size_t)256 * ND, (size_t)(2 * DFF) * ND, (size_t)256 * ND};
        EpiGU E{p.act, p.b_gu}; pg8::gemm_phase<EpiGU, MoeOrder, true>(lds, g, S, E, wave);
        if (PROBE == 1) { __syncthreads(); pg8::gemm_phase<EpiGU, MoeOrder, true>(lds, g, S, E, wave); } }
    xcd_barrier(bar, wave);
    {
        pg8::Gemm g{(const bf16_t*)p.act, (const bf16_t*)p.wt_down, DFF / 2, DFF / 2, DFF / 2};
        MoeOrder S{G, bid, ND / 256, ntiles, (const LAS unsigned*)(lds + LDS_MISC), (size_t)256 * DFF, (size_t)ND * DFF, (size_t)256 * DFF};
        EpiDown E{p.yb, p.b_down}; pg8::gemm_phase<EpiDown, MoeOrder, true>(lds, g, S, E, wave);
        if (PROBE == 1) { __syncthreads(); pg8::gemm_phase<EpiDown, MoeOrder, true>(lds, g, S, E, wave); } }
    xcd_barrier(bar, wave);
    phase13(p, wave);
    if (PROBE == 3) { xcd_barrier(bar, wave); phase13(p, wave); }
}

static inline size_t align_up(size_t v, size_t a) { return (v + a - 1) / a * a; }

extern "C" void kernel_launch(void* const* d_in, const int* in_sizes, int n_in, void* d_out, int out_size, void* d_ws, size_t ws_size, hipStream_t stream) {
    (void)in_sizes; (void)n_in; (void)out_size;
    Params p{};
    const float** ins = (const float**)&p;
    for (int i = 0; i < 30; ++i) ins[i] = (const float*)d_in[i];
    p.out = (float*)d_out;
    char* ws = (char*)d_ws; size_t off = 0;
    auto take = [&](size_t bytes) { char* r = ws + off; off = align_up(off + bytes, 4096); return r; };
    const size_t ctl_bytes = (size_t)(XCD_BAR_WORDS + CTL_WORDS) * 4;
    p.bar = (unsigned*)take(ctl_bytes); p.ctl = p.bar + XCD_BAR_WORDS;
    p.modp = (float*)take((size_t)KS_MOD * 4 * NMOD * 4); p.mod = (float*)take((size_t)NB * NMOD * 4);
    p.hb = (bf16_t*)take((size_t)NM * ND * 2);
    p.wt_in = (bf16_t*)take((size_t)NINP * ND * 2); p.wt_rwkv = (bf16_t*)take((size_t)ND * NC * 2); p.wt_pool = (bf16_t*)take((size_t)ND * 256 * 2);
    p.wt_out = (bf16_t*)take((size_t)ND * ND * 2); p.bt_lora = (bf16_t*)take((size_t)LORA_N * LORA_K * 2);
    p.wt_gu = (fp8_t*)take((size_t)NE * 2 * DFF * ND); p.wt_down = (fp8_t*)take((size_t)NE * ND * DFF);
    p.P = (bf16_t*)take((size_t)NM * NINP * 2); p.a_lora = (bf16_t*)take((size_t)NM * LORA_K * 2); p.dp = (bf16_t*)take((size_t)NM * NC * 2);
    p.dec = (float*)take((size_t)NM * NC * 4); p.iclr = (bf16_t*)take((size_t)NM * NC * 2); p.gg = (bf16_t*)take((size_t)NM * NC * 2); p.t1 = (bf16_t*)take((size_t)NM * ND * 2);
    p.yr = (bf16_t*)take((size_t)NM * NC * 2); p.mx = (bf16_t*)take((size_t)NM * ND * 2); p.z1 = (float*)take((size_t)NM * ND * 4); p.lnst = (float*)take((size_t)NM * 2 * 4);
    p.h2 = (fp8_t*)take((size_t)NM * ND);
    p.sel = (int*)take((size_t)NM * TOPK * 4); p.rnk = (int*)take((size_t)NM * TOPK * 4); p.prob = (float*)take((size_t)NM * TOPK * 4); p.dest = (int*)take((size_t)NM * TOPK * 4);
    p.xb = (fp8_t*)take((size_t)MP * ND); p.act = (fp8_t*)take((size_t)MP * DFF); p.yb = (bf16_t*)take((size_t)MP * ND * 2);
    if (off > ws_size) { fprintf(stderr, "kernel_launch: workspace too small (%zu > %zu)\n", off, ws_size); return; }

    static int grid = 0;
    if (!grid) {
        int dev = 0, cus = 0, per_cu = 0;
        hipGetDevice(&dev); hipDeviceGetAttribute(&cus, hipDeviceAttributeMultiprocessorCount, dev);
        hipFuncSetAttribute((const void*)fwd, hipFuncAttributeMaxDynamicSharedMemorySize, LDS_BYTES);
        hipOccupancyMaxActiveBlocksPerMultiprocessor(&per_cu, (const void*)fwd, NTHREADS, LDS_BYTES);
        if (per_cu < 1) fprintf(stderr, "kernel_launch: occupancy query reports %d workgroups per CU\n", per_cu);
        if (cus != 256) fprintf(stderr, "kernel_launch: %d CUs; this kernel is laid out for 256\n", cus);
        grid = 256;
    }
    hipMemsetAsync(p.bar, 0, ctl_bytes, stream);
    hipLaunchKernelGGL(fwd, dim3(grid), dim3(NTHREADS), LDS_BYTES, stream, p);
}
```

```cpp
#include <hip/hip_runtime.h>
#include <cstdio>
#include <cstdint>

#ifndef PROBE
#define PROBE 0
#endif
#define LAS __attribute__((address_space(3)))
typedef unsigned short bf16_t;
typedef short bf16x8 __attribute__((ext_vector_type(8)));
typedef float f32x4 __attribute__((ext_vector_type(4)));
typedef float f32x2 __attribute__((ext_vector_type(2)));
typedef unsigned u32x4 __attribute__((ext_vector_type(4)));
typedef unsigned u32x2 __attribute__((ext_vector_type(2)));
typedef int i32x4 __attribute__((ext_vector_type(4)));
typedef int i32x8 __attribute__((ext_vector_type(8)));
typedef unsigned char fp8_t;
constexpr float W8_SCALE = 64.0f, W8_INV = 1.0f / 64.0f;

constexpr int NB = 4, NT = 2048, NM = NB * NT, ND = 2048, NC = 1024, NH = 16, HS = 64;
constexpr int NSHIFT = 3360, NIN = 8480, NINP = 8704;
constexpr int OFF_R = 0, OFF_K = 1024, OFF_V = 2048, OFF_WD = 3072, OFF_AD = 3136, OFF_GD = 3200, OFF_POOL = 3360, OFF_GA = 4384, OFF_GB = 6432;
constexpr int NE = 32, TOPK = 4, DFF = 2048;
constexpr int LORA_K = 384, LORA_N = 3072;
constexpr int MAXTILES = 160, MP = MAXTILES * 256;
constexpr int NMOD = 6 * ND;
constexpr int KS_MOD = 32;
constexpr float LN_EPS = 1e-5f, GN_EPS = 64e-5f;
constexpr float DN_ALPHA = 1.189207115002721f;
constexpr float SW_LIMIT = 7.0f, SW_ALPHA = 1.702f;
constexpr int NWAVES = 8, NTHREADS = 512;
constexpr int LDS_BYTES = 147456;
constexpr int LDS_BARW = LDS_BYTES - 16;
constexpr int LDS_MISC = 131072;

constexpr int CW_CNT = 0;
constexpr int CW_CONV = 64 * 32;
constexpr int CW_CONV2 = 64 * 32 + 32;
constexpr int CW_NTILES = 64 * 33;
constexpr int CW_TILEE = 64 * 34;
constexpr int CTL_WORDS = 64 * 34 + 256;

#define XB_TMO      128
#define XB_XCNT(j)  (256  + 64 * (j))
#define XB_XSUB(j)  (1280 + 64 * (j))
#define XB_XGEN(j)  (2304 + 64 * (j))
#define XB_TOP      3328
#define XB_TOPGEN   3392
#define XCD_BAR_WORDS 3456
#define XB_SPIN_CAP (1u << 18)

__device__ __forceinline__ unsigned xb_ld(unsigned* p)              { return __hip_atomic_load(p, __ATOMIC_RELAXED, __HIP_MEMORY_SCOPE_AGENT); }
__device__ __forceinline__ unsigned xb_add(unsigned* p, unsigned v) { return __hip_atomic_fetch_add(p, v, __ATOMIC_RELAXED, __HIP_MEMORY_SCOPE_AGENT); }
__device__ __forceinline__ unsigned xb_xcc_id() { return (unsigned)__builtin_amdgcn_s_getreg((3 << 11) | 20) & 0xFu; }
#define XB_SPIN(cond, bar) do { unsigned _sp = 0; while (cond) { __builtin_amdgcn_s_sleep(1); \
    if ((++_sp & 255u) == 0u) { if (xb_ld(&(bar)[XB_TMO])) break; if (_sp > XB_SPIN_CAP) { atomicAdd(&(bar)[XB_TMO], 1u); break; } } } } while (0)

__device__ __forceinline__ int phase_tid(int wave);
struct XcdBarrier { unsigned* bar; unsigned x; volatile LAS unsigned* st; };

__device__ __forceinline__ XcdBarrier xcd_barrier_post(unsigned* bar, volatile LAS unsigned* st) {
    XcdBarrier b; b.bar = bar; b.x = xb_xcc_id(); b.st = st;
    if (threadIdx.x == 0) (void)xb_add(&bar[XB_XCNT(b.x)], 1u);
    return b;
}
__device__ __forceinline__ void xcd_barrier_complete(unsigned* bar, unsigned x, unsigned& nloc, unsigned& nx) {
    const unsigned G = gridDim.x * gridDim.y * gridDim.z;
    unsigned sum, cnt, mine, sp = 0u;
    for (;;) {
        sum = 0u; cnt = 0u; mine = 0u;
#pragma unroll
        for (unsigned j = 0; j < 16; ++j) { const unsigned c = xb_ld(&bar[XB_XCNT(j)]); sum += c; cnt += (c > 0u) ? 1u : 0u; mine = (j == x) ? c : mine; }
        if (sum == G) break;
        __builtin_amdgcn_s_sleep(1);
        if ((++sp & 255u) == 0u) { if (xb_ld(&bar[XB_TMO])) break; if (sp > XB_SPIN_CAP) { atomicAdd(&bar[XB_TMO], 1u); break; } }
    }
    nloc = mine > 0u ? mine : 1u; nx = cnt > 0u ? cnt : 1u;
}
__device__ __forceinline__ void xcd_barrier(const XcdBarrier& b, const int wave) {
    asm volatile("s_waitcnt vmcnt(0)" ::: "memory");
    __syncthreads();
    if (phase_tid(wave) == 0) {
        unsigned* bar = b.bar;
        __builtin_amdgcn_s_waitcnt(0);
        unsigned nloc = b.st[0], nx = b.st[1];
        if (nloc == 0u) { xcd_barrier_complete(bar, b.x, nloc, nx); b.st[0] = nloc; b.st[1] = nx; }
        const unsigned old = xb_add(&bar[XB_XSUB(b.x)], 1u);
        const unsigned gen = old / nloc;
        if (old + 1u == (gen + 1u) * nloc) {
            __builtin_amdgcn_fence(__ATOMIC_RELEASE, "agent");
            asm volatile("s_waitcnt vmcnt(0)" ::: "memory");
            const unsigned og = xb_add(&bar[XB_TOP], 1u);
            const unsigned tg = og / nx;
            if (og + 1u == (tg + 1u) * nx) xb_add(&bar[XB_TOPGEN], 1u);
            else XB_SPIN(xb_ld(&bar[XB_TOPGEN]) == tg, bar);
            __builtin_amdgcn_fence(__ATOMIC_ACQUIRE, "agent");
            xb_add(&bar[XB_XGEN(b.x)], 1u);
            asm volatile("s_waitcnt vmcnt(0)" ::: "memory");
        } else {
            XB_SPIN(xb_ld(&bar[XB_XGEN(b.x)]) == gen, bar);
            __builtin_amdgcn_fence(__ATOMIC_ACQUIRE, "agent");
            asm volatile("s_waitcnt vmcnt(0)" ::: "memory");
        }
    }
    __syncthreads();
}

__device__ __forceinline__ int phase_tid(int wave) {
    int lane; asm volatile("v_mbcnt_lo_u32_b32 %0, -1, 0\n\tv_mbcnt_hi_u32_b32 %0, -1, %0" : "=v"(lane));
    return wave * 64 + lane;
}
typedef __bf16 bf16x2_t __attribute__((ext_vector_type(2)));
__device__ __forceinline__ unsigned cvt_pk_bf16(float lo, float hi) { return __builtin_bit_cast(unsigned, __builtin_convertvector((f32x2){lo, hi}, bf16x2_t)); }
template <int CTRL> __device__ __forceinline__ float dpp_f(float x) {
    return __builtin_bit_cast(float, __builtin_amdgcn_update_dpp(0, __builtin_bit_cast(int, x), CTRL, 0xf, 0xf, false));
}
__device__ __forceinline__ float row16_allsum(float x) {
    x += dpp_f<0x128>(x); x += dpp_f<0x124>(x); x += dpp_f<0x122>(x); x += dpp_f<0x121>(x); return x;
}
__device__ __forceinline__ float wave_allsum(float x) {
    x = row16_allsum(x);
    const int xi = __builtin_bit_cast(int, x);
    return (__builtin_bit_cast(float, __builtin_amdgcn_readlane(xi, 0)) + __builtin_bit_cast(float, __builtin_amdgcn_readlane(xi, 16))) +
           (__builtin_bit_cast(float, __builtin_amdgcn_readlane(xi, 32)) + __builtin_bit_cast(float, __builtin_amdgcn_readlane(xi, 48)));
}
__device__ __forceinline__ unsigned pack4_fp8(float a, float b, float c, float d) { int r = 0; r = __builtin_amdgcn_cvt_pk_fp8_f32(a, b, r, false); r = __builtin_amdgcn_cvt_pk_fp8_f32(c, d, r, true); return (unsigned)r; }
__device__ __forceinline__ f32x2 bf2_unpack(unsigned u) { return (f32x2){__uint_as_float(u << 16), __uint_as_float(u & 0xffff0000u)}; }
__device__ __forceinline__ f32x4 bf4_unpack(u32x2 u) { const f32x2 a = bf2_unpack(u.x), b = bf2_unpack(u.y); return (f32x4){a[0], a[1], b[0], b[1]}; }
__device__ __forceinline__ float bf1(bf16_t h) { return __uint_as_float(((unsigned)h) << 16); }
__device__ __forceinline__ float sigmoidf_(float v) { return __builtin_amdgcn_rcpf(1.0f + __builtin_amdgcn_exp2f(v * -1.4426950408889634f)); }
__device__ __forceinline__ f32x4 ld4(const float* p) { return *(const f32x4*)p; }
__device__ __forceinline__ f32x4 ld4nt(const float* p) { return __builtin_nontemporal_load((const f32x4*)p); }
__device__ __forceinline__ u32x4 ldu4nt(const void* p) { return __builtin_nontemporal_load((const u32x4*)p); }
__device__ __forceinline__ float dot4(f32x4 a, f32x4 b) { return (a[0] * b[0] + a[1] * b[1]) + (a[2] * b[2] + a[3] * b[3]); }

struct Params {
    const float *x, *c, *w_ada, *b_ada, *w_in, *mu_shift, *w0, *w_decay_up, *a0, *w_iclr_up, *w_glora_up, *k_k, *k_a, *r_k, *lnx_g, *lnx_b,
                *w_rwkv_out, *w_pool, *pool_scale, *w_out, *ln1_g, *ln1_b, *w_router, *b_router, *w_gu, *b_gu, *w_down, *b_down, *ln2_g, *ln2_b;
    float* out;
    unsigned* bar; unsigned* ctl;
    float* modp; float* mod;
    bf16_t* hb; bf16_t* wt_in; bf16_t* wt_rwkv; bf16_t* wt_pool; bf16_t* wt_out; bf16_t* bt_lora; fp8_t* wt_gu; fp8_t* wt_down;
    bf16_t* P; bf16_t* a_lora; bf16_t* dp; float* dec; bf16_t* iclr; bf16_t* gg; bf16_t* t1;
    bf16_t* yr; bf16_t* mx; float* z1; float* lnst; fp8_t* h2;
    int* sel; int* rnk; float* prob; int* dest;
    fp8_t* xb; fp8_t* act; bf16_t* yb;
};

namespace pg8 {
constexpr int BM = 256, BK = 64, HALF = 128, HTB = HALF * BK * 2, STAGE_BYTES = 8 * HTB, NXCD = 8, WGM = 8;
__host__ __device__ __forceinline__ int lds_byte(int r, int c) { const int st = (r >> 4) * 2 + (c >> 5), rr = r & 15, cc = c & 31, ob = rr * 64 + cc * 2; return st * 1024 + (ob ^ (((ob >> 9) & 1) << 5)); }
__host__ __device__ __forceinline__ void stage_rc(int b, int& R, int& C) { const int st = b / 1024, sb = b % 1024, swz = sb ^ (((sb >> 9) & 1) << 5); R = (st >> 1) * 16 + swz / 64; C = (st & 1) * 32 + (swz % 64) / 2; }
__host__ __device__ __forceinline__ int perm32(int rho) { const int n = rho >> 4, i = rho & 15; return 8 * (i >> 2) + 4 * n + (i & 3); }

struct Unit { int pm, pn, e; unsigned aoff, boff; };
struct Gemm { const bf16_t* A; const bf16_t* Bt; int lda, ldb, K; };

struct DenseOrder {
    int nM, nN, nwg, G, c, skip_from = 1 << 30, skip_n = 0; size_t a_tile, b_tile;
    __device__ void init(int nM_, int nN_, int G_, int c_, size_t a_tile_, size_t b_tile_) { nM = nM_; nN = nN_; nwg = nM * nN; G = G_; c = c_; a_tile = a_tile_; b_tile = b_tile_; }
    __device__ bool next(int i, Unit& u) const {
        const long L = (long)i * G + c; if (c < 0 || L >= nwg) return false;
        int wgid = (int)L; { const int q = nwg / NXCD, r = nwg % NXCD, xcd = wgid % NXCD, off = wgid / NXCD; wgid = (xcd < r ? xcd * (q + 1) : r * (q + 1) + (xcd - r) * q) + off; }
        const int nig = WGM * nN, gid = wgid / nig, fm = gid * WGM, gsz = (nM - fm) < WGM ? (nM - fm) : WGM;
        u.pm = fm + ((wgid % nig) % gsz); u.pn = (wgid % nig) / gsz; u.e = 0; if (u.pn >= skip_from) u.pn += skip_n;
        u.aoff = (unsigned)((size_t)u.pm * a_tile); u.boff = (unsigned)((size_t)u.pn * b_tile); return true;
    }
};

template <class Epi, class Sched, bool FP8 = false>
__device__ __forceinline__ void gemm_phase(LAS unsigned char* lds, const Gemm g, const Sched& S, const Epi& E, const int wave) {
    const int tid = phase_tid(wave);
    const int wid = __builtin_amdgcn_readfirstlane(tid >> 6), lane = tid & 63, wr = wid >> 2, wc = wid & 3, fr = lane & 15, fq = lane >> 4;
    const int K = g.K, nt = K / BK;
    unsigned voffA[2], voffB[2];
#pragma unroll
    for (int i = 0; i < 2; ++i) { int R, C; stage_rc(tid * 16 + i * 8192, R, C); const int Rb = Epi::PERM ? ((R & ~31) + perm32(R & 31)) : R;
        voffA[i] = (unsigned)(R * g.lda + C) * 2u; voffB[i] = (unsigned)(Rb * g.ldb + C) * 2u; }
    const unsigned kstep = (unsigned)(BK * 2);
    const unsigned hstepA = (unsigned)HALF * g.lda * 2u, hstepB = (unsigned)HALF * g.ldb * 2u;
    const __amdgpu_buffer_rsrc_t rsA = __builtin_amdgcn_make_buffer_rsrc((void*)g.A, (short)0, -1, 0x00020000), rsB = __builtin_amdgcn_make_buffer_rsrc((void*)g.Bt, (short)0, -1, 0x00020000);
    const unsigned ldsw = (unsigned)wid * 1024u;
    const int aoff = lds_byte(wr * 64 + fr, fq * 8), boff = lds_byte(wc * 32 + fr, fq * 8);
#define PG8_SA(b, h) (((b) * 2 + (h)) * HTB)
#define PG8_SB(b, h) ((4 + (b) * 2 + (h)) * HTB)
#define PG8_STAGE(bufoff, rs, soff, voff) do { _Pragma("unroll") for (int _i = 0; _i < 2; ++_i) \
        __builtin_amdgcn_raw_ptr_buffer_load_lds(rs, (LAS void*)(lds + (bufoff) + ldsw + _i * 8192), 16, (voff)[_i], (soff), 0, 0); } while (0)
#define PG8_LDA(dst, b, h) do { _Pragma("unroll") for (int m = 0; m < 4; ++m) _Pragma("unroll") for (int k = 0; k < 2; ++k) dst[m][k] = *(const LAS bf16x8*)(lds + PG8_SA(b, h) + aoff + m * 2048 + k * 1024); } while (0)
#define PG8_LDB(dst, b, h) do { _Pragma("unroll") for (int n = 0; n < 2; ++n) _Pragma("unroll") for (int k = 0; k < 2; ++k) dst[n][k] = *(const LAS bf16x8*)(lds + PG8_SB(b, h) + boff + n * 2048 + k * 1024); } while (0)
#define PG8_CAT(x) __builtin_shufflevector(__builtin_bit_cast(i32x4, (x)[0]), __builtin_bit_cast(i32x4, (x)[1]), 0, 1, 2, 3, 4, 5, 6, 7)
#define PG8_MMA(ai, bj, At, Bt) do { __builtin_amdgcn_s_setprio(1); \
        if constexpr (FP8) { _Pragma("unroll") for (int m = 0; m < 4; ++m) _Pragma("unroll") for (int n = 0; n < 2; ++n) \
            acc[ai][bj][m][n] = __builtin_amdgcn_mfma_scale_f32_16x16x128_f8f6f4(PG8_CAT(Bt[n]), PG8_CAT(At[m]), acc[ai][bj][m][n], 0, 0, 0, 0x7F7F7F7F, 0, 0x7F7F7F7F); } \
        else { _Pragma("unroll") for (int m = 0; m < 4; ++m) _Pragma("unroll") for (int n = 0; n < 2; ++n) _Pragma("unroll") for (int k = 0; k < 2; ++k) \
            acc[ai][bj][m][n] = __builtin_amdgcn_mfma_f32_16x16x32_bf16(Bt[n][k], At[m][k], acc[ai][bj][m][n], 0, 0, 0); } \
        __builtin_amdgcn_s_setprio(0); } while (0)
#define PG8_WAIT_V(n) asm volatile("s_waitcnt vmcnt(" #n ")" ::: "memory")
#define PG8_WAIT_L(n) asm volatile("s_waitcnt lgkmcnt(" #n ")" ::: "memory")
#define PG8_BAR __builtin_amdgcn_s_barrier()
#define PG8_SCHED __builtin_amdgcn_sched_barrier(0)
    Unit cur, nxt; int ui = 0;
    if (!S.next(0, cur)) return;
    f32x4 acc[2][2][4][2];
#pragma unroll
    for (int a = 0; a < 2; ++a)
#pragma unroll
        for (int b = 0; b < 2; ++b)
#pragma unroll
            for (int m = 0; m < 4; ++m)
#pragma unroll
                for (int n = 0; n < 2; ++n) acc[a][b][m][n] = (f32x4){0.f, 0.f, 0.f, 0.f};
    bf16x8 At[4][2], B0[2][2], B1[2][2];
    unsigned cA = cur.aoff, cB = cur.boff;
    PG8_STAGE(PG8_SB(0, 0), rsB, cB, voffB); PG8_STAGE(PG8_SA(0, 0), rsA, cA, voffA); PG8_STAGE(PG8_SB(0, 1), rsB, cB + hstepB, voffB); PG8_STAGE(PG8_SA(0, 1), rsA, cA + hstepA, voffA);
    if (wr == 1) PG8_BAR;
    PG8_WAIT_V(4); PG8_BAR;
    PG8_STAGE(PG8_SB(1, 0), rsB, cB + kstep, voffB); PG8_STAGE(PG8_SA(1, 0), rsA, cA + kstep, voffA); PG8_STAGE(PG8_SB(1, 1), rsB, cB + hstepB + kstep, voffB);
    PG8_WAIT_V(6); PG8_BAR;
    for (;;) {
        const bool has_next = S.next(ui + 1, nxt);
        const unsigned nA = has_next ? nxt.aoff : cA, nB = has_next ? nxt.boff : cB;
        for (int t = 0; t < nt; t += 2) {
            const bool last = (t == nt - 2);
            const unsigned a1 = cA + (unsigned)(t + 1) * kstep;
            const unsigned a2 = last ? nA : cA + (unsigned)(t + 2) * kstep, b2 = last ? nB : cB + (unsigned)(t + 2) * kstep;
            const unsigned a3 = a2 + kstep, b3 = b2 + kstep;
            PG8_LDB(B0, 0, 0); PG8_SCHED; PG8_LDA(At, 0, 0); PG8_STAGE(PG8_SA(1, 1), rsA, a1 + hstepA, voffA);
            PG8_WAIT_L(8); PG8_BAR; PG8_WAIT_L(0); PG8_MMA(0, 0, At, B0); PG8_BAR; PG8_SCHED;
            PG8_LDB(B1, 0, 1); PG8_STAGE(PG8_SB(0, 0), rsB, b2, voffB);
            PG8_BAR; PG8_WAIT_L(0); PG8_MMA(0, 1, At, B1); PG8_BAR;
            PG8_LDA(At, 0, 1); PG8_STAGE(PG8_SA(0, 0), rsA, a2, voffA);
            PG8_BAR; PG8_WAIT_L(0); PG8_MMA(1, 0, At, B0); PG8_BAR; PG8_SCHED;
            PG8_STAGE(PG8_SB(0, 1), rsB, b2 + hstepB, voffB);
            PG8_WAIT_V(6); PG8_BAR; PG8_MMA(1, 1, At, B1); PG8_BAR;
            PG8_LDB(B0, 1, 0); PG8_SCHED; PG8_LDA(At, 1, 0); PG8_STAGE(PG8_SA(0, 1), rsA, a2 + hstepA, voffA);
            PG8_WAIT_L(8); PG8_BAR; PG8_WAIT_L(0); PG8_MMA(0, 0, At, B0); PG8_BAR; PG8_SCHED;
            PG8_LDB(B1, 1, 1); PG8_STAGE(PG8_SB(1, 0), rsB, b3, voffB);
            PG8_BAR; PG8_WAIT_L(0); PG8_MMA(0, 1, At, B1); PG8_BAR;
            PG8_LDA(At, 1, 1); PG8_STAGE(PG8_SA(1, 0), rsA, a3, voffA);
            PG8_BAR; PG8_WAIT_L(0); PG8_MMA(1, 0, At, B0); PG8_BAR; PG8_SCHED;
            PG8_STAGE(PG8_SB(1, 1), rsB, b3 + hstepB, voffB);
            PG8_WAIT_V(6); PG8_BAR; PG8_MMA(1, 1, At, B1); PG8_BAR;
        }
        { const int l2 = phase_tid(wave) & 63; E(acc, cur, wr, wc, l2 & 15, l2 >> 4); }
        if (!has_next) break;
#pragma unroll
        for (int a = 0; a < 2; ++a)
#pragma unroll
            for (int b = 0; b < 2; ++b)
#pragma unroll
                for (int m = 0; m < 4; ++m)
#pragma unroll
                    for (int n = 0; n < 2; ++n) acc[a][b][m][n] = (f32x4){0.f, 0.f, 0.f, 0.f};
        cur = nxt; cA = nA; cB = nB; ++ui;
    }
    PG8_WAIT_V(0);
    if (wr == 0) PG8_BAR;
    PG8_BAR;
#undef PG8_SA
#undef PG8_SB
#undef PG8_STAGE
#undef PG8_LDA
#undef PG8_LDB
#undef PG8_MMA
#undef PG8_CAT
#undef PG8_WAIT_V
#undef PG8_WAIT_L
#undef PG8_BAR
#undef PG8_SCHED
}
}
using pg8::Unit;

#define EPI_LOOP_BEGIN \
    _Pragma("unroll") for (int ai = 0; ai < 2; ++ai) _Pragma("unroll") for (int m = 0; m < 4; ++m) { const int r = u.pm * 256 + ai * 128 + wr * 64 + m * 16 + fr; \
    _Pragma("unroll") for (int bj = 0; bj < 2; ++bj) _Pragma("unroll") for (int n = 0; n < 2; ++n) { const int cl = bj * 128 + wc * 32 + 16 * n + 4 * fq; const f32x4 a = acc[ai][bj][m][n];
#define EPI_LOOP_END } }

struct EpiP {
    static constexpr bool PERM = true; bf16_t* C;
    __device__ __forceinline__ void operator()(const f32x4 (&acc)[2][2][4][2], const Unit& u, int wr, int wc, int fr, int fq) const {
#pragma unroll
        for (int ai = 0; ai < 2; ++ai)
#pragma unroll
            for (int m = 0; m < 4; ++m) { const int r = u.pm * 256 + ai * 128 + wr * 64 + m * 16 + fr;
#pragma unroll
                for (int bj = 0; bj < 2; ++bj) { const int c0 = u.pn * 256 + bj * 128 + wc * 32 + 8 * fq; const f32x4 v0 = acc[ai][bj][m][0], v1 = acc[ai][bj][m][1];
                    u32x4 w; w.x = cvt_pk_bf16(v0[0], v0[1]); w.y = cvt_pk_bf16(v0[2], v0[3]); w.z = cvt_pk_bf16(v1[0], v1[1]); w.w = cvt_pk_bf16(v1[2], v1[3]);
                    *(u32x4*)(C + (size_t)r * NINP + c0) = w; } }
    }
};
#define EPI_COLS(ptr) f32x4 cv[2][2]; _Pragma("unroll") for (int bj = 0; bj < 2; ++bj) _Pragma("unroll") for (int n = 0; n < 2; ++n) cv[bj][n] = ld4((ptr) + bj * 128 + wc * 32 + 16 * n + 4 * fq);
#define EPI_COLS_PERM(ptr) f32x4 cv[2][2]; _Pragma("unroll") for (int bj = 0; bj < 2; ++bj) _Pragma("unroll") for (int n = 0; n < 2; ++n) cv[bj][n] = ld4((ptr) + bj * 128 + wc * 32 + 8 * fq + 4 * n);
struct EpiLora {
    static constexpr bool PERM = false; float* dec; bf16_t *iclr, *gg; const float *w0, *a0;
    __device__ __forceinline__ void operator()(const f32x4 (&acc)[2][2][4][2], const Unit& u, int wr, int wc, int fr, int fq) const {
        const int sect = u.pn >> 2, cb = (u.pn & 3) * 256;
        EPI_COLS((sect == 0 ? w0 : a0) + cb)
        EPI_LOOP_BEGIN
            const int c = cb + cl; f32x4 o;
            if (sect == 0) {
#pragma unroll
                for (int j = 0; j < 4; ++j) o[j] = __builtin_amdgcn_exp2f(-0.6065306597126334f * 1.4426950408889634f * sigmoidf_(cv[bj][n][j] + a[j]));
                *(f32x4*)(dec + (size_t)r * NC + c) = o; }
            else if (sect == 1) {
#pragma unroll
                for (int j = 0; j < 4; ++j) o[j] = sigmoidf_(cv[bj][n][j] + a[j]);
                u32x2 wv; wv.x = cvt_pk_bf16(o[0], o[1]); wv.y = cvt_pk_bf16(o[2], o[3]); *(u32x2*)(iclr + (size_t)r * NC + c) = wv; }
            else { u32x2 wv; wv.x = cvt_pk_bf16(a[0], a[1]); wv.y = cvt_pk_bf16(a[2], a[3]); *(u32x2*)(gg + (size_t)r * NC + c) = wv; }
        EPI_LOOP_END
    }
};
struct EpiPool {
    static constexpr bool PERM = true; bf16_t* t1; const bf16_t* P; const float* pscale;
    __device__ __forceinline__ void operator()(const f32x4 (&acc)[2][2][4][2], const Unit& u, int wr, int wc, int fr, int fq) const {
        EPI_COLS_PERM(pscale + u.pn * 256)
#pragma unroll
        for (int ai = 0; ai < 2; ++ai) { u32x4 gq[4][2];
#pragma unroll
            for (int m = 0; m < 4; ++m)
#pragma unroll
                for (int bj = 0; bj < 2; ++bj) gq[m][bj] = ldu4nt(P + (size_t)(u.pm * 256 + ai * 128 + wr * 64 + m * 16 + fr) * NINP + OFF_GB + u.pn * 256 + bj * 128 + wc * 32 + 8 * fq);
#pragma unroll
            for (int m = 0; m < 4; ++m) { const int r = u.pm * 256 + ai * 128 + wr * 64 + m * 16 + fr;
#pragma unroll
                for (int bj = 0; bj < 2; ++bj) { const int c0 = u.pn * 256 + bj * 128 + wc * 32 + 8 * fq;
                    const f32x4 g0 = bf4_unpack((u32x2){gq[m][bj].x, gq[m][bj].y}), g1 = bf4_unpack((u32x2){gq[m][bj].z, gq[m][bj].w}), a0 = acc[ai][bj][m][0], a1 = acc[ai][bj][m][1]; f32x4 o0, o1;
#pragma unroll
                    for (int j = 0; j < 4; ++j) { o0[j] = sigmoidf_(g0[j]) * cv[bj][0][j] * a0[j]; o1[j] = sigmoidf_(g1[j]) * cv[bj][1][j] * a1[j]; }
                    u32x4 w; w.x = cvt_pk_bf16(o0[0], o0[1]); w.y = cvt_pk_bf16(o0[2], o0[3]); w.z = cvt_pk_bf16(o1[0], o1[1]); w.w = cvt_pk_bf16(o1[2], o1[3]);
                    *(u32x4*)(t1 + (size_t)r * ND + c0) = w; } } }
    }
};
struct EpiRwkv {
    static constexpr bool PERM = true; bf16_t* mx; const bf16_t* P; const bf16_t* t1;
    __device__ __forceinline__ void operator()(const f32x4 (&acc)[2][2][4][2], const Unit& u, int wr, int wc, int fr, int fq) const {
#pragma unroll
        for (int ai = 0; ai < 2; ++ai) { u32x4 gq[4][2], tq[4][2];
#pragma unroll
            for (int m = 0; m < 4; ++m)
#pragma unroll
                for (int bj = 0; bj < 2; ++bj) { const int r = u.pm * 256 + ai * 128 + wr * 64 + m * 16 + fr, c0 = u.pn * 256 + bj * 128 + wc * 32 + 8 * fq;
                    gq[m][bj] = ldu4nt(P + (size_t)r * NINP + OFF_GA + c0); tq[m][bj] = ldu4nt(t1 + (size_t)r * ND + c0); }
#pragma unroll
            for (int m = 0; m < 4; ++m) { const int r = u.pm * 256 + ai * 128 + wr * 64 + m * 16 + fr;
#pragma unroll
                for (int bj = 0; bj < 2; ++bj) { const int c0 = u.pn * 256 + bj * 128 + wc * 32 + 8 * fq;
                    const f32x4 g0 = bf4_unpack((u32x2){gq[m][bj].x, gq[m][bj].y}), g1 = bf4_unpack((u32x2){gq[m][bj].z, gq[m][bj].w});
                    const f32x4 t0 = bf4_unpack((u32x2){tq[m][bj].x, tq[m][bj].y}), t1v = bf4_unpack((u32x2){tq[m][bj].z, tq[m][bj].w}), a0 = acc[ai][bj][m][0], a1 = acc[ai][bj][m][1]; f32x4 o0, o1;
#pragma unroll
                    for (int j = 0; j < 4; ++j) { o0[j] = sigmoidf_(g0[j]) * a0[j] + t0[j]; o1[j] = sigmoidf_(g1[j]) * a1[j] + t1v[j]; }
                    u32x4 w; w.x = cvt_pk_bf16(o0[0], o0[1]); w.y = cvt_pk_bf16(o0[2], o0[3]); w.z = cvt_pk_bf16(o1[0], o1[1]); w.w = cvt_pk_bf16(o1[2], o1[3]);
                    *(u32x4*)(mx + (size_t)r * ND + c0) = w; } } }
    }
};
struct EpiWout {
    static constexpr bool PERM = true; float* z1; const float* x; const float* mod;
    __device__ __forceinline__ void operator()(const f32x4 (&acc)[2][2][4][2], const Unit& u, int wr, int wc, int fr, int fq) const {
        const int b = u.pm >> 3;
        EPI_COLS_PERM(mod + (size_t)b * NMOD + 2 * ND + u.pn * 256)
#pragma unroll
        for (int ai = 0; ai < 2; ++ai)
#pragma unroll
            for (int mh = 0; mh < 2; ++mh) { f32x4 xq[2][2][2];
#pragma unroll
                for (int m2 = 0; m2 < 2; ++m2)
#pragma unroll
                    for (int bj = 0; bj < 2; ++bj)
#pragma unroll
                        for (int n = 0; n < 2; ++n) xq[m2][bj][n] = ld4nt(x + (size_t)(u.pm * 256 + ai * 128 + wr * 64 + (mh * 2 + m2) * 16 + fr) * ND + u.pn * 256 + bj * 128 + wc * 32 + 8 * fq + 4 * n);
#pragma unroll
                for (int m2 = 0; m2 < 2; ++m2) { const int m = mh * 2 + m2, r = u.pm * 256 + ai * 128 + wr * 64 + m * 16 + fr;
#pragma unroll
                    for (int bj = 0; bj < 2; ++bj)
#pragma unroll
                        for (int n = 0; n < 2; ++n) { const int c = u.pn * 256 + bj * 128 + wc * 32 + 8 * fq + 4 * n;
                            *(f32x4*)(z1 + (size_t)r * ND + c) = xq[m2][bj][n] * DN_ALPHA + cv[bj][n] * acc[ai][bj][m][n]; } } }
    }
};
struct EpiGU {
    static constexpr bool PERM = true; fp8_t* act; const float* b_gu;
    __device__ __forceinline__ void operator()(const f32x4 (&acc)[2][2][4][2], const Unit& u, int wr, int wc, int fr, int fq) const {
        const float* bias = b_gu + (size_t)u.e * (2 * DFF) + u.pn * 256 + wc * 32 + 8 * fq;
#pragma unroll
        for (int bj = 0; bj < 2; ++bj) { const f32x4 c0v = ld4(bias + bj * 128), c1v = ld4(bias + bj * 128 + 4); const int c0 = u.pn * 256 + bj * 128 + wc * 32 + 8 * fq;
#pragma unroll
            for (int ai = 0; ai < 2; ++ai)
#pragma unroll
                for (int m = 0; m < 4; ++m) { const int r = u.pm * 256 + ai * 128 + wr * 64 + m * 16 + fr;
                    const f32x4 v0 = acc[ai][bj][m][0] * W8_INV + c0v, v1 = acc[ai][bj][m][1] * W8_INV + c1v;
                    float o[4];
#pragma unroll
                    for (int j = 0; j < 4; ++j) { const float gt = fminf(j < 2 ? v0[2 * j] : v1[2 * j - 4], SW_LIMIT); const float up = fminf(fmaxf(j < 2 ? v0[2 * j + 1] : v1[2 * j - 3], -SW_LIMIT), SW_LIMIT);
                        o[j] = (up + 1.0f) * (gt * __builtin_amdgcn_rcpf(1.0f + __builtin_amdgcn_exp2f(gt * (-SW_ALPHA * 1.4426950408889634f)))); }
                    *(unsigned*)(act + (size_t)r * DFF + (c0 >> 1)) = pack4_fp8(o[0], o[1], o[2], o[3]); } }
    }
};
struct EpiDown {
    static constexpr bool PERM = true; bf16_t* yb; const float* b_down;
    __device__ __forceinline__ void operator()(const f32x4 (&acc)[2][2][4][2], const Unit& u, int wr, int wc, int fr, int fq) const {
        const float* bias = b_down + (size_t)u.e * ND + u.pn * 256 + wc * 32 + 8 * fq;
#pragma unroll
        for (int bj = 0; bj < 2; ++bj) { const f32x4 c0v = ld4(bias + bj * 128), c1v = ld4(bias + bj * 128 + 4); const int c0 = u.pn * 256 + bj * 128 + wc * 32 + 8 * fq;
#pragma unroll
            for (int ai = 0; ai < 2; ++ai)
#pragma unroll
                for (int m = 0; m < 4; ++m) { const int r = u.pm * 256 + ai * 128 + wr * 64 + m * 16 + fr;
                    const f32x4 v0 = acc[ai][bj][m][0] * W8_INV + c0v, v1 = acc[ai][bj][m][1] * W8_INV + c1v;
                    u32x4 w; w.x = cvt_pk_bf16(v0[0], v0[1]); w.y = cvt_pk_bf16(v0[2], v0[3]); w.z = cvt_pk_bf16(v1[0], v1[1]); w.w = cvt_pk_bf16(v1[2], v1[3]);
                    *(u32x4*)(yb + (size_t)r * ND + c0) = w; } }
    }
};

struct WinRestOrder {
    int c; size_t a_tile, b_tile;
    __device__ bool next(int i, Unit& u) const {
        if (i > 0 || c < 0 || c >= 64) return false;
        u.pm = c >> 1; u.pn = 23 + (c & 1); u.e = 0; u.aoff = (unsigned)((size_t)u.pm * a_tile); u.boff = (unsigned)((size_t)u.pn * b_tile); return true;
    }
};
struct PoolOrder {
    int G, c;
    __device__ bool next(int i, Unit& u) const {
        const int L = i * G + c; if (c < 0 || L >= 256) return false;
        u.pm = L >> 3; u.pn = L & 7; u.e = 0;
        u.aoff = (unsigned)(((size_t)u.pm * 256 * NC + (size_t)(u.pn >> 1) * 256) * 2); u.boff = (unsigned)((size_t)u.pn * 256 * 256 * 2); return true;
    }
};
struct MoeOrder {
    int G, c, nN, ntiles; const LAS unsigned* tile_e; size_t a_tile, b_expert, b_tile;
    __device__ bool next(int i, Unit& u) const {
        const int L = i * G + c; if (L >= ntiles * nN) return false;
        u.pm = L / nN; u.pn = L % nN; u.e = __builtin_amdgcn_readfirstlane((int)tile_e[u.pm]);
        u.aoff = (unsigned)((size_t)u.pm * a_tile); u.boff = (unsigned)((size_t)u.e * b_expert + (size_t)u.pn * b_tile); return true;
    }
};

__device__ __forceinline__ void cvt_block_T(const float* src, int ld_src, bf16_t* dst, int ld_dst, int lane) {
    const int k8 = lane & 7, nq = lane >> 3;
    const float* s = src + (size_t)(k8 * 8) * ld_src + nq * 4;
    f32x4 v[8];
#pragma unroll
    for (int j = 0; j < 8; ++j) v[j] = __builtin_nontemporal_load((const f32x4*)(s + (size_t)j * ld_src));
#pragma unroll
    for (int i = 0; i < 4; ++i) { u32x4 w; w.x = cvt_pk_bf16(v[0][i], v[1][i]); w.y = cvt_pk_bf16(v[2][i], v[3][i]); w.z = cvt_pk_bf16(v[4][i], v[5][i]); w.w = cvt_pk_bf16(v[6][i], v[7][i]);
        *(u32x4*)(dst + (size_t)(nq * 4 + i) * ld_dst + k8 * 8) = w; }
}
__device__ __forceinline__ void cvt_block_T2(const float* src, int ld_src, bf16_t* dst, int ld_dst, int lane) {
    const int k8 = lane & 7, nq = lane >> 3;
    const float* s = src + (size_t)(k8 * 8) * ld_src + nq * 4;
    f32x4 v[8], w2[8];
#pragma unroll
    for (int j = 0; j < 8; ++j) { v[j] = ld4(s + (size_t)j * ld_src); w2[j] = ld4(s + (size_t)j * ld_src + 32); }
#pragma unroll
    for (int i = 0; i < 4; ++i) { u32x4 w; w.x = cvt_pk_bf16(v[0][i], v[1][i]); w.y = cvt_pk_bf16(v[2][i], v[3][i]); w.z = cvt_pk_bf16(v[4][i], v[5][i]); w.w = cvt_pk_bf16(v[6][i], v[7][i]);
        *(u32x4*)(dst + (size_t)(nq * 4 + i) * ld_dst + k8 * 8) = w; }
#pragma unroll
    for (int i = 0; i < 4; ++i) { u32x4 w; w.x = cvt_pk_bf16(w2[0][i], w2[1][i]); w.y = cvt_pk_bf16(w2[2][i], w2[3][i]); w.z = cvt_pk_bf16(w2[4][i], w2[5][i]); w.w = cvt_pk_bf16(w2[6][i], w2[7][i]);
        *(u32x4*)(dst + (size_t)(32 + nq * 4 + i) * ld_dst + k8 * 8) = w; }
}

__device__ __forceinline__ void cvt8_load(f32x4 (&v)[16], const float* s, int ld_src) {
#pragma unroll
    for (int j = 0; j < 16; ++j) v[j] = __builtin_nontemporal_load((const f32x4*)(s + (size_t)j * ld_src));
}
__device__ __forceinline__ void cvt8_store(const f32x4 (&v)[16], fp8_t* d, int ld_dst) {
#pragma unroll
    for (int i = 0; i < 4; ++i) { u32x4 w; w.x = pack4_fp8(v[0][i] * W8_SCALE, v[1][i] * W8_SCALE, v[2][i] * W8_SCALE, v[3][i] * W8_SCALE); w.y = pack4_fp8(v[4][i] * W8_SCALE, v[5][i] * W8_SCALE, v[6][i] * W8_SCALE, v[7][i] * W8_SCALE);
        w.z = pack4_fp8(v[8][i] * W8_SCALE, v[9][i] * W8_SCALE, v[10][i] * W8_SCALE, v[11][i] * W8_SCALE); w.w = pack4_fp8(v[12][i] * W8_SCALE, v[13][i] * W8_SCALE, v[14][i] * W8_SCALE, v[15][i] * W8_SCALE);
        __builtin_nontemporal_store(w, (u32x4*)(d + (size_t)i * ld_dst)); }
}
__device__ __forceinline__ void cvt_wave_T8x8(const float* src, int ld_src, fp8_t* dst, int ld_dst, int lane) {
    const int k16 = lane & 7, nq = lane >> 3;
    const float* s = src + (size_t)(k16 * 16) * ld_src + nq * 4; fp8_t* d = dst + (size_t)(nq * 4) * ld_dst + k16 * 16;
    f32x4 va[16], vb[16];
    cvt8_load(va, s, ld_src);
#pragma unroll
    for (int i = 0; i < 8; i += 2) {
        cvt8_load(vb, s + (i + 1) * 32, ld_src);
        cvt8_store(va, d + (size_t)(i * 32) * ld_dst, ld_dst);
        if (i + 2 < 8) cvt8_load(va, s + (i + 2) * 32, ld_src);
        cvt8_store(vb, d + (size_t)((i + 1) * 32) * ld_dst, ld_dst);
    }
}

__device__ __forceinline__ void phase0(const Params& p, LAS unsigned char* lds, const int wave) {
    const int tid = phase_tid(wave);
    const int bid = blockIdx.x, lane = tid & 63, wv = tid >> 6;
    LAS float* cond = (LAS float*)lds;
    if (bid < 192) {
        for (int i = tid; i < NB * ND; i += NTHREADS) { const int b = i >> 11, k = i & 2047; const float cv = p.c[i]; cond[k * 4 + b] = cv / (1.0f + expf(-cv)); }
        __syncthreads();
        const int gid = bid * NTHREADS + tid, ks = gid / 3072, j4 = gid % 3072;
        f32x4 a0 = {0.f, 0.f, 0.f, 0.f}, a1 = a0, a2 = a0, a3 = a0;
        const float* wp = p.w_ada + (size_t)(ks * 64) * NMOD + j4 * 4;
#pragma unroll 16
        for (int kk = 0; kk < 64; ++kk) { const f32x4 w = __builtin_nontemporal_load((const f32x4*)(wp + (size_t)kk * NMOD)); const f32x4 cd = *(const LAS f32x4*)(cond + (ks * 64 + kk) * 4);
            a0 += w * cd[0]; a1 += w * cd[1]; a2 += w * cd[2]; a3 += w * cd[3]; }
        *(f32x4*)(p.modp + (size_t)(ks * 4 + 0) * NMOD + j4 * 4) = a0; *(f32x4*)(p.modp + (size_t)(ks * 4 + 1) * NMOD + j4 * 4) = a1;
        *(f32x4*)(p.modp + (size_t)(ks * 4 + 2) * NMOD + j4 * 4) = a2; *(f32x4*)(p.modp + (size_t)(ks * 4 + 3) * NMOD + j4 * 4) = a3;
    }
    const int gw = bid * NWAVES + wv, GW = gridDim.x * NWAVES;
    constexpr int I_IN = 32 * 265, I_RW = 16 * 64, I_PL = 4 * 4 * 16, I_OUT = 32 * 64, I_ALL = I_IN + I_RW + I_PL + I_OUT;
    for (int it = gw; it < I_ALL; it += GW) {
        if (it < I_IN) { const int kb = it / 265, nb = it % 265; cvt_block_T(p.w_in + (size_t)(kb * 64) * NIN + nb * 32, NIN, p.wt_in + (size_t)(nb * 32) * ND + kb * 64, ND, lane); }
        else if (it < I_IN + I_RW) { const int j = it - I_IN, kb = j / 64, nb = j % 64; cvt_block_T(p.w_rwkv_out + (size_t)(kb * 64) * ND + nb * 32, ND, p.wt_rwkv + (size_t)(nb * 32) * NC + kb * 64, NC, lane); }
        else if (it < I_IN + I_RW + I_PL) { const int j = it - I_IN - I_RW, g = j / 64, kb = (j % 64) / 16, nb = j % 16;
            cvt_block_T(p.w_pool + (size_t)g * 256 * 512 + (size_t)(kb * 64) * 512 + nb * 32, 512, p.wt_pool + (size_t)g * 512 * 256 + (size_t)(nb * 32) * 256 + kb * 64, 256, lane); }
        else { const int j = it - I_IN - I_RW - I_PL, kb = j / 64, nb = j % 64; cvt_block_T(p.w_out + (size_t)(kb * 64) * ND + nb * 32, ND, p.wt_out + (size_t)(nb * 32) * ND + kb * 64, ND, lane); }
    }
    for (int idx = bid * NTHREADS + tid; idx < LORA_N * (LORA_K / 8); idx += gridDim.x * NTHREADS) {
        const int n = idx / (LORA_K / 8), k0 = (idx % (LORA_K / 8)) * 8; float v[8];
#pragma unroll
        for (int j = 0; j < 8; ++j) { const int k = k0 + j; float x = 0.f;
            if (n < 1024) { if (k < 64) x = p.w_decay_up[k * NC + n]; }
            else if (n < 2048) { if (k >= 64 && k < 128) x = p.w_iclr_up[(k - 64) * NC + (n - 1024)]; }
            else { if (k >= 128 && k < 288) x = p.w_glora_up[(k - 128) * NC + (n - 2048)]; }
            v[j] = x; }
        u32x4 w; w.x = cvt_pk_bf16(v[0], v[1]); w.y = cvt_pk_bf16(v[2], v[3]); w.z = cvt_pk_bf16(v[4], v[5]); w.w = cvt_pk_bf16(v[6], v[7]);
        *(u32x4*)(p.bt_lora + (size_t)n * LORA_K + k0) = w;
    }
}

__device__ __forceinline__ void phase1(const Params& p, LAS unsigned char* lds, const int wave) {
    const int tid = phase_tid(wave);
    const int bid = blockIdx.x;
    if (tid < 192) { const int idx = bid * 192 + tid, b = idx / NMOD, j = idx % NMOD; float s = p.b_ada[j];
        for (int ks = 0; ks < KS_MOD; ++ks) s += p.modp[(size_t)(ks * 4 + b) * NMOD + j];
        p.mod[idx] = s; }
    LAS float* ss = (LAS float*)lds;
    const int m0 = bid * 32, b = m0 >> 11;
    {   const int j = tid * 8; f32x4 s0 = ld4(p.b_ada + j), s1 = ld4(p.b_ada + j + 4);
#pragma unroll 8
        for (int ks = 0; ks < KS_MOD; ++ks) { s0 += ld4(p.modp + (size_t)(ks * 4 + b) * NMOD + j); s1 += ld4(p.modp + (size_t)(ks * 4 + b) * NMOD + j + 4); }
        *(LAS f32x4*)(ss + j) = s0; *(LAS f32x4*)(ss + j + 4) = s1; }
    __syncthreads();
    const int k = (tid & 255) * 8, rh = tid >> 8;
    const f32x4 sh0 = *(const LAS f32x4*)(ss + k), sh1v = *(const LAS f32x4*)(ss + k + 4), sc0 = *(const LAS f32x4*)(ss + ND + k) + 1.0f, sc1v = *(const LAS f32x4*)(ss + ND + k + 4) + 1.0f;
#pragma unroll 4
    for (int i = 0; i < 16; ++i) { const size_t m = (size_t)(m0 + 2 * i + rh); const f32x4 x0 = ld4nt(p.x + m * ND + k), x1 = ld4nt(p.x + m * ND + k + 4); const f32x4 h0 = x0 * sc0 + sh0, h1 = x1 * sc1v + sh1v;
        u32x4 w; w.x = cvt_pk_bf16(h0[0], h0[1]); w.y = cvt_pk_bf16(h0[2], h0[3]); w.z = cvt_pk_bf16(h1[0], h1[1]); w.w = cvt_pk_bf16(h1[2], h1[3]); *(u32x4*)(p.hb + m * ND + k) = w; }
    __syncthreads();
}

__device__ __forceinline__ void phase3(const Params& p, LAS unsigned char* lds, const int wave) {
    const int tid = phase_tid(wave);
    const int bid = blockIdx.x, m0 = bid * 32, t0 = m0 & (NT - 1), hist = t0 > 0 ? 15 : 0;
    constexpr int TC = OFF_GA - OFF_WD, TCH = TC / 8;
    LAS bf16_t* T = (LAS bf16_t*)lds;
    for (int idx = tid; idx < 47 * TCH; idx += NTHREADS) { const int r = idx / TCH, ck = idx % TCH;
        if (r >= 15 - hist) *(LAS u32x4*)(T + r * TC + ck * 8) = ldu4nt(p.P + (size_t)(m0 - 15 + r) * NINP + OFF_WD + ck * 8); }
    __syncthreads();
    for (int idx = tid; idx < 32 * (LORA_K / 8); idx += NTHREADS) { const int i = idx / (LORA_K / 8), j0 = (idx % (LORA_K / 8)) * 8; u32x4 w = {0u, 0u, 0u, 0u};
        if (j0 < 288) { const u32x4 cu = *(const LAS u32x4*)(T + (15 + i) * TC + j0); u32x4 pu = {0u, 0u, 0u, 0u}; if (t0 + i > 0) pu = *(const LAS u32x4*)(T + (14 + i) * TC + j0);
            const f32x4 c0 = bf4_unpack((u32x2){cu.x, cu.y}), c1 = bf4_unpack((u32x2){cu.z, cu.w}), q0 = bf4_unpack((u32x2){pu.x, pu.y}), q1 = bf4_unpack((u32x2){pu.z, pu.w});
            const f32x4 s0 = c0 + (q0 - c0) * ld4(p.mu_shift + OFF_WD + j0), s1 = c1 + (q1 - c1) * ld4(p.mu_shift + OFF_WD + j0 + 4); float v[8];
#pragma unroll
            for (int j = 0; j < 8; ++j) { const float x = j < 4 ? s0[j] : s1[j - 4];
                v[j] = j0 < 64 ? (1.0f - 2.0f * __builtin_amdgcn_rcpf(1.0f + __builtin_amdgcn_exp2f(x * 2.8853900817779268f))) : (j0 < 128 ? x : sigmoidf_(x)); }
            w.x = cvt_pk_bf16(v[0], v[1]); w.y = cvt_pk_bf16(v[2], v[3]); w.z = cvt_pk_bf16(v[4], v[5]); w.w = cvt_pk_bf16(v[6], v[7]); }
        *(u32x4*)(p.a_lora + (size_t)(m0 + i) * LORA_K + j0) = w; }
    for (int idx = tid; idx < 32 * (NC / 8); idx += NTHREADS) { const int i = idx >> 7, c = (idx & 127) * 8; const int win = 2 << (c >> 8), t = t0 + i, n = (t + 1) < win ? (t + 1) : win;
        const LAS bf16_t* up = T + (15 + i) * TC + (OFF_POOL - OFF_WD) + c; f32x4 a0 = {0.f, 0.f, 0.f, 0.f}, a1 = a0;
        for (int q = 0; q < n; ++q) { const u32x4 uu = *(const LAS u32x4*)(up - q * TC); a0 += bf4_unpack((u32x2){uu.x, uu.y}); a1 += bf4_unpack((u32x2){uu.z, uu.w}); }
        const u32x4 u0 = *(const LAS u32x4*)(up); const float rn = 1.0f / (float)n;
        const f32x4 d0 = a0 * rn - bf4_unpack((u32x2){u0.x, u0.y}), d1 = a1 * rn - bf4_unpack((u32x2){u0.z, u0.w});
        u32x4 w; w.x = cvt_pk_bf16(d0[0], d0[1]); w.y = cvt_pk_bf16(d0[2], d0[3]); w.z = cvt_pk_bf16(d1[0], d1[1]); w.w = cvt_pk_bf16(d1[2], d1[3]);
        *(u32x4*)(p.dp + (size_t)(m0 + i) * NC + c) = w; }
    __syncthreads();
}

__device__ __forceinline__ float row8_allsum(float x) {
    x += dpp_f<0x141>(x); x += dpp_f<0x1B>(x); x += dpp_f<0xB1>(x); return x;
}
__device__ __forceinline__ void scan_head(const Params& p, LAS unsigned char* lds, int bh, const int wave) {
    const int tid = phase_tid(wave);
    const int lane = tid & 63;
    const int b = bh >> 4, h = bh & 15;
    constexpr int L_AW = 0, L_W = 16384, L_BK = 32768, L_Y = 65536, L_V = 81920, L_G = 106496, L_SC = 131072, L_CS = 131840, L_Z = 132352, L_DUMMY = 132864, L_CST = 133888;
    constexpr int NCH = NT / 32;
    if (tid < 128) *(LAS unsigned*)(lds + L_Z + tid * 4) = 0u;
    {
        const int a8 = tid >> 6, cc = tid & 63, gch = h * HS + cc;
        const float* src = a8 == 0 ? p.mu_shift + OFF_R : a8 == 1 ? p.mu_shift + OFF_K : a8 == 2 ? p.mu_shift + OFF_V : a8 == 3 ? p.k_k : a8 == 4 ? p.k_a : a8 == 5 ? p.r_k : a8 == 6 ? p.lnx_g : p.lnx_b;
        *(LAS float*)(lds + L_CST + a8 * 256 + cc * 4) = src[gch]; }
    __syncthreads();
#define CST4(a8, u_) (*(const LAS f32x4*)(lds + L_CST + (a8) * 256 + (c8 + 4 * (u_)) * 4))
    const int ht = tid - 256, ls = (ht >> 3) & 31, c8 = (ht & 7) * 8, ch0 = h * HS + c8;
    f32x4 pr[2], pk[2], pv[2], qr[2], qk[2], qv[2], dc[2], ic[2], gt[2]; u32x4 pr8, pk8, pv8, qr8, qk8, qv8, ic8, gt8;
    const f32x4 zero4 = {0.f, 0.f, 0.f, 0.f};
#define SCAN_ISSUE(chunk) do { int ch = ch0; asm volatile("" : "+v"(ch)); const int t_ = (chunk) * 32 + ls; const size_t m_ = (size_t)b * NT + t_; const bf16_t* row_ = p.P + m_ * NINP + ch; \
        pr8 = *(const u32x4*)(row_ + OFF_R); pk8 = *(const u32x4*)(row_ + OFF_K); pv8 = *(const u32x4*)(row_ + OFF_V); \
        if (t_ > 0) { qr8 = *(const u32x4*)(row_ - NINP + OFF_R); qk8 = *(const u32x4*)(row_ - NINP + OFF_K); qv8 = *(const u32x4*)(row_ - NINP + OFF_V); } else { qr8 = (u32x4){0u, 0u, 0u, 0u}; qk8 = qr8; qv8 = qr8; } \
        ic8 = ldu4nt(p.iclr + m_ * NC + ch); gt8 = ldu4nt(p.gg + m_ * NC + ch); \
        _Pragma("unroll") for (int u_ = 0; u_ < 2; ++u_) dc[u_] = ld4nt(p.dec + m_ * NC + ch + 4 * u_); } while (0)
#define SCAN_UNPACK() do { ic[0] = bf4_unpack((u32x2){ic8.x, ic8.y}); ic[1] = bf4_unpack((u32x2){ic8.z, ic8.w}); gt[0] = bf4_unpack((u32x2){gt8.x, gt8.y}); gt[1] = bf4_unpack((u32x2){gt8.z, gt8.w}); pr[0] = bf4_unpack((u32x2){pr8.x, pr8.y}); pr[1] = bf4_unpack((u32x2){pr8.z, pr8.w}); pk[0] = bf4_unpack((u32x2){pk8.x, pk8.y}); pk[1] = bf4_unpack((u32x2){pk8.z, pk8.w}); \
        pv[0] = bf4_unpack((u32x2){pv8.x, pv8.y}); pv[1] = bf4_unpack((u32x2){pv8.z, pv8.w}); qr[0] = bf4_unpack((u32x2){qr8.x, qr8.y}); qr[1] = bf4_unpack((u32x2){qr8.z, qr8.w}); \
        qk[0] = bf4_unpack((u32x2){qk8.x, qk8.y}); qk[1] = bf4_unpack((u32x2){qk8.z, qk8.w}); qv[0] = bf4_unpack((u32x2){qv8.x, qv8.y}); qv[1] = bf4_unpack((u32x2){qv8.z, qv8.w}); } while (0)
#define SCAN_STAGE(chunk) do { SCAN_UNPACK(); int ch = ch0; asm volatile("" : "+v"(ch)); const int bp_ = (chunk) & 1, vb_ = (chunk) % 3; f32x4 r_[2], k_[2], v_[2], kk_[2], km_[2], bb_[2]; float ss_ = 0.f; \
        _Pragma("unroll") for (int u_ = 0; u_ < 2; ++u_) { const f32x4 mu_r = CST4(0, u_), mu_k = CST4(1, u_), mu_v = CST4(2, u_); \
            r_[u_] = pr[u_] + (qr[u_] - pr[u_]) * mu_r; k_[u_] = pk[u_] + (qk[u_] - pk[u_]) * mu_k; v_[u_] = pv[u_] + (qv[u_] - pv[u_]) * mu_v; \
            kk_[u_] = k_[u_] * CST4(3, u_); ss_ += dot4(kk_[u_], kk_[u_]); } \
        ss_ = row8_allsum(ss_); const float inv_ = 1.0f / fmaxf(sqrtf(ss_), 1e-12f); float br_ = 0.f, kr_ = 0.f, rk_ = 0.f; \
        _Pragma("unroll") for (int u_ = 0; u_ < 2; ++u_) { kk_[u_] = kk_[u_] * inv_; km_[u_] = k_[u_] * ((ic[u_] - 1.0f) * CST4(4, u_) + 1.0f); bb_[u_] = kk_[u_] * ic[u_]; \
            br_ += dot4(bb_[u_], r_[u_]); kr_ += dot4(km_[u_], r_[u_]); rk_ += dot4(r_[u_] * km_[u_], CST4(5, u_)); } \
        br_ = row8_allsum(br_); kr_ = row8_allsum(kr_); rk_ = row8_allsum(rk_); \
          \
        const int pp_ = ls >> 1, odd_ = ls & 1; float c1_ = 0.f, c2_ = 0.f, c3_ = 0.f, c4_ = 0.f; \
        _Pragma("unroll") for (int u_ = 0; u_ < 2; ++u_) { const int k0_ = c8 + 4 * u_; const int pos_ = (k0_ >> 5) * 32 + ((k0_ & 15) >> 2) * 8 + ((k0_ >> 4) & 1) * 4; \
            const f32x4 a_ = -kk_[u_], wr_ = dc[u_] * r_[u_] + a_ * br_; f32x4 pw_, pb_, pk_; \
            _Pragma("unroll") for (int j_ = 0; j_ < 4; ++j_) { pw_[j_] = dpp_f<0x118>(dc[u_][j_]); pb_[j_] = dpp_f<0x118>(bb_[u_][j_]); pk_[j_] = dpp_f<0x118>(km_[u_][j_]); } \
            const f32x4 x0_ = odd_ ? pw_ * a_ : a_, x1_ = odd_ ? pw_ * wr_ : wr_; \
            u32x2 wa_, ww_; wa_.x = cvt_pk_bf16(x0_[0], x0_[1]); wa_.y = cvt_pk_bf16(x0_[2], x0_[3]); ww_.x = cvt_pk_bf16(x1_[0], x1_[1]); ww_.y = cvt_pk_bf16(x1_[2], x1_[3]); \
            *(LAS u32x2*)(lds + L_AW + bp_ * 8192 + pp_ * 512 + odd_ * 256 + pos_ * 2) = wa_; *(LAS u32x2*)(lds + L_AW + bp_ * 8192 + pp_ * 512 + odd_ * 256 + 128 + pos_ * 2) = ww_; \
            if (odd_) { *(LAS f32x4*)(lds + L_W + bp_ * 8192 + pp_ * 256 + k0_ * 4) = pw_ * dc[u_]; \
                *(LAS f32x4*)(lds + L_BK + bp_ * 16384 + pp_ * 1024 + k0_ * 4) = pb_ * dc[u_]; *(LAS f32x4*)(lds + L_BK + bp_ * 16384 + pp_ * 1024 + 256 + k0_ * 4) = pk_ * dc[u_]; \
                *(LAS f32x4*)(lds + L_BK + bp_ * 16384 + pp_ * 1024 + 512 + k0_ * 4) = bb_[u_]; *(LAS f32x4*)(lds + L_BK + bp_ * 16384 + pp_ * 1024 + 768 + k0_ * 4) = km_[u_]; \
                c1_ += dot4(pb_, a_); c2_ += dot4(pk_, a_); c3_ += dot4(pb_, wr_); c4_ += dot4(pk_, wr_); } \
            *(LAS f32x4*)(lds + L_V + vb_ * 8192 + ls * 256 + k0_ * 4) = v_[u_]; *(LAS f32x4*)(lds + L_G + vb_ * 8192 + ls * 256 + k0_ * 4) = gt[u_]; } \
        c1_ = row8_allsum(c1_); c2_ = row8_allsum(c2_); c3_ = row8_allsum(c3_); c4_ = row8_allsum(c4_); \
        if ((ht & 7) == 0) { *(LAS f32x2*)(lds + L_SC + vb_ * 256 + ls * 8) = (f32x2){kr_, rk_}; if (odd_) *(LAS f32x4*)(lds + L_CS + bp_ * 256 + pp_ * 16) = (f32x4){c1_, c2_, c3_, c4_}; } } while (0)
#define SCAN_POST(chunk) do { int ch = ch0; asm volatile("" : "+v"(ch)); const int bp_ = (chunk) & 1, vb_ = (chunk) % 3; const f32x2 sc_ = *(const LAS f32x2*)(lds + L_SC + vb_ * 256 + ls * 8); f32x4 y_[2], v_[2]; float s_ = 0.f; \
        _Pragma("unroll") for (int u_ = 0; u_ < 2; ++u_) { v_[u_] = *(const LAS f32x4*)(lds + L_V + vb_ * 8192 + ls * 256 + (c8 + 4 * u_) * 4); \
            y_[u_] = *(const LAS f32x4*)(lds + L_Y + bp_ * 8192 + ls * 256 + (c8 + 4 * u_) * 4) + v_[u_] * sc_[0]; s_ += (y_[u_][0] + y_[u_][1]) + (y_[u_][2] + y_[u_][3]); } \
        const float mean_ = row8_allsum(s_) * (1.0f / 64.0f); float q_ = 0.f; \
        _Pragma("unroll") for (int u_ = 0; u_ < 2; ++u_) { y_[u_] = y_[u_] - mean_; q_ += dot4(y_[u_], y_[u_]); } \
        const float rstd_ = rsqrtf(row8_allsum(q_) * (1.0f / 64.0f) + GN_EPS); const size_t m_ = (size_t)b * NT + (chunk) * 32 + ls; u32x4 o_; \
        _Pragma("unroll") for (int u_ = 0; u_ < 2; ++u_) { const f32x4 g_ = *(const LAS f32x4*)(lds + L_G + vb_ * 8192 + ls * 256 + (c8 + 4 * u_) * 4); \
            const f32x4 yn_ = y_[u_] * rstd_ * CST4(6, u_) + CST4(7, u_); const f32x4 f_ = (yn_ + v_[u_] * sc_[1]) * g_; \
            if (u_ == 0) { o_.x = cvt_pk_bf16(f_[0], f_[1]); o_.y = cvt_pk_bf16(f_[2], f_[3]); } else { o_.z = cvt_pk_bf16(f_[0], f_[1]); o_.w = cvt_pk_bf16(f_[2], f_[3]); } } \
        *(u32x4*)(p.yr + m_ * NC + ch) = o_; } while (0)
    const int ri = lane & 15, rg = lane >> 4, sel = ri & 3;
    f32x4 X0 = zero4, X1 = zero4, X2 = zero4, X3 = zero4;
    if (wave >= 4) { SCAN_ISSUE(0); SCAN_STAGE(0); }
    __syncthreads();
    for (int chunk = 0; chunk < NCH; ++chunk) {
        if (wave < 4) {
            __builtin_amdgcn_s_setprio(3);
            const int bp = chunk & 1, vb = chunk % 3;
            const LAS unsigned char* awp = lds + L_AW + bp * 8192 + sel * 128 + rg * 16;
            const LAS unsigned char* wwp = lds + L_W + bp * 8192 + rg * 16;
            const LAS unsigned char* abp = lds + L_BK + bp * 16384 + rg * 256 + ri * 4;
            const LAS unsigned char* vp = lds + L_V + vb * 8192 + (16 * wave + ri) * 4;
            const LAS unsigned char* csp = lds + L_CS + bp * 256;
            LAS unsigned char* yp = (rg == 0) ? (lds + L_Y + bp * 8192 + (16 * wave + ri) * 4) : ((rg == 2) ? (lds + L_Y + bp * 8192 + 256 + (16 * wave + ri) * 4) : (lds + L_DUMMY + tid * 4));
            const int y_st = (rg & 1) ? 0 : 512;
#define SCAN_LD(S, pi) do { S##a0 = *(const LAS bf16x8*)(awp + (pi) * 512); S##a1 = *(const LAS bf16x8*)(awp + (pi) * 512 + 64); \
                S##w0 = *(const LAS f32x4*)(wwp + (pi) * 256); S##w1 = *(const LAS f32x4*)(wwp + (pi) * 256 + 64); S##w2 = *(const LAS f32x4*)(wwp + (pi) * 256 + 128); S##w3 = *(const LAS f32x4*)(wwp + (pi) * 256 + 192); \
                S##b0 = *(const LAS float*)(abp + (pi) * 1024); S##b1 = *(const LAS float*)(abp + (pi) * 1024 + 64); S##b2 = *(const LAS float*)(abp + (pi) * 1024 + 128); S##b3 = *(const LAS float*)(abp + (pi) * 1024 + 192); \
                S##vt = *(const LAS float*)(vp + (pi) * 512); S##vu = *(const LAS float*)(vp + (pi) * 512 + 256); S##cs = *(const LAS f32x4*)(csp + (pi) * 16); } while (0)
#define SCAN_STEP(S, pi) do { u32x4 xa, xc; \
                xa.x = cvt_pk_bf16(X0[0], X0[1]); xa.y = cvt_pk_bf16(X0[2], X0[3]); xa.z = cvt_pk_bf16(X1[0], X1[1]); xa.w = cvt_pk_bf16(X1[2], X1[3]); \
                xc.x = cvt_pk_bf16(X2[0], X2[1]); xc.y = cvt_pk_bf16(X2[2], X2[3]); xc.z = cvt_pk_bf16(X3[0], X3[1]); xc.w = cvt_pk_bf16(X3[2], X3[3]); \
                const f32x4 d0 = __builtin_amdgcn_mfma_f32_16x16x32_bf16(S##a0, __builtin_bit_cast(bf16x8, xa), zero4, 0, 0, 0); \
                const f32x4 d1 = __builtin_amdgcn_mfma_f32_16x16x32_bf16(S##a1, __builtin_bit_cast(bf16x8, xc), zero4, 0, 0, 0); \
                const f32x4 d = d0 + d1; const float sat = d[0]; \
                const float sau = d[2] + sat * S##cs[0] + S##vt * S##cs[1], yu = d[3] + sat * S##cs[2] + S##vt * S##cs[3]; \
                const float bsel = (rg == 0) ? sat : ((rg == 1) ? S##vt : ((rg == 2) ? sau : S##vu)); \
                X0 = __builtin_amdgcn_mfma_f32_16x16x4f32(S##b0, bsel, X0 * S##w0, 0, 0, 0); \
                X1 = __builtin_amdgcn_mfma_f32_16x16x4f32(S##b1, bsel, X1 * S##w1, 0, 0, 0); \
                X2 = __builtin_amdgcn_mfma_f32_16x16x4f32(S##b2, bsel, X2 * S##w2, 0, 0, 0); \
                X3 = __builtin_amdgcn_mfma_f32_16x16x4f32(S##b3, bsel, X3 * S##w3, 0, 0, 0); \
                *(LAS float*)(yp + (pi) * y_st) = (rg == 0) ? d[1] : yu; } while (0)
            bf16x8 Pa0, Pa1, Qa0, Qa1; f32x4 Pw0, Pw1, Pw2, Pw3, Qw0, Qw1, Qw2, Qw3, Pcs, Qcs; float Pb0, Pb1, Pb2, Pb3, Pvt, Pvu, Qb0, Qb1, Qb2, Qb3, Qvt, Qvu;
            SCAN_LD(P, 0);
#pragma unroll 1
            for (int pi = 0; pi < 16; pi += 2) {
                SCAN_LD(Q, pi + 1);
                SCAN_STEP(P, pi);
                if (pi + 2 < 16) SCAN_LD(P, pi + 2);
                SCAN_STEP(Q, pi + 1);
            }
#undef SCAN_LD
#undef SCAN_STEP
        } else {
            if (chunk + 1 < NCH) SCAN_ISSUE(chunk + 1);
            if (chunk > 0) SCAN_POST(chunk - 1);
            if (chunk + 1 < NCH) SCAN_STAGE(chunk + 1);
        }
        __syncthreads();
    }
    if (wave >= 4) SCAN_POST(NCH - 1);
    __syncthreads();
#undef SCAN_ISSUE
#undef CST4
#undef SCAN_STAGE
#undef SCAN_UNPACK
#undef SCAN_POST
}
__device__ __forceinline__ void conv_queue(const Params& p, LAS unsigned char* lds, const int wave, const int cw) {
    const int tid = phase_tid(wave);
    const int lane = tid & 63, wv = tid >> 6;
    LAS int* slot = (LAS int*)(lds + LDS_MISC);
    constexpr int N_GU = NE * 16 * 2, N_DN = NE * 16, N_ALL = N_GU + N_DN;
    for (;;) {
        __syncthreads();
        if (tid == 0) *slot = (int)atomicAdd(&p.ctl[cw], 1u);
        __syncthreads();
        const int it = *slot;
        if (it >= N_ALL) break;
        if (it < N_GU) { const int e = it >> 5, rem = it & 31, kb = rem >> 1, nh = rem & 1;
            const float* src = p.w_gu + (size_t)e * ND * (2 * DFF) + (size_t)(kb * 128) * (2 * DFF) + nh * 2048;
            fp8_t* dst = p.wt_gu + (size_t)e * (2 * DFF) * ND + (size_t)(nh * 2048) * ND + kb * 128;
            cvt_wave_T8x8(src + wv * 256, 2 * DFF, dst + (size_t)(wv * 256) * ND, ND, lane); }
        else { const int j = it - N_GU, e = j >> 4, kb = j & 15;
            const float* src = p.w_down + (size_t)e * DFF * ND + (size_t)(kb * 128) * ND;
            fp8_t* dst = p.wt_down + (size_t)e * ND * DFF + kb * 128;
            cvt_wave_T8x8(src + wv * 256, ND, dst + (size_t)(wv * 256) * DFF, DFF, lane); }
    }
}

__device__ __forceinline__ void phase8(const Params& p, LAS unsigned char* lds, const int wave) {
    const int tid = phase_tid(wave);
    const int bid = blockIdx.x, lane = tid & 63, wv = tid >> 6;
    constexpr int HP = ND + 4;
    LAS float* hs = (LAS float*)lds;
    LAS float* lg = hs + 16 * HP;
    LAS float* part = lg + 16 * 32;
    LAS float* topv = part + 4 * 16 * 32;
    LAS int* topi = (LAS int*)(topv + 64);
    const int b = (bid * 32) >> 11;
    const float* sh2 = p.mod + (size_t)b * NMOD + 3 * ND; const float* sc2 = p.mod + (size_t)b * NMOD + 4 * ND;
    for (int pass = 0; pass < 2; ++pass) {
        const int mb = bid * 32 + pass * 16;
        for (int rr = 0; rr < 2; ++rr) { const int r = wv * 2 + rr; const size_t m = (size_t)(mb + r);
            f32x4 z[8]; float s = 0.f;
#pragma unroll
            for (int j = 0; j < 4; ++j) { z[2 * j] = ld4nt(p.z1 + m * ND + j * 512 + lane * 8); z[2 * j + 1] = ld4nt(p.z1 + m * ND + j * 512 + lane * 8 + 4);
                s += ((z[2 * j][0] + z[2 * j][1]) + (z[2 * j][2] + z[2 * j][3])) + ((z[2 * j + 1][0] + z[2 * j + 1][1]) + (z[2 * j + 1][2] + z[2 * j + 1][3])); }
            const float mean = wave_allsum(s) * (1.0f / ND); float qv = 0.f;
#pragma unroll
            for (int j = 0; j < 8; ++j) { const f32x4 d = z[j] - mean; qv += dot4(d, d); }
            const float rstd = rsqrtf(wave_allsum(qv) * (1.0f / ND) + LN_EPS);
            if (lane == 0) *(f32x2*)(p.lnst + m * 2) = (f32x2){mean, rstd};
#pragma unroll
            for (int j = 0; j < 8; ++j) { const int k = (j >> 1) * 512 + lane * 8 + (j & 1) * 4;
                const f32x4 x1 = (z[j] - mean) * rstd * ld4(p.ln1_g + k) + ld4(p.ln1_b + k);
                const f32x4 h = x1 * (ld4(sc2 + k) + 1.0f) + ld4(sh2 + k);
                *(unsigned*)(p.h2 + m * ND + k) = pack4_fp8(h[0], h[1], h[2], h[3]);
                *(LAS f32x4*)(hs + r * HP + k) = h; } }
        __syncthreads();
        {
            const int kq = wv >> 1, ntl = wv & 1, ar = lane & 15, ak = lane >> 4;
            f32x4 acc = {0.f, 0.f, 0.f, 0.f};
            const LAS float* ap = hs + ar * HP + kq * 512 + ak; const float* bp = p.w_router + (size_t)(kq * 512 + ak) * NE + ntl * 16 + ar;
#pragma unroll 1
            for (int kb = 0; kb < 128; kb += 32) { float bq[32];
#pragma unroll
                for (int j = 0; j < 32; ++j) bq[j] = bp[(size_t)(kb + j) * 4 * NE];
#pragma unroll
                for (int j = 0; j < 32; ++j) acc = __builtin_amdgcn_mfma_f32_16x16x4f32(ap[(kb + j) * 4], bq[j], acc, 0, 0, 0); }
#pragma unroll
            for (int j = 0; j < 4; ++j) part[(kq * 16 + ak * 4 + j) * 32 + ntl * 16 + ar] = acc[j]; }
        __syncthreads();
        {   const int r = tid >> 5, e = tid & 31;
            lg[r * 32 + e] = p.b_router[e] + (part[(0 * 16 + r) * 32 + e] + part[(1 * 16 + r) * 32 + e]) + (part[(2 * 16 + r) * 32 + e] + part[(3 * 16 + r) * 32 + e]); }
        __syncthreads();
        {
            const int r = tid >> 5, e = tid & 31; const LAS float* l = lg + r * 32; const float mine = l[e]; int rank = 0;
#pragma unroll
            for (int q = 0; q < 8; ++q) { const f32x4 o = *(const LAS f32x4*)(l + q * 4);
#pragma unroll
                for (int j = 0; j < 4; ++j) rank += (o[j] > mine || (o[j] == mine && (q * 4 + j) < e)) ? 1 : 0; }
            if (rank < 4) { topv[r * 4 + rank] = mine; topi[r * 4 + rank] = e; } }
        __syncthreads();
        if (tid < 64) { const int r = tid >> 2, k = tid & 3, m = mb + r; const f32x4 tv = *(const LAS f32x4*)(topv + r * 4); const int ei = topi[r * 4 + k];
            const float e0 = 1.0f, e1 = expf(tv[1] - tv[0]), e2 = expf(tv[2] - tv[0]), e3 = expf(tv[3] - tv[0]); const float sum = (e0 + e1) + (e2 + e3);
            const float mineexp = k == 0 ? e0 : (k == 1 ? e1 : (k == 2 ? e2 : e3));
            const unsigned rk = atomicAdd(&p.ctl[CW_CNT + 64 * ei], 1u);
            p.sel[m * 4 + k] = ei; p.rnk[m * 4 + k] = (int)rk; p.prob[m * 4 + k] = mineexp / sum; }
        __syncthreads();
    }
}

__device__ __forceinline__ void phase9(const Params& p, LAS unsigned char* lds, const int wave) {
    const int tid = phase_tid(wave);
    const int bid = blockIdx.x, lane = tid & 63, wv = tid >> 6;
    LAS int* seg = (LAS int*)lds;
    if (tid == 0) { int s = 0;
        for (int e = 0; e < NE; ++e) { seg[e] = s; const int c = (int)xb_ld(&p.ctl[CW_CNT + 64 * e]); s += (c + 255) & ~255; }
        seg[NE] = s;
        if (bid == 0) { int t = 0;
            for (int e = 0; e < NE; ++e) { const int nt = (seg[e + 1] - seg[e]) >> 8; for (int i = 0; i < nt; ++i) p.ctl[CW_TILEE + t + i] = (unsigned)e; t += nt; }
            p.ctl[CW_NTILES] = (unsigned)t; } }
    __syncthreads();
    {
        const int gw = bid * NWAVES + wv; i32x4 e4[4], r4[4]; u32x4 v0[4], v1[4];
#pragma unroll
        for (int i = 0; i < 4; ++i) { const int m = gw + i * 2048; e4[i] = *(const i32x4*)(p.sel + m * 4); r4[i] = *(const i32x4*)(p.rnk + m * 4);
            const u32x4* src = (const u32x4*)(p.h2 + (size_t)m * ND); v0[i] = src[lane]; v1[i] = src[64 + lane]; }
#pragma unroll
        for (int i = 0; i < 4; ++i) { const int m = gw + i * 2048; i32x4 dd;
#pragma unroll
            for (int k = 0; k < 4; ++k) { dd[k] = seg[e4[i][k]] + r4[i][k]; u32x4* q = (u32x4*)(p.xb + (size_t)dd[k] * ND); q[lane] = v0[i]; q[64 + lane] = v1[i]; }
            if (lane == 0) *(i32x4*)(p.dest + m * 4) = dd; } }
    __syncthreads();
}

__device__ __forceinline__ void phase13(const Params& p, const int wave) {
    const int tid = phase_tid(wave);
    const int bid = blockIdx.x, lane0 = tid & 63, wv = wave;
    const int GW = gridDim.x * NWAVES;
    for (int m = bid * NWAVES + wv; m < NM; m += GW) { const int b = m >> 11;
        int lane = lane0; asm volatile("" : "+v"(lane));
        const float* g2 = p.mod + (size_t)b * NMOD + 5 * ND;
        int d[4]; float pr[4]; const f32x2 st = *(const f32x2*)(p.lnst + (size_t)m * 2);
#pragma unroll
        for (int k = 0; k < 4; ++k) { d[k] = p.dest[m * 4 + k]; pr[k] = p.prob[m * 4 + k]; }
        f32x4 z[8]; float s = 0.f; u32x4 yq[4][4];
#pragma unroll
        for (int j = 0; j < 4; ++j) {
#pragma unroll
            for (int k = 0; k < 4; ++k) yq[j][k] = ldu4nt(p.yb + (size_t)d[k] * ND + j * 512 + lane * 8);
            z[2 * j] = ld4nt(p.z1 + (size_t)m * ND + j * 512 + lane * 8); z[2 * j + 1] = ld4nt(p.z1 + (size_t)m * ND + j * 512 + lane * 8 + 4); }
#pragma unroll
        for (int j = 0; j < 4; ++j) { const int c = j * 512 + lane * 8; f32x4 f0 = {0.f, 0.f, 0.f, 0.f}, f1 = f0;
#pragma unroll
            for (int k = 0; k < 4; ++k) { f0 += bf4_unpack((u32x2){yq[j][k].x, yq[j][k].y}) * pr[k]; f1 += bf4_unpack((u32x2){yq[j][k].z, yq[j][k].w}) * pr[k]; }
            const f32x4 xa = (z[2 * j] - st[0]) * st[1] * ld4(p.ln1_g + c) + ld4(p.ln1_b + c), xb2 = (z[2 * j + 1] - st[0]) * st[1] * ld4(p.ln1_g + c + 4) + ld4(p.ln1_b + c + 4);
            z[2 * j] = xa * DN_ALPHA + ld4(g2 + c) * f0; z[2 * j + 1] = xb2 * DN_ALPHA + ld4(g2 + c + 4) * f1;
            s += ((z[2 * j][0] + z[2 * j][1]) + (z[2 * j][2] + z[2 * j][3])) + ((z[2 * j + 1][0] + z[2 * j + 1][1]) + (z[2 * j + 1][2] + z[2 * j + 1][3])); }
        const float mean = wave_allsum(s) * (1.0f / ND); float qv = 0.f;
#pragma unroll
        for (int j = 0; j < 8; ++j) { const f32x4 dd = z[j] - mean; qv += dot4(dd, dd); }
        const float rstd = rsqrtf(wave_allsum(qv) * (1.0f / ND) + LN_EPS);
#pragma unroll
        for (int j = 0; j < 8; ++j) { const int c = (j >> 1) * 512 + lane * 8 + (j & 1) * 4;
            *(f32x4*)(p.out + (size_t)m * ND + c) = (z[j] - mean) * rstd * ld4(p.ln2_g + c) + ld4(p.ln2_b + c); } }
}

__global__ void __launch_bounds__(NTHREADS, 2) fwd(Params p) {
    extern __shared__ __attribute__((aligned(16))) unsigned char shm[];
    LAS unsigned char* lds = (LAS unsigned char*)shm;
    const int bid = blockIdx.x, G = gridDim.x;
    const int wave = __builtin_amdgcn_readfirstlane(threadIdx.x >> 6);
    if (threadIdx.x == 0) *(LAS u32x4*)(lds + LDS_BARW) = (u32x4){0u, 0u, 0u, 0u};
    __syncthreads();
    XcdBarrier bar = xcd_barrier_post(p.bar, (volatile LAS unsigned*)(lds + LDS_BARW));

    phase0(p, lds, wave);
    xcd_barrier(bar, wave);
    if (PROBE == 3) { phase0(p, lds, wave); xcd_barrier(bar, wave); }
    phase1(p, lds, wave);
    xcd_barrier(bar, wave);
    if (PROBE == 3) { phase1(p, lds, wave); xcd_barrier(bar, wave); }
    {
        pg8::Gemm g{p.hb, p.wt_in, ND, ND, ND}; pg8::DenseOrder S; S.init(NM / 256, NINP / 256 - 2, G, bid, (size_t)256 * ND * 2, (size_t)256 * ND * 2); S.skip_from = 23; S.skip_n = 2;
        EpiP E{p.P}; pg8::gemm_phase(lds, g, S, E, wave);
        if (PROBE == 1) { __syncthreads(); pg8::gemm_phase(lds, g, S, E, wave); } }
    xcd_barrier(bar, wave);
    phase3(p, lds, wave);
    xcd_barrier(bar, wave);
    if (PROBE == 3) { phase3(p, lds, wave); xcd_barrier(bar, wave); }
    {
        pg8::Gemm g{p.hb, p.wt_in, ND, ND, ND}; WinRestOrder S{bid, (size_t)256 * ND * 2, (size_t)256 * ND * 2};
        EpiP E{p.P}; pg8::gemm_phase(lds, g, S, E, wave); }
    __syncthreads();
    {
        pg8::Gemm g{p.a_lora, p.bt_lora, LORA_K, LORA_K, LORA_K}; pg8::DenseOrder S; S.init(NM / 256, LORA_N / 256, G - 64, bid - 64, (size_t)256 * LORA_K * 2, (size_t)256 * LORA_K * 2);
        EpiLora E{p.dec, p.iclr, p.gg, p.w0, p.a0}; pg8::gemm_phase(lds, g, S, E, wave);
        if (PROBE == 1) { __syncthreads(); pg8::gemm_phase(lds, g, S, E, wave); } }
    __syncthreads();
    {
        pg8::Gemm g{p.dp, p.wt_pool, NC, 256, 256}; PoolOrder S{1 << 20, bid >= 64 ? bid - 64 : 192 + bid};
        EpiPool E{p.t1, p.P, p.pool_scale}; pg8::gemm_phase(lds, g, S, E, wave);
        if (PROBE == 1) { __syncthreads(); pg8::gemm_phase(lds, g, S, E, wave); } }
    xcd_barrier(bar, wave);
    if (bid < NB * NH) { scan_head(p, lds, bid, wave); if (PROBE == 4) scan_head(p, lds, bid, wave); }
    conv_queue(p, lds, wave, CW_CONV);
    if (PROBE == 5) conv_queue(p, lds, wave, CW_CONV2);
    xcd_barrier(bar, wave);
    if (PROBE == 2) { if (bid < NB * NH) scan_head(p, lds, bid, wave); conv_queue(p, lds, wave, CW_CONV2); xcd_barrier(bar, wave); }
    {
        pg8::Gemm g{p.yr, p.wt_rwkv, NC, NC, NC}; pg8::DenseOrder S; S.init(NM / 256, ND / 256, G, bid, (size_t)256 * NC * 2, (size_t)256 * NC * 2);
        EpiRwkv E{p.mx, p.P, p.t1}; pg8::gemm_phase(lds, g, S, E, wave);
        if (PROBE == 1) { __syncthreads(); pg8::gemm_phase(lds, g, S, E, wave); } }
    xcd_barrier(bar, wave);
    {
        pg8::Gemm g{p.mx, p.wt_out, ND, ND, ND}; pg8::DenseOrder S; S.init(NM / 256, ND / 256, G, bid, (size_t)256 * ND * 2, (size_t)256 * ND * 2);
        EpiWout E{p.z1, p.x, p.mod}; pg8::gemm_phase(lds, g, S, E, wave);
        if (PROBE == 1) { __syncthreads(); pg8::gemm_phase(lds, g, S, E, wave); } }
    xcd_barrier(bar, wave);
    phase8(p, lds, wave);
    xcd_barrier(bar, wave);
    phase9(p, lds, wave);
    xcd_barrier(bar, wave);
    if (PROBE == 3) { phase9(p, lds, wave); xcd_barrier(bar, wave); }
    const int ntiles = (int)xb_ld(&p.ctl[CW_NTILES]);
    {   const int t_ = phase_tid(wave); if (t_ < MAXTILES) *(LAS unsigned*)(lds + LDS_MISC + 4 * t_) = p.ctl[CW_TILEE + t_]; }
    __syncthreads();
    {
        pg8::Gemm g{(const bf16_t*)p.xb, (const bf16_t*)p.wt_gu, ND / 2, ND / 2, ND / 2};
        MoeOrder S{G, bid, 2 * DFF / 256, ntiles, (const LAS unsigned*)(lds + LDS_MISC), (size_t)256 * ND, (size_t)(2 * DFF) * ND, (size_t)256 * ND};
        EpiGU E{p.act, p.b_gu}; pg8::gemm_phase<EpiGU, MoeOrder, true>(lds, g, S, E, wave);
        if (PROBE == 1) { __syncthreads(); pg8::gemm_phase<EpiGU, MoeOrder, true>(lds, g, S, E, wave); } }
    xcd_barrier(bar, wave);
    {
        pg8::Gemm g{(const bf16_t*)p.act, (const bf16_t*)p.wt_down, DFF / 2, DFF / 2, DFF / 2};
        MoeOrder S{G, bid, ND / 256, ntiles, (const LAS unsigned*)(lds + LDS_MISC), (size_t)256 * DFF, (size_t)ND * DFF, (size_t)256 * DFF};
        EpiDown E{p.yb, p.b_down}; pg8::gemm_phase<EpiDown, MoeOrder, true>(lds, g, S, E, wave);
        if (PROBE == 1) { __syncthreads(); pg8::gemm_phase<EpiDown, MoeOrder, true>(lds, g, S, E, wave); } }
    xcd_barrier(bar, wave);
    phase13(p, wave);
    if (PROBE == 3) { xcd_barrier(bar, wave); phase13(p, wave); }
}

static inline size_t align_up(size_t v, size_t a) { return (v + a - 1) / a * a; }

extern "C" void kernel_launch(void* const* d_in, const int* in_sizes, int n_in, void* d_out, int out_size, void* d_ws, size_t ws_size, hipStream_t stream) {
    (void)in_sizes; (void)n_in; (void)out_size;
    Params p{};
    const float** ins = (const float**)&p;
    for (int i = 0; i < 30; ++i) ins[i] = (const float*)d_in[i];
    p.out = (float*)d_out;
    char* ws = (char*)d_ws; size_t off = 0;
    auto take = [&](size_t bytes) { char* r = ws + off; off = align_up(off + bytes, 4096); return r; };
    const size_t ctl_bytes = (size_t)(XCD_BAR_WORDS + CTL_WORDS) * 4;
    p.bar = (unsigned*)take(ctl_bytes); p.ctl = p.bar + XCD_BAR_WORDS;
    p.modp = (float*)take((size_t)KS_MOD * 4 * NMOD * 4); p.mod = (float*)take((size_t)NB * NMOD * 4);
    p.hb = (bf16_t*)take((size_t)NM * ND * 2);
    p.wt_in = (bf16_t*)take((size_t)NINP * ND * 2); p.wt_rwkv = (bf16_t*)take((size_t)ND * NC * 2); p.wt_pool = (bf16_t*)take((size_t)ND * 256 * 2);
    p.wt_out = (bf16_t*)take((size_t)ND * ND * 2); p.bt_lora = (bf16_t*)take((size_t)LORA_N * LORA_K * 2);
    p.wt_gu = (fp8_t*)take((size_t)NE * 2 * DFF * ND); p.wt_down = (fp8_t*)take((size_t)NE * ND * DFF);
    p.P = (bf16_t*)take((size_t)NM * NINP * 2); p.a_lora = (bf16_t*)take((size_t)NM * LORA_K * 2); p.dp = (bf16_t*)take((size_t)NM * NC * 2);
    p.dec = (float*)take((size_t)NM * NC * 4); p.iclr = (bf16_t*)take((size_t)NM * NC * 2); p.gg = (bf16_t*)take((size_t)NM * NC * 2); p.t1 = (bf16_t*)take((size_t)NM * ND * 2);
    p.yr = (bf16_t*)take((size_t)NM * NC * 2); p.mx = (bf16_t*)take((size_t)NM * ND * 2); p.z1 = (float*)take((size_t)NM * ND * 4); p.lnst = (float*)take((size_t)NM * 2 * 4);
    p.h2 = (fp8_t*)take((size_t)NM * ND);
    p.sel = (int*)take((size_t)NM * TOPK * 4); p.rnk = (int*)take((size_t)NM * TOPK * 4); p.prob = (float*)take((size_t)NM * TOPK * 4); p.dest = (int*)take((size_t)NM * TOPK * 4);
    p.xb = (fp8_t*)take((size_t)MP * ND); p.act = (fp8_t*)take((size_t)MP * DFF); p.yb = (bf16_t*)take((size_t)MP * ND * 2);
    if (off > ws_size) { fprintf(stderr, "kernel_launch: workspace too small (%zu > %zu)\n", off, ws_size); return; }

    static int grid = 0;
    if (!grid) {
        int dev = 0, cus = 0, per_cu = 0;
        hipGetDevice(&dev); hipDeviceGetAttribute(&cus, hipDeviceAttributeMultiprocessorCount, dev);
        hipFuncSetAttribute((const void*)fwd, hipFuncAttributeMaxDynamicSharedMemorySize, LDS_BYTES);
        hipOccupancyMaxActiveBlocksPerMultiprocessor(&per_cu, (const void*)fwd, NTHREADS, LDS_BYTES);
        if (per_cu < 1) fprintf(stderr, "kernel_launch: occupancy query reports %d workgroups per CU\n", per_cu);
        if (cus != 256) fprintf(stderr, "kernel_launch: %d CUs; this kernel is laid out for 256\n", cus);
        grid = 256;
    }
    hipMemsetAsync(p.bar, 0, ctl_bytes, stream);
    hipLaunchKernelGGL(fwd, dim3(grid), dim3(NTHREADS), LDS_BYTES, stream, p);
}
```

```cpp
#include <hip/hip_runtime.h>
#include <cstdio>
#include <cstdint>

#ifndef PROBE
#define PROBE 0
#endif
#define LAS __attribute__((address_space(3)))
typedef unsigned short bf16_t;
typedef short bf16x8 __attribute__((ext_vector_type(8)));
typedef float f32x4 __attribute__((ext_vector_type(4)));
typedef float f32x2 __attribute__((ext_vector_type(2)));
typedef unsigned u32x4 __attribute__((ext_vector_type(4)));
typedef unsigned u32x2 __attribute__((ext_vector_type(2)));
typedef int i32x4 __attribute__((ext_vector_type(4)));
typedef int i32x8 __attribute__((ext_vector_type(8)));
typedef unsigned char fp8_t;
constexpr float W8_SCALE = 64.0f, W8_INV = 1.0f / 64.0f;

constexpr int NB = 4, NT = 2048, NM = NB * NT, ND = 2048, NC = 1024, NH = 16, HS = 64;
constexpr int NSHIFT = 3360, NIN = 8480, NINP = 8704;
constexpr int OFF_R = 0, OFF_K = 1024, OFF_V = 2048, OFF_WD = 3072, OFF_AD = 3136, OFF_GD = 3200, OFF_POOL = 3360, OFF_GA = 4384, OFF_GB = 6432;
constexpr int NE = 32, TOPK = 4, DFF = 2048;
constexpr int LORA_K = 384, LORA_N = 3072;
constexpr int MAXTILES = 160, MP = MAXTILES * 256;
constexpr int NMOD = 6 * ND;
constexpr int KS_MOD = 32;
constexpr float LN_EPS = 1e-5f, GN_EPS = 64e-5f;
constexpr float DN_ALPHA = 1.189207115002721f;
constexpr float SW_LIMIT = 7.0f, SW_ALPHA = 1.702f;
constexpr int NWAVES = 8, NTHREADS = 512;
constexpr int LDS_BYTES = 147456;
constexpr int LDS_BARW = LDS_BYTES - 16;
constexpr int LDS_MISC = 131072;

constexpr int CW_CNT = 0;
constexpr int CW_CONV = 64 * 32;
constexpr int CW_CONV2 = 64 * 32 + 32;
constexpr int CW_CONV3 = 64 * 32 + 48;
constexpr int N_DEFER = 96;
constexpr int CW_NTILES = 64 * 33;
constexpr int CW_TILEE = 64 * 34;
constexpr int CTL_WORDS = 64 * 34 + 256;

#define XB_TMO      128
#define XB_XCNT(j)  (256  + 64 * (j))
#define XB_XSUB(j)  (1280 + 64 * (j))
#define XB_XGEN(j)  (2304 + 64 * (j))
#define XB_TOP      3328
#define XB_TOPGEN   3392
#define XCD_BAR_WORDS 3456
#define XB_SPIN_CAP (1u << 18)

__device__ __forceinline__ unsigned xb_ld(unsigned* p)              { return __hip_atomic_load(p, __ATOMIC_RELAXED, __HIP_MEMORY_SCOPE_AGENT); }
__device__ __forceinline__ unsigned xb_add(unsigned* p, unsigned v) { return __hip_atomic_fetch_add(p, v, __ATOMIC_RELAXED, __HIP_MEMORY_SCOPE_AGENT); }
__device__ __forceinline__ unsigned xb_xcc_id() { return (unsigned)__builtin_amdgcn_s_getreg((3 << 11) | 20) & 0xFu; }
#define XB_SPIN(cond, bar) do { unsigned _sp = 0; while (cond) { __builtin_amdgcn_s_sleep(1); \
    if ((++_sp & 255u) == 0u) { if (xb_ld(&(bar)[XB_TMO])) break; if (_sp > XB_SPIN_CAP) { atomicAdd(&(bar)[XB_TMO], 1u); break; } } } } while (0)

__device__ __forceinline__ int phase_tid(int wave);
struct XcdBarrier { unsigned* bar; unsigned x; volatile LAS unsigned* st; };

__device__ __forceinline__ XcdBarrier xcd_barrier_post(unsigned* bar, volatile LAS unsigned* st) {
    XcdBarrier b; b.bar = bar; b.x = xb_xcc_id(); b.st = st;
    if (threadIdx.x == 0) (void)xb_add(&bar[XB_XCNT(b.x)], 1u);
    return b;
}
__device__ __forceinline__ void xcd_barrier_complete(unsigned* bar, unsigned x, unsigned& nloc, unsigned& nx) {
    const unsigned G = gridDim.x * gridDim.y * gridDim.z;
    unsigned sum, cnt, mine, sp = 0u;
    for (;;) {
        sum = 0u; cnt = 0u; mine = 0u;
#pragma unroll
        for (unsigned j = 0; j < 16; ++j) { const unsigned c = xb_ld(&bar[XB_XCNT(j)]); sum += c; cnt += (c > 0u) ? 1u : 0u; mine = (j == x) ? c : mine; }
        if (sum == G) break;
        __builtin_amdgcn_s_sleep(1);
        if ((++sp & 255u) == 0u) { if (xb_ld(&bar[XB_TMO])) break; if (sp > XB_SPIN_CAP) { atomicAdd(&bar[XB_TMO], 1u); break; } }
    }
    nloc = mine > 0u ? mine : 1u; nx = cnt > 0u ? cnt : 1u;
}
__device__ __forceinline__ void xcd_barrier(const XcdBarrier& b, const int wave) {
    asm volatile("s_waitcnt vmcnt(0)" ::: "memory");
    __syncthreads();
    if (phase_tid(wave) == 0) {
        unsigned* bar = b.bar;
        __builtin_amdgcn_s_waitcnt(0);
        unsigned nloc = b.st[0], nx = b.st[1];
        if (nloc == 0u) { xcd_barrier_complete(bar, b.x, nloc, nx); b.st[0] = nloc; b.st[1] = nx; }
        const unsigned old = xb_add(&bar[XB_XSUB(b.x)], 1u);
        const unsigned gen = old / nloc;
        if (old + 1u == (gen + 1u) * nloc) {
            __builtin_amdgcn_fence(__ATOMIC_RELEASE, "agent");
            asm volatile("s_waitcnt vmcnt(0)" ::: "memory");
            const unsigned og = xb_add(&bar[XB_TOP], 1u);
            const unsigned tg = og / nx;
            if (og + 1u == (tg + 1u) * nx) xb_add(&bar[XB_TOPGEN], 1u);
            else XB_SPIN(xb_ld(&bar[XB_TOPGEN]) == tg, bar);
            __builtin_amdgcn_fence(__ATOMIC_ACQUIRE, "agent");
            xb_add(&bar[XB_XGEN(b.x)], 1u);
            asm volatile("s_waitcnt vmcnt(0)" ::: "memory");
        } else {
            XB_SPIN(xb_ld(&bar[XB_XGEN(b.x)]) == gen, bar);
            __builtin_amdgcn_fence(__ATOMIC_ACQUIRE, "agent");
            asm volatile("s_waitcnt vmcnt(0)" ::: "memory");
        }
    }
    __syncthreads();
}

__device__ __forceinline__ int phase_tid(int wave) {
    int lane; asm volatile("v_mbcnt_lo_u32_b32 %0, -1, 0\n\tv_mbcnt_hi_u32_b32 %0, -1, %0" : "=v"(lane));
    return wave * 64 + lane;
}
typedef __bf16 bf16x2_t __attribute__((ext_vector_type(2)));
__device__ __forceinline__ unsigned cvt_pk_bf16(float lo, float hi) { return __builtin_bit_cast(unsigned, __builtin_convertvector((f32x2){lo, hi}, bf16x2_t)); }
template <int CTRL> __device__ __forceinline__ float dpp_f(float x) {
    return __builtin_bit_cast(float, __builtin_amdgcn_update_dpp(0, __builtin_bit_cast(int, x), CTRL, 0xf, 0xf, false));
}
__device__ __forceinline__ float row16_allsum(float x) {
    x += dpp_f<0x128>(x); x += dpp_f<0x124>(x); x += dpp_f<0x122>(x); x += dpp_f<0x121>(x); return x;
}
__device__ __forceinline__ float wave_allsum(float x) {
    x = row16_allsum(x);
    const int xi = __builtin_bit_cast(int, x);
    return (__builtin_bit_cast(float, __builtin_amdgcn_readlane(xi, 0)) + __builtin_bit_cast(float, __builtin_amdgcn_readlane(xi, 16))) +
           (__builtin_bit_cast(float, __builtin_amdgcn_readlane(xi, 32)) + __builtin_bit_cast(float, __builtin_amdgcn_readlane(xi, 48)));
}
__device__ __forceinline__ unsigned pack4_fp8(float a, float b, float c, float d) { int r = 0; r = __builtin_amdgcn_cvt_pk_fp8_f32(a, b, r, false); r = __builtin_amdgcn_cvt_pk_fp8_f32(c, d, r, true); return (unsigned)r; }
__device__ __forceinline__ f32x2 bf2_unpack(unsigned u) { return (f32x2){__uint_as_float(u << 16), __uint_as_float(u & 0xffff0000u)}; }
__device__ __forceinline__ f32x4 bf4_unpack(u32x2 u) { const f32x2 a = bf2_unpack(u.x), b = bf2_unpack(u.y); return (f32x4){a[0], a[1], b[0], b[1]}; }
__device__ __forceinline__ float bf1(bf16_t h) { return __uint_as_float(((unsigned)h) << 16); }
__device__ __forceinline__ float sigmoidf_(float v) { return __builtin_amdgcn_rcpf(1.0f + __builtin_amdgcn_exp2f(v * -1.4426950408889634f)); }
__device__ __forceinline__ f32x4 ld4(const float* p) { return *(const f32x4*)p; }
__device__ __forceinline__ f32x4 ld4nt(const float* p) { return __builtin_nontemporal_load((const f32x4*)p); }
__device__ __forceinline__ u32x4 ldu4nt(const void* p) { return __builtin_nontemporal_load((const u32x4*)p); }
__device__ __forceinline__ float dot4(f32x4 a, f32x4 b) { return (a[0] * b[0] + a[1] * b[1]) + (a[2] * b[2] + a[3] * b[3]); }

struct Params {
    const float *x, *c, *w_ada, *b_ada, *w_in, *mu_shift, *w0, *w_decay_up, *a0, *w_iclr_up, *w_glora_up, *k_k, *k_a, *r_k, *lnx_g, *lnx_b,
                *w_rwkv_out, *w_pool, *pool_scale, *w_out, *ln1_g, *ln1_b, *w_router, *b_router, *w_gu, *b_gu, *w_down, *b_down, *ln2_g, *ln2_b;
    float* out;
    unsigned* bar; unsigned* ctl;
    float* modp; float* mod;
    bf16_t* hb; bf16_t* wt_in; bf16_t* wt_rwkv; bf16_t* wt_pool; bf16_t* wt_out; bf16_t* bt_lora; fp8_t* wt_gu; fp8_t* wt_down;
    bf16_t* P; bf16_t* a_lora; bf16_t* dp; float* dec; bf16_t* iclr; bf16_t* gg; bf16_t* t1;
    bf16_t* yr; bf16_t* mx; float* z1; float* lnst; fp8_t* h2;
    int* sel; int* rnk; float* prob; int* dest;
    fp8_t* xb; fp8_t* act; bf16_t* yb;
};

namespace pg8 {
constexpr int BM = 256, BK = 64, HALF = 128, HTB = HALF * BK * 2, STAGE_BYTES = 8 * HTB, NXCD = 8, WGM = 8;
__host__ __device__ __forceinline__ int lds_byte(int r, int c) { const int st = (r >> 4) * 2 + (c >> 5), rr = r & 15, cc = c & 31, ob = rr * 64 + cc * 2; return st * 1024 + (ob ^ (((ob >> 9) & 1) << 5)); }
__host__ __device__ __forceinline__ void stage_rc(int b, int& R, int& C) { const int st = b / 1024, sb = b % 1024, swz = sb ^ (((sb >> 9) & 1) << 5); R = (st >> 1) * 16 + swz / 64; C = (st & 1) * 32 + (swz % 64) / 2; }
__host__ __device__ __forceinline__ int perm32(int rho) { const int n = rho >> 4, i = rho & 15; return 8 * (i >> 2) + 4 * n + (i & 3); }

struct Unit { int pm, pn, e; unsigned aoff, boff; };
struct Gemm { const bf16_t* A; const bf16_t* Bt; int lda, ldb, K; };

struct DenseOrder {
    int nM, nN, nwg, G, c, skip_from = 1 << 30, skip_n = 0; size_t a_tile, b_tile;
    __device__ void init(int nM_, int nN_, int G_, int c_, size_t a_tile_, size_t b_tile_) { nM = nM_; nN = nN_; nwg = nM * nN; G = G_; c = c_; a_tile = a_tile_; b_tile = b_tile_; }
    __device__ bool next(int i, Unit& u) const {
        const long L = (long)i * G + c; if (c < 0 || L >= nwg) return false;
        int wgid = (int)L; { const int q = nwg / NXCD, r = nwg % NXCD, xcd = wgid % NXCD, off = wgid / NXCD; wgid = (xcd < r ? xcd * (q + 1) : r * (q + 1) + (xcd - r) * q) + off; }
        const int nig = WGM * nN, gid = wgid / nig, fm = gid * WGM, gsz = (nM - fm) < WGM ? (nM - fm) : WGM;
        u.pm = fm + ((wgid % nig) % gsz); u.pn = (wgid % nig) / gsz; u.e = 0; if (u.pn >= skip_from) u.pn += skip_n;
        u.aoff = (unsigned)((size_t)u.pm * a_tile); u.boff = (unsigned)((size_t)u.pn * b_tile); return true;
    }
};

template <class Epi, class Sched, bool FP8 = false>
__device__ __forceinline__ void gemm_phase(LAS unsigned char* lds, const Gemm g, const Sched& S, const Epi& E, const int wave) {
    const int tid = phase_tid(wave);
    const int wid = __builtin_amdgcn_readfirstlane(tid >> 6), lane = tid & 63, wr = wid >> 2, wc = wid & 3, fr = lane & 15, fq = lane >> 4;
    const int K = g.K, nt = K / BK;
    unsigned voffA[2], voffB[2];
#pragma unroll
    for (int i = 0; i < 2; ++i) { int R, C; stage_rc(tid * 16 + i * 8192, R, C); const int Rb = Epi::PERM ? ((R & ~31) + perm32(R & 31)) : R;
        voffA[i] = (unsigned)(R * g.lda + C) * 2u; voffB[i] = (unsigned)(Rb * g.ldb + C) * 2u; }
    const unsigned kstep = (unsigned)(BK * 2);
    const unsigned hstepA = (unsigned)HALF * g.lda * 2u, hstepB = (unsigned)HALF * g.ldb * 2u;
    const __amdgpu_buffer_rsrc_t rsA = __builtin_amdgcn_make_buffer_rsrc((void*)g.A, (short)0, -1, 0x00020000), rsB = __builtin_amdgcn_make_buffer_rsrc((void*)g.Bt, (short)0, -1, 0x00020000);
    const unsigned ldsw = (unsigned)wid * 1024u;
    const int aoff = lds_byte(wr * 64 + fr, fq * 8), boff = lds_byte(wc * 32 + fr, fq * 8);
#define PG8_SA(b, h) (((b) * 2 + (h)) * HTB)
#define PG8_SB(b, h) ((4 + (b) * 2 + (h)) * HTB)
#define PG8_STAGE(bufoff, rs, soff, voff) do { _Pragma("unroll") for (int _i = 0; _i < 2; ++_i) \
        __builtin_amdgcn_raw_ptr_buffer_load_lds(rs, (LAS void*)(lds + (bufoff) + ldsw + _i * 8192), 16, (voff)[_i], (soff), 0, 0); } while (0)
#define PG8_LDA(dst, b, h) do { _Pragma("unroll") for (int m = 0; m < 4; ++m) _Pragma("unroll") for (int k = 0; k < 2; ++k) dst[m][k] = *(const LAS bf16x8*)(lds + PG8_SA(b, h) + aoff + m * 2048 + k * 1024); } while (0)
#define PG8_LDB(dst, b, h) do { _Pragma("unroll") for (int n = 0; n < 2; ++n) _Pragma("unroll") for (int k = 0; k < 2; ++k) dst[n][k] = *(const LAS bf16x8*)(lds + PG8_SB(b, h) + boff + n * 2048 + k * 1024); } while (0)
#define PG8_CAT(x) __builtin_shufflevector(__builtin_bit_cast(i32x4, (x)[0]), __builtin_bit_cast(i32x4, (x)[1]), 0, 1, 2, 3, 4, 5, 6, 7)
#define PG8_MMA(ai, bj, At, Bt) do { __builtin_amdgcn_s_setprio(1); \
        if constexpr (FP8) { _Pragma("unroll") for (int m = 0; m < 4; ++m) _Pragma("unroll") for (int n = 0; n < 2; ++n) \
            acc[ai][bj][m][n] = __builtin_amdgcn_mfma_scale_f32_16x16x128_f8f6f4(PG8_CAT(Bt[n]), PG8_CAT(At[m]), acc[ai][bj][m][n], 0, 0, 0, 0x7F7F7F7F, 0, 0x7F7F7F7F); } \
        else { _Pragma("unroll") for (int m = 0; m < 4; ++m) _Pragma("unroll") for (int n = 0; n < 2; ++n) _Pragma("unroll") for (int k = 0; k < 2; ++k) \
            acc[ai][bj][m][n] = __builtin_amdgcn_mfma_f32_16x16x32_bf16(Bt[n][k], At[m][k], acc[ai][bj][m][n], 0, 0, 0); } \
        __builtin_amdgcn_s_setprio(0); } while (0)
#define PG8_WAIT_V(n) asm volatile("s_waitcnt vmcnt(" #n ")" ::: "memory")
#define PG8_WAIT_L(n) asm volatile("s_waitcnt lgkmcnt(" #n ")" ::: "memory")
#define PG8_BAR __builtin_amdgcn_s_barrier()
#define PG8_SCHED __builtin_amdgcn_sched_barrier(0)
    Unit cur, nxt; int ui = 0;
    if (!S.next(0, cur)) return;
    f32x4 acc[2][2][4][2];
#pragma unroll
    for (int a = 0; a < 2; ++a)
#pragma unroll
        for (int b = 0; b < 2; ++b)
#pragma unroll
            for (int m = 0; m < 4; ++m)
#pragma unroll
                for (int n = 0; n < 2; ++n) acc[a][b][m][n] = (f32x4){0.f, 0.f, 0.f, 0.f};
    bf16x8 At[4][2], B0[2][2], B1[2][2];
    unsigned cA = cur.aoff, cB = cur.boff;
    PG8_STAGE(PG8_SB(0, 0), rsB, cB, voffB); PG8_STAGE(PG8_SA(0, 0), rsA, cA, voffA); PG8_STAGE(PG8_SB(0, 1), rsB, cB + hstepB, voffB); PG8_STAGE(PG8_SA(0, 1), rsA, cA + hstepA, voffA);
    if (wr == 1) PG8_BAR;
    PG8_WAIT_V(4); PG8_BAR;
    PG8_STAGE(PG8_SB(1, 0), rsB, cB + kstep, voffB); PG8_STAGE(PG8_SA(1, 0), rsA, cA + kstep, voffA); PG8_STAGE(PG8_SB(1, 1), rsB, cB + hstepB + kstep, voffB);
    PG8_WAIT_V(6); PG8_BAR;
    for (;;) {
        const bool has_next = S.next(ui + 1, nxt);
        const unsigned nA = has_next ? nxt.aoff : cA, nB = has_next ? nxt.boff : cB;
        for (int t = 0; t < nt; t += 2) {
            const bool last = (t == nt - 2);
            const unsigned a1 = cA + (unsigned)(t + 1) * kstep;
            const unsigned a2 = last ? nA : cA + (unsigned)(t + 2) * kstep, b2 = last ? nB : cB + (unsigned)(t + 2) * kstep;
            const unsigned a3 = a2 + kstep, b3 = b2 + kstep;
            PG8_LDB(B0, 0, 0); PG8_SCHED; PG8_LDA(At, 0, 0); PG8_STAGE(PG8_SA(1, 1), rsA, a1 + hstepA, voffA);
            PG8_WAIT_L(8); PG8_BAR; PG8_WAIT_L(0); PG8_MMA(0, 0, At, B0); PG8_BAR; PG8_SCHED;
            PG8_LDB(B1, 0, 1); PG8_STAGE(PG8_SB(0, 0), rsB, b2, voffB);
            PG8_BAR; PG8_WAIT_L(0); PG8_MMA(0, 1, At, B1); PG8_BAR;
            PG8_LDA(At, 0, 1); PG8_STAGE(PG8_SA(0, 0), rsA, a2, voffA);
            PG8_BAR; PG8_WAIT_L(0); PG8_MMA(1, 0, At, B0); PG8_BAR; PG8_SCHED;
            PG8_STAGE(PG8_SB(0, 1), rsB, b2 + hstepB, voffB);
            PG8_WAIT_V(6); PG8_BAR; PG8_MMA(1, 1, At, B1); PG8_BAR;
            PG8_LDB(B0, 1, 0); PG8_SCHED; PG8_LDA(At, 1, 0); PG8_STAGE(PG8_SA(0, 1), rsA, a2 + hstepA, voffA);
            PG8_WAIT_L(8); PG8_BAR; PG8_WAIT_L(0); PG8_MMA(0, 0, At, B0); PG8_BAR; PG8_SCHED;
            PG8_LDB(B1, 1, 1); PG8_STAGE(PG8_SB(1, 0), rsB, b3, voffB);
            PG8_BAR; PG8_WAIT_L(0); PG8_MMA(0, 1, At, B1); PG8_BAR;
            PG8_LDA(At, 1, 1); PG8_STAGE(PG8_SA(1, 0), rsA, a3, voffA);
            PG8_BAR; PG8_WAIT_L(0); PG8_MMA(1, 0, At, B0); PG8_BAR; PG8_SCHED;
            PG8_STAGE(PG8_SB(1, 1), rsB, b3 + hstepB, voffB);
            PG8_WAIT_V(6); PG8_BAR; PG8_MMA(1, 1, At, B1); PG8_BAR;
        }
        { const int l2 = phase_tid(wave) & 63; E(acc, cur, wr, wc, l2 & 15, l2 >> 4); }
        if (!has_next) break;
#pragma unroll
        for (int a = 0; a < 2; ++a)
#pragma unroll
            for (int b = 0; b < 2; ++b)
#pragma unroll
                for (int m = 0; m < 4; ++m)
#pragma unroll
                    for (int n = 0; n < 2; ++n) acc[a][b][m][n] = (f32x4){0.f, 0.f, 0.f, 0.f};
        cur = nxt; cA = nA; cB = nB; ++ui;
    }
    PG8_WAIT_V(0);
    if (wr == 0) PG8_BAR;
    PG8_BAR;
#undef PG8_SA
#undef PG8_SB
#undef PG8_STAGE
#undef PG8_LDA
#undef PG8_LDB
#undef PG8_MMA
#undef PG8_CAT
#undef PG8_WAIT_V
#undef PG8_WAIT_L
#undef PG8_BAR
#undef PG8_SCHED
}
}
using pg8::Unit;

#define EPI_LOOP_BEGIN \
    _Pragma("unroll") for (int ai = 0; ai < 2; ++ai) _Pragma("unroll") for (int m = 0; m < 4; ++m) { const int r = u.pm * 256 + ai * 128 + wr * 64 + m * 16 + fr; \
    _Pragma("unroll") for (int bj = 0; bj < 2; ++bj) _Pragma("unroll") for (int n = 0; n < 2; ++n) { const int cl = bj * 128 + wc * 32 + 16 * n + 4 * fq; const f32x4 a = acc[ai][bj][m][n];
#define EPI_LOOP_END } }

struct EpiP {
    static constexpr bool PERM = true; bf16_t* C;
    __device__ __forceinline__ void operator()(const f32x4 (&acc)[2][2][4][2], const Unit& u, int wr, int wc, int fr, int fq) const {
#pragma unroll
        for (int ai = 0; ai < 2; ++ai)
#pragma unroll
            for (int m = 0; m < 4; ++m) { const int r = u.pm * 256 + ai * 128 + wr * 64 + m * 16 + fr;
#pragma unroll
                for (int bj = 0; bj < 2; ++bj) { const int c0 = u.pn * 256 + bj * 128 + wc * 32 + 8 * fq; const f32x4 v0 = acc[ai][bj][m][0], v1 = acc[ai][bj][m][1];
                    u32x4 w; w.x = cvt_pk_bf16(v0[0], v0[1]); w.y = cvt_pk_bf16(v0[2], v0[3]); w.z = cvt_pk_bf16(v1[0], v1[1]); w.w = cvt_pk_bf16(v1[2], v1[3]);
                    *(u32x4*)(C + (size_t)r * NINP + c0) = w; } }
    }
};
#define EPI_COLS(ptr) f32x4 cv[2][2]; _Pragma("unroll") for (int bj = 0; bj < 2; ++bj) _Pragma("unroll") for (int n = 0; n < 2; ++n) cv[bj][n] = ld4((ptr) + bj * 128 + wc * 32 + 16 * n + 4 * fq);
#define EPI_COLS_PERM(ptr) f32x4 cv[2][2]; _Pragma("unroll") for (int bj = 0; bj < 2; ++bj) _Pragma("unroll") for (int n = 0; n < 2; ++n) cv[bj][n] = ld4((ptr) + bj * 128 + wc * 32 + 8 * fq + 4 * n);
struct EpiLora {
    static constexpr bool PERM = false; float* dec; bf16_t *iclr, *gg; const float *w0, *a0;
    __device__ __forceinline__ void operator()(const f32x4 (&acc)[2][2][4][2], const Unit& u, int wr, int wc, int fr, int fq) const {
        const int sect = u.pn >> 2, cb = (u.pn & 3) * 256;
        EPI_COLS((sect == 0 ? w0 : a0) + cb)
        EPI_LOOP_BEGIN
            const int c = cb + cl; f32x4 o;
            if (sect == 0) {
#pragma unroll
                for (int j = 0; j < 4; ++j) o[j] = __builtin_amdgcn_exp2f(-0.6065306597126334f * 1.4426950408889634f * sigmoidf_(cv[bj][n][j] + a[j]));
                *(f32x4*)(dec + (size_t)r * NC + c) = o; }
            else if (sect == 1) {
#pragma unroll
                for (int j = 0; j < 4; ++j) o[j] = sigmoidf_(cv[bj][n][j] + a[j]);
                u32x2 wv; wv.x = cvt_pk_bf16(o[0], o[1]); wv.y = cvt_pk_bf16(o[2], o[3]); *(u32x2*)(iclr + (size_t)r * NC + c) = wv; }
            else { u32x2 wv; wv.x = cvt_pk_bf16(a[0], a[1]); wv.y = cvt_pk_bf16(a[2], a[3]); *(u32x2*)(gg + (size_t)r * NC + c) = wv; }
        EPI_LOOP_END
    }
};
struct EpiPool {
    static constexpr bool PERM = true; bf16_t* t1; const bf16_t* P; const float* pscale;
    __device__ __forceinline__ void operator()(const f32x4 (&acc)[2][2][4][2], const Unit& u, int wr, int wc, int fr, int fq) const {
        EPI_COLS_PERM(pscale + u.pn * 256)
#pragma unroll
        for (int ai = 0; ai < 2; ++ai) { u32x4 gq[4][2];
#pragma unroll
            for (int m = 0; m < 4; ++m)
#pragma unroll
                for (int bj = 0; bj < 2; ++bj) gq[m][bj] = ldu4nt(P + (size_t)(u.pm * 256 + ai * 128 + wr * 64 + m * 16 + fr) * NINP + OFF_GB + u.pn * 256 + bj * 128 + wc * 32 + 8 * fq);
#pragma unroll
            for (int m = 0; m < 4; ++m) { const int r = u.pm * 256 + ai * 128 + wr * 64 + m * 16 + fr;
#pragma unroll
                for (int bj = 0; bj < 2; ++bj) { const int c0 = u.pn * 256 + bj * 128 + wc * 32 + 8 * fq;
                    const f32x4 g0 = bf4_unpack((u32x2){gq[m][bj].x, gq[m][bj].y}), g1 = bf4_unpack((u32x2){gq[m][bj].z, gq[m][bj].w}), a0 = acc[ai][bj][m][0], a1 = acc[ai][bj][m][1]; f32x4 o0, o1;
#pragma unroll
                    for (int j = 0; j < 4; ++j) { o0[j] = sigmoidf_(g0[j]) * cv[bj][0][j] * a0[j]; o1[j] = sigmoidf_(g1[j]) * cv[bj][1][j] * a1[j]; }
                    u32x4 w; w.x = cvt_pk_bf16(o0[0], o0[1]); w.y = cvt_pk_bf16(o0[2], o0[3]); w.z = cvt_pk_bf16(o1[0], o1[1]); w.w = cvt_pk_bf16(o1[2], o1[3]);
                    *(u32x4*)(t1 + (size_t)r * ND + c0) = w; } } }
    }
};
struct EpiRwkv {
    static constexpr bool PERM = true; bf16_t* mx; const bf16_t* P; const bf16_t* t1;
    __device__ __forceinline__ void operator()(const f32x4 (&acc)[2][2][4][2], const Unit& u, int wr, int wc, int fr, int fq) const {
#pragma unroll
        for (int ai = 0; ai < 2; ++ai) { u32x4 gq[4][2], tq[4][2];
#pragma unroll
            for (int m = 0; m < 4; ++m)
#pragma unroll
                for (int bj = 0; bj < 2; ++bj) { const int r = u.pm * 256 + ai * 128 + wr * 64 + m * 16 + fr, c0 = u.pn * 256 + bj * 128 + wc * 32 + 8 * fq;
                    gq[m][bj] = ldu4nt(P + (size_t)r * NINP + OFF_GA + c0); tq[m][bj] = ldu4nt(t1 + (size_t)r * ND + c0); }
#pragma unroll
            for (int m = 0; m < 4; ++m) { const int r = u.pm * 256 + ai * 128 + wr * 64 + m * 16 + fr;
#pragma unroll
                for (int bj = 0; bj < 2; ++bj) { const int c0 = u.pn * 256 + bj * 128 + wc * 32 + 8 * fq;
                    const f32x4 g0 = bf4_unpack((u32x2){gq[m][bj].x, gq[m][bj].y}), g1 = bf4_unpack((u32x2){gq[m][bj].z, gq[m][bj].w});
                    const f32x4 t0 = bf4_unpack((u32x2){tq[m][bj].x, tq[m][bj].y}), t1v = bf4_unpack((u32x2){tq[m][bj].z, tq[m][bj].w}), a0 = acc[ai][bj][m][0], a1 = acc[ai][bj][m][1]; f32x4 o0, o1;
#pragma unroll
                    for (int j = 0; j < 4; ++j) { o0[j] = sigmoidf_(g0[j]) * a0[j] + t0[j]; o1[j] = sigmoidf_(g1[j]) * a1[j] + t1v[j]; }
                    u32x4 w; w.x = cvt_pk_bf16(o0[0], o0[1]); w.y = cvt_pk_bf16(o0[2], o0[3]); w.z = cvt_pk_bf16(o1[0], o1[1]); w.w = cvt_pk_bf16(o1[2], o1[3]);
                    *(u32x4*)(mx + (size_t)r * ND + c0) = w; } } }
    }
};
struct EpiWout {
    static constexpr bool PERM = true; float* z1; const float* x; const float* mod;
    __device__ __forceinline__ void operator()(const f32x4 (&acc)[2][2][4][2], const Unit& u, int wr, int wc, int fr, int fq) const {
        const int b = u.pm >> 3;
        EPI_COLS_PERM(mod + (size_t)b * NMOD + 2 * ND + u.pn * 256)
#pragma unroll
        for (int ai = 0; ai < 2; ++ai)
#pragma unroll
            for (int mh = 0; mh < 2; ++mh) { f32x4 xq[2][2][2];
#pragma unroll
                for (int m2 = 0; m2 < 2; ++m2)
#pragma unroll
                    for (int bj = 0; bj < 2; ++bj)
#pragma unroll
                        for (int n = 0; n < 2; ++n) xq[m2][bj][n] = ld4nt(x + (size_t)(u.pm * 256 + ai * 128 + wr * 64 + (mh * 2 + m2) * 16 + fr) * ND + u.pn * 256 + bj * 128 + wc * 32 + 8 * fq + 4 * n);
#pragma unroll
                for (int m2 = 0; m2 < 2; ++m2) { const int m = mh * 2 + m2, r = u.pm * 256 + ai * 128 + wr * 64 + m * 16 + fr;
#pragma unroll
                    for (int bj = 0; bj < 2; ++bj)
#pragma unroll
                        for (int n = 0; n < 2; ++n) { const int c = u.pn * 256 + bj * 128 + wc * 32 + 8 * fq + 4 * n;
                            *(f32x4*)(z1 + (size_t)r * ND + c) = xq[m2][bj][n] * DN_ALPHA + cv[bj][n] * acc[ai][bj][m][n]; } } }
    }
};
struct EpiGU {
    static constexpr bool PERM = true; fp8_t* act; const float* b_gu;
    __device__ __forceinline__ void operator()(const f32x4 (&acc)[2][2][4][2], const Unit& u, int wr, int wc, int fr, int fq) const {
        const float* bias = b_gu + (size_t)u.e * (2 * DFF) + u.pn * 256 + wc * 32 + 8 * fq;
#pragma unroll
        for (int bj = 0; bj < 2; ++bj) { const f32x4 c0v = ld4(bias + bj * 128), c1v = ld4(bias + bj * 128 + 4); const int c0 = u.pn * 256 + bj * 128 + wc * 32 + 8 * fq;
#pragma unroll
            for (int ai = 0; ai < 2; ++ai)
#pragma unroll
                for (int m = 0; m < 4; ++m) { const int r = u.pm * 256 + ai * 128 + wr * 64 + m * 16 + fr;
                    const f32x4 v0 = acc[ai][bj][m][0] * W8_INV + c0v, v1 = acc[ai][bj][m][1] * W8_INV + c1v;
                    float o[4];
#pragma unroll
                    for (int j = 0; j < 4; ++j) { const float gt = fminf(j < 2 ? v0[2 * j] : v1[2 * j - 4], SW_LIMIT); const float up = fminf(fmaxf(j < 2 ? v0[2 * j + 1] : v1[2 * j - 3], -SW_LIMIT), SW_LIMIT);
                        o[j] = (up + 1.0f) * (gt * __builtin_amdgcn_rcpf(1.0f + __builtin_amdgcn_exp2f(gt * (-SW_ALPHA * 1.4426950408889634f)))); }
                    *(unsigned*)(act + (size_t)r * DFF + (c0 >> 1)) = pack4_fp8(o[0], o[1], o[2], o[3]); } }
    }
};
struct EpiDown {
    static constexpr bool PERM = true; bf16_t* yb; const float* b_down;
    __device__ __forceinline__ void operator()(const f32x4 (&acc)[2][2][4][2], const Unit& u, int wr, int wc, int fr, int fq) const {
        const float* bias = b_down + (size_t)u.e * ND + u.pn * 256 + wc * 32 + 8 * fq;
#pragma unroll
        for (int bj = 0; bj < 2; ++bj) { const f32x4 c0v = ld4(bias + bj * 128), c1v = ld4(bias + bj * 128 + 4); const int c0 = u.pn * 256 + bj * 128 + wc * 32 + 8 * fq;
#pragma unroll
            for (int ai = 0; ai < 2; ++ai)
#pragma unroll
                for (int m = 0; m < 4; ++m) { const int r = u.pm * 256 + ai * 128 + wr * 64 + m * 16 + fr;
                    const f32x4 v0 = acc[ai][bj][m][0] * W8_INV + c0v, v1 = acc[ai][bj][m][1] * W8_INV + c1v;
                    u32x4 w; w.x = cvt_pk_bf16(v0[0], v0[1]); w.y = cvt_pk_bf16(v0[2], v0[3]); w.z = cvt_pk_bf16(v1[0], v1[1]); w.w = cvt_pk_bf16(v1[2], v1[3]);
                    *(u32x4*)(yb + (size_t)r * ND + c0) = w; } }
    }
};

struct WinRestOrder {
    int c; size_t a_tile, b_tile;
    __device__ bool next(int i, Unit& u) const {
        if (i > 0 || c < 0 || c >= 64) return false;
        u.pm = c >> 1; u.pn = 23 + (c & 1); u.e = 0; u.aoff = (unsigned)((size_t)u.pm * a_tile); u.boff = (unsigned)((size_t)u.pn * b_tile); return true;
    }
};
struct PoolOrder {
    int G, c;
    __device__ bool next(int i, Unit& u) const {
        const int L = i * G + c; if (c < 0 || L >= 256) return false;
        u.pm = L >> 3; u.pn = L & 7; u.e = 0;
        u.aoff = (unsigned)(((size_t)u.pm * 256 * NC + (size_t)(u.pn >> 1) * 256) * 2); u.boff = (unsigned)((size_t)u.pn * 256 * 256 * 2); return true;
    }
};
struct MoeOrder {
    int G, c, nN, ntiles; const LAS unsigned* tile_e; size_t a_tile, b_expert, b_tile;
    __device__ bool next(int i, Unit& u) const {
        const int L = i * G + c; if (L >= ntiles * nN) return false;
        u.pm = L / nN; u.pn = L % nN; u.e = __builtin_amdgcn_readfirstlane((int)tile_e[u.pm]);
        u.aoff = (unsigned)((size_t)u.pm * a_tile); u.boff = (unsigned)((size_t)u.e * b_expert + (size_t)u.pn * b_tile); return true;
    }
};

__device__ __forceinline__ void cvt_block_T(const float* src, int ld_src, bf16_t* dst, int ld_dst, int lane) {
    const int k8 = lane & 7, nq = lane >> 3;
    const float* s = src + (size_t)(k8 * 8) * ld_src + nq * 4;
    f32x4 v[8];
#pragma unroll
    for (int j = 0; j < 8; ++j) v[j] = __builtin_nontemporal_load((const f32x4*)(s + (size_t)j * ld_src));
#pragma unroll
    for (int i = 0; i < 4; ++i) { u32x4 w; w.x = cvt_pk_bf16(v[0][i], v[1][i]); w.y = cvt_pk_bf16(v[2][i], v[3][i]); w.z = cvt_pk_bf16(v[4][i], v[5][i]); w.w = cvt_pk_bf16(v[6][i], v[7][i]);
        *(u32x4*)(dst + (size_t)(nq * 4 + i) * ld_dst + k8 * 8) = w; }
}
__device__ __forceinline__ void cvt_block_T2(const float* src, int ld_src, bf16_t* dst, int ld_dst, int lane) {
    const int k8 = lane & 7, nq = lane >> 3;
    const float* s = src + (size_t)(k8 * 8) * ld_src + nq * 4;
    f32x4 v[8], w2[8];
#pragma unroll
    for (int j = 0; j < 8; ++j) { v[j] = ld4(s + (size_t)j * ld_src); w2[j] = ld4(s + (size_t)j * ld_src + 32); }
#pragma unroll
    for (int i = 0; i < 4; ++i) { u32x4 w; w.x = cvt_pk_bf16(v[0][i], v[1][i]); w.y = cvt_pk_bf16(v[2][i], v[3][i]); w.z = cvt_pk_bf16(v[4][i], v[5][i]); w.w = cvt_pk_bf16(v[6][i], v[7][i]);
        *(u32x4*)(dst + (size_t)(nq * 4 + i) * ld_dst + k8 * 8) = w; }
#pragma unroll
    for (int i = 0; i < 4; ++i) { u32x4 w; w.x = cvt_pk_bf16(w2[0][i], w2[1][i]); w.y = cvt_pk_bf16(w2[2][i], w2[3][i]); w.z = cvt_pk_bf16(w2[4][i], w2[5][i]); w.w = cvt_pk_bf16(w2[6][i], w2[7][i]);
        *(u32x4*)(dst + (size_t)(32 + nq * 4 + i) * ld_dst + k8 * 8) = w; }
}

__device__ __forceinline__ void cvt8_load(f32x4 (&v)[16], const float* s, int ld_src) {
#pragma unroll
    for (int j = 0; j < 16; ++j) v[j] = __builtin_nontemporal_load((const f32x4*)(s + (size_t)j * ld_src));
}
__device__ __forceinline__ void cvt8_store(const f32x4 (&v)[16], fp8_t* d, int ld_dst) {
#pragma unroll
    for (int i = 0; i < 4; ++i) { u32x4 w; w.x = pack4_fp8(v[0][i] * W8_SCALE, v[1][i] * W8_SCALE, v[2][i] * W8_SCALE, v[3][i] * W8_SCALE); w.y = pack4_fp8(v[4][i] * W8_SCALE, v[5][i] * W8_SCALE, v[6][i] * W8_SCALE, v[7][i] * W8_SCALE);
        w.z = pack4_fp8(v[8][i] * W8_SCALE, v[9][i] * W8_SCALE, v[10][i] * W8_SCALE, v[11][i] * W8_SCALE); w.w = pack4_fp8(v[12][i] * W8_SCALE, v[13][i] * W8_SCALE, v[14][i] * W8_SCALE, v[15][i] * W8_SCALE);
        __builtin_nontemporal_store(w, (u32x4*)(d + (size_t)i * ld_dst)); }
}
__device__ __forceinline__ void cvt_wave_T8x8(const float* src, int ld_src, fp8_t* dst, int ld_dst, int lane) {
    const int k16 = lane & 7, nq = lane >> 3;
    const float* s = src + (size_t)(k16 * 16) * ld_src + nq * 4; fp8_t* d = dst + (size_t)(nq * 4) * ld_dst + k16 * 16;
    f32x4 va[16], vb[16];
    cvt8_load(va, s, ld_src);
#pragma unroll
    for (int i = 0; i < 8; i += 2) {
        cvt8_load(vb, s + (i + 1) * 32, ld_src);
        cvt8_store(va, d + (size_t)(i * 32) * ld_dst, ld_dst);
        if (i + 2 < 8) cvt8_load(va, s + (i + 2) * 32, ld_src);
        cvt8_store(vb, d + (size_t)((i + 1) * 32) * ld_dst, ld_dst);
    }
}

__device__ __forceinline__ void phase0(const Params& p, LAS unsigned char* lds, const int wave) {
    const int tid = phase_tid(wave);
    const int bid = blockIdx.x, lane = tid & 63, wv = tid >> 6;
    LAS float* cond = (LAS float*)lds;
    if (bid < 192) {
        for (int i = tid; i < NB * ND; i += NTHREADS) { const int b = i >> 11, k = i & 2047; const float cv = p.c[i]; cond[k * 4 + b] = cv / (1.0f + expf(-cv)); }
        __syncthreads();
        const int gid = bid * NTHREADS + tid, ks = gid / 3072, j4 = gid % 3072;
        f32x4 a0 = {0.f, 0.f, 0.f, 0.f}, a1 = a0, a2 = a0, a3 = a0;
        const float* wp = p.w_ada + (size_t)(ks * 64) * NMOD + j4 * 4;
#pragma unroll 16
        for (int kk = 0; kk < 64; ++kk) { const f32x4 w = __builtin_nontemporal_load((const f32x4*)(wp + (size_t)kk * NMOD)); const f32x4 cd = *(const LAS f32x4*)(cond + (ks * 64 + kk) * 4);
            a0 += w * cd[0]; a1 += w * cd[1]; a2 += w * cd[2]; a3 += w * cd[3]; }
        *(f32x4*)(p.modp + (size_t)(ks * 4 + 0) * NMOD + j4 * 4) = a0; *(f32x4*)(p.modp + (size_t)(ks * 4 + 1) * NMOD + j4 * 4) = a1;
        *(f32x4*)(p.modp + (size_t)(ks * 4 + 2) * NMOD + j4 * 4) = a2; *(f32x4*)(p.modp + (size_t)(ks * 4 + 3) * NMOD + j4 * 4) = a3;
    }
    const int gw = bid * NWAVES + wv, GW = gridDim.x * NWAVES;
    constexpr int I_IN = 32 * 265, I_RW = 16 * 64, I_PL = 4 * 4 * 16, I_OUT = 32 * 64, I_ALL = I_IN + I_RW + I_PL + I_OUT;
    for (int it = gw; it < I_ALL; it += GW) {
        if (it < I_IN) { const int kb = it / 265, nb = it % 265; cvt_block_T(p.w_in + (size_t)(kb * 64) * NIN + nb * 32, NIN, p.wt_in + (size_t)(nb * 32) * ND + kb * 64, ND, lane); }
        else if (it < I_IN + I_RW) { const int j = it - I_IN, kb = j / 64, nb = j % 64; cvt_block_T(p.w_rwkv_out + (size_t)(kb * 64) * ND + nb * 32, ND, p.wt_rwkv + (size_t)(nb * 32) * NC + kb * 64, NC, lane); }
        else if (it < I_IN + I_RW + I_PL) { const int j = it - I_IN - I_RW, g = j / 64, kb = (j % 64) / 16, nb = j % 16;
            cvt_block_T(p.w_pool + (size_t)g * 256 * 512 + (size_t)(kb * 64) * 512 + nb * 32, 512, p.wt_pool + (size_t)g * 512 * 256 + (size_t)(nb * 32) * 256 + kb * 64, 256, lane); }
        else { const int j = it - I_IN - I_RW - I_PL, kb = j / 64, nb = j % 64; cvt_block_T(p.w_out + (size_t)(kb * 64) * ND + nb * 32, ND, p.wt_out + (size_t)(nb * 32) * ND + kb * 64, ND, lane); }
    }
    for (int idx = bid * NTHREADS + tid; idx < LORA_N * (LORA_K / 8); idx += gridDim.x * NTHREADS) {
        const int n = idx / (LORA_K / 8), k0 = (idx % (LORA_K / 8)) * 8; float v[8];
#pragma unroll
        for (int j = 0; j < 8; ++j) { const int k = k0 + j; float x = 0.f;
            if (n < 1024) { if (k < 64) x = p.w_decay_up[k * NC + n]; }
            else if (n < 2048) { if (k >= 64 && k < 128) x = p.w_iclr_up[(k - 64) * NC + (n - 1024)]; }
            else { if (k >= 128 && k < 288) x = p.w_glora_up[(k - 128) * NC + (n - 2048)]; }
            v[j] = x; }
        u32x4 w; w.x = cvt_pk_bf16(v[0], v[1]); w.y = cvt_pk_bf16(v[2], v[3]); w.z = cvt_pk_bf16(v[4], v[5]); w.w = cvt_pk_bf16(v[6], v[7]);
        *(u32x4*)(p.bt_lora + (size_t)n * LORA_K + k0) = w;
    }
}

__device__ __forceinline__ void phase1(const Params& p, LAS unsigned char* lds, const int wave) {
    const int tid = phase_tid(wave);
    const int bid = blockIdx.x;
    if (tid < 192) { const int idx = bid * 192 + tid, b = idx / NMOD, j = idx % NMOD; float s = p.b_ada[j];
        for (int ks = 0; ks < KS_MOD; ++ks) s += p.modp[(size_t)(ks * 4 + b) * NMOD + j];
        p.mod[idx] = s; }
    LAS float* ss = (LAS float*)lds;
    const int m0 = bid * 32, b = m0 >> 11;
    {   const int j = tid * 8; f32x4 s0 = ld4(p.b_ada + j), s1 = ld4(p.b_ada + j + 4);
#pragma unroll 8
        for (int ks = 0; ks < KS_MOD; ++ks) { s0 += ld4(p.modp + (size_t)(ks * 4 + b) * NMOD + j); s1 += ld4(p.modp + (size_t)(ks * 4 + b) * NMOD + j + 4); }
        *(LAS f32x4*)(ss + j) = s0; *(LAS f32x4*)(ss + j + 4) = s1; }
    __syncthreads();
    const int k = (tid & 255) * 8, rh = tid >> 8;
    const f32x4 sh0 = *(const LAS f32x4*)(ss + k), sh1v = *(const LAS f32x4*)(ss + k + 4), sc0 = *(const LAS f32x4*)(ss + ND + k) + 1.0f, sc1v = *(const LAS f32x4*)(ss + ND + k + 4) + 1.0f;
#pragma unroll 4
    for (int i = 0; i < 16; ++i) { const size_t m = (size_t)(m0 + 2 * i + rh); const f32x4 x0 = ld4nt(p.x + m * ND + k), x1 = ld4nt(p.x + m * ND + k + 4); const f32x4 h0 = x0 * sc0 + sh0, h1 = x1 * sc1v + sh1v;
        u32x4 w; w.x = cvt_pk_bf16(h0[0], h0[1]); w.y = cvt_pk_bf16(h0[2], h0[3]); w.z = cvt_pk_bf16(h1[0], h1[1]); w.w = cvt_pk_bf16(h1[2], h1[3]); *(u32x4*)(p.hb + m * ND + k) = w; }
    __syncthreads();
}

__device__ __forceinline__ void phase3(const Params& p, LAS unsigned char* lds, const int wave) {
    const int tid = phase_tid(wave);
    const int bid = blockIdx.x, m0 = bid * 32, t0 = m0 & (NT - 1), hist = t0 > 0 ? 15 : 0;
    constexpr int TC = OFF_GA - OFF_WD, TCH = TC / 8;
    LAS bf16_t* T = (LAS bf16_t*)lds;
    for (int idx = tid; idx < 47 * TCH; idx += NTHREADS) { const int r = idx / TCH, ck = idx % TCH;
        if (r >= 15 - hist) *(LAS u32x4*)(T + r * TC + ck * 8) = ldu4nt(p.P + (size_t)(m0 - 15 + r) * NINP + OFF_WD + ck * 8); }
    __syncthreads();
    for (int idx = tid; idx < 32 * (LORA_K / 8); idx += NTHREADS) { const int i = idx / (LORA_K / 8), j0 = (idx % (LORA_K / 8)) * 8; u32x4 w = {0u, 0u, 0u, 0u};
        if (j0 < 288) { const u32x4 cu = *(const LAS u32x4*)(T + (15 + i) * TC + j0); u32x4 pu = {0u, 0u, 0u, 0u}; if (t0 + i > 0) pu = *(const LAS u32x4*)(T + (14 + i) * TC + j0);
            const f32x4 c0 = bf4_unpack((u32x2){cu.x, cu.y}), c1 = bf4_unpack((u32x2){cu.z, cu.w}), q0 = bf4_unpack((u32x2){pu.x, pu.y}), q1 = bf4_unpack((u32x2){pu.z, pu.w});
            const f32x4 s0 = c0 + (q0 - c0) * ld4(p.mu_shift + OFF_WD + j0), s1 = c1 + (q1 - c1) * ld4(p.mu_shift + OFF_WD + j0 + 4); float v[8];
#pragma unroll
            for (int j = 0; j < 8; ++j) { const float x = j < 4 ? s0[j] : s1[j - 4];
                v[j] = j0 < 64 ? (1.0f - 2.0f * __builtin_amdgcn_rcpf(1.0f + __builtin_amdgcn_exp2f(x * 2.8853900817779268f))) : (j0 < 128 ? x : sigmoidf_(x)); }
            w.x = cvt_pk_bf16(v[0], v[1]); w.y = cvt_pk_bf16(v[2], v[3]); w.z = cvt_pk_bf16(v[4], v[5]); w.w = cvt_pk_bf16(v[6], v[7]); }
        *(u32x4*)(p.a_lora + (size_t)(m0 + i) * LORA_K + j0) = w; }
    for (int idx = tid; idx < 32 * (NC / 8); idx += NTHREADS) { const int i = idx >> 7, c = (idx & 127) * 8; const int win = 2 << (c >> 8), t = t0 + i, n = (t + 1) < win ? (t + 1) : win;
        const LAS bf16_t* up = T + (15 + i) * TC + (OFF_POOL - OFF_WD) + c; f32x4 a0 = {0.f, 0.f, 0.f, 0.f}, a1 = a0;
        for (int q = 0; q < n; ++q) { const u32x4 uu = *(const LAS u32x4*)(up - q * TC); a0 += bf4_unpack((u32x2){uu.x, uu.y}); a1 += bf4_unpack((u32x2){uu.z, uu.w}); }
        const u32x4 u0 = *(const LAS u32x4*)(up); const float rn = 1.0f / (float)n;
        const f32x4 d0 = a0 * rn - bf4_unpack((u32x2){u0.x, u0.y}), d1 = a1 * rn - bf4_unpack((u32x2){u0.z, u0.w});
        u32x4 w; w.x = cvt_pk_bf16(d0[0], d0[1]); w.y = cvt_pk_bf16(d0[2], d0[3]); w.z = cvt_pk_bf16(d1[0], d1[1]); w.w = cvt_pk_bf16(d1[2], d1[3]);
        *(u32x4*)(p.dp + (size_t)(m0 + i) * NC + c) = w; }
    __syncthreads();
}

__device__ __forceinline__ float row8_allsum(float x) {
    x += dpp_f<0x141>(x); x += dpp_f<0x1B>(x); x += dpp_f<0xB1>(x); return x;
}
__device__ __forceinline__ void scan_head(const Params& p, LAS unsigned char* lds, int bh, const int wave) {
    const int tid = phase_tid(wave);
    const int lane = tid & 63;
    const int b = bh >> 4, h = bh & 15;
    constexpr int L_AW = 0, L_W = 16384, L_BK = 32768, L_Y = 65536, L_V = 81920, L_G = 106496, L_SC = 131072, L_CS = 131840, L_Z = 132352, L_DUMMY = 132864, L_CST = 133888;
    constexpr int NCH = NT / 32;
    if (tid < 128) *(LAS unsigned*)(lds + L_Z + tid * 4) = 0u;
    {
        const int a8 = tid >> 6, cc = tid & 63, gch = h * HS + cc;
        const float* src = a8 == 0 ? p.mu_shift + OFF_R : a8 == 1 ? p.mu_shift + OFF_K : a8 == 2 ? p.mu_shift + OFF_V : a8 == 3 ? p.k_k : a8 == 4 ? p.k_a : a8 == 5 ? p.r_k : a8 == 6 ? p.lnx_g : p.lnx_b;
        *(LAS float*)(lds + L_CST + a8 * 256 + cc * 4) = src[gch]; }
    __syncthreads();
#define CST4(a8, u_) (*(const LAS f32x4*)(lds + L_CST + (a8) * 256 + (c8 + 4 * (u_)) * 4))
    const int ht = tid - 256, ls = (ht >> 3) & 31, c8 = (ht & 7) * 8, ch0 = h * HS + c8;
    f32x4 pr[2], pk[2], pv[2], qr[2], qk[2], qv[2], dc[2], ic[2], gt[2]; u32x4 pr8, pk8, pv8, qr8, qk8, qv8, ic8, gt8;
    const f32x4 zero4 = {0.f, 0.f, 0.f, 0.f};
#define SCAN_ISSUE(chunk) do { int ch = ch0; asm volatile("" : "+v"(ch)); const int t_ = (chunk) * 32 + ls; const size_t m_ = (size_t)b * NT + t_; const bf16_t* row_ = p.P + m_ * NINP + ch; \
        pr8 = *(const u32x4*)(row_ + OFF_R); pk8 = *(const u32x4*)(row_ + OFF_K); pv8 = *(const u32x4*)(row_ + OFF_V); \
        if (t_ > 0) { qr8 = *(const u32x4*)(row_ - NINP + OFF_R); qk8 = *(const u32x4*)(row_ - NINP + OFF_K); qv8 = *(const u32x4*)(row_ - NINP + OFF_V); } else { qr8 = (u32x4){0u, 0u, 0u, 0u}; qk8 = qr8; qv8 = qr8; } \
        ic8 = ldu4nt(p.iclr + m_ * NC + ch); gt8 = ldu4nt(p.gg + m_ * NC + ch); \
        _Pragma("unroll") for (int u_ = 0; u_ < 2; ++u_) dc[u_] = ld4nt(p.dec + m_ * NC + ch + 4 * u_); } while (0)
#define SCAN_UNPACK() do { ic[0] = bf4_unpack((u32x2){ic8.x, ic8.y}); ic[1] = bf4_unpack((u32x2){ic8.z, ic8.w}); gt[0] = bf4_unpack((u32x2){gt8.x, gt8.y}); gt[1] = bf4_unpack((u32x2){gt8.z, gt8.w}); pr[0] = bf4_unpack((u32x2){pr8.x, pr8.y}); pr[1] = bf4_unpack((u32x2){pr8.z, pr8.w}); pk[0] = bf4_unpack((u32x2){pk8.x, pk8.y}); pk[1] = bf4_unpack((u32x2){pk8.z, pk8.w}); \
        pv[0] = bf4_unpack((u32x2){pv8.x, pv8.y}); pv[1] = bf4_unpack((u32x2){pv8.z, pv8.w}); qr[0] = bf4_unpack((u32x2){qr8.x, qr8.y}); qr[1] = bf4_unpack((u32x2){qr8.z, qr8.w}); \
        qk[0] = bf4_unpack((u32x2){qk8.x, qk8.y}); qk[1] = bf4_unpack((u32x2){qk8.z, qk8.w}); qv[0] = bf4_unpack((u32x2){qv8.x, qv8.y}); qv[1] = bf4_unpack((u32x2){qv8.z, qv8.w}); } while (0)
#define SCAN_STAGE(chunk) do { SCAN_UNPACK(); int ch = ch0; asm volatile("" : "+v"(ch)); const int bp_ = (chunk) & 1, vb_ = (chunk) % 3; f32x4 r_[2], k_[2], v_[2], kk_[2], km_[2], bb_[2]; float ss_ = 0.f; \
        _Pragma("unroll") for (int u_ = 0; u_ < 2; ++u_) { const f32x4 mu_r = CST4(0, u_), mu_k = CST4(1, u_), mu_v = CST4(2, u_); \
            r_[u_] = pr[u_] + (qr[u_] - pr[u_]) * mu_r; k_[u_] = pk[u_] + (qk[u_] - pk[u_]) * mu_k; v_[u_] = pv[u_] + (qv[u_] - pv[u_]) * mu_v; \
            kk_[u_] = k_[u_] * CST4(3, u_); ss_ += dot4(kk_[u_], kk_[u_]); } \
        ss_ = row8_allsum(ss_); const float inv_ = 1.0f / fmaxf(sqrtf(ss_), 1e-12f); float br_ = 0.f, kr_ = 0.f, rk_ = 0.f; \
        _Pragma("unroll") for (int u_ = 0; u_ < 2; ++u_) { kk_[u_] = kk_[u_] * inv_; km_[u_] = k_[u_] * ((ic[u_] - 1.0f) * CST4(4, u_) + 1.0f); bb_[u_] = kk_[u_] * ic[u_]; \
            br_ += dot4(bb_[u_], r_[u_]); kr_ += dot4(km_[u_], r_[u_]); rk_ += dot4(r_[u_] * km_[u_], CST4(5, u_)); } \
        br_ = row8_allsum(br_); kr_ = row8_allsum(kr_); rk_ = row8_allsum(rk_); \
          \
        const int pp_ = ls >> 1, odd_ = ls & 1; float c1_ = 0.f, c2_ = 0.f, c3_ = 0.f, c4_ = 0.f; \
        _Pragma("unroll") for (int u_ = 0; u_ < 2; ++u_) { const int k0_ = c8 + 4 * u_; const int pos_ = (k0_ >> 5) * 32 + ((k0_ & 15) >> 2) * 8 + ((k0_ >> 4) & 1) * 4; \
            const f32x4 a_ = -kk_[u_], wr_ = dc[u_] * r_[u_] + a_ * br_; f32x4 pw_, pb_, pk_; \
            _Pragma("unroll") for (int j_ = 0; j_ < 4; ++j_) { pw_[j_] = dpp_f<0x118>(dc[u_][j_]); pb_[j_] = dpp_f<0x118>(bb_[u_][j_]); pk_[j_] = dpp_f<0x118>(km_[u_][j_]); } \
            const f32x4 x0_ = odd_ ? pw_ * a_ : a_, x1_ = odd_ ? pw_ * wr_ : wr_; \
            u32x2 wa_, ww_; wa_.x = cvt_pk_bf16(x0_[0], x0_[1]); wa_.y = cvt_pk_bf16(x0_[2], x0_[3]); ww_.x = cvt_pk_bf16(x1_[0], x1_[1]); ww_.y = cvt_pk_bf16(x1_[2], x1_[3]); \
            *(LAS u32x2*)(lds + L_AW + bp_ * 8192 + pp_ * 512 + odd_ * 256 + pos_ * 2) = wa_; *(LAS u32x2*)(lds + L_AW + bp_ * 8192 + pp_ * 512 + odd_ * 256 + 128 + pos_ * 2) = ww_; \
            if (odd_) { *(LAS f32x4*)(lds + L_W + bp_ * 8192 + pp_ * 256 + k0_ * 4) = pw_ * dc[u_]; \
                *(LAS f32x4*)(lds + L_BK + bp_ * 16384 + pp_ * 1024 + k0_ * 4) = pb_ * dc[u_]; *(LAS f32x4*)(lds + L_BK + bp_ * 16384 + pp_ * 1024 + 256 + k0_ * 4) = pk_ * dc[u_]; \
                *(LAS f32x4*)(lds + L_BK + bp_ * 16384 + pp_ * 1024 + 512 + k0_ * 4) = bb_[u_]; *(LAS f32x4*)(lds + L_BK + bp_ * 16384 + pp_ * 1024 + 768 + k0_ * 4) = km_[u_]; \
                c1_ += dot4(pb_, a_); c2_ += dot4(pk_, a_); c3_ += dot4(pb_, wr_); c4_ += dot4(pk_, wr_); } \
            *(LAS f32x4*)(lds + L_V + vb_ * 8192 + ls * 256 + k0_ * 4) = v_[u_]; *(LAS f32x4*)(lds + L_G + vb_ * 8192 + ls * 256 + k0_ * 4) = gt[u_]; } \
        c1_ = row8_allsum(c1_); c2_ = row8_allsum(c2_); c3_ = row8_allsum(c3_); c4_ = row8_allsum(c4_); \
        if ((ht & 7) == 0) { *(LAS f32x2*)(lds + L_SC + vb_ * 256 + ls * 8) = (f32x2){kr_, rk_}; if (odd_) *(LAS f32x4*)(lds + L_CS + bp_ * 256 + pp_ * 16) = (f32x4){c1_, c2_, c3_, c4_}; } } while (0)
#define SCAN_POST(chunk) do { int ch = ch0; asm volatile("" : "+v"(ch)); const int bp_ = (chunk) & 1, vb_ = (chunk) % 3; const f32x2 sc_ = *(const LAS f32x2*)(lds + L_SC + vb_ * 256 + ls * 8); f32x4 y_[2], v_[2]; float s_ = 0.f; \
        _Pragma("unroll") for (int u_ = 0; u_ < 2; ++u_) { v_[u_] = *(const LAS f32x4*)(lds + L_V + vb_ * 8192 + ls * 256 + (c8 + 4 * u_) * 4); \
            y_[u_] = *(const LAS f32x4*)(lds + L_Y + bp_ * 8192 + ls * 256 + (c8 + 4 * u_) * 4) + v_[u_] * sc_[0]; s_ += (y_[u_][0] + y_[u_][1]) + (y_[u_][2] + y_[u_][3]); } \
        const float mean_ = row8_allsum(s_) * (1.0f / 64.0f); float q_ = 0.f; \
        _Pragma("unroll") for (int u_ = 0; u_ < 2; ++u_) { y_[u_] = y_[u_] - mean_; q_ += dot4(y_[u_], y_[u_]); } \
        const float rstd_ = rsqrtf(row8_allsum(q_) * (1.0f / 64.0f) + GN_EPS); const size_t m_ = (size_t)b * NT + (chunk) * 32 + ls; u32x4 o_; \
        _Pragma("unroll") for (int u_ = 0; u_ < 2; ++u_) { const f32x4 g_ = *(const LAS f32x4*)(lds + L_G + vb_ * 8192 + ls * 256 + (c8 + 4 * u_) * 4); \
            const f32x4 yn_ = y_[u_] * rstd_ * CST4(6, u_) + CST4(7, u_); const f32x4 f_ = (yn_ + v_[u_] * sc_[1]) * g_; \
            if (u_ == 0) { o_.x = cvt_pk_bf16(f_[0], f_[1]); o_.y = cvt_pk_bf16(f_[2], f_[3]); } else { o_.z = cvt_pk_bf16(f_[0], f_[1]); o_.w = cvt_pk_bf16(f_[2], f_[3]); } } \
        *(u32x4*)(p.yr + m_ * NC + ch) = o_; } while (0)
    const int ri = lane & 15, rg = lane >> 4, sel = ri & 3;
    f32x4 X0 = zero4, X1 = zero4, X2 = zero4, X3 = zero4;
    if (wave >= 4) { SCAN_ISSUE(0); SCAN_STAGE(0); }
    __syncthreads();
    for (int chunk = 0; chunk < NCH; ++chunk) {
        if (wave < 4) {
            __builtin_amdgcn_s_setprio(3);
            const int bp = chunk & 1, vb = chunk % 3;
            const LAS unsigned char* awp = lds + L_AW + bp * 8192 + sel * 128 + rg * 16;
            const LAS unsigned char* wwp = lds + L_W + bp * 8192 + rg * 16;
            const LAS unsigned char* abp = lds + L_BK + bp * 16384 + rg * 256 + ri * 4;
            const LAS unsigned char* vp = lds + L_V + vb * 8192 + (16 * wave + ri) * 4;
            const LAS unsigned char* csp = lds + L_CS + bp * 256;
            LAS unsigned char* yp = (rg == 0) ? (lds + L_Y + bp * 8192 + (16 * wave + ri) * 4) : ((rg == 2) ? (lds + L_Y + bp * 8192 + 256 + (16 * wave + ri) * 4) : (lds + L_DUMMY + tid * 4));
            const int y_st = (rg & 1) ? 0 : 512;
#define SCAN_LD(S, pi) do { S##a0 = *(const LAS bf16x8*)(awp + (pi) * 512); S##a1 = *(const LAS bf16x8*)(awp + (pi) * 512 + 64); \
                S##w0 = *(const LAS f32x4*)(wwp + (pi) * 256); S##w1 = *(const LAS f32x4*)(wwp + (pi) * 256 + 64); S##w2 = *(const LAS f32x4*)(wwp + (pi) * 256 + 128); S##w3 = *(const LAS f32x4*)(wwp + (pi) * 256 + 192); \
                S##b0 = *(const LAS float*)(abp + (pi) * 1024); S##b1 = *(const LAS float*)(abp + (pi) * 1024 + 64); S##b2 = *(const LAS float*)(abp + (pi) * 1024 + 128); S##b3 = *(const LAS float*)(abp + (pi) * 1024 + 192); \
                S##vt = *(const LAS float*)(vp + (pi) * 512); S##vu = *(const LAS float*)(vp + (pi) * 512 + 256); S##cs = *(const LAS f32x4*)(csp + (pi) * 16); } while (0)
#define SCAN_STEP(S, pi) do { u32x4 xa, xc; \
                xa.x = cvt_pk_bf16(X0[0], X0[1]); xa.y = cvt_pk_bf16(X0[2], X0[3]); xa.z = cvt_pk_bf16(X1[0], X1[1]); xa.w = cvt_pk_bf16(X1[2], X1[3]); \
                xc.x = cvt_pk_bf16(X2[0], X2[1]); xc.y = cvt_pk_bf16(X2[2], X2[3]); xc.z = cvt_pk_bf16(X3[0], X3[1]); xc.w = cvt_pk_bf16(X3[2], X3[3]); \
                const f32x4 d0 = __builtin_amdgcn_mfma_f32_16x16x32_bf16(S##a0, __builtin_bit_cast(bf16x8, xa), zero4, 0, 0, 0); \
                const f32x4 d1 = __builtin_amdgcn_mfma_f32_16x16x32_bf16(S##a1, __builtin_bit_cast(bf16x8, xc), zero4, 0, 0, 0); \
                const f32x4 d = d0 + d1; const float sat = d[0]; \
                const float sau = d[2] + sat * S##cs[0] + S##vt * S##cs[1], yu = d[3] + sat * S##cs[2] + S##vt * S##cs[3]; \
                const float bsel = (rg == 0) ? sat : ((rg == 1) ? S##vt : ((rg == 2) ? sau : S##vu)); \
                X0 = __builtin_amdgcn_mfma_f32_16x16x4f32(S##b0, bsel, X0 * S##w0, 0, 0, 0); \
                X1 = __builtin_amdgcn_mfma_f32_16x16x4f32(S##b1, bsel, X1 * S##w1, 0, 0, 0); \
                X2 = __builtin_amdgcn_mfma_f32_16x16x4f32(S##b2, bsel, X2 * S##w2, 0, 0, 0); \
                X3 = __builtin_amdgcn_mfma_f32_16x16x4f32(S##b3, bsel, X3 * S##w3, 0, 0, 0); \
                *(LAS float*)(yp + (pi) * y_st) = (rg == 0) ? d[1] : yu; } while (0)
            bf16x8 Pa0, Pa1, Qa0, Qa1; f32x4 Pw0, Pw1, Pw2, Pw3, Qw0, Qw1, Qw2, Qw3, Pcs, Qcs; float Pb0, Pb1, Pb2, Pb3, Pvt, Pvu, Qb0, Qb1, Qb2, Qb3, Qvt, Qvu;
            SCAN_LD(P, 0);
#pragma unroll 1
            for (int pi = 0; pi < 16; pi += 2) {
                SCAN_LD(Q, pi + 1);
                SCAN_STEP(P, pi);
                if (pi + 2 < 16) SCAN_LD(P, pi + 2);
                SCAN_STEP(Q, pi + 1);
            }
#undef SCAN_LD
#undef SCAN_STEP
        } else {
            if (chunk + 1 < NCH) SCAN_ISSUE(chunk + 1);
            if (chunk > 0) SCAN_POST(chunk - 1);
            if (chunk + 1 < NCH) SCAN_STAGE(chunk + 1);
        }
        __syncthreads();
    }
    if (wave >= 4) SCAN_POST(NCH - 1);
    __syncthreads();
#undef SCAN_ISSUE
#undef CST4
#undef SCAN_STAGE
#undef SCAN_UNPACK
#undef SCAN_POST
}
__device__ __forceinline__ void conv_queue(const Params& p, LAS unsigned char* lds, const int wave, const int cw, const int n_defer = N_DEFER) {
    const int tid = phase_tid(wave);
    const int lane = tid & 63, wv = tid >> 6;
    LAS int* slot = (LAS int*)(lds + LDS_MISC);
    constexpr int N_GU = NE * 16 * 2, N_DN = NE * 16, N_ALL = N_GU + N_DN;
    for (;;) {
        __syncthreads();
        if (tid == 0) *slot = (int)atomicAdd(&p.ctl[cw], 1u);
        __syncthreads();
        const int it = *slot;
        if (it >= N_ALL - n_defer) break;
        if (it < N_GU) { const int e = it >> 5, rem = it & 31, kb = rem >> 1, nh = rem & 1;
            const float* src = p.w_gu + (size_t)e * ND * (2 * DFF) + (size_t)(kb * 128) * (2 * DFF) + nh * 2048;
            fp8_t* dst = p.wt_gu + (size_t)e * (2 * DFF) * ND + (size_t)(nh * 2048) * ND + kb * 128;
            cvt_wave_T8x8(src + wv * 256, 2 * DFF, dst + (size_t)(wv * 256) * ND, ND, lane); }
        else { const int j = it - N_GU, e = j >> 4, kb = j & 15;
            const float* src = p.w_down + (size_t)e * DFF * ND + (size_t)(kb * 128) * ND;
            fp8_t* dst = p.wt_down + (size_t)e * ND * DFF + kb * 128;
            cvt_wave_T8x8(src + wv * 256, ND, dst + (size_t)(wv * 256) * DFF, DFF, lane); }
    }
}

__device__ __forceinline__ void conv_queue_tail(const Params& p, LAS unsigned char* lds, const int wave) {
    const int tid = phase_tid(wave);
    const int lane = tid & 63, wv = tid >> 6;
    LAS int* slot = (LAS int*)(lds + LDS_MISC + 1024);
    for (;;) {
        __syncthreads();
        if (tid == 0) *slot = (int)atomicAdd(&p.ctl[CW_CONV3], 1u);
        __syncthreads();
        const int it = *slot;
        if (it >= N_DEFER * 8) break;
        const int j = NE * 16 - N_DEFER + (it >> 3), sub = it & 7, e = j >> 4, kb = j & 15, k16 = lane & 7, nq = lane >> 3;
        const float* src = p.w_down + (size_t)e * DFF * ND + (size_t)(kb * 128 + k16 * 16) * ND + sub * 256 + wv * 32 + nq * 4;
        fp8_t* dst = p.wt_down + (size_t)e * ND * DFF + (size_t)(sub * 256 + wv * 32 + nq * 4) * DFF + kb * 128 + k16 * 16;
        f32x4 cv[16]; cvt8_load(cv, src, ND); cvt8_store(cv, dst, DFF);
    }
}

__device__ __forceinline__ void phase8(const Params& p, LAS unsigned char* lds, const int wave) {
    const int tid = phase_tid(wave);
    const int bid = blockIdx.x, lane = tid & 63, wv = tid >> 6;
    constexpr int HP = ND + 4;
    LAS float* hs = (LAS float*)lds;
    LAS float* lg = hs + 16 * HP;
    LAS float* part = lg + 16 * 32;
    LAS float* topv = part + 4 * 16 * 32;
    LAS int* topi = (LAS int*)(topv + 64);
    const int b = (bid * 32) >> 11;
    const float* sh2 = p.mod + (size_t)b * NMOD + 3 * ND; const float* sc2 = p.mod + (size_t)b * NMOD + 4 * ND;
    for (int pass = 0; pass < 2; ++pass) {
        const int mb = bid * 32 + pass * 16;
        for (int rr = 0; rr < 2; ++rr) { const int r = wv * 2 + rr; const size_t m = (size_t)(mb + r);
            f32x4 z[8]; float s = 0.f;
#pragma unroll
            for (int j = 0; j < 4; ++j) { z[2 * j] = ld4nt(p.z1 + m * ND + j * 512 + lane * 8); z[2 * j + 1] = ld4nt(p.z1 + m * ND + j * 512 + lane * 8 + 4);
                s += ((z[2 * j][0] + z[2 * j][1]) + (z[2 * j][2] + z[2 * j][3])) + ((z[2 * j + 1][0] + z[2 * j + 1][1]) + (z[2 * j + 1][2] + z[2 * j + 1][3])); }
            const float mean = wave_allsum(s) * (1.0f / ND); float qv = 0.f;
#pragma unroll
            for (int j = 0; j < 8; ++j) { const f32x4 d = z[j] - mean; qv += dot4(d, d); }
            const float rstd = rsqrtf(wave_allsum(qv) * (1.0f / ND) + LN_EPS);
            if (lane == 0) *(f32x2*)(p.lnst + m * 2) = (f32x2){mean, rstd};
#pragma unroll
            for (int j = 0; j < 8; ++j) { const int k = (j >> 1) * 512 + lane * 8 + (j & 1) * 4;
                const f32x4 x1 = (z[j] - mean) * rstd * ld4(p.ln1_g + k) + ld4(p.ln1_b + k);
                const f32x4 h = x1 * (ld4(sc2 + k) + 1.0f) + ld4(sh2 + k);
                *(unsigned*)(p.h2 + m * ND + k) = pack4_fp8(h[0], h[1], h[2], h[3]);
                *(LAS f32x4*)(hs + r * HP + k) = h; } }
        __syncthreads();
        {
            const int kq = wv >> 1, ntl = wv & 1, ar = lane & 15, ak = lane >> 4;
            f32x4 acc = {0.f, 0.f, 0.f, 0.f};
            const LAS float* ap = hs + ar * HP + kq * 512 + ak; const float* bp = p.w_router + (size_t)(kq * 512 + ak) * NE + ntl * 16 + ar;
#pragma unroll 1
            for (int kb = 0; kb < 128; kb += 32) { float bq[32];
#pragma unroll
                for (int j = 0; j < 32; ++j) bq[j] = bp[(size_t)(kb + j) * 4 * NE];
#pragma unroll
                for (int j = 0; j < 32; ++j) acc = __builtin_amdgcn_mfma_f32_16x16x4f32(ap[(kb + j) * 4], bq[j], acc, 0, 0, 0); }
#pragma unroll
            for (int j = 0; j < 4; ++j) part[(kq * 16 + ak * 4 + j) * 32 + ntl * 16 + ar] = acc[j]; }
        __syncthreads();
        {   const int r = tid >> 5, e = tid & 31;
            lg[r * 32 + e] = p.b_router[e] + (part[(0 * 16 + r) * 32 + e] + part[(1 * 16 + r) * 32 + e]) + (part[(2 * 16 + r) * 32 + e] + part[(3 * 16 + r) * 32 + e]); }
        __syncthreads();
        {
            const int r = tid >> 5, e = tid & 31; const LAS float* l = lg + r * 32; const float mine = l[e]; int rank = 0;
#pragma unroll
            for (int q = 0; q < 8; ++q) { const f32x4 o = *(const LAS f32x4*)(l + q * 4);
#pragma unroll
                for (int j = 0; j < 4; ++j) rank += (o[j] > mine || (o[j] == mine && (q * 4 + j) < e)) ? 1 : 0; }
            if (rank < 4) { topv[r * 4 + rank] = mine; topi[r * 4 + rank] = e; } }
        __syncthreads();
        if (tid < 64) { const int r = tid >> 2, k = tid & 3, m = mb + r; const f32x4 tv = *(const LAS f32x4*)(topv + r * 4); const int ei = topi[r * 4 + k];
            const float e0 = 1.0f, e1 = expf(tv[1] - tv[0]), e2 = expf(tv[2] - tv[0]), e3 = expf(tv[3] - tv[0]); const float sum = (e0 + e1) + (e2 + e3);
            const float mineexp = k == 0 ? e0 : (k == 1 ? e1 : (k == 2 ? e2 : e3));
            const unsigned rk = atomicAdd(&p.ctl[CW_CNT + 64 * ei], 1u);
            p.sel[m * 4 + k] = ei; p.rnk[m * 4 + k] = (int)rk; p.prob[m * 4 + k] = mineexp / sum; }
        __syncthreads();
    }
}

__device__ __forceinline__ void phase9(const Params& p, LAS unsigned char* lds, const int wave) {
    const int tid = phase_tid(wave);
    const int bid = blockIdx.x, lane = tid & 63, wv = tid >> 6;
    LAS int* seg = (LAS int*)lds;
    if (tid == 0) { int s = 0;
        for (int e = 0; e < NE; ++e) { seg[e] = s; const int c = (int)xb_ld(&p.ctl[CW_CNT + 64 * e]); s += (c + 255) & ~255; }
        seg[NE] = s;
        if (bid == 0) { int t = 0;
            for (int e = 0; e < NE; ++e) { const int nt = (seg[e + 1] - seg[e]) >> 8; for (int i = 0; i < nt; ++i) p.ctl[CW_TILEE + t + i] = (unsigned)e; t += nt; }
            p.ctl[CW_NTILES] = (unsigned)t; } }
    __syncthreads();
    {
        const int gw = bid * NWAVES + wv; i32x4 e4[4], r4[4]; u32x4 v0[4], v1[4];
#pragma unroll
        for (int i = 0; i < 4; ++i) { const int m = gw + i * 2048; e4[i] = *(const i32x4*)(p.sel + m * 4); r4[i] = *(const i32x4*)(p.rnk + m * 4);
            const u32x4* src = (const u32x4*)(p.h2 + (size_t)m * ND); v0[i] = src[lane]; v1[i] = src[64 + lane]; }
#pragma unroll
        for (int i = 0; i < 4; ++i) { const int m = gw + i * 2048; i32x4 dd;
#pragma unroll
            for (int k = 0; k < 4; ++k) { dd[k] = seg[e4[i][k]] + r4[i][k]; u32x4* q = (u32x4*)(p.xb + (size_t)dd[k] * ND); q[lane] = v0[i]; q[64 + lane] = v1[i]; }
            if (lane == 0) *(i32x4*)(p.dest + m * 4) = dd; } }
    __syncthreads();
}

__device__ __forceinline__ void phase13(const Params& p, const int wave) {
    const int tid = phase_tid(wave);
    const int bid = blockIdx.x, lane0 = tid & 63, wv = wave;
    const int GW = gridDim.x * NWAVES;
    for (int m = bid * NWAVES + wv; m < NM; m += GW) { const int b = m >> 11;
        int lane = lane0; asm volatile("" : "+v"(lane));
        const float* g2 = p.mod + (size_t)b * NMOD + 5 * ND;
        int d[4]; float pr[4]; const f32x2 st = *(const f32x2*)(p.lnst + (size_t)m * 2);
#pragma unroll
        for (int k = 0; k < 4; ++k) { d[k] = p.dest[m * 4 + k]; pr[k] = p.prob[m * 4 + k]; }
        f32x4 z[8]; float s = 0.f; u32x4 yq[4][4];
#pragma unroll
        for (int j = 0; j < 4; ++j) {
#pragma unroll
            for (int k = 0; k < 4; ++k) yq[j][k] = ldu4nt(p.yb + (size_t)d[k] * ND + j * 512 + lane * 8);
            z[2 * j] = ld4nt(p.z1 + (size_t)m * ND + j * 512 + lane * 8); z[2 * j + 1] = ld4nt(p.z1 + (size_t)m * ND + j * 512 + lane * 8 + 4); }
#pragma unroll
        for (int j = 0; j < 4; ++j) { const int c = j * 512 + lane * 8; f32x4 f0 = {0.f, 0.f, 0.f, 0.f}, f1 = f0;
#pragma unroll
            for (int k = 0; k < 4; ++k) { f0 += bf4_unpack((u32x2){yq[j][k].x, yq[j][k].y}) * pr[k]; f1 += bf4_unpack((u32x2){yq[j][k].z, yq[j][k].w}) * pr[k]; }
            const f32x4 xa = (z[2 * j] - st[0]) * st[1] * ld4(p.ln1_g + c) + ld4(p.ln1_b + c), xb2 = (z[2 * j + 1] - st[0]) * st[1] * ld4(p.ln1_g + c + 4) + ld4(p.ln1_b + c + 4);
            z[2 * j] = xa * DN_ALPHA + ld4(g2 + c) * f0; z[2 * j + 1] = xb2 * DN_ALPHA + ld4(g2 + c + 4) * f1;
            s += ((z[2 * j][0] + z[2 * j][1]) + (z[2 * j][2] + z[2 * j][3])) + ((z[2 * j + 1][0] + z[2 * j + 1][1]) + (z[2 * j + 1][2] + z[2 * j + 1][3])); }
        const float mean = wave_allsum(s) * (1.0f / ND); float qv = 0.f;
#pragma unroll
        for (int j = 0; j < 8; ++j) { const f32x4 dd = z[j] - mean; qv += dot4(dd, dd); }
        const float rstd = rsqrtf(wave_allsum(qv) * (1.0f / ND) + LN_EPS);
#pragma unroll
        for (int j = 0; j < 8; ++j) { const int c = (j >> 1) * 512 + lane * 8 + (j & 1) * 4;
            *(f32x4*)(p.out + (size_t)m * ND + c) = (z[j] - mean) * rstd * ld4(p.ln2_g + c) + ld4(p.ln2_b + c); } }
}

__global__ void __launch_bounds__(NTHREADS, 2) fwd(Params p) {
    extern __shared__ __attribute__((aligned(16))) unsigned char shm[];
    LAS unsigned char* lds = (LAS unsigned char*)shm;
    const int bid = blockIdx.x, G = gridDim.x;
    const int wave = __builtin_amdgcn_readfirstlane(threadIdx.x >> 6);
    if (threadIdx.x == 0) *(LAS u32x4*)(lds + LDS_BARW) = (u32x4){0u, 0u, 0u, 0u};
    __syncthreads();
    XcdBarrier bar = xcd_barrier_post(p.bar, (volatile LAS unsigned*)(lds + LDS_BARW));

    phase0(p, lds, wave);
    xcd_barrier(bar, wave);
    if (PROBE == 3) { phase0(p, lds, wave); xcd_barrier(bar, wave); }
    phase1(p, lds, wave);
    xcd_barrier(bar, wave);
    if (PROBE == 3) { phase1(p, lds, wave); xcd_barrier(bar, wave); }
    {
        pg8::Gemm g{p.hb, p.wt_in, ND, ND, ND}; pg8::DenseOrder S; S.init(NM / 256, NINP / 256 - 2, G, bid, (size_t)256 * ND * 2, (size_t)256 * ND * 2); S.skip_from = 23; S.skip_n = 2;
        EpiP E{p.P}; pg8::gemm_phase(lds, g, S, E, wave);
        if (PROBE == 1) { __syncthreads(); pg8::gemm_phase(lds, g, S, E, wave); } }
    xcd_barrier(bar, wave);
    phase3(p, lds, wave);
    xcd_barrier(bar, wave);
    if (PROBE == 3) { phase3(p, lds, wave); xcd_barrier(bar, wave); }
    {
        pg8::Gemm g{p.hb, p.wt_in, ND, ND, ND}; WinRestOrder S{bid, (size_t)256 * ND * 2, (size_t)256 * ND * 2};
        EpiP E{p.P}; pg8::gemm_phase(lds, g, S, E, wave); }
    __syncthreads();
    {
        pg8::Gemm g{p.a_lora, p.bt_lora, LORA_K, LORA_K, LORA_K}; pg8::DenseOrder S; S.init(NM / 256, LORA_N / 256, G - 64, bid - 64, (size_t)256 * LORA_K * 2, (size_t)256 * LORA_K * 2);
        EpiLora E{p.dec, p.iclr, p.gg, p.w0, p.a0}; pg8::gemm_phase(lds, g, S, E, wave);
        if (PROBE == 1) { __syncthreads(); pg8::gemm_phase(lds, g, S, E, wave); } }
    __syncthreads();
    {
        pg8::Gemm g{p.dp, p.wt_pool, NC, 256, 256}; PoolOrder S{1 << 20, bid >= 64 ? bid - 64 : 192 + bid};
        EpiPool E{p.t1, p.P, p.pool_scale}; pg8::gemm_phase(lds, g, S, E, wave);
        if (PROBE == 1) { __syncthreads(); pg8::gemm_phase(lds, g, S, E, wave); } }
    xcd_barrier(bar, wave);
    if (bid < NB * NH) { scan_head(p, lds, bid, wave); if (PROBE == 4) scan_head(p, lds, bid, wave); }
    conv_queue(p, lds, wave, CW_CONV);
    if (PROBE == 5) conv_queue(p, lds, wave, CW_CONV2);
    xcd_barrier(bar, wave);
    if (PROBE == 2) { if (bid < NB * NH) scan_head(p, lds, bid, wave); conv_queue(p, lds, wave, CW_CONV2); xcd_barrier(bar, wave); }
    {
        pg8::Gemm g{p.yr, p.wt_rwkv, NC, NC, NC}; pg8::DenseOrder S; S.init(NM / 256, ND / 256, G, bid, (size_t)256 * NC * 2, (size_t)256 * NC * 2);
        EpiRwkv E{p.mx, p.P, p.t1}; pg8::gemm_phase(lds, g, S, E, wave);
        if (PROBE == 1) { __syncthreads(); pg8::gemm_phase(lds, g, S, E, wave); } }
    xcd_barrier(bar, wave);
    {
        pg8::Gemm g{p.mx, p.wt_out, ND, ND, ND}; pg8::DenseOrder S; S.init(NM / 256, ND / 256, G, bid, (size_t)256 * ND * 2, (size_t)256 * ND * 2);
        EpiWout E{p.z1, p.x, p.mod}; pg8::gemm_phase(lds, g, S, E, wave);
        if (PROBE == 1) { __syncthreads(); pg8::gemm_phase(lds, g, S, E, wave); } }
    xcd_barrier(bar, wave);
    phase8(p, lds, wave);
    xcd_barrier(bar, wave);
    phase9(p, lds, wave);
    xcd_barrier(bar, wave);
    if (PROBE == 3) { phase9(p, lds, wave); xcd_barrier(bar, wave); }
    const int ntiles = (int)xb_ld(&p.ctl[CW_NTILES]);
    {   const int t_ = phase_tid(wave); if (t_ < MAXTILES) *(LAS unsigned*)(lds + LDS_MISC + 4 * t_) = p.ctl[CW_TILEE + t_]; }
    __syncthreads();
    {
        pg8::Gemm g{(const bf16_t*)p.xb, (const bf16_t*)p.wt_gu, ND / 2, ND / 2, ND / 2};
        MoeOrder S{G, bid, 2 * DFF / 256, ntiles, (const LAS unsigned*)(lds + LDS_MISC), (size_t)256 * ND, (size_t)(2 * DFF) * ND, (size_t)256 * ND};
        EpiGU E{p.act, p.b_gu}; pg8::gemm_phase<EpiGU, MoeOrder, true>(lds, g, S, E, wave);
        if (PROBE == 1) { __syncthreads(); pg8::gemm_phase<EpiGU, MoeOrder, true>(lds, g, S, E, wave); } }
    conv_queue_tail(p, lds, wave);
    xcd_barrier(bar, wave);
    {
        pg8::Gemm g{(const bf16_t*)p.act, (const bf16_t*)p.wt_down, DFF / 2, DFF / 2, DFF / 2};
        MoeOrder S{G, bid, ND / 256, ntiles, (const LAS unsigned*)(lds + LDS_MISC), (size_t)256 * DFF, (size_t)ND * DFF, (size_t)256 * DFF};
        EpiDown E{p.yb, p.b_down}; pg8::gemm_phase<EpiDown, MoeOrder, true>(lds, g, S, E, wave);
        if (PROBE == 1) { __syncthreads(); pg8::gemm_phase<EpiDown, MoeOrder, true>(lds, g, S, E, wave); } }
    xcd_barrier(bar, wave);
    phase13(p, wave);
    if (PROBE == 3) { xcd_barrier(bar, wave); phase13(p, wave); }
}

static inline size_t align_up(size_t v, size_t a) { return (v + a - 1) / a * a; }

extern "C" void kernel_launch(void* const* d_in, const int* in_sizes, int n_in, void* d_out, int out_size, void* d_ws, size_t ws_size, hipStream_t stream) {
    (void)in_sizes; (void)n_in; (void)out_size;
    Params p{};
    const float** ins = (const float**)&p;
    for (int i = 0; i < 30; ++i) ins[i] = (const float*)d_in[i];
    p.out = (float*)d_out;
    char* ws = (char*)d_ws; size_t off = 0;
    auto take = [&](size_t bytes) { char* r = ws + off; off = align_up(off + bytes, 4096); return r; };
    const size_t ctl_bytes = (size_t)(XCD_BAR_WORDS + CTL_WORDS) * 4;
    p.bar = (unsigned*)take(ctl_bytes); p.ctl = p.bar + XCD_BAR_WORDS;
    p.modp = (float*)take((size_t)KS_MOD * 4 * NMOD * 4); p.mod = (float*)take((size_t)NB * NMOD * 4);
    p.hb = (bf16_t*)take((size_t)NM * ND * 2);
    p.wt_in = (bf16_t*)take((size_t)NINP * ND * 2); p.wt_rwkv = (bf16_t*)take((size_t)ND * NC * 2); p.wt_pool = (bf16_t*)take((size_t)ND * 256 * 2);
    p.wt_out = (bf16_t*)take((size_t)ND * ND * 2); p.bt_lora = (bf16_t*)take((size_t)LORA_N * LORA_K * 2);
    p.wt_gu = (fp8_t*)take((size_t)NE * 2 * DFF * ND); p.wt_down = (fp8_t*)take((size_t)NE * ND * DFF);
    p.P = (bf16_t*)take((size_t)NM * NINP * 2); p.a_lora = (bf16_t*)take((size_t)NM * LORA_K * 2); p.dp = (bf16_t*)take((size_t)NM * NC * 2);
    p.dec = (float*)take((size_t)NM * NC * 4); p.iclr = (bf16_t*)take((size_t)NM * NC * 2); p.gg = (bf16_t*)take((size_t)NM * NC * 2); p.t1 = (bf16_t*)take((size_t)NM * ND * 2);
    p.yr = (bf16_t*)take((size_t)NM * NC * 2); p.mx = (bf16_t*)take((size_t)NM * ND * 2); p.z1 = (float*)take((size_t)NM * ND * 4); p.lnst = (float*)take((size_t)NM * 2 * 4);
    p.h2 = (fp8_t*)take((size_t)NM * ND);
    p.sel = (int*)take((size_t)NM * TOPK * 4); p.rnk = (int*)take((size_t)NM * TOPK * 4); p.prob = (float*)take((size_t)NM * TOPK * 4); p.dest = (int*)take((size_t)NM * TOPK * 4);
    p.xb = (fp8_t*)take((size_t)MP * ND); p.act = (fp8_t*)take((size_t)MP * DFF); p.yb = (bf16_t*)take((size_t)MP * ND * 2);
    if (off > ws_size) { fprintf(stderr, "kernel_launch: workspace too small (%zu > %zu)\n", off, ws_size); return; }

    static int grid = 0;
    if (!grid) {
        int dev = 0, cus = 0, per_cu = 0;
        hipGetDevice(&dev); hipDeviceGetAttribute(&cus, hipDeviceAttributeMultiprocessorCount, dev);
        hipFuncSetAttribute((const void*)fwd, hipFuncAttributeMaxDynamicSharedMemorySize, LDS_BYTES);
        hipOccupancyMaxActiveBlocksPerMultiprocessor(&per_cu, (const void*)fwd, NTHREADS, LDS_BYTES);
        if (per_cu < 1) fprintf(stderr, "kernel_launch: occupancy query reports %d workgroups per CU\n", per_cu);
        if (cus != 256) fprintf(stderr, "kernel_launch: %d CUs; this kernel is laid out for 256\n", cus);
        grid = 256;
    }
    hipMemsetAsync(p.bar, 0, ctl_bytes, stream);
    hipLaunchKernelGGL(fwd, dim3(grid), dim3(NTHREADS), LDS_BYTES, stream, p);
}
```

```cpp
#include <hip/hip_runtime.h>
#include <cstdio>
#include <cstdint>

#ifndef PROBE
#define PROBE 0
#endif
#define LAS __attribute__((address_space(3)))
typedef unsigned short bf16_t;
typedef short bf16x8 __attribute__((ext_vector_type(8)));
typedef float f32x4 __attribute__((ext_vector_type(4)));
typedef float f32x2 __attribute__((ext_vector_type(2)));
typedef unsigned u32x4 __attribute__((ext_vector_type(4)));
typedef unsigned u32x2 __attribute__((ext_vector_type(2)));
typedef int i32x4 __attribute__((ext_vector_type(4)));
typedef int i32x8 __attribute__((ext_vector_type(8)));
typedef unsigned char fp8_t;
constexpr float W8_SCALE = 64.0f, W8_INV = 1.0f / 64.0f;

constexpr int NB = 4, NT = 2048, NM = NB * NT, ND = 2048, NC = 1024, NH = 16, HS = 64;
constexpr int NSHIFT = 3360, NIN = 8480, NINP = 8704;
constexpr int OFF_R = 0, OFF_K = 1024, OFF_V = 2048, OFF_WD = 3072, OFF_AD = 3136, OFF_GD = 3200, OFF_POOL = 3360, OFF_GA = 4384, OFF_GB = 6432;
constexpr int NE = 32, TOPK = 4, DFF = 2048;
constexpr int LORA_K = 384, LORA_N = 3072;
constexpr int MAXTILES = 160, MP = MAXTILES * 256;
constexpr int NMOD = 6 * ND;
constexpr int KS_MOD = 32;
constexpr float LN_EPS = 1e-5f, GN_EPS = 64e-5f;
constexpr float DN_ALPHA = 1.189207115002721f;
constexpr float SW_LIMIT = 7.0f, SW_ALPHA = 1.702f;
constexpr int NWAVES = 8, NTHREADS = 512;
constexpr int LDS_BYTES = 163840;
constexpr int LDS_EPI = 131072 + 2048;
constexpr int LDS_BARW = LDS_BYTES - 16;
constexpr int LDS_MISC = 131072;

constexpr int CW_CNT = 0;
constexpr int CW_CONV = 64 * 32;
constexpr int CW_CONV2 = 64 * 32 + 32;
constexpr int CW_CONV3 = 64 * 32 + 48;
constexpr int N_DEFER = 96;
constexpr int CW_NTILES = 64 * 33;
constexpr int CW_TILEE = 64 * 34;
constexpr int CTL_WORDS = 64 * 34 + 256;

#define XB_TMO      128
#define XB_XCNT(j)  (256  + 64 * (j))
#define XB_XSUB(j)  (1280 + 64 * (j))
#define XB_XGEN(j)  (2304 + 64 * (j))
#define XB_TOP      3328
#define XB_TOPGEN   3392
#define XCD_BAR_WORDS 3456
#define XB_SPIN_CAP (1u << 18)

__device__ __forceinline__ unsigned xb_ld(unsigned* p)              { return __hip_atomic_load(p, __ATOMIC_RELAXED, __HIP_MEMORY_SCOPE_AGENT); }
__device__ __forceinline__ unsigned xb_add(unsigned* p, unsigned v) { return __hip_atomic_fetch_add(p, v, __ATOMIC_RELAXED, __HIP_MEMORY_SCOPE_AGENT); }
__device__ __forceinline__ unsigned xb_xcc_id() { return (unsigned)__builtin_amdgcn_s_getreg((3 << 11) | 20) & 0xFu; }
#define XB_SPIN(cond, bar) do { unsigned _sp = 0; while (cond) { __builtin_amdgcn_s_sleep(1); \
    if ((++_sp & 255u) == 0u) { if (xb_ld(&(bar)[XB_TMO])) break; if (_sp > XB_SPIN_CAP) { atomicAdd(&(bar)[XB_TMO], 1u); break; } } } } while (0)

__device__ __forceinline__ int phase_tid(int wave);
struct XcdBarrier { unsigned* bar; unsigned x; volatile LAS unsigned* st; };

__device__ __forceinline__ XcdBarrier xcd_barrier_post(unsigned* bar, volatile LAS unsigned* st) {
    XcdBarrier b; b.bar = bar; b.x = xb_xcc_id(); b.st = st;
    if (threadIdx.x == 0) (void)xb_add(&bar[XB_XCNT(b.x)], 1u);
    return b;
}
__device__ __forceinline__ void xcd_barrier_complete(unsigned* bar, unsigned x, unsigned& nloc, unsigned& nx) {
    const unsigned G = gridDim.x * gridDim.y * gridDim.z;
    unsigned sum, cnt, mine, sp = 0u;
    for (;;) {
        sum = 0u; cnt = 0u; mine = 0u;
#pragma unroll
        for (unsigned j = 0; j < 16; ++j) { const unsigned c = xb_ld(&bar[XB_XCNT(j)]); sum += c; cnt += (c > 0u) ? 1u : 0u; mine = (j == x) ? c : mine; }
        if (sum == G) break;
        __builtin_amdgcn_s_sleep(1);
        if ((++sp & 255u) == 0u) { if (xb_ld(&bar[XB_TMO])) break; if (sp > XB_SPIN_CAP) { atomicAdd(&bar[XB_TMO], 1u); break; } }
    }
    nloc = mine > 0u ? mine : 1u; nx = cnt > 0u ? cnt : 1u;
}
__device__ __forceinline__ void xcd_barrier(const XcdBarrier& b, const int wave) {
    asm volatile("s_waitcnt vmcnt(0)" ::: "memory");
    __syncthreads();
    if (phase_tid(wave) == 0) {
        unsigned* bar = b.bar;
        __builtin_amdgcn_s_waitcnt(0);
        unsigned nloc = b.st[0], nx = b.st[1];
        if (nloc == 0u) { xcd_barrier_complete(bar, b.x, nloc, nx); b.st[0] = nloc; b.st[1] = nx; }
        const unsigned old = xb_add(&bar[XB_XSUB(b.x)], 1u);
        const unsigned gen = old / nloc;
        if (old + 1u == (gen + 1u) * nloc) {
            __builtin_amdgcn_fence(__ATOMIC_RELEASE, "agent");
            asm volatile("s_waitcnt vmcnt(0)" ::: "memory");
            const unsigned og = xb_add(&bar[XB_TOP], 1u);
            const unsigned tg = og / nx;
            if (og + 1u == (tg + 1u) * nx) xb_add(&bar[XB_TOPGEN], 1u);
            else XB_SPIN(xb_ld(&bar[XB_TOPGEN]) == tg, bar);
            __builtin_amdgcn_fence(__ATOMIC_ACQUIRE, "agent");
            xb_add(&bar[XB_XGEN(b.x)], 1u);
            asm volatile("s_waitcnt vmcnt(0)" ::: "memory");
        } else {
            XB_SPIN(xb_ld(&bar[XB_XGEN(b.x)]) == gen, bar);
            __builtin_amdgcn_fence(__ATOMIC_ACQUIRE, "agent");
            asm volatile("s_waitcnt vmcnt(0)" ::: "memory");
        }
    }
    __syncthreads();
}

__device__ __forceinline__ int phase_tid(int wave) {
    int lane; asm volatile("v_mbcnt_lo_u32_b32 %0, -1, 0\n\tv_mbcnt_hi_u32_b32 %0, -1, %0" : "=v"(lane));
    return wave * 64 + lane;
}
typedef __bf16 bf16x2_t __attribute__((ext_vector_type(2)));
__device__ __forceinline__ unsigned cvt_pk_bf16(float lo, float hi) { return __builtin_bit_cast(unsigned, __builtin_convertvector((f32x2){lo, hi}, bf16x2_t)); }
template <int CTRL> __device__ __forceinline__ float dpp_f(float x) {
    return __builtin_bit_cast(float, __builtin_amdgcn_update_dpp(0, __builtin_bit_cast(int, x), CTRL, 0xf, 0xf, false));
}
__device__ __forceinline__ float row16_allsum(float x) {
    x += dpp_f<0x128>(x); x += dpp_f<0x124>(x); x += dpp_f<0x122>(x); x += dpp_f<0x121>(x); return x;
}
__device__ __forceinline__ float wave_allsum(float x) {
    x = row16_allsum(x);
    const int xi = __builtin_bit_cast(int, x);
    return (__builtin_bit_cast(float, __builtin_amdgcn_readlane(xi, 0)) + __builtin_bit_cast(float, __builtin_amdgcn_readlane(xi, 16))) +
           (__builtin_bit_cast(float, __builtin_amdgcn_readlane(xi, 32)) + __builtin_bit_cast(float, __builtin_amdgcn_readlane(xi, 48)));
}
__device__ __forceinline__ unsigned pack4_fp8(float a, float b, float c, float d) { int r = 0; r = __builtin_amdgcn_cvt_pk_fp8_f32(a, b, r, false); r = __builtin_amdgcn_cvt_pk_fp8_f32(c, d, r, true); return (unsigned)r; }
__device__ __forceinline__ f32x2 bf2_unpack(unsigned u) { return (f32x2){__uint_as_float(u << 16), __uint_as_float(u & 0xffff0000u)}; }
__device__ __forceinline__ f32x4 bf4_unpack(u32x2 u) { const f32x2 a = bf2_unpack(u.x), b = bf2_unpack(u.y); return (f32x4){a[0], a[1], b[0], b[1]}; }
__device__ __forceinline__ float bf1(bf16_t h) { return __uint_as_float(((unsigned)h) << 16); }
__device__ __forceinline__ float sigmoidf_(float v) { return __builtin_amdgcn_rcpf(1.0f + __builtin_amdgcn_exp2f(v * -1.4426950408889634f)); }
__device__ __forceinline__ f32x4 ld4(const float* p) { return *(const f32x4*)p; }
__device__ __forceinline__ f32x4 ld4nt(const float* p) { return __builtin_nontemporal_load((const f32x4*)p); }
__device__ __forceinline__ u32x4 ldu4nt(const void* p) { return __builtin_nontemporal_load((const u32x4*)p); }
__device__ __forceinline__ float dot4(f32x4 a, f32x4 b) { return (a[0] * b[0] + a[1] * b[1]) + (a[2] * b[2] + a[3] * b[3]); }

struct Params {
    const float *x, *c, *w_ada, *b_ada, *w_in, *mu_shift, *w0, *w_decay_up, *a0, *w_iclr_up, *w_glora_up, *k_k, *k_a, *r_k, *lnx_g, *lnx_b,
                *w_rwkv_out, *w_pool, *pool_scale, *w_out, *ln1_g, *ln1_b, *w_router, *b_router, *w_gu, *b_gu, *w_down, *b_down, *ln2_g, *ln2_b;
    float* out;
    unsigned* bar; unsigned* ctl;
    float* modp; float* mod;
    bf16_t* hb; bf16_t* wt_in; bf16_t* wt_rwkv; bf16_t* wt_pool; bf16_t* wt_out; bf16_t* bt_lora; fp8_t* wt_gu; fp8_t* wt_down;
    bf16_t* P; bf16_t* a_lora; bf16_t* dp; float* dec; bf16_t* iclr; bf16_t* gg; bf16_t* t1;
    bf16_t* yr; bf16_t* mx; float* z1; float* lnst; fp8_t* h2;
    int* sel; int* rnk; float* prob; int* dest;
    fp8_t* xb; fp8_t* act; bf16_t* yb;
};

namespace pg8 {
constexpr int BM = 256, BK = 64, HALF = 128, HTB = HALF * BK * 2, STAGE_BYTES = 8 * HTB, NXCD = 8, WGM = 8;
__host__ __device__ __forceinline__ int lds_byte(int r, int c) { const int st = (r >> 4) * 2 + (c >> 5), rr = r & 15, cc = c & 31, ob = rr * 64 + cc * 2; return st * 1024 + (ob ^ (((ob >> 9) & 1) << 5)); }
__host__ __device__ __forceinline__ void stage_rc(int b, int& R, int& C) { const int st = b / 1024, sb = b % 1024, swz = sb ^ (((sb >> 9) & 1) << 5); R = (st >> 1) * 16 + swz / 64; C = (st & 1) * 32 + (swz % 64) / 2; }
__host__ __device__ __forceinline__ int perm32(int rho) { const int n = rho >> 4, i = rho & 15; return 8 * (i >> 2) + 4 * n + (i & 3); }

struct Unit { int pm, pn, e; unsigned aoff, boff; };
struct Gemm { const bf16_t* A; const bf16_t* Bt; int lda, ldb, K; };

struct DenseOrder {
    int nM, nN, nwg, G, c, skip_from = 1 << 30, skip_n = 0; size_t a_tile, b_tile;
    __device__ void init(int nM_, int nN_, int G_, int c_, size_t a_tile_, size_t b_tile_) { nM = nM_; nN = nN_; nwg = nM * nN; G = G_; c = c_; a_tile = a_tile_; b_tile = b_tile_; }
    __device__ bool next(int i, Unit& u) const {
        const long L = (long)i * G + c; if (c < 0 || L >= nwg) return false;
        int wgid = (int)L; { const int q = nwg / NXCD, r = nwg % NXCD, xcd = wgid % NXCD, off = wgid / NXCD; wgid = (xcd < r ? xcd * (q + 1) : r * (q + 1) + (xcd - r) * q) + off; }
        const int nig = WGM * nN, gid = wgid / nig, fm = gid * WGM, gsz = (nM - fm) < WGM ? (nM - fm) : WGM;
        u.pm = fm + ((wgid % nig) % gsz); u.pn = (wgid % nig) / gsz; u.e = 0; if (u.pn >= skip_from) u.pn += skip_n;
        u.aoff = (unsigned)((size_t)u.pm * a_tile); u.boff = (unsigned)((size_t)u.pn * b_tile); return true;
    }
};

template <class Epi, class Sched, bool FP8 = false>
__device__ __forceinline__ void gemm_phase(LAS unsigned char* lds, const Gemm g, const Sched& S, const Epi& E, const int wave) {
    const int tid = phase_tid(wave);
    const int wid = __builtin_amdgcn_readfirstlane(tid >> 6), lane = tid & 63, wr = wid >> 2, wc = wid & 3, fr = lane & 15, fq = lane >> 4;
    const int K = g.K, nt = K / BK;
    unsigned voffA, voffB;
    {   int R, C; stage_rc(tid * 16, R, C); const int Rb = Epi::PERM ? ((R & ~31) + perm32(R & 31)) : R;
        voffA = (unsigned)(R * g.lda + C) * 2u; voffB = (unsigned)(Rb * g.ldb + C) * 2u; }
    const unsigned pieceA = 64u * (unsigned)g.lda * 2u, pieceB = 64u * (unsigned)g.ldb * 2u;
    const unsigned kstep = (unsigned)(BK * 2);
    const unsigned hstepA = (unsigned)HALF * g.lda * 2u, hstepB = (unsigned)HALF * g.ldb * 2u;
    const __amdgpu_buffer_rsrc_t rsA = __builtin_amdgcn_make_buffer_rsrc((void*)g.A, (short)0, -1, 0x00020000), rsB = __builtin_amdgcn_make_buffer_rsrc((void*)g.Bt, (short)0, -1, 0x00020000);
    const unsigned ldsw = (unsigned)wid * 1024u;
    const int aoff = lds_byte(wr * 64 + fr, fq * 8), boff = lds_byte(wc * 32 + fr, fq * 8);
#define PG8_SA(b, h) (((b) * 2 + (h)) * HTB)
#define PG8_SB(b, h) ((4 + (b) * 2 + (h)) * HTB)
#define PG8_STAGE(bufoff, rs, soff, voff) do { _Pragma("unroll") for (int _i = 0; _i < 2; ++_i) \
        __builtin_amdgcn_raw_ptr_buffer_load_lds(rs, (LAS void*)(lds + (bufoff) + ldsw + _i * 8192), 16, (voff), (soff) + _i * ((&(voff) == &voffA) ? pieceA : pieceB), 0, 0); } while (0)
#define PG8_LDA(dst, b, h) do { _Pragma("unroll") for (int m = 0; m < 4; ++m) _Pragma("unroll") for (int k = 0; k < 2; ++k) dst[m][k] = *(const LAS bf16x8*)(lds + PG8_SA(b, h) + aoff + m * 2048 + k * 1024); } while (0)
#define PG8_LDB(dst, b, h) do { _Pragma("unroll") for (int n = 0; n < 2; ++n) _Pragma("unroll") for (int k = 0; k < 2; ++k) dst[n][k] = *(const LAS bf16x8*)(lds + PG8_SB(b, h) + boff + n * 2048 + k * 1024); } while (0)
#define PG8_CAT(x) __builtin_shufflevector(__builtin_bit_cast(i32x4, (x)[0]), __builtin_bit_cast(i32x4, (x)[1]), 0, 1, 2, 3, 4, 5, 6, 7)
#define PG8_MMA(ai, bj, At, Bt) do { __builtin_amdgcn_s_setprio(1); \
        if constexpr (FP8) { _Pragma("unroll") for (int m = 0; m < 4; ++m) _Pragma("unroll") for (int n = 0; n < 2; ++n) \
            acc[ai][bj][m][n] = __builtin_amdgcn_mfma_scale_f32_16x16x128_f8f6f4(PG8_CAT(Bt[n]), PG8_CAT(At[m]), acc[ai][bj][m][n], 0, 0, 0, 0x7F7F7F7F, 0, 0x7F7F7F7F); } \
        else { _Pragma("unroll") for (int m = 0; m < 4; ++m) _Pragma("unroll") for (int n = 0; n < 2; ++n) _Pragma("unroll") for (int k = 0; k < 2; ++k) \
            acc[ai][bj][m][n] = __builtin_amdgcn_mfma_f32_16x16x32_bf16(Bt[n][k], At[m][k], acc[ai][bj][m][n], 0, 0, 0); } \
        __builtin_amdgcn_s_setprio(0); } while (0)
#define PG8_WAIT_V(n) asm volatile("s_waitcnt vmcnt(" #n ")" ::: "memory")
#define PG8_WAIT_L(n) asm volatile("s_waitcnt lgkmcnt(" #n ")" ::: "memory")
#define PG8_BAR __builtin_amdgcn_s_barrier()
#define PG8_SCHED __builtin_amdgcn_sched_barrier(0)
    Unit cur, nxt; int ui = 0;
    if (!S.next(0, cur)) return;
    f32x4 acc[2][2][4][2];
#pragma unroll
    for (int a = 0; a < 2; ++a)
#pragma unroll
        for (int b = 0; b < 2; ++b)
#pragma unroll
            for (int m = 0; m < 4; ++m)
#pragma unroll
                for (int n = 0; n < 2; ++n) acc[a][b][m][n] = (f32x4){0.f, 0.f, 0.f, 0.f};
    bf16x8 At[4][2], B0[2][2], B1[2][2];
    unsigned cA = cur.aoff, cB = cur.boff;
    PG8_STAGE(PG8_SB(0, 0), rsB, cB, voffB); PG8_STAGE(PG8_SA(0, 0), rsA, cA, voffA); PG8_STAGE(PG8_SB(0, 1), rsB, cB + hstepB, voffB); PG8_STAGE(PG8_SA(0, 1), rsA, cA + hstepA, voffA);
    if (wr == 1) PG8_BAR;
    PG8_WAIT_V(4); PG8_BAR;
    PG8_STAGE(PG8_SB(1, 0), rsB, cB + kstep, voffB); PG8_STAGE(PG8_SA(1, 0), rsA, cA + kstep, voffA); PG8_STAGE(PG8_SB(1, 1), rsB, cB + hstepB + kstep, voffB);
    PG8_WAIT_V(6); PG8_BAR;
    for (;;) {
        const bool has_next = S.next(ui + 1, nxt);
        const unsigned nA = has_next ? nxt.aoff : cA, nB = has_next ? nxt.boff : cB;
        for (int t = 0; t < nt; t += 2) {
            const bool last = (t == nt - 2);
            const unsigned a1 = cA + (unsigned)(t + 1) * kstep;
            const unsigned a2 = last ? nA : cA + (unsigned)(t + 2) * kstep, b2 = last ? nB : cB + (unsigned)(t + 2) * kstep;
            const unsigned a3 = a2 + kstep, b3 = b2 + kstep;
            PG8_LDB(B0, 0, 0); PG8_SCHED; PG8_LDA(At, 0, 0); PG8_STAGE(PG8_SA(1, 1), rsA, a1 + hstepA, voffA);
            PG8_WAIT_L(8); PG8_BAR; PG8_WAIT_L(0); PG8_MMA(0, 0, At, B0); PG8_BAR; PG8_SCHED;
            PG8_LDB(B1, 0, 1); PG8_STAGE(PG8_SB(0, 0), rsB, b2, voffB);
            PG8_BAR; PG8_WAIT_L(0); PG8_MMA(0, 1, At, B1); PG8_BAR;
            PG8_LDA(At, 0, 1); PG8_STAGE(PG8_SA(0, 0), rsA, a2, voffA);
            PG8_BAR; PG8_WAIT_L(0); PG8_MMA(1, 0, At, B0); PG8_BAR; PG8_SCHED;
            PG8_STAGE(PG8_SB(0, 1), rsB, b2 + hstepB, voffB);
            PG8_WAIT_V(6); PG8_BAR; PG8_MMA(1, 1, At, B1); PG8_BAR;
            PG8_LDB(B0, 1, 0); PG8_SCHED; PG8_LDA(At, 1, 0); PG8_STAGE(PG8_SA(0, 1), rsA, a2 + hstepA, voffA);
            PG8_WAIT_L(8); PG8_BAR; PG8_WAIT_L(0); PG8_MMA(0, 0, At, B0); PG8_BAR; PG8_SCHED;
            PG8_LDB(B1, 1, 1); PG8_STAGE(PG8_SB(1, 0), rsB, b3, voffB);
            PG8_BAR; PG8_WAIT_L(0); PG8_MMA(0, 1, At, B1); PG8_BAR;
            PG8_LDA(At, 1, 1); PG8_STAGE(PG8_SA(1, 0), rsA, a3, voffA);
            PG8_BAR; PG8_WAIT_L(0); PG8_MMA(1, 0, At, B0); PG8_BAR; PG8_SCHED;
            PG8_STAGE(PG8_SB(1, 1), rsB, b3 + hstepB, voffB);
            PG8_WAIT_V(6); PG8_BAR; PG8_MMA(1, 1, At, B1); PG8_BAR;
        }
        { const int l2 = phase_tid(wave) & 63; E(acc, cur, wr, wc, l2 & 15, l2 >> 4); }
        if (!has_next) break;
#pragma unroll
        for (int a = 0; a < 2; ++a)
#pragma unroll
            for (int b = 0; b < 2; ++b)
#pragma unroll
                for (int m = 0; m < 4; ++m)
#pragma unroll
                    for (int n = 0; n < 2; ++n) acc[a][b][m][n] = (f32x4){0.f, 0.f, 0.f, 0.f};
        cur = nxt; cA = nA; cB = nB; ++ui;
    }
    PG8_WAIT_V(0);
    if (wr == 0) PG8_BAR;
    PG8_BAR;
#undef PG8_SA
#undef PG8_SB
#undef PG8_STAGE
#undef PG8_LDA
#undef PG8_LDB
#undef PG8_MMA
#undef PG8_CAT
#undef PG8_WAIT_V
#undef PG8_WAIT_L
#undef PG8_BAR
#undef PG8_SCHED
}
}
using pg8::Unit;

#define EPI_LOOP_BEGIN \
    _Pragma("unroll") for (int ai = 0; ai < 2; ++ai) _Pragma("unroll") for (int m = 0; m < 4; ++m) { const int r = u.pm * 256 + ai * 128 + wr * 64 + m * 16 + fr; \
    _Pragma("unroll") for (int bj = 0; bj < 2; ++bj) _Pragma("unroll") for (int n = 0; n < 2; ++n) { const int cl = bj * 128 + wc * 32 + 16 * n + 4 * fq; const f32x4 a = acc[ai][bj][m][n];
#define EPI_LOOP_END } }

struct EpiP {
    static constexpr bool PERM = true; bf16_t* C;
    __device__ __forceinline__ void operator()(const f32x4 (&acc)[2][2][4][2], const Unit& u, int wr, int wc, int fr, int fq) const {
#pragma unroll
        for (int ai = 0; ai < 2; ++ai)
#pragma unroll
            for (int m = 0; m < 4; ++m) { const int r = u.pm * 256 + ai * 128 + wr * 64 + m * 16 + fr;
#pragma unroll
                for (int bj = 0; bj < 2; ++bj) { const int c0 = u.pn * 256 + bj * 128 + wc * 32 + 8 * fq; const f32x4 v0 = acc[ai][bj][m][0], v1 = acc[ai][bj][m][1];
                    u32x4 w; w.x = cvt_pk_bf16(v0[0], v0[1]); w.y = cvt_pk_bf16(v0[2], v0[3]); w.z = cvt_pk_bf16(v1[0], v1[1]); w.w = cvt_pk_bf16(v1[2], v1[3]);
                    *(u32x4*)(C + (size_t)r * NINP + c0) = w; } }
    }
};
#define EPI_COLS(ptr) f32x4 cv[2][2]; _Pragma("unroll") for (int bj = 0; bj < 2; ++bj) _Pragma("unroll") for (int n = 0; n < 2; ++n) cv[bj][n] = ld4((ptr) + bj * 128 + wc * 32 + 16 * n + 4 * fq);
#define EPI_COLS_PERM(ptr) f32x4 cv[2][2]; _Pragma("unroll") for (int bj = 0; bj < 2; ++bj) _Pragma("unroll") for (int n = 0; n < 2; ++n) cv[bj][n] = ld4((ptr) + bj * 128 + wc * 32 + 8 * fq + 4 * n);
struct EpiLora {
    static constexpr bool PERM = false; float* dec; bf16_t *iclr, *gg; const float *w0, *a0;
    __device__ __forceinline__ void operator()(const f32x4 (&acc)[2][2][4][2], const Unit& u, int wr, int wc, int fr, int fq) const {
        const int sect = u.pn >> 2, cb = (u.pn & 3) * 256;
        EPI_COLS((sect == 0 ? w0 : a0) + cb)
        EPI_LOOP_BEGIN
            const int c = cb + cl; f32x4 o;
            if (sect == 0) {
#pragma unroll
                for (int j = 0; j < 4; ++j) o[j] = __builtin_amdgcn_exp2f(-0.6065306597126334f * 1.4426950408889634f * sigmoidf_(cv[bj][n][j] + a[j]));
                *(f32x4*)(dec + (size_t)r * NC + c) = o; }
            else if (sect == 1) {
#pragma unroll
                for (int j = 0; j < 4; ++j) o[j] = sigmoidf_(cv[bj][n][j] + a[j]);
                u32x2 wv; wv.x = cvt_pk_bf16(o[0], o[1]); wv.y = cvt_pk_bf16(o[2], o[3]); *(u32x2*)(iclr + (size_t)r * NC + c) = wv; }
            else { u32x2 wv; wv.x = cvt_pk_bf16(a[0], a[1]); wv.y = cvt_pk_bf16(a[2], a[3]); *(u32x2*)(gg + (size_t)r * NC + c) = wv; }
        EPI_LOOP_END
    }
};
struct EpiPool {
    static constexpr bool PERM = true; bf16_t* t1; const bf16_t* P; const float* pscale;
    __device__ __forceinline__ void operator()(const f32x4 (&acc)[2][2][4][2], const Unit& u, int wr, int wc, int fr, int fq) const {
        EPI_COLS_PERM(pscale + u.pn * 256)
#pragma unroll
        for (int ai = 0; ai < 2; ++ai) { u32x4 gq[4][2];
#pragma unroll
            for (int m = 0; m < 4; ++m)
#pragma unroll
                for (int bj = 0; bj < 2; ++bj) gq[m][bj] = ldu4nt(P + (size_t)(u.pm * 256 + ai * 128 + wr * 64 + m * 16 + fr) * NINP + OFF_GB + u.pn * 256 + bj * 128 + wc * 32 + 8 * fq);
#pragma unroll
            for (int m = 0; m < 4; ++m) { const int r = u.pm * 256 + ai * 128 + wr * 64 + m * 16 + fr;
#pragma unroll
                for (int bj = 0; bj < 2; ++bj) { const int c0 = u.pn * 256 + bj * 128 + wc * 32 + 8 * fq;
                    const f32x4 g0 = bf4_unpack((u32x2){gq[m][bj].x, gq[m][bj].y}), g1 = bf4_unpack((u32x2){gq[m][bj].z, gq[m][bj].w}), a0 = acc[ai][bj][m][0], a1 = acc[ai][bj][m][1]; f32x4 o0, o1;
#pragma unroll
                    for (int j = 0; j < 4; ++j) { o0[j] = sigmoidf_(g0[j]) * cv[bj][0][j] * a0[j]; o1[j] = sigmoidf_(g1[j]) * cv[bj][1][j] * a1[j]; }
                    u32x4 w; w.x = cvt_pk_bf16(o0[0], o0[1]); w.y = cvt_pk_bf16(o0[2], o0[3]); w.z = cvt_pk_bf16(o1[0], o1[1]); w.w = cvt_pk_bf16(o1[2], o1[3]);
                    *(u32x4*)(t1 + (size_t)r * ND + c0) = w; } } }
    }
};
struct EpiRwkv {
    static constexpr bool PERM = true; bf16_t* mx; const bf16_t* P; const bf16_t* t1;
    __device__ __forceinline__ void operator()(const f32x4 (&acc)[2][2][4][2], const Unit& u, int wr, int wc, int fr, int fq) const {
#pragma unroll
        for (int ai = 0; ai < 2; ++ai) { u32x4 gq[4][2], tq[4][2];
#pragma unroll
            for (int m = 0; m < 4; ++m)
#pragma unroll
                for (int bj = 0; bj < 2; ++bj) { const int r = u.pm * 256 + ai * 128 + wr * 64 + m * 16 + fr, c0 = u.pn * 256 + bj * 128 + wc * 32 + 8 * fq;
                    gq[m][bj] = ldu4nt(P + (size_t)r * NINP + OFF_GA + c0); tq[m][bj] = ldu4nt(t1 + (size_t)r * ND + c0); }
#pragma unroll
            for (int m = 0; m < 4; ++m) { const int r = u.pm * 256 + ai * 128 + wr * 64 + m * 16 + fr;
#pragma unroll
                for (int bj = 0; bj < 2; ++bj) { const int c0 = u.pn * 256 + bj * 128 + wc * 32 + 8 * fq;
                    const f32x4 g0 = bf4_unpack((u32x2){gq[m][bj].x, gq[m][bj].y}), g1 = bf4_unpack((u32x2){gq[m][bj].z, gq[m][bj].w});
                    const f32x4 t0 = bf4_unpack((u32x2){tq[m][bj].x, tq[m][bj].y}), t1v = bf4_unpack((u32x2){tq[m][bj].z, tq[m][bj].w}), a0 = acc[ai][bj][m][0], a1 = acc[ai][bj][m][1]; f32x4 o0, o1;
#pragma unroll
                    for (int j = 0; j < 4; ++j) { o0[j] = sigmoidf_(g0[j]) * a0[j] + t0[j]; o1[j] = sigmoidf_(g1[j]) * a1[j] + t1v[j]; }
                    u32x4 w; w.x = cvt_pk_bf16(o0[0], o0[1]); w.y = cvt_pk_bf16(o0[2], o0[3]); w.z = cvt_pk_bf16(o1[0], o1[1]); w.w = cvt_pk_bf16(o1[2], o1[3]);
                    *(u32x4*)(mx + (size_t)r * ND + c0) = w; } } }
    }
};
struct EpiWout {
    static constexpr bool PERM = true; float* z1; const float* x; const float* mod;
    __device__ __forceinline__ void operator()(const f32x4 (&acc)[2][2][4][2], const Unit& u, int wr, int wc, int fr, int fq) const {
        const int b = u.pm >> 3;
        EPI_COLS_PERM(mod + (size_t)b * NMOD + 2 * ND + u.pn * 256)
#pragma unroll
        for (int ai = 0; ai < 2; ++ai)
#pragma unroll
            for (int mh = 0; mh < 2; ++mh) { f32x4 xq[2][2][2];
#pragma unroll
                for (int m2 = 0; m2 < 2; ++m2)
#pragma unroll
                    for (int bj = 0; bj < 2; ++bj)
#pragma unroll
                        for (int n = 0; n < 2; ++n) xq[m2][bj][n] = ld4nt(x + (size_t)(u.pm * 256 + ai * 128 + wr * 64 + (mh * 2 + m2) * 16 + fr) * ND + u.pn * 256 + bj * 128 + wc * 32 + 8 * fq + 4 * n);
#pragma unroll
                for (int m2 = 0; m2 < 2; ++m2) { const int m = mh * 2 + m2, r = u.pm * 256 + ai * 128 + wr * 64 + m * 16 + fr;
#pragma unroll
                    for (int bj = 0; bj < 2; ++bj)
#pragma unroll
                        for (int n = 0; n < 2; ++n) { const int c = u.pn * 256 + bj * 128 + wc * 32 + 8 * fq + 4 * n;
                            *(f32x4*)(z1 + (size_t)r * ND + c) = xq[m2][bj][n] * DN_ALPHA + cv[bj][n] * acc[ai][bj][m][n]; } } }
    }
};
struct EpiGU {
    static constexpr bool PERM = true; fp8_t* act; const float* b_gu; LAS unsigned char* lds;
    __device__ __forceinline__ void operator()(const f32x4 (&acc)[2][2][4][2], const Unit& u, int wr, int wc, int fr, int fq) const {
        const float* bias = b_gu + (size_t)u.e * (2 * DFF) + u.pn * 256 + wc * 32 + 8 * fq;
        LAS unsigned char* const buf = lds + LDS_EPI + wr * 9216;
#pragma unroll
        for (int ai = 0; ai < 2; ++ai) {
#pragma unroll
            for (int bj = 0; bj < 2; ++bj) { const f32x4 c0v = ld4(bias + bj * 128), c1v = ld4(bias + bj * 128 + 4);
#pragma unroll
                for (int m = 0; m < 4; ++m) {
                    const f32x4 v0 = acc[ai][bj][m][0] * W8_INV + c0v, v1 = acc[ai][bj][m][1] * W8_INV + c1v;
                    float o[4];
#pragma unroll
                    for (int j = 0; j < 4; ++j) { const float gt = fminf(j < 2 ? v0[2 * j] : v1[2 * j - 4], SW_LIMIT); const float up = fminf(fmaxf(j < 2 ? v0[2 * j + 1] : v1[2 * j - 3], -SW_LIMIT), SW_LIMIT);
                        o[j] = (up + 1.0f) * (gt * __builtin_amdgcn_rcpf(1.0f + __builtin_amdgcn_exp2f(gt * (-SW_ALPHA * 1.4426950408889634f)))); }
                    *(LAS unsigned*)(buf + (m * 16 + fr) * 144 + bj * 64 + wc * 16 + fq * 4) = pack4_fp8(o[0], o[1], o[2], o[3]); } }
            asm volatile("s_waitcnt lgkmcnt(0)" ::: "memory"); __builtin_amdgcn_s_barrier(); asm volatile("" ::: "memory");
            {   const int l2 = fr + 16 * fq;
#pragma unroll
                for (int i = 0; i < 2; ++i) { const int idx = wc * 64 + l2 + i * 256, row = idx >> 3, ck = idx & 7;
                    const u32x4 w = *(const LAS u32x4*)(buf + row * 144 + ck * 16);
                    *(u32x4*)(act + (size_t)(u.pm * 256 + ai * 128 + wr * 64 + row) * DFF + u.pn * 128 + ck * 16) = w; } }
            asm volatile("s_waitcnt lgkmcnt(0)" ::: "memory"); __builtin_amdgcn_s_barrier(); asm volatile("" ::: "memory");
        }
    }
};
struct EpiDown {
    static constexpr bool PERM = true; bf16_t* yb; const float* b_down;
    __device__ __forceinline__ void operator()(const f32x4 (&acc)[2][2][4][2], const Unit& u, int wr, int wc, int fr, int fq) const {
        const float* bias = b_down + (size_t)u.e * ND + u.pn * 256 + wc * 32 + 8 * fq;
#pragma unroll
        for (int bj = 0; bj < 2; ++bj) { const f32x4 c0v = ld4(bias + bj * 128), c1v = ld4(bias + bj * 128 + 4); const int c0 = u.pn * 256 + bj * 128 + wc * 32 + 8 * fq;
#pragma unroll
            for (int ai = 0; ai < 2; ++ai)
#pragma unroll
                for (int m = 0; m < 4; ++m) { const int r = u.pm * 256 + ai * 128 + wr * 64 + m * 16 + fr;
                    const f32x4 v0 = acc[ai][bj][m][0] * W8_INV + c0v, v1 = acc[ai][bj][m][1] * W8_INV + c1v;
                    u32x4 w; w.x = cvt_pk_bf16(v0[0], v0[1]); w.y = cvt_pk_bf16(v0[2], v0[3]); w.z = cvt_pk_bf16(v1[0], v1[1]); w.w = cvt_pk_bf16(v1[2], v1[3]);
                    *(u32x4*)(yb + (size_t)r * ND + c0) = w; } }
    }
};

struct WinRestOrder {
    int c; size_t a_tile, b_tile;
    __device__ bool next(int i, Unit& u) const {
        if (i > 0 || c < 0 || c >= 64) return false;
        u.pm = c >> 1; u.pn = 23 + (c & 1); u.e = 0; u.aoff = (unsigned)((size_t)u.pm * a_tile); u.boff = (unsigned)((size_t)u.pn * b_tile); return true;
    }
};
struct PoolOrder {
    int G, c;
    __device__ bool next(int i, Unit& u) const {
        const int L = i * G + c; if (c < 0 || L >= 256) return false;
        u.pm = L >> 3; u.pn = L & 7; u.e = 0;
        u.aoff = (unsigned)(((size_t)u.pm * 256 * NC + (size_t)(u.pn >> 1) * 256) * 2); u.boff = (unsigned)((size_t)u.pn * 256 * 256 * 2); return true;
    }
};
struct MoeOrder {
    int G, c, nN, ntiles; const LAS unsigned* tile_e; size_t a_tile, b_expert, b_tile;
    __device__ bool next(int i, Unit& u) const {
        const int L = i * G + c; if (L >= ntiles * nN) return false;
        u.pm = L / nN; u.pn = L % nN; u.e = __builtin_amdgcn_readfirstlane((int)tile_e[u.pm]);
        u.aoff = (unsigned)((size_t)u.pm * a_tile); u.boff = (unsigned)((size_t)u.e * b_expert + (size_t)u.pn * b_tile); return true;
    }
};

__device__ __forceinline__ void cvt_block_T(const float* src, int ld_src, bf16_t* dst, int ld_dst, int lane) {
    const int k8 = lane & 7, nq = lane >> 3;
    const float* s = src + (size_t)(k8 * 8) * ld_src + nq * 4;
    f32x4 v[8];
#pragma unroll
    for (int j = 0; j < 8; ++j) v[j] = __builtin_nontemporal_load((const f32x4*)(s + (size_t)j * ld_src));
#pragma unroll
    for (int i = 0; i < 4; ++i) { u32x4 w; w.x = cvt_pk_bf16(v[0][i], v[1][i]); w.y = cvt_pk_bf16(v[2][i], v[3][i]); w.z = cvt_pk_bf16(v[4][i], v[5][i]); w.w = cvt_pk_bf16(v[6][i], v[7][i]);
        *(u32x4*)(dst + (size_t)(nq * 4 + i) * ld_dst + k8 * 8) = w; }
}
__device__ __forceinline__ void cvt_block_T2(const float* src, int ld_src, bf16_t* dst, int ld_dst, int lane) {
    const int k8 = lane & 7, nq = lane >> 3;
    const float* s = src + (size_t)(k8 * 8) * ld_src + nq * 4;
    f32x4 v[8], w2[8];
#pragma unroll
    for (int j = 0; j < 8; ++j) { v[j] = ld4(s + (size_t)j * ld_src); w2[j] = ld4(s + (size_t)j * ld_src + 32); }
#pragma unroll
    for (int i = 0; i < 4; ++i) { u32x4 w; w.x = cvt_pk_bf16(v[0][i], v[1][i]); w.y = cvt_pk_bf16(v[2][i], v[3][i]); w.z = cvt_pk_bf16(v[4][i], v[5][i]); w.w = cvt_pk_bf16(v[6][i], v[7][i]);
        *(u32x4*)(dst + (size_t)(nq * 4 + i) * ld_dst + k8 * 8) = w; }
#pragma unroll
    for (int i = 0; i < 4; ++i) { u32x4 w; w.x = cvt_pk_bf16(w2[0][i], w2[1][i]); w.y = cvt_pk_bf16(w2[2][i], w2[3][i]); w.z = cvt_pk_bf16(w2[4][i], w2[5][i]); w.w = cvt_pk_bf16(w2[6][i], w2[7][i]);
        *(u32x4*)(dst + (size_t)(32 + nq * 4 + i) * ld_dst + k8 * 8) = w; }
}

__device__ __forceinline__ void cvt8_load(f32x4 (&v)[16], const float* s, int ld_src) {
#pragma unroll
    for (int j = 0; j < 16; ++j) v[j] = __builtin_nontemporal_load((const f32x4*)(s + (size_t)j * ld_src));
}
__device__ __forceinline__ void cvt8_store(const f32x4 (&v)[16], fp8_t* d, int ld_dst) {
#pragma unroll
    for (int i = 0; i < 4; ++i) { u32x4 w; w.x = pack4_fp8(v[0][i] * W8_SCALE, v[1][i] * W8_SCALE, v[2][i] * W8_SCALE, v[3][i] * W8_SCALE); w.y = pack4_fp8(v[4][i] * W8_SCALE, v[5][i] * W8_SCALE, v[6][i] * W8_SCALE, v[7][i] * W8_SCALE);
        w.z = pack4_fp8(v[8][i] * W8_SCALE, v[9][i] * W8_SCALE, v[10][i] * W8_SCALE, v[11][i] * W8_SCALE); w.w = pack4_fp8(v[12][i] * W8_SCALE, v[13][i] * W8_SCALE, v[14][i] * W8_SCALE, v[15][i] * W8_SCALE);
        __builtin_nontemporal_store(w, (u32x4*)(d + (size_t)i * ld_dst)); }
}
__device__ __forceinline__ void cvt_wave_T8x8(const float* src, int ld_src, fp8_t* dst, int ld_dst, int lane) {
    const int k16 = lane & 7, nq = lane >> 3;
    const float* s = src + (size_t)(k16 * 16) * ld_src + nq * 4; fp8_t* d = dst + (size_t)(nq * 4) * ld_dst + k16 * 16;
    f32x4 va[16], vb[16];
    cvt8_load(va, s, ld_src);
#pragma unroll
    for (int i = 0; i < 8; i += 2) {
        cvt8_load(vb, s + (i + 1) * 32, ld_src);
        cvt8_store(va, d + (size_t)(i * 32) * ld_dst, ld_dst);
        if (i + 2 < 8) cvt8_load(va, s + (i + 2) * 32, ld_src);
        cvt8_store(vb, d + (size_t)((i + 1) * 32) * ld_dst, ld_dst);
    }
}

__device__ __forceinline__ void phase0(const Params& p, LAS unsigned char* lds, const int wave) {
    const int tid = phase_tid(wave);
    const int bid = blockIdx.x, lane = tid & 63, wv = tid >> 6;
    LAS float* cond = (LAS float*)lds;
    if (bid < 192) {
        for (int i = tid; i < NB * ND; i += NTHREADS) { const int b = i >> 11, k = i & 2047; const float cv = p.c[i]; cond[k * 4 + b] = cv / (1.0f + expf(-cv)); }
        __syncthreads();
        const int gid = bid * NTHREADS + tid, ks = gid / 3072, j4 = gid % 3072;
        f32x4 a0 = {0.f, 0.f, 0.f, 0.f}, a1 = a0, a2 = a0, a3 = a0;
        const float* wp = p.w_ada + (size_t)(ks * 64) * NMOD + j4 * 4;
#pragma unroll 16
        for (int kk = 0; kk < 64; ++kk) { const f32x4 w = __builtin_nontemporal_load((const f32x4*)(wp + (size_t)kk * NMOD)); const f32x4 cd = *(const LAS f32x4*)(cond + (ks * 64 + kk) * 4);
            a0 += w * cd[0]; a1 += w * cd[1]; a2 += w * cd[2]; a3 += w * cd[3]; }
        *(f32x4*)(p.modp + (size_t)(ks * 4 + 0) * NMOD + j4 * 4) = a0; *(f32x4*)(p.modp + (size_t)(ks * 4 + 1) * NMOD + j4 * 4) = a1;
        *(f32x4*)(p.modp + (size_t)(ks * 4 + 2) * NMOD + j4 * 4) = a2; *(f32x4*)(p.modp + (size_t)(ks * 4 + 3) * NMOD + j4 * 4) = a3;
    }
    const int gw = bid * NWAVES + wv, GW = gridDim.x * NWAVES;
    constexpr int I_IN = 32 * 265, I_RW = 16 * 64, I_PL = 4 * 4 * 16, I_OUT = 32 * 64, I_ALL = I_IN + I_RW + I_PL + I_OUT;
    for (int it = gw; it < I_ALL; it += GW) {
        if (it < I_IN) { const int kb = it / 265, nb = it % 265; cvt_block_T(p.w_in + (size_t)(kb * 64) * NIN + nb * 32, NIN, p.wt_in + (size_t)(nb * 32) * ND + kb * 64, ND, lane); }
        else if (it < I_IN + I_RW) { const int j = it - I_IN, kb = j / 64, nb = j % 64; cvt_block_T(p.w_rwkv_out + (size_t)(kb * 64) * ND + nb * 32, ND, p.wt_rwkv + (size_t)(nb * 32) * NC + kb * 64, NC, lane); }
        else if (it < I_IN + I_RW + I_PL) { const int j = it - I_IN - I_RW, g = j / 64, kb = (j % 64) / 16, nb = j % 16;
            cvt_block_T(p.w_pool + (size_t)g * 256 * 512 + (size_t)(kb * 64) * 512 + nb * 32, 512, p.wt_pool + (size_t)g * 512 * 256 + (size_t)(nb * 32) * 256 + kb * 64, 256, lane); }
        else { const int j = it - I_IN - I_RW - I_PL, kb = j / 64, nb = j % 64; cvt_block_T(p.w_out + (size_t)(kb * 64) * ND + nb * 32, ND, p.wt_out + (size_t)(nb * 32) * ND + kb * 64, ND, lane); }
    }
    for (int idx = bid * NTHREADS + tid; idx < LORA_N * (LORA_K / 8); idx += gridDim.x * NTHREADS) {
        const int n = idx / (LORA_K / 8), k0 = (idx % (LORA_K / 8)) * 8; float v[8];
#pragma unroll
        for (int j = 0; j < 8; ++j) { const int k = k0 + j; float x = 0.f;
            if (n < 1024) { if (k < 64) x = p.w_decay_up[k * NC + n]; }
            else if (n < 2048) { if (k >= 64 && k < 128) x = p.w_iclr_up[(k - 64) * NC + (n - 1024)]; }
            else { if (k >= 128 && k < 288) x = p.w_glora_up[(k - 128) * NC + (n - 2048)]; }
            v[j] = x; }
        u32x4 w; w.x = cvt_pk_bf16(v[0], v[1]); w.y = cvt_pk_bf16(v[2], v[3]); w.z = cvt_pk_bf16(v[4], v[5]); w.w = cvt_pk_bf16(v[6], v[7]);
        *(u32x4*)(p.bt_lora + (size_t)n * LORA_K + k0) = w;
    }
}

__device__ __forceinline__ void phase1(const Params& p, LAS unsigned char* lds, const int wave) {
    const int tid = phase_tid(wave);
    const int bid = blockIdx.x;
    if (tid < 192) { const int idx = bid * 192 + tid, b = idx / NMOD, j = idx % NMOD; float s = p.b_ada[j];
        for (int ks = 0; ks < KS_MOD; ++ks) s += p.modp[(size_t)(ks * 4 + b) * NMOD + j];
        p.mod[idx] = s; }
    LAS float* ss = (LAS float*)lds;
    const int m0 = bid * 32, b = m0 >> 11;
    {   const int j = tid * 8; f32x4 s0 = ld4(p.b_ada + j), s1 = ld4(p.b_ada + j + 4);
#pragma unroll 8
        for (int ks = 0; ks < KS_MOD; ++ks) { s0 += ld4(p.modp + (size_t)(ks * 4 + b) * NMOD + j); s1 += ld4(p.modp + (size_t)(ks * 4 + b) * NMOD + j + 4); }
        *(LAS f32x4*)(ss + j) = s0; *(LAS f32x4*)(ss + j + 4) = s1; }
    __syncthreads();
    const int k = (tid & 255) * 8, rh = tid >> 8;
    const f32x4 sh0 = *(const LAS f32x4*)(ss + k), sh1v = *(const LAS f32x4*)(ss + k + 4), sc0 = *(const LAS f32x4*)(ss + ND + k) + 1.0f, sc1v = *(const LAS f32x4*)(ss + ND + k + 4) + 1.0f;
#pragma unroll 4
    for (int i = 0; i < 16; ++i) { const size_t m = (size_t)(m0 + 2 * i + rh); const f32x4 x0 = ld4nt(p.x + m * ND + k), x1 = ld4nt(p.x + m * ND + k + 4); const f32x4 h0 = x0 * sc0 + sh0, h1 = x1 * sc1v + sh1v;
        u32x4 w; w.x = cvt_pk_bf16(h0[0], h0[1]); w.y = cvt_pk_bf16(h0[2], h0[3]); w.z = cvt_pk_bf16(h1[0], h1[1]); w.w = cvt_pk_bf16(h1[2], h1[3]); *(u32x4*)(p.hb + m * ND + k) = w; }
    __syncthreads();
}

__device__ __forceinline__ void phase3(const Params& p, LAS unsigned char* lds, const int wave) {
    const int tid = phase_tid(wave);
    const int bid = blockIdx.x, m0 = bid * 32, t0 = m0 & (NT - 1), hist = t0 > 0 ? 15 : 0;
    constexpr int TC = OFF_GA - OFF_WD, TCH = TC / 8;
    LAS bf16_t* T = (LAS bf16_t*)lds;
    for (int idx = tid; idx < 47 * TCH; idx += NTHREADS) { const int r = idx / TCH, ck = idx % TCH;
        if (r >= 15 - hist) *(LAS u32x4*)(T + r * TC + ck * 8) = ldu4nt(p.P + (size_t)(m0 - 15 + r) * NINP + OFF_WD + ck * 8); }
    __syncthreads();
    for (int idx = tid; idx < 32 * (LORA_K / 8); idx += NTHREADS) { const int i = idx / (LORA_K / 8), j0 = (idx % (LORA_K / 8)) * 8; u32x4 w = {0u, 0u, 0u, 0u};
        if (j0 < 288) { const u32x4 cu = *(const LAS u32x4*)(T + (15 + i) * TC + j0); u32x4 pu = {0u, 0u, 0u, 0u}; if (t0 + i > 0) pu = *(const LAS u32x4*)(T + (14 + i) * TC + j0);
            const f32x4 c0 = bf4_unpack((u32x2){cu.x, cu.y}), c1 = bf4_unpack((u32x2){cu.z, cu.w}), q0 = bf4_unpack((u32x2){pu.x, pu.y}), q1 = bf4_unpack((u32x2){pu.z, pu.w});
            const f32x4 s0 = c0 + (q0 - c0) * ld4(p.mu_shift + OFF_WD + j0), s1 = c1 + (q1 - c1) * ld4(p.mu_shift + OFF_WD + j0 + 4); float v[8];
#pragma unroll
            for (int j = 0; j < 8; ++j) { const float x = j < 4 ? s0[j] : s1[j - 4];
                v[j] = j0 < 64 ? (1.0f - 2.0f * __builtin_amdgcn_rcpf(1.0f + __builtin_amdgcn_exp2f(x * 2.8853900817779268f))) : (j0 < 128 ? x : sigmoidf_(x)); }
            w.x = cvt_pk_bf16(v[0], v[1]); w.y = cvt_pk_bf16(v[2], v[3]); w.z = cvt_pk_bf16(v[4], v[5]); w.w = cvt_pk_bf16(v[6], v[7]); }
        *(u32x4*)(p.a_lora + (size_t)(m0 + i) * LORA_K + j0) = w; }
    for (int idx = tid; idx < 32 * (NC / 8); idx += NTHREADS) { const int i = idx >> 7, c = (idx & 127) * 8; const int win = 2 << (c >> 8), t = t0 + i, n = (t + 1) < win ? (t + 1) : win;
        const LAS bf16_t* up = T + (15 + i) * TC + (OFF_POOL - OFF_WD) + c; f32x4 a0 = {0.f, 0.f, 0.f, 0.f}, a1 = a0;
        for (int q = 0; q < n; ++q) { const u32x4 uu = *(const LAS u32x4*)(up - q * TC); a0 += bf4_unpack((u32x2){uu.x, uu.y}); a1 += bf4_unpack((u32x2){uu.z, uu.w}); }
        const u32x4 u0 = *(const LAS u32x4*)(up); const float rn = 1.0f / (float)n;
        const f32x4 d0 = a0 * rn - bf4_unpack((u32x2){u0.x, u0.y}), d1 = a1 * rn - bf4_unpack((u32x2){u0.z, u0.w});
        u32x4 w; w.x = cvt_pk_bf16(d0[0], d0[1]); w.y = cvt_pk_bf16(d0[2], d0[3]); w.z = cvt_pk_bf16(d1[0], d1[1]); w.w = cvt_pk_bf16(d1[2], d1[3]);
        *(u32x4*)(p.dp + (size_t)(m0 + i) * NC + c) = w; }
    __syncthreads();
}

__device__ __forceinline__ float row8_allsum(float x) {
    x += dpp_f<0x141>(x); x += dpp_f<0x1B>(x); x += dpp_f<0xB1>(x); return x;
}
__device__ __forceinline__ void scan_head(const Params& p, LAS unsigned char* lds, int bh, const int wave) {
    const int tid = phase_tid(wave);
    const int lane = tid & 63;
    const int b = bh >> 4, h = bh & 15;
    constexpr int L_AW = 0, L_W = 16384, L_BK = 32768, L_Y = 65536, L_V = 81920, L_G = 106496, L_SC = 131072, L_CS = 131840, L_Z = 132352, L_DUMMY = 132864, L_CST = 133888;
    constexpr int NCH = NT / 32;
    if (tid < 128) *(LAS unsigned*)(lds + L_Z + tid * 4) = 0u;
    {
        const int a8 = tid >> 6, cc = tid & 63, gch = h * HS + cc;
        const float* src = a8 == 0 ? p.mu_shift + OFF_R : a8 == 1 ? p.mu_shift + OFF_K : a8 == 2 ? p.mu_shift + OFF_V : a8 == 3 ? p.k_k : a8 == 4 ? p.k_a : a8 == 5 ? p.r_k : a8 == 6 ? p.lnx_g : p.lnx_b;
        *(LAS float*)(lds + L_CST + a8 * 256 + cc * 4) = src[gch]; }
    __syncthreads();
#define CST4(a8, u_) (*(const LAS f32x4*)(lds + L_CST + (a8) * 256 + (c8 + 4 * (u_)) * 4))
    const int ht = tid - 256, ls = (ht >> 3) & 31, c8 = (ht & 7) * 8, ch0 = h * HS + c8;
    f32x4 pr[2], pk[2], pv[2], qr[2], qk[2], qv[2], dc[2], ic[2], gt[2]; u32x4 pr8, pk8, pv8, qr8, qk8, qv8, ic8, gt8;
    const f32x4 zero4 = {0.f, 0.f, 0.f, 0.f};
#define SCAN_ISSUE(chunk) do { int ch = ch0; asm volatile("" : "+v"(ch)); const int t_ = (chunk) * 32 + ls; const size_t m_ = (size_t)b * NT + t_; const bf16_t* row_ = p.P + m_ * NINP + ch; \
        pr8 = *(const u32x4*)(row_ + OFF_R); pk8 = *(const u32x4*)(row_ + OFF_K); pv8 = *(const u32x4*)(row_ + OFF_V); \
        if (t_ > 0) { qr8 = *(const u32x4*)(row_ - NINP + OFF_R); qk8 = *(const u32x4*)(row_ - NINP + OFF_K); qv8 = *(const u32x4*)(row_ - NINP + OFF_V); } else { qr8 = (u32x4){0u, 0u, 0u, 0u}; qk8 = qr8; qv8 = qr8; } \
        ic8 = ldu4nt(p.iclr + m_ * NC + ch); gt8 = ldu4nt(p.gg + m_ * NC + ch); \
        _Pragma("unroll") for (int u_ = 0; u_ < 2; ++u_) dc[u_] = ld4nt(p.dec + m_ * NC + ch + 4 * u_); } while (0)
#define SCAN_UNPACK() do { ic[0] = bf4_unpack((u32x2){ic8.x, ic8.y}); ic[1] = bf4_unpack((u32x2){ic8.z, ic8.w}); gt[0] = bf4_unpack((u32x2){gt8.x, gt8.y}); gt[1] = bf4_unpack((u32x2){gt8.z, gt8.w}); pr[0] = bf4_unpack((u32x2){pr8.x, pr8.y}); pr[1] = bf4_unpack((u32x2){pr8.z, pr8.w}); pk[0] = bf4_unpack((u32x2){pk8.x, pk8.y}); pk[1] = bf4_unpack((u32x2){pk8.z, pk8.w}); \
        pv[0] = bf4_unpack((u32x2){pv8.x, pv8.y}); pv[1] = bf4_unpack((u32x2){pv8.z, pv8.w}); qr[0] = bf4_unpack((u32x2){qr8.x, qr8.y}); qr[1] = bf4_unpack((u32x2){qr8.z, qr8.w}); \
        qk[0] = bf4_unpack((u32x2){qk8.x, qk8.y}); qk[1] = bf4_unpack((u32x2){qk8.z, qk8.w}); qv[0] = bf4_unpack((u32x2){qv8.x, qv8.y}); qv[1] = bf4_unpack((u32x2){qv8.z, qv8.w}); } while (0)
#define SCAN_STAGE(chunk) do { SCAN_UNPACK(); int ch = ch0; asm volatile("" : "+v"(ch)); const int bp_ = (chunk) & 1, vb_ = (chunk) % 3; f32x4 r_[2], k_[2], v_[2], kk_[2], km_[2], bb_[2]; float ss_ = 0.f; \
        _Pragma("unroll") for (int u_ = 0; u_ < 2; ++u_) { const f32x4 mu_r = CST4(0, u_), mu_k = CST4(1, u_), mu_v = CST4(2, u_); \
            r_[u_] = pr[u_] + (qr[u_] - pr[u_]) * mu_r; k_[u_] = pk[u_] + (qk[u_] - pk[u_]) * mu_k; v_[u_] = pv[u_] + (qv[u_] - pv[u_]) * mu_v; \
            kk_[u_] = k_[u_] * CST4(3, u_); ss_ += dot4(kk_[u_], kk_[u_]); } \
        ss_ = row8_allsum(ss_); const float inv_ = 1.0f / fmaxf(sqrtf(ss_), 1e-12f); float br_ = 0.f, kr_ = 0.f, rk_ = 0.f; \
        _Pragma("unroll") for (int u_ = 0; u_ < 2; ++u_) { kk_[u_] = kk_[u_] * inv_; km_[u_] = k_[u_] * ((ic[u_] - 1.0f) * CST4(4, u_) + 1.0f); bb_[u_] = kk_[u_] * ic[u_]; \
            br_ += dot4(bb_[u_], r_[u_]); kr_ += dot4(km_[u_], r_[u_]); rk_ += dot4(r_[u_] * km_[u_], CST4(5, u_)); } \
        br_ = row8_allsum(br_); kr_ = row8_allsum(kr_); rk_ = row8_allsum(rk_); \
          \
        const int pp_ = ls >> 1, odd_ = ls & 1; float c1_ = 0.f, c2_ = 0.f, c3_ = 0.f, c4_ = 0.f; \
        _Pragma("unroll") for (int u_ = 0; u_ < 2; ++u_) { const int k0_ = c8 + 4 * u_; const int pos_ = (k0_ >> 5) * 32 + ((k0_ & 15) >> 2) * 8 + ((k0_ >> 4) & 1) * 4; \
            const f32x4 a_ = -kk_[u_], wr_ = dc[u_] * r_[u_] + a_ * br_; f32x4 pw_, pb_, pk_; \
            _Pragma("unroll") for (int j_ = 0; j_ < 4; ++j_) { pw_[j_] = dpp_f<0x118>(dc[u_][j_]); pb_[j_] = dpp_f<0x118>(bb_[u_][j_]); pk_[j_] = dpp_f<0x118>(km_[u_][j_]); } \
            const f32x4 x0_ = odd_ ? pw_ * a_ : a_, x1_ = odd_ ? pw_ * wr_ : wr_; \
            u32x2 wa_, ww_; wa_.x = cvt_pk_bf16(x0_[0], x0_[1]); wa_.y = cvt_pk_bf16(x0_[2], x0_[3]); ww_.x = cvt_pk_bf16(x1_[0], x1_[1]); ww_.y = cvt_pk_bf16(x1_[2], x1_[3]); \
            *(LAS u32x2*)(lds + L_AW + bp_ * 8192 + pp_ * 512 + odd_ * 256 + pos_ * 2) = wa_; *(LAS u32x2*)(lds + L_AW + bp_ * 8192 + pp_ * 512 + odd_ * 256 + 128 + pos_ * 2) = ww_; \
            if (odd_) { *(LAS f32x4*)(lds + L_W + bp_ * 8192 + pp_ * 256 + k0_ * 4) = pw_ * dc[u_]; \
                *(LAS f32x4*)(lds + L_BK + bp_ * 16384 + pp_ * 1024 + k0_ * 4) = pb_ * dc[u_]; *(LAS f32x4*)(lds + L_BK + bp_ * 16384 + pp_ * 1024 + 256 + k0_ * 4) = pk_ * dc[u_]; \
                *(LAS f32x4*)(lds + L_BK + bp_ * 16384 + pp_ * 1024 + 512 + k0_ * 4) = bb_[u_]; *(LAS f32x4*)(lds + L_BK + bp_ * 16384 + pp_ * 1024 + 768 + k0_ * 4) = km_[u_]; \
                c1_ += dot4(pb_, a_); c2_ += dot4(pk_, a_); c3_ += dot4(pb_, wr_); c4_ += dot4(pk_, wr_); } \
            *(LAS f32x4*)(lds + L_V + vb_ * 8192 + ls * 256 + k0_ * 4) = v_[u_]; *(LAS f32x4*)(lds + L_G + vb_ * 8192 + ls * 256 + k0_ * 4) = gt[u_]; } \
        c1_ = row8_allsum(c1_); c2_ = row8_allsum(c2_); c3_ = row8_allsum(c3_); c4_ = row8_allsum(c4_); \
        if ((ht & 7) == 0) { *(LAS f32x2*)(lds + L_SC + vb_ * 256 + ls * 8) = (f32x2){kr_, rk_}; if (odd_) *(LAS f32x4*)(lds + L_CS + bp_ * 256 + pp_ * 16) = (f32x4){c1_, c2_, c3_, c4_}; } } while (0)
#define SCAN_POST(chunk) do { int ch = ch0; asm volatile("" : "+v"(ch)); const int bp_ = (chunk) & 1, vb_ = (chunk) % 3; const f32x2 sc_ = *(const LAS f32x2*)(lds + L_SC + vb_ * 256 + ls * 8); f32x4 y_[2], v_[2]; float s_ = 0.f; \
        _Pragma("unroll") for (int u_ = 0; u_ < 2; ++u_) { v_[u_] = *(const LAS f32x4*)(lds + L_V + vb_ * 8192 + ls * 256 + (c8 + 4 * u_) * 4); \
            y_[u_] = *(const LAS f32x4*)(lds + L_Y + bp_ * 8192 + ls * 256 + (c8 + 4 * u_) * 4) + v_[u_] * sc_[0]; s_ += (y_[u_][0] + y_[u_][1]) + (y_[u_][2] + y_[u_][3]); } \
        const float mean_ = row8_allsum(s_) * (1.0f / 64.0f); float q_ = 0.f; \
        _Pragma("unroll") for (int u_ = 0; u_ < 2; ++u_) { y_[u_] = y_[u_] - mean_; q_ += dot4(y_[u_], y_[u_]); } \
        const float rstd_ = rsqrtf(row8_allsum(q_) * (1.0f / 64.0f) + GN_EPS); const size_t m_ = (size_t)b * NT + (chunk) * 32 + ls; u32x4 o_; \
        _Pragma("unroll") for (int u_ = 0; u_ < 2; ++u_) { const f32x4 g_ = *(const LAS f32x4*)(lds + L_G + vb_ * 8192 + ls * 256 + (c8 + 4 * u_) * 4); \
            const f32x4 yn_ = y_[u_] * rstd_ * CST4(6, u_) + CST4(7, u_); const f32x4 f_ = (yn_ + v_[u_] * sc_[1]) * g_; \
            if (u_ == 0) { o_.x = cvt_pk_bf16(f_[0], f_[1]); o_.y = cvt_pk_bf16(f_[2], f_[3]); } else { o_.z = cvt_pk_bf16(f_[0], f_[1]); o_.w = cvt_pk_bf16(f_[2], f_[3]); } } \
        *(u32x4*)(p.yr + m_ * NC + ch) = o_; } while (0)
    const int ri = lane & 15, rg = lane >> 4, sel = ri & 3;
    f32x4 X0 = zero4, X1 = zero4, X2 = zero4, X3 = zero4;
    if (wave >= 4) { SCAN_ISSUE(0); SCAN_STAGE(0); }
    __syncthreads();
    for (int chunk = 0; chunk < NCH; ++chunk) {
        if (wave < 4) {
            __builtin_amdgcn_s_setprio(3);
            const int bp = chunk & 1, vb = chunk % 3;
            const LAS unsigned char* awp = lds + L_AW + bp * 8192 + sel * 128 + rg * 16;
            const LAS unsigned char* wwp = lds + L_W + bp * 8192 + rg * 16;
            const LAS unsigned char* abp = lds + L_BK + bp * 16384 + rg * 256 + ri * 4;
            const LAS unsigned char* vp = lds + L_V + vb * 8192 + (16 * wave + ri) * 4;
            const LAS unsigned char* csp = lds + L_CS + bp * 256;
            LAS unsigned char* yp = (rg == 0) ? (lds + L_Y + bp * 8192 + (16 * wave + ri) * 4) : ((rg == 2) ? (lds + L_Y + bp * 8192 + 256 + (16 * wave + ri) * 4) : (lds + L_DUMMY + tid * 4));
            const int y_st = (rg & 1) ? 0 : 512;
#define SCAN_LD(S, pi) do { S##a0 = *(const LAS bf16x8*)(awp + (pi) * 512); S##a1 = *(const LAS bf16x8*)(awp + (pi) * 512 + 64); \
                S##w0 = *(const LAS f32x4*)(wwp + (pi) * 256); S##w1 = *(const LAS f32x4*)(wwp + (pi) * 256 + 64); S##w2 = *(const LAS f32x4*)(wwp + (pi) * 256 + 128); S##w3 = *(const LAS f32x4*)(wwp + (pi) * 256 + 192); \
                S##b0 = *(const LAS float*)(abp + (pi) * 1024); S##b1 = *(const LAS float*)(abp + (pi) * 1024 + 64); S##b2 = *(const LAS float*)(abp + (pi) * 1024 + 128); S##b3 = *(const LAS float*)(abp + (pi) * 1024 + 192); \
                S##vt = *(const LAS float*)(vp + (pi) * 512); S##vu = *(const LAS float*)(vp + (pi) * 512 + 256); S##cs = *(const LAS f32x4*)(csp + (pi) * 16); } while (0)
#define SCAN_STEP(S, pi) do { u32x4 xa, xc; \
                xa.x = cvt_pk_bf16(X0[0], X0[1]); xa.y = cvt_pk_bf16(X0[2], X0[3]); xa.z = cvt_pk_bf16(X1[0], X1[1]); xa.w = cvt_pk_bf16(X1[2], X1[3]); \
                xc.x = cvt_pk_bf16(X2[0], X2[1]); xc.y = cvt_pk_bf16(X2[2], X2[3]); xc.z = cvt_pk_bf16(X3[0], X3[1]); xc.w = cvt_pk_bf16(X3[2], X3[3]); \
                const f32x4 d0 = __builtin_amdgcn_mfma_f32_16x16x32_bf16(S##a0, __builtin_bit_cast(bf16x8, xa), zero4, 0, 0, 0); \
                const f32x4 d1 = __builtin_amdgcn_mfma_f32_16x16x32_bf16(S##a1, __builtin_bit_cast(bf16x8, xc), zero4, 0, 0, 0); \
                const f32x4 d = d0 + d1; const float sat = d[0]; \
                const float sau = d[2] + sat * S##cs[0] + S##vt * S##cs[1], yu = d[3] + sat * S##cs[2] + S##vt * S##cs[3]; \
                const float bsel = (rg == 0) ? sat : ((rg == 1) ? S##vt : ((rg == 2) ? sau : S##vu)); \
                X0 = __builtin_amdgcn_mfma_f32_16x16x4f32(S##b0, bsel, X0 * S##w0, 0, 0, 0); \
                X1 = __builtin_amdgcn_mfma_f32_16x16x4f32(S##b1, bsel, X1 * S##w1, 0, 0, 0); \
                X2 = __builtin_amdgcn_mfma_f32_16x16x4f32(S##b2, bsel, X2 * S##w2, 0, 0, 0); \
                X3 = __builtin_amdgcn_mfma_f32_16x16x4f32(S##b3, bsel, X3 * S##w3, 0, 0, 0); \
                *(LAS float*)(yp + (pi) * y_st) = (rg == 0) ? d[1] : yu; } while (0)
            bf16x8 Pa0, Pa1, Qa0, Qa1; f32x4 Pw0, Pw1, Pw2, Pw3, Qw0, Qw1, Qw2, Qw3, Pcs, Qcs; float Pb0, Pb1, Pb2, Pb3, Pvt, Pvu, Qb0, Qb1, Qb2, Qb3, Qvt, Qvu;
            SCAN_LD(P, 0);
#pragma unroll 1
            for (int pi = 0; pi < 16; pi += 2) {
                SCAN_LD(Q, pi + 1);
                SCAN_STEP(P, pi);
                if (pi + 2 < 16) SCAN_LD(P, pi + 2);
                SCAN_STEP(Q, pi + 1);
            }
#undef SCAN_LD
#undef SCAN_STEP
        } else {
            if (chunk + 1 < NCH) SCAN_ISSUE(chunk + 1);
            if (chunk > 0) SCAN_POST(chunk - 1);
            if (chunk + 1 < NCH) SCAN_STAGE(chunk + 1);
        }
        __syncthreads();
    }
    if (wave >= 4) SCAN_POST(NCH - 1);
    __syncthreads();
#undef SCAN_ISSUE
#undef CST4
#undef SCAN_STAGE
#undef SCAN_UNPACK
#undef SCAN_POST
}
__device__ __forceinline__ void conv_queue(const Params& p, LAS unsigned char* lds, const int wave, const int cw, const int n_defer = N_DEFER) {
    const int tid = phase_tid(wave);
    const int lane = tid & 63, wv = tid >> 6;
    LAS int* slot = (LAS int*)(lds + LDS_MISC);
    constexpr int N_GU = NE * 16 * 2, N_DN = NE * 16, N_ALL = N_GU + N_DN;
    for (;;) {
        __syncthreads();
        if (tid == 0) *slot = (int)atomicAdd(&p.ctl[cw], 1u);
        __syncthreads();
        const int it = *slot;
        if (it >= N_ALL - n_defer) break;
        if (it < N_GU) { const int e = it >> 5, rem = it & 31, kb = rem >> 1, nh = rem & 1;
            const float* src = p.w_gu + (size_t)e * ND * (2 * DFF) + (size_t)(kb * 128) * (2 * DFF) + nh * 2048;
            fp8_t* dst = p.wt_gu + (size_t)e * (2 * DFF) * ND + (size_t)(nh * 2048) * ND + kb * 128;
            cvt_wave_T8x8(src + wv * 256, 2 * DFF, dst + (size_t)(wv * 256) * ND, ND, lane); }
        else { const int j = it - N_GU, e = j >> 4, kb = j & 15;
            const float* src = p.w_down + (size_t)e * DFF * ND + (size_t)(kb * 128) * ND;
            fp8_t* dst = p.wt_down + (size_t)e * ND * DFF + kb * 128;
            cvt_wave_T8x8(src + wv * 256, ND, dst + (size_t)(wv * 256) * DFF, DFF, lane); }
    }
}

__device__ __forceinline__ void conv_queue_tail(const Params& p, LAS unsigned char* lds, const int wave) {
    const int tid = phase_tid(wave);
    const int lane = tid & 63, wv = tid >> 6;
    LAS int* slot = (LAS int*)(lds + LDS_MISC + 1024);
    for (;;) {
        __syncthreads();
        if (tid == 0) *slot = (int)atomicAdd(&p.ctl[CW_CONV3], 1u);
        __syncthreads();
        const int it = *slot;
        if (it >= N_DEFER * 8) break;
        const int j = NE * 16 - N_DEFER + (it >> 3), sub = it & 7, e = j >> 4, kb = j & 15, k16 = lane & 7, nq = lane >> 3;
        const float* src = p.w_down + (size_t)e * DFF * ND + (size_t)(kb * 128 + k16 * 16) * ND + sub * 256 + wv * 32 + nq * 4;
        fp8_t* dst = p.wt_down + (size_t)e * ND * DFF + (size_t)(sub * 256 + wv * 32 + nq * 4) * DFF + kb * 128 + k16 * 16;
        f32x4 cv[16]; cvt8_load(cv, src, ND); cvt8_store(cv, dst, DFF);
    }
}

__device__ __forceinline__ void phase8(const Params& p, LAS unsigned char* lds, const int wave) {
    const int tid = phase_tid(wave);
    const int bid = blockIdx.x, lane = tid & 63, wv = tid >> 6;
    constexpr int HP = ND + 4;
    LAS float* hs = (LAS float*)lds;
    LAS float* lg = hs + 16 * HP;
    LAS float* part = lg + 16 * 32;
    LAS float* topv = part + 4 * 16 * 32;
    LAS int* topi = (LAS int*)(topv + 64);
    const int b = (bid * 32) >> 11;
    const float* sh2 = p.mod + (size_t)b * NMOD + 3 * ND; const float* sc2 = p.mod + (size_t)b * NMOD + 4 * ND;
    for (int pass = 0; pass < 2; ++pass) {
        const int mb = bid * 32 + pass * 16;
        for (int rr = 0; rr < 2; ++rr) { const int r = wv * 2 + rr; const size_t m = (size_t)(mb + r);
            f32x4 z[8]; float s = 0.f;
#pragma unroll
            for (int j = 0; j < 4; ++j) { z[2 * j] = ld4nt(p.z1 + m * ND + j * 512 + lane * 8); z[2 * j + 1] = ld4nt(p.z1 + m * ND + j * 512 + lane * 8 + 4);
                s += ((z[2 * j][0] + z[2 * j][1]) + (z[2 * j][2] + z[2 * j][3])) + ((z[2 * j + 1][0] + z[2 * j + 1][1]) + (z[2 * j + 1][2] + z[2 * j + 1][3])); }
            const float mean = wave_allsum(s) * (1.0f / ND); float qv = 0.f;
#pragma unroll
            for (int j = 0; j < 8; ++j) { const f32x4 d = z[j] - mean; qv += dot4(d, d); }
            const float rstd = rsqrtf(wave_allsum(qv) * (1.0f / ND) + LN_EPS);
            if (lane == 0) *(f32x2*)(p.lnst + m * 2) = (f32x2){mean, rstd};
#pragma unroll
            for (int j = 0; j < 8; ++j) { const int k = (j >> 1) * 512 + lane * 8 + (j & 1) * 4;
                const f32x4 x1 = (z[j] - mean) * rstd * ld4(p.ln1_g + k) + ld4(p.ln1_b + k);
                const f32x4 h = x1 * (ld4(sc2 + k) + 1.0f) + ld4(sh2 + k);
                *(unsigned*)(p.h2 + m * ND + k) = pack4_fp8(h[0], h[1], h[2], h[3]);
                *(LAS f32x4*)(hs + r * HP + k) = h; } }
        __syncthreads();
        {
            const int kq = wv >> 1, ntl = wv & 1, ar = lane & 15, ak = lane >> 4;
            f32x4 acc = {0.f, 0.f, 0.f, 0.f};
            const LAS float* ap = hs + ar * HP + kq * 512 + ak; const float* bp = p.w_router + (size_t)(kq * 512 + ak) * NE + ntl * 16 + ar;
#pragma unroll 1
            for (int kb = 0; kb < 128; kb += 32) { float bq[32];
#pragma unroll
                for (int j = 0; j < 32; ++j) bq[j] = bp[(size_t)(kb + j) * 4 * NE];
#pragma unroll
                for (int j = 0; j < 32; ++j) acc = __builtin_amdgcn_mfma_f32_16x16x4f32(ap[(kb + j) * 4], bq[j], acc, 0, 0, 0); }
#pragma unroll
            for (int j = 0; j < 4; ++j) part[(kq * 16 + ak * 4 + j) * 32 + ntl * 16 + ar] = acc[j]; }
        __syncthreads();
        {   const int r = tid >> 5, e = tid & 31;
            lg[r * 32 + e] = p.b_router[e] + (part[(0 * 16 + r) * 32 + e] + part[(1 * 16 + r) * 32 + e]) + (part[(2 * 16 + r) * 32 + e] + part[(3 * 16 + r) * 32 + e]); }
        __syncthreads();
        {
            const int r = tid >> 5, e = tid & 31; const LAS float* l = lg + r * 32; const float mine = l[e]; int rank = 0;
#pragma unroll
            for (int q = 0; q < 8; ++q) { const f32x4 o = *(const LAS f32x4*)(l + q * 4);
#pragma unroll
                for (int j = 0; j < 4; ++j) rank += (o[j] > mine || (o[j] == mine && (q * 4 + j) < e)) ? 1 : 0; }
            if (rank < 4) { topv[r * 4 + rank] = mine; topi[r * 4 + rank] = e; } }
        __syncthreads();
        if (tid < 64) { const int r = tid >> 2, k = tid & 3, m = mb + r; const f32x4 tv = *(const LAS f32x4*)(topv + r * 4); const int ei = topi[r * 4 + k];
            const float e0 = 1.0f, e1 = expf(tv[1] - tv[0]), e2 = expf(tv[2] - tv[0]), e3 = expf(tv[3] - tv[0]); const float sum = (e0 + e1) + (e2 + e3);
            const float mineexp = k == 0 ? e0 : (k == 1 ? e1 : (k == 2 ? e2 : e3));
            const unsigned rk = atomicAdd(&p.ctl[CW_CNT + 64 * ei], 1u);
            p.sel[m * 4 + k] = ei; p.rnk[m * 4 + k] = (int)rk; p.prob[m * 4 + k] = mineexp / sum; }
        __syncthreads();
    }
}

__device__ __forceinline__ void phase9(const Params& p, LAS unsigned char* lds, const int wave) {
    const int tid = phase_tid(wave);
    const int bid = blockIdx.x, lane = tid & 63, wv = tid >> 6;
    LAS int* seg = (LAS int*)lds;
    if (tid == 0) { int s = 0;
        for (int e = 0; e < NE; ++e) { seg[e] = s; const int c = (int)xb_ld(&p.ctl[CW_CNT + 64 * e]); s += (c + 255) & ~255; }
        seg[NE] = s;
        if (bid == 0) { int t = 0;
            for (int e = 0; e < NE; ++e) { const int nt = (seg[e + 1] - seg[e]) >> 8; for (int i = 0; i < nt; ++i) p.ctl[CW_TILEE + t + i] = (unsigned)e; t += nt; }
            p.ctl[CW_NTILES] = (unsigned)t; } }
    __syncthreads();
    {
        const int gw = bid * NWAVES + wv; i32x4 e4[4], r4[4]; u32x4 v0[4], v1[4];
#pragma unroll
        for (int i = 0; i < 4; ++i) { const int m = gw + i * 2048; e4[i] = *(const i32x4*)(p.sel + m * 4); r4[i] = *(const i32x4*)(p.rnk + m * 4);
            const u32x4* src = (const u32x4*)(p.h2 + (size_t)m * ND); v0[i] = src[lane]; v1[i] = src[64 + lane]; }
#pragma unroll
        for (int i = 0; i < 4; ++i) { const int m = gw + i * 2048; i32x4 dd;
#pragma unroll
            for (int k = 0; k < 4; ++k) { dd[k] = seg[e4[i][k]] + r4[i][k]; u32x4* q = (u32x4*)(p.xb + (size_t)dd[k] * ND); q[lane] = v0[i]; q[64 + lane] = v1[i]; }
            if (lane == 0) *(i32x4*)(p.dest + m * 4) = dd; } }
    __syncthreads();
}

__device__ __forceinline__ void phase13(const Params& p, const int wave) {
    const int tid = phase_tid(wave);
    const int bid = blockIdx.x, lane0 = tid & 63, wv = wave;
    const int GW = gridDim.x * NWAVES;
    for (int m = bid * NWAVES + wv; m < NM; m += GW) { const int b = m >> 11;
        int lane = lane0; asm volatile("" : "+v"(lane));
        const float* g2 = p.mod + (size_t)b * NMOD + 5 * ND;
        int d[4]; float pr[4]; const f32x2 st = *(const f32x2*)(p.lnst + (size_t)m * 2);
#pragma unroll
        for (int k = 0; k < 4; ++k) { d[k] = p.dest[m * 4 + k]; pr[k] = p.prob[m * 4 + k]; }
        f32x4 z[8]; float s = 0.f; u32x4 yq[4][4];
#pragma unroll
        for (int j = 0; j < 4; ++j) {
#pragma unroll
            for (int k = 0; k < 4; ++k) yq[j][k] = ldu4nt(p.yb + (size_t)d[k] * ND + j * 512 + lane * 8);
            z[2 * j] = ld4nt(p.z1 + (size_t)m * ND + j * 512 + lane * 8); z[2 * j + 1] = ld4nt(p.z1 + (size_t)m * ND + j * 512 + lane * 8 + 4); }
#pragma unroll
        for (int j = 0; j < 4; ++j) { const int c = j * 512 + lane * 8; f32x4 f0 = {0.f, 0.f, 0.f, 0.f}, f1 = f0;
#pragma unroll
            for (int k = 0; k < 4; ++k) { f0 += bf4_unpack((u32x2){yq[j][k].x, yq[j][k].y}) * pr[k]; f1 += bf4_unpack((u32x2){yq[j][k].z, yq[j][k].w}) * pr[k]; }
            const f32x4 xa = (z[2 * j] - st[0]) * st[1] * ld4(p.ln1_g + c) + ld4(p.ln1_b + c), xb2 = (z[2 * j + 1] - st[0]) * st[1] * ld4(p.ln1_g + c + 4) + ld4(p.ln1_b + c + 4);
            z[2 * j] = xa * DN_ALPHA + ld4(g2 + c) * f0; z[2 * j + 1] = xb2 * DN_ALPHA + ld4(g2 + c + 4) * f1;
            s += ((z[2 * j][0] + z[2 * j][1]) + (z[2 * j][2] + z[2 * j][3])) + ((z[2 * j + 1][0] + z[2 * j + 1][1]) + (z[2 * j + 1][2] + z[2 * j + 1][3])); }
        const float mean = wave_allsum(s) * (1.0f / ND); float qv = 0.f;
#pragma unroll
        for (int j = 0; j < 8; ++j) { const f32x4 dd = z[j] - mean; qv += dot4(dd, dd); }
        const float rstd = rsqrtf(wave_allsum(qv) * (1.0f / ND) + LN_EPS);
#pragma unroll
        for (int j = 0; j < 8; ++j) { const int c = (j >> 1) * 512 + lane * 8 + (j & 1) * 4;
            *(f32x4*)(p.out + (size_t)m * ND + c) = (z[j] - mean) * rstd * ld4(p.ln2_g + c) + ld4(p.ln2_b + c); } }
}

__global__ void __launch_bounds__(NTHREADS, 2) fwd(Params p) {
    extern __shared__ __attribute__((aligned(16))) unsigned char shm[];
    LAS unsigned char* lds = (LAS unsigned char*)shm;
    const int bid = blockIdx.x, G = gridDim.x;
    const int wave = __builtin_amdgcn_readfirstlane(threadIdx.x >> 6);
    if (threadIdx.x == 0) *(LAS u32x4*)(lds + LDS_BARW) = (u32x4){0u, 0u, 0u, 0u};
    __syncthreads();
    XcdBarrier bar = xcd_barrier_post(p.bar, (volatile LAS unsigned*)(lds + LDS_BARW));

    phase0(p, lds, wave);
    xcd_barrier(bar, wave);
    if (PROBE == 3) { phase0(p, lds, wave); xcd_barrier(bar, wave); }
    phase1(p, lds, wave);
    xcd_barrier(bar, wave);
    if (PROBE == 3) { phase1(p, lds, wave); xcd_barrier(bar, wave); }
    {
        pg8::Gemm g{p.hb, p.wt_in, ND, ND, ND}; pg8::DenseOrder S; S.init(NM / 256, NINP / 256 - 2, G, bid, (size_t)256 * ND * 2, (size_t)256 * ND * 2); S.skip_from = 23; S.skip_n = 2;
        EpiP E{p.P}; pg8::gemm_phase(lds, g, S, E, wave);
        if (PROBE == 1) { __syncthreads(); pg8::gemm_phase(lds, g, S, E, wave); } }
    xcd_barrier(bar, wave);
    phase3(p, lds, wave);
    xcd_barrier(bar, wave);
    if (PROBE == 3) { phase3(p, lds, wave); xcd_barrier(bar, wave); }
    {
        pg8::Gemm g{p.hb, p.wt_in, ND, ND, ND}; WinRestOrder S{bid, (size_t)256 * ND * 2, (size_t)256 * ND * 2};
        EpiP E{p.P}; pg8::gemm_phase(lds, g, S, E, wave); }
    __syncthreads();
    {
        pg8::Gemm g{p.a_lora, p.bt_lora, LORA_K, LORA_K, LORA_K}; pg8::DenseOrder S; S.init(NM / 256, LORA_N / 256, G - 64, bid - 64, (size_t)256 * LORA_K * 2, (size_t)256 * LORA_K * 2);
        EpiLora E{p.dec, p.iclr, p.gg, p.w0, p.a0}; pg8::gemm_phase(lds, g, S, E, wave);
        if (PROBE == 1) { __syncthreads(); pg8::gemm_phase(lds, g, S, E, wave); } }
    __syncthreads();
    {
        pg8::Gemm g{p.dp, p.wt_pool, NC, 256, 256}; PoolOrder S{1 << 20, bid >= 64 ? bid - 64 : 192 + bid};
        EpiPool E{p.t1, p.P, p.pool_scale}; pg8::gemm_phase(lds, g, S, E, wave);
        if (PROBE == 1) { __syncthreads(); pg8::gemm_phase(lds, g, S, E, wave); } }
    xcd_barrier(bar, wave);
    if (bid < NB * NH) { scan_head(p, lds, bid, wave); if (PROBE == 4) scan_head(p, lds, bid, wave); }
    conv_queue(p, lds, wave, CW_CONV);
    if (PROBE == 5) conv_queue(p, lds, wave, CW_CONV2);
    xcd_barrier(bar, wave);
    if (PROBE == 2) { if (bid < NB * NH) scan_head(p, lds, bid, wave); conv_queue(p, lds, wave, CW_CONV2); xcd_barrier(bar, wave); }
    {
        pg8::Gemm g{p.yr, p.wt_rwkv, NC, NC, NC}; pg8::DenseOrder S; S.init(NM / 256, ND / 256, G, bid, (size_t)256 * NC * 2, (size_t)256 * NC * 2);
        EpiRwkv E{p.mx, p.P, p.t1}; pg8::gemm_phase(lds, g, S, E, wave);
        if (PROBE == 1) { __syncthreads(); pg8::gemm_phase(lds, g, S, E, wave); } }
    xcd_barrier(bar, wave);
    {
        pg8::Gemm g{p.mx, p.wt_out, ND, ND, ND}; pg8::DenseOrder S; S.init(NM / 256, ND / 256, G, bid, (size_t)256 * ND * 2, (size_t)256 * ND * 2);
        EpiWout E{p.z1, p.x, p.mod}; pg8::gemm_phase(lds, g, S, E, wave);
        if (PROBE == 1) { __syncthreads(); pg8::gemm_phase(lds, g, S, E, wave); } }
    xcd_barrier(bar, wave);
    phase8(p, lds, wave);
    xcd_barrier(bar, wave);
    phase9(p, lds, wave);
    xcd_barrier(bar, wave);
    if (PROBE == 3) { phase9(p, lds, wave); xcd_barrier(bar, wave); }
    const int ntiles = (int)xb_ld(&p.ctl[CW_NTILES]);
    {   const int t_ = phase_tid(wave); if (t_ < MAXTILES) *(LAS unsigned*)(lds + LDS_MISC + 4 * t_) = p.ctl[CW_TILEE + t_]; }
    __syncthreads();
    {
        pg8::Gemm g{(const bf16_t*)p.xb, (const bf16_t*)p.wt_gu, ND / 2, ND / 2, ND / 2};
        MoeOrder S{G, bid, 2 * DFF / 256, ntiles, (const LAS unsigned*)(lds + LDS_MISC), (size_t)256 * ND, (size_t)(2 * DFF) * ND, (size_t)256 * ND};
        EpiGU E{p.act, p.b_gu, lds}; pg8::gemm_phase<EpiGU, MoeOrder, true>(lds, g, S, E, wave);
        if (PROBE == 1) { __syncthreads(); pg8::gemm_phase<EpiGU, MoeOrder, true>(lds, g, S, E, wave); } }
    conv_queue_tail(p, lds, wave);
    xcd_barrier(bar, wave);
    {
        pg8::Gemm g{(const bf16_t*)p.act, (const bf16_t*)p.wt_down, DFF / 2, DFF / 2, DFF / 2};
        MoeOrder S{G, bid, ND / 256, ntiles, (const LAS unsigned*)(lds + LDS_MISC), (size_t)256 * DFF, (size_t)ND * DFF, (size_t)256 * DFF};
        EpiDown E{p.yb, p.b_down}; pg8::gemm_phase<EpiDown, MoeOrder, true>(lds, g, S, E, wave);
        if (PROBE == 1) { __syncthreads(); pg8::gemm_phase<EpiDown, MoeOrder, true>(lds, g, S, E, wave); } }
    xcd_barrier(bar, wave);
    phase13(p, wave);
    if (PROBE == 3) { xcd_barrier(bar, wave); phase13(p, wave); }
}

static inline size_t align_up(size_t v, size_t a) { return (v + a - 1) / a * a; }

extern "C" void kernel_launch(void* const* d_in, const int* in_sizes, int n_in, void* d_out, int out_size, void* d_ws, size_t ws_size, hipStream_t stream) {
    (void)in_sizes; (void)n_in; (void)out_size;
    Params p{};
    const float** ins = (const float**)&p;
    for (int i = 0; i < 30; ++i) ins[i] = (const float*)d_in[i];
    p.out = (float*)d_out;
    char* ws = (char*)d_ws; size_t off = 0;
    auto take = [&](size_t bytes) { char* r = ws + off; off = align_up(off + bytes, 4096); return r; };
    const size_t ctl_bytes = (size_t)(XCD_BAR_WORDS + CTL_WORDS) * 4;
    p.bar = (unsigned*)take(ctl_bytes); p.ctl = p.bar + XCD_BAR_WORDS;
    p.modp = (float*)take((size_t)KS_MOD * 4 * NMOD * 4); p.mod = (float*)take((size_t)NB * NMOD * 4);
    p.hb = (bf16_t*)take((size_t)NM * ND * 2);
    p.wt_in = (bf16_t*)take((size_t)NINP * ND * 2); p.wt_rwkv = (bf16_t*)take((size_t)ND * NC * 2); p.wt_pool = (bf16_t*)take((size_t)ND * 256 * 2);
    p.wt_out = (bf16_t*)take((size_t)ND * ND * 2); p.bt_lora = (bf16_t*)take((size_t)LORA_N * LORA_K * 2);
    p.wt_gu = (fp8_t*)take((size_t)NE * 2 * DFF * ND); p.wt_down = (fp8_t*)take((size_t)NE * ND * DFF);
    p.P = (bf16_t*)take((size_t)NM * NINP * 2); p.a_lora = (bf16_t*)take((size_t)NM * LORA_K * 2); p.dp = (bf16_t*)take((size_t)NM * NC * 2);
    p.dec = (float*)take((size_t)NM * NC * 4); p.iclr = (bf16_t*)take((size_t)NM * NC * 2); p.gg = (bf16_t*)take((size_t)NM * NC * 2); p.t1 = (bf16_t*)take((size_t)NM * ND * 2);
    p.yr = (bf16_t*)take((size_t)NM * NC * 2); p.mx = (bf16_t*)take((size_t)NM * ND * 2); p.z1 = (float*)take((size_t)NM * ND * 4); p.lnst = (float*)take((size_t)NM * 2 * 4);
    p.h2 = (fp8_t*)take((size_t)NM * ND);
    p.sel = (int*)take((size_t)NM * TOPK * 4); p.rnk = (int*)take((size_t)NM * TOPK * 4); p.prob = (float*)take((size_t)NM * TOPK * 4); p.dest = (int*)take((size_t)NM * TOPK * 4);
    p.xb = (fp8_t*)take((size_t)MP * ND); p.act = (fp8_t*)take((size_t)MP * DFF); p.yb = (bf16_t*)take((size_t)MP * ND * 2);
    if (off > ws_size) { fprintf(stderr, "kernel_launch: workspace too small (%zu > %zu)\n", off, ws_size); return; }

    static int grid = 0;
    if (!grid) {
        int dev = 0, cus = 0, per_cu = 0;
        hipGetDevice(&dev); hipDeviceGetAttribute(&cus, hipDeviceAttributeMultiprocessorCount, dev);
        hipFuncSetAttribute((const void*)fwd, hipFuncAttributeMaxDynamicSharedMemorySize, LDS_BYTES);
        hipOccupancyMaxActiveBlocksPerMultiprocessor(&per_cu, (const void*)fwd, NTHREADS, LDS_BYTES);
        if (per_cu < 1) fprintf(stderr, "kernel_launch: occupancy query reports %d workgroups per CU\n", per_cu);
        if (cus != 256) fprintf(stderr, "kernel_launch: %d CUs; this kernel is laid out for 256\n", cus);
        grid = 256;
    }
    hipMemsetAsync(p.bar, 0, ctl_bytes, stream);
    hipLaunchKernelGGL(fwd, dim3(grid), dim3(NTHREADS), LDS_BYTES, stream, p);
}
```

```cpp
#include <hip/hip_runtime.h>
#include <cstdio>
#include <cstdint>

#ifndef PROBE
#define PROBE 0
#endif
#define LAS __attribute__((address_space(3)))
typedef unsigned short bf16_t;
typedef short bf16x8 __attribute__((ext_vector_type(8)));
typedef float f32x4 __attribute__((ext_vector_type(4)));
typedef float f32x2 __attribute__((ext_vector_type(2)));
typedef unsigned u32x4 __attribute__((ext_vector_type(4)));
typedef unsigned u32x2 __attribute__((ext_vector_type(2)));
typedef int i32x4 __attribute__((ext_vector_type(4)));
typedef int i32x8 __attribute__((ext_vector_type(8)));
typedef unsigned char fp8_t;
constexpr float W8_SCALE = 64.0f, W8_INV = 1.0f / 64.0f;

constexpr int NB = 4, NT = 2048, NM = NB * NT, ND = 2048, NC = 1024, NH = 16, HS = 64;
constexpr int NSHIFT = 3360, NIN = 8480, NINP = 8704;
constexpr int OFF_R = 0, OFF_K = 1024, OFF_V = 2048, OFF_WD = 3072, OFF_AD = 3136, OFF_GD = 3200, OFF_POOL = 3360, OFF_GA = 4384, OFF_GB = 6432;
constexpr int NE = 32, TOPK = 4, DFF = 2048;
constexpr int LORA_K = 384, LORA_N = 3072;
constexpr int MAXTILES = 160, MP = MAXTILES * 256;
constexpr int NMOD = 6 * ND;
constexpr int KS_MOD = 32;
constexpr float LN_EPS = 1e-5f, GN_EPS = 64e-5f;
constexpr float DN_ALPHA = 1.189207115002721f;
constexpr float SW_LIMIT = 7.0f, SW_ALPHA = 1.702f;
constexpr int NWAVES = 8, NTHREADS = 512;
constexpr int LDS_BYTES = 163840;
constexpr int LDS_EPI = 131072 + 2048;
constexpr int LDS_BARW = LDS_BYTES - 16;
constexpr int LDS_MISC = 131072;

constexpr int CW_CNT = 0;
constexpr int CW_CONV = 64 * 32;
constexpr int CW_CONV2 = 64 * 32 + 32;
constexpr int CW_CONV3 = 64 * 32 + 48;
constexpr int N_DEFER = 96;
constexpr int CW_NTILES = 64 * 33;
constexpr int CW_TILEE = 64 * 34;
constexpr int CTL_WORDS = 64 * 34 + 256;

#define XB_TMO      128
#define XB_XCNT(j)  (256  + 64 * (j))
#define XB_XSUB(j)  (1280 + 64 * (j))
#define XB_XGEN(j)  (2304 + 64 * (j))
#define XB_TOP      3328
#define XB_TOPGEN   3392
#define XCD_BAR_WORDS 3456
#define XB_SPIN_CAP (1u << 18)

__device__ __forceinline__ unsigned xb_ld(unsigned* p)              { return __hip_atomic_load(p, __ATOMIC_RELAXED, __HIP_MEMORY_SCOPE_AGENT); }
__device__ __forceinline__ unsigned xb_add(unsigned* p, unsigned v) { return __hip_atomic_fetch_add(p, v, __ATOMIC_RELAXED, __HIP_MEMORY_SCOPE_AGENT); }
__device__ __forceinline__ unsigned xb_xcc_id() { return (unsigned)__builtin_amdgcn_s_getreg((3 << 11) | 20) & 0xFu; }
#define XB_SPIN(cond, bar) do { unsigned _sp = 0; while (cond) { __builtin_amdgcn_s_sleep(1); \
    if ((++_sp & 255u) == 0u) { if (xb_ld(&(bar)[XB_TMO])) break; if (_sp > XB_SPIN_CAP) { atomicAdd(&(bar)[XB_TMO], 1u); break; } } } } while (0)

__device__ __forceinline__ int phase_tid(int wave);
struct XcdBarrier { unsigned* bar; unsigned x; volatile LAS unsigned* st; };

__device__ __forceinline__ XcdBarrier xcd_barrier_post(unsigned* bar, volatile LAS unsigned* st) {
    XcdBarrier b; b.bar = bar; b.x = xb_xcc_id(); b.st = st;
    if (threadIdx.x == 0) (void)xb_add(&bar[XB_XCNT(b.x)], 1u);
    return b;
}
__device__ __forceinline__ void xcd_barrier_complete(unsigned* bar, unsigned x, unsigned& nloc, unsigned& nx) {
    const unsigned G = gridDim.x * gridDim.y * gridDim.z;
    unsigned sum, cnt, mine, sp = 0u;
    for (;;) {
        sum = 0u; cnt = 0u; mine = 0u;
#pragma unroll
        for (unsigned j = 0; j < 16; ++j) { const unsigned c = xb_ld(&bar[XB_XCNT(j)]); sum += c; cnt += (c > 0u) ? 1u : 0u; mine = (j == x) ? c : mine; }
        if (sum == G) break;
        __builtin_amdgcn_s_sleep(1);
        if ((++sp & 255u) == 0u) { if (xb_ld(&bar[XB_TMO])) break; if (sp > XB_SPIN_CAP) { atomicAdd(&bar[XB_TMO], 1u); break; } }
    }
    nloc = mine > 0u ? mine : 1u; nx = cnt > 0u ? cnt : 1u;
}
__device__ __forceinline__ void xcd_barrier(const XcdBarrier& b, const int wave) {
    asm volatile("s_waitcnt vmcnt(0)" ::: "memory");
    __syncthreads();
    if (phase_tid(wave) == 0) {
        unsigned* bar = b.bar;
        __builtin_amdgcn_s_waitcnt(0);
        unsigned nloc = b.st[0], nx = b.st[1];
        if (nloc == 0u) { xcd_barrier_complete(bar, b.x, nloc, nx); b.st[0] = nloc; b.st[1] = nx; }
        const unsigned old = xb_add(&bar[XB_XSUB(b.x)], 1u);
        const unsigned gen = old / nloc;
        if (old + 1u == (gen + 1u) * nloc) {
            __builtin_amdgcn_fence(__ATOMIC_RELEASE, "agent");
            asm volatile("s_waitcnt vmcnt(0)" ::: "memory");
            const unsigned og = xb_add(&bar[XB_TOP], 1u);
            const unsigned tg = og / nx;
            if (og + 1u == (tg + 1u) * nx) xb_add(&bar[XB_TOPGEN], 1u);
            else XB_SPIN(xb_ld(&bar[XB_TOPGEN]) == tg, bar);
            __builtin_amdgcn_fence(__ATOMIC_ACQUIRE, "agent");
            xb_add(&bar[XB_XGEN(b.x)], 1u);
            asm volatile("s_waitcnt vmcnt(0)" ::: "memory");
        } else {
            XB_SPIN(xb_ld(&bar[XB_XGEN(b.x)]) == gen, bar);
            __builtin_amdgcn_fence(__ATOMIC_ACQUIRE, "agent");
            asm volatile("s_waitcnt vmcnt(0)" ::: "memory");
        }
    }
    __syncthreads();
}

__device__ __forceinline__ int phase_tid(int wave) {
    int lane; asm volatile("v_mbcnt_lo_u32_b32 %0, -1, 0\n\tv_mbcnt_hi_u32_b32 %0, -1, %0" : "=v"(lane));
    return wave * 64 + lane;
}
typedef __bf16 bf16x2_t __attribute__((ext_vector_type(2)));
__device__ __forceinline__ unsigned cvt_pk_bf16(float lo, float hi) { return __builtin_bit_cast(unsigned, __builtin_convertvector((f32x2){lo, hi}, bf16x2_t)); }
template <int CTRL> __device__ __forceinline__ float dpp_f(float x) {
    return __builtin_bit_cast(float, __builtin_amdgcn_update_dpp(0, __builtin_bit_cast(int, x), CTRL, 0xf, 0xf, false));
}
__device__ __forceinline__ float row16_allsum(float x) {
    x += dpp_f<0x128>(x); x += dpp_f<0x124>(x); x += dpp_f<0x122>(x); x += dpp_f<0x121>(x); return x;
}
__device__ __forceinline__ float wave_allsum(float x) {
    x = row16_allsum(x);
    const int xi = __builtin_bit_cast(int, x);
    return (__builtin_bit_cast(float, __builtin_amdgcn_readlane(xi, 0)) + __builtin_bit_cast(float, __builtin_amdgcn_readlane(xi, 16))) +
           (__builtin_bit_cast(float, __builtin_amdgcn_readlane(xi, 32)) + __builtin_bit_cast(float, __builtin_amdgcn_readlane(xi, 48)));
}
__device__ __forceinline__ unsigned pack4_fp8(float a, float b, float c, float d) { int r = 0; r = __builtin_amdgcn_cvt_pk_fp8_f32(a, b, r, false); r = __builtin_amdgcn_cvt_pk_fp8_f32(c, d, r, true); return (unsigned)r; }
__device__ __forceinline__ f32x2 bf2_unpack(unsigned u) { return (f32x2){__uint_as_float(u << 16), __uint_as_float(u & 0xffff0000u)}; }
__device__ __forceinline__ f32x4 bf4_unpack(u32x2 u) { const f32x2 a = bf2_unpack(u.x), b = bf2_unpack(u.y); return (f32x4){a[0], a[1], b[0], b[1]}; }
__device__ __forceinline__ float bf1(bf16_t h) { return __uint_as_float(((unsigned)h) << 16); }
__device__ __forceinline__ float sigmoidf_(float v) { return __builtin_amdgcn_rcpf(1.0f + __builtin_amdgcn_exp2f(v * -1.4426950408889634f)); }
__device__ __forceinline__ f32x4 ld4(const float* p) { return *(const f32x4*)p; }
__device__ __forceinline__ f32x4 ld4nt(const float* p) { return __builtin_nontemporal_load((const f32x4*)p); }
__device__ __forceinline__ u32x4 ldu4nt(const void* p) { return __builtin_nontemporal_load((const u32x4*)p); }
__device__ __forceinline__ float dot4(f32x4 a, f32x4 b) { return (a[0] * b[0] + a[1] * b[1]) + (a[2] * b[2] + a[3] * b[3]); }

struct Params {
    const float *x, *c, *w_ada, *b_ada, *w_in, *mu_shift, *w0, *w_decay_up, *a0, *w_iclr_up, *w_glora_up, *k_k, *k_a, *r_k, *lnx_g, *lnx_b,
                *w_rwkv_out, *w_pool, *pool_scale, *w_out, *ln1_g, *ln1_b, *w_router, *b_router, *w_gu, *b_gu, *w_down, *b_down, *ln2_g, *ln2_b;
    float* out;
    unsigned* bar; unsigned* ctl;
    float* modp; float* mod;
    fp8_t* hb; fp8_t* wt_in; bf16_t* wt_rwkv; bf16_t* wt_pool; bf16_t* wt_out; bf16_t* bt_lora; fp8_t* wt_gu; fp8_t* wt_down;
    bf16_t* P; bf16_t* a_lora; bf16_t* dp; float* dec; bf16_t* iclr; bf16_t* gg; bf16_t* t1;
    bf16_t* yr; bf16_t* mx; float* z1; float* lnst; fp8_t* h2;
    int* sel; int* rnk; float* prob; int* dest;
    fp8_t* xb; fp8_t* act; bf16_t* yb;
};

namespace pg8 {
constexpr int BM = 256, BK = 64, HALF = 128, HTB = HALF * BK * 2, STAGE_BYTES = 8 * HTB, NXCD = 8, WGM = 8;
__host__ __device__ __forceinline__ int lds_byte(int r, int c) { const int st = (r >> 4) * 2 + (c >> 5), rr = r & 15, cc = c & 31, ob = rr * 64 + cc * 2; return st * 1024 + (ob ^ (((ob >> 9) & 1) << 5)); }
__host__ __device__ __forceinline__ void stage_rc(int b, int& R, int& C) { const int st = b / 1024, sb = b % 1024, swz = sb ^ (((sb >> 9) & 1) << 5); R = (st >> 1) * 16 + swz / 64; C = (st & 1) * 32 + (swz % 64) / 2; }
__host__ __device__ __forceinline__ int perm32(int rho) { const int n = rho >> 4, i = rho & 15; return 8 * (i >> 2) + 4 * n + (i & 3); }

struct Unit { int pm, pn, e; unsigned aoff, boff; };
struct Gemm { const bf16_t* A; const bf16_t* Bt; int lda, ldb, K; };

struct DenseOrder {
    int nM, nN, nwg, G, c, skip_from = 1 << 30, skip_n = 0; size_t a_tile, b_tile;
    __device__ void init(int nM_, int nN_, int G_, int c_, size_t a_tile_, size_t b_tile_) { nM = nM_; nN = nN_; nwg = nM * nN; G = G_; c = c_; a_tile = a_tile_; b_tile = b_tile_; }
    __device__ bool next(int i, Unit& u) const {
        const long L = (long)i * G + c; if (c < 0 || L >= nwg) return false;
        int wgid = (int)L; { const int q = nwg / NXCD, r = nwg % NXCD, xcd = wgid % NXCD, off = wgid / NXCD; wgid = (xcd < r ? xcd * (q + 1) : r * (q + 1) + (xcd - r) * q) + off; }
        const int nig = WGM * nN, gid = wgid / nig, fm = gid * WGM, gsz = (nM - fm) < WGM ? (nM - fm) : WGM;
        u.pm = fm + ((wgid % nig) % gsz); u.pn = (wgid % nig) / gsz; u.e = 0; if (u.pn >= skip_from) u.pn += skip_n;
        u.aoff = (unsigned)((size_t)u.pm * a_tile); u.boff = (unsigned)((size_t)u.pn * b_tile); return true;
    }
};

template <class Epi, class Sched, bool FP8 = false>
__device__ __forceinline__ void gemm_phase(LAS unsigned char* lds, const Gemm g, const Sched& S, const Epi& E, const int wave) {
    const int tid = phase_tid(wave);
    const int wid = __builtin_amdgcn_readfirstlane(tid >> 6), lane = tid & 63, wr = wid >> 2, wc = wid & 3, fr = lane & 15, fq = lane >> 4;
    const int K = g.K, nt = K / BK;
    unsigned voffA, voffB;
    {   int R, C; stage_rc(tid * 16, R, C); const int Rb = Epi::PERM ? ((R & ~31) + perm32(R & 31)) : R;
        voffA = (unsigned)(R * g.lda + C) * 2u; voffB = (unsigned)(Rb * g.ldb + C) * 2u; }
    const unsigned pieceA = 64u * (unsigned)g.lda * 2u, pieceB = 64u * (unsigned)g.ldb * 2u;
    const unsigned kstep = (unsigned)(BK * 2);
    const unsigned hstepA = (unsigned)HALF * g.lda * 2u, hstepB = (unsigned)HALF * g.ldb * 2u;
    const __amdgpu_buffer_rsrc_t rsA = __builtin_amdgcn_make_buffer_rsrc((void*)g.A, (short)0, -1, 0x00020000), rsB = __builtin_amdgcn_make_buffer_rsrc((void*)g.Bt, (short)0, -1, 0x00020000);
    const unsigned ldsw = (unsigned)wid * 1024u;
    const int aoff = lds_byte(wr * 64 + fr, fq * 8), boff = lds_byte(wc * 32 + fr, fq * 8);
#define PG8_SA(b, h) (((b) * 2 + (h)) * HTB)
#define PG8_SB(b, h) ((4 + (b) * 2 + (h)) * HTB)
#define PG8_STAGE(bufoff, rs, soff, voff) do { _Pragma("unroll") for (int _i = 0; _i < 2; ++_i) \
        __builtin_amdgcn_raw_ptr_buffer_load_lds(rs, (LAS void*)(lds + (bufoff) + ldsw + _i * 8192), 16, (voff), (soff) + _i * ((&(voff) == &voffA) ? pieceA : pieceB), 0, 0); } while (0)
#define PG8_LDA(dst, b, h) do { _Pragma("unroll") for (int m = 0; m < 4; ++m) _Pragma("unroll") for (int k = 0; k < 2; ++k) dst[m][k] = *(const LAS bf16x8*)(lds + PG8_SA(b, h) + aoff + m * 2048 + k * 1024); } while (0)
#define PG8_LDB(dst, b, h) do { _Pragma("unroll") for (int n = 0; n < 2; ++n) _Pragma("unroll") for (int k = 0; k < 2; ++k) dst[n][k] = *(const LAS bf16x8*)(lds + PG8_SB(b, h) + boff + n * 2048 + k * 1024); } while (0)
#define PG8_CAT(x) __builtin_shufflevector(__builtin_bit_cast(i32x4, (x)[0]), __builtin_bit_cast(i32x4, (x)[1]), 0, 1, 2, 3, 4, 5, 6, 7)
#define PG8_MMA(ai, bj, At, Bt) do { __builtin_amdgcn_s_setprio(1); \
        if constexpr (FP8) { _Pragma("unroll") for (int m = 0; m < 4; ++m) _Pragma("unroll") for (int n = 0; n < 2; ++n) \
            acc[ai][bj][m][n] = __builtin_amdgcn_mfma_scale_f32_16x16x128_f8f6f4(PG8_CAT(Bt[n]), PG8_CAT(At[m]), acc[ai][bj][m][n], 0, 0, 0, 0x7F7F7F7F, 0, 0x7F7F7F7F); } \
        else { _Pragma("unroll") for (int m = 0; m < 4; ++m) _Pragma("unroll") for (int n = 0; n < 2; ++n) _Pragma("unroll") for (int k = 0; k < 2; ++k) \
            acc[ai][bj][m][n] = __builtin_amdgcn_mfma_f32_16x16x32_bf16(Bt[n][k], At[m][k], acc[ai][bj][m][n], 0, 0, 0); } \
        __builtin_amdgcn_s_setprio(0); } while (0)
#define PG8_WAIT_V(n) asm volatile("s_waitcnt vmcnt(" #n ")" ::: "memory")
#define PG8_WAIT_L(n) asm volatile("s_waitcnt lgkmcnt(" #n ")" ::: "memory")
#define PG8_BAR __builtin_amdgcn_s_barrier()
#define PG8_SCHED __builtin_amdgcn_sched_barrier(0)
    Unit cur, nxt; int ui = 0;
    if (!S.next(0, cur)) return;
    f32x4 acc[2][2][4][2];
#pragma unroll
    for (int a = 0; a < 2; ++a)
#pragma unroll
        for (int b = 0; b < 2; ++b)
#pragma unroll
            for (int m = 0; m < 4; ++m)
#pragma unroll
                for (int n = 0; n < 2; ++n) acc[a][b][m][n] = (f32x4){0.f, 0.f, 0.f, 0.f};
    bf16x8 At[4][2], B0[2][2], B1[2][2];
    unsigned cA = cur.aoff, cB = cur.boff;
    PG8_STAGE(PG8_SB(0, 0), rsB, cB, voffB); PG8_STAGE(PG8_SA(0, 0), rsA, cA, voffA); PG8_STAGE(PG8_SB(0, 1), rsB, cB + hstepB, voffB); PG8_STAGE(PG8_SA(0, 1), rsA, cA + hstepA, voffA);
    if (wr == 1) PG8_BAR;
    PG8_WAIT_V(4); PG8_BAR;
    PG8_STAGE(PG8_SB(1, 0), rsB, cB + kstep, voffB); PG8_STAGE(PG8_SA(1, 0), rsA, cA + kstep, voffA); PG8_STAGE(PG8_SB(1, 1), rsB, cB + hstepB + kstep, voffB);
    PG8_WAIT_V(6); PG8_BAR;
    for (;;) {
        const bool has_next = S.next(ui + 1, nxt);
        const unsigned nA = has_next ? nxt.aoff : cA, nB = has_next ? nxt.boff : cB;
        for (int t = 0; t < nt; t += 2) {
            const bool last = (t == nt - 2);
            const unsigned a1 = cA + (unsigned)(t + 1) * kstep;
            const unsigned a2 = last ? nA : cA + (unsigned)(t + 2) * kstep, b2 = last ? nB : cB + (unsigned)(t + 2) * kstep;
            const unsigned a3 = a2 + kstep, b3 = b2 + kstep;
            PG8_LDB(B0, 0, 0); PG8_SCHED; PG8_LDA(At, 0, 0); PG8_STAGE(PG8_SA(1, 1), rsA, a1 + hstepA, voffA);
            PG8_WAIT_L(8); PG8_BAR; PG8_WAIT_L(0); PG8_MMA(0, 0, At, B0); PG8_BAR; PG8_SCHED;
            PG8_LDB(B1, 0, 1); PG8_STAGE(PG8_SB(0, 0), rsB, b2, voffB);
            PG8_BAR; PG8_WAIT_L(0); PG8_MMA(0, 1, At, B1); PG8_BAR;
            PG8_LDA(At, 0, 1); PG8_STAGE(PG8_SA(0, 0), rsA, a2, voffA);
            PG8_BAR; PG8_WAIT_L(0); PG8_MMA(1, 0, At, B0); PG8_BAR; PG8_SCHED;
            PG8_STAGE(PG8_SB(0, 1), rsB, b2 + hstepB, voffB);
            PG8_WAIT_V(6); PG8_BAR; PG8_MMA(1, 1, At, B1); PG8_BAR;
            PG8_LDB(B0, 1, 0); PG8_SCHED; PG8_LDA(At, 1, 0); PG8_STAGE(PG8_SA(0, 1), rsA, a2 + hstepA, voffA);
            PG8_WAIT_L(8); PG8_BAR; PG8_WAIT_L(0); PG8_MMA(0, 0, At, B0); PG8_BAR; PG8_SCHED;
            PG8_LDB(B1, 1, 1); PG8_STAGE(PG8_SB(1, 0), rsB, b3, voffB);
            PG8_BAR; PG8_WAIT_L(0); PG8_MMA(0, 1, At, B1); PG8_BAR;
            PG8_LDA(At, 1, 1); PG8_STAGE(PG8_SA(1, 0), rsA, a3, voffA);
            PG8_BAR; PG8_WAIT_L(0); PG8_MMA(1, 0, At, B0); PG8_BAR; PG8_SCHED;
            PG8_STAGE(PG8_SB(1, 1), rsB, b3 + hstepB, voffB);
            PG8_WAIT_V(6); PG8_BAR; PG8_MMA(1, 1, At, B1); PG8_BAR;
        }
        { const int l2 = phase_tid(wave) & 63; E(acc, cur, wr, wc, l2 & 15, l2 >> 4); }
        if (!has_next) break;
#pragma unroll
        for (int a = 0; a < 2; ++a)
#pragma unroll
            for (int b = 0; b < 2; ++b)
#pragma unroll
                for (int m = 0; m < 4; ++m)
#pragma unroll
                    for (int n = 0; n < 2; ++n) acc[a][b][m][n] = (f32x4){0.f, 0.f, 0.f, 0.f};
        cur = nxt; cA = nA; cB = nB; ++ui;
    }
    PG8_WAIT_V(0);
    if (wr == 0) PG8_BAR;
    PG8_BAR;
#undef PG8_SA
#undef PG8_SB
#undef PG8_STAGE
#undef PG8_LDA
#undef PG8_LDB
#undef PG8_MMA
#undef PG8_CAT
#undef PG8_WAIT_V
#undef PG8_WAIT_L
#undef PG8_BAR
#undef PG8_SCHED
}
}
using pg8::Unit;

#define EPI_LOOP_BEGIN \
    _Pragma("unroll") for (int ai = 0; ai < 2; ++ai) _Pragma("unroll") for (int m = 0; m < 4; ++m) { const int r = u.pm * 256 + ai * 128 + wr * 64 + m * 16 + fr; \
    _Pragma("unroll") for (int bj = 0; bj < 2; ++bj) _Pragma("unroll") for (int n = 0; n < 2; ++n) { const int cl = bj * 128 + wc * 32 + 16 * n + 4 * fq; const f32x4 a = acc[ai][bj][m][n];
#define EPI_LOOP_END } }

struct EpiP {
    static constexpr bool PERM = true; bf16_t* C;
    __device__ __forceinline__ void operator()(const f32x4 (&acc)[2][2][4][2], const Unit& u, int wr, int wc, int fr, int fq) const {
#pragma unroll
        for (int ai = 0; ai < 2; ++ai)
#pragma unroll
            for (int m = 0; m < 4; ++m) { const int r = u.pm * 256 + ai * 128 + wr * 64 + m * 16 + fr;
#pragma unroll
                for (int bj = 0; bj < 2; ++bj) { const int c0 = u.pn * 256 + bj * 128 + wc * 32 + 8 * fq; const f32x4 v0 = acc[ai][bj][m][0] * W8_INV, v1 = acc[ai][bj][m][1] * W8_INV;
                    u32x4 w; w.x = cvt_pk_bf16(v0[0], v0[1]); w.y = cvt_pk_bf16(v0[2], v0[3]); w.z = cvt_pk_bf16(v1[0], v1[1]); w.w = cvt_pk_bf16(v1[2], v1[3]);
                    *(u32x4*)(C + (size_t)r * NINP + c0) = w; } }
    }
};
#define EPI_COLS(ptr) f32x4 cv[2][2]; _Pragma("unroll") for (int bj = 0; bj < 2; ++bj) _Pragma("unroll") for (int n = 0; n < 2; ++n) cv[bj][n] = ld4((ptr) + bj * 128 + wc * 32 + 16 * n + 4 * fq);
#define EPI_COLS_PERM(ptr) f32x4 cv[2][2]; _Pragma("unroll") for (int bj = 0; bj < 2; ++bj) _Pragma("unroll") for (int n = 0; n < 2; ++n) cv[bj][n] = ld4((ptr) + bj * 128 + wc * 32 + 8 * fq + 4 * n);
struct EpiLora {
    static constexpr bool PERM = false; float* dec; bf16_t *iclr, *gg; const float *w0, *a0;
    __device__ __forceinline__ void operator()(const f32x4 (&acc)[2][2][4][2], const Unit& u, int wr, int wc, int fr, int fq) const {
        const int sect = u.pn >> 2, cb = (u.pn & 3) * 256;
        EPI_COLS((sect == 0 ? w0 : a0) + cb)
        EPI_LOOP_BEGIN
            const int c = cb + cl; f32x4 o;
            if (sect == 0) {
#pragma unroll
                for (int j = 0; j < 4; ++j) o[j] = __builtin_amdgcn_exp2f(-0.6065306597126334f * 1.4426950408889634f * sigmoidf_(cv[bj][n][j] + a[j]));
                *(f32x4*)(dec + (size_t)r * NC + c) = o; }
            else if (sect == 1) {
#pragma unroll
                for (int j = 0; j < 4; ++j) o[j] = sigmoidf_(cv[bj][n][j] + a[j]);
                u32x2 wv; wv.x = cvt_pk_bf16(o[0], o[1]); wv.y = cvt_pk_bf16(o[2], o[3]); *(u32x2*)(iclr + (size_t)r * NC + c) = wv; }
            else { u32x2 wv; wv.x = cvt_pk_bf16(a[0], a[1]); wv.y = cvt_pk_bf16(a[2], a[3]); *(u32x2*)(gg + (size_t)r * NC + c) = wv; }
        EPI_LOOP_END
    }
};
struct EpiPool {
    static constexpr bool PERM = true; bf16_t* t1; const bf16_t* P; const float* pscale;
    __device__ __forceinline__ void operator()(const f32x4 (&acc)[2][2][4][2], const Unit& u, int wr, int wc, int fr, int fq) const {
        EPI_COLS_PERM(pscale + u.pn * 256)
#pragma unroll
        for (int ai = 0; ai < 2; ++ai) { u32x4 gq[4][2];
#pragma unroll
            for (int m = 0; m < 4; ++m)
#pragma unroll
                for (int bj = 0; bj < 2; ++bj) gq[m][bj] = ldu4nt(P + (size_t)(u.pm * 256 + ai * 128 + wr * 64 + m * 16 + fr) * NINP + OFF_GB + u.pn * 256 + bj * 128 + wc * 32 + 8 * fq);
#pragma unroll
            for (int m = 0; m < 4; ++m) { const int r = u.pm * 256 + ai * 128 + wr * 64 + m * 16 + fr;
#pragma unroll
                for (int bj = 0; bj < 2; ++bj) { const int c0 = u.pn * 256 + bj * 128 + wc * 32 + 8 * fq;
                    const f32x4 g0 = bf4_unpack((u32x2){gq[m][bj].x, gq[m][bj].y}), g1 = bf4_unpack((u32x2){gq[m][bj].z, gq[m][bj].w}), a0 = acc[ai][bj][m][0], a1 = acc[ai][bj][m][1]; f32x4 o0, o1;
#pragma unroll
                    for (int j = 0; j < 4; ++j) { o0[j] = sigmoidf_(g0[j]) * cv[bj][0][j] * a0[j]; o1[j] = sigmoidf_(g1[j]) * cv[bj][1][j] * a1[j]; }
                    u32x4 w; w.x = cvt_pk_bf16(o0[0], o0[1]); w.y = cvt_pk_bf16(o0[2], o0[3]); w.z = cvt_pk_bf16(o1[0], o1[1]); w.w = cvt_pk_bf16(o1[2], o1[3]);
                    *(u32x4*)(t1 + (size_t)r * ND + c0) = w; } } }
    }
};
struct EpiRwkv {
    static constexpr bool PERM = true; bf16_t* mx; const bf16_t* P; const bf16_t* t1;
    __device__ __forceinline__ void operator()(const f32x4 (&acc)[2][2][4][2], const Unit& u, int wr, int wc, int fr, int fq) const {
#pragma unroll
        for (int ai = 0; ai < 2; ++ai) { u32x4 gq[4][2], tq[4][2];
#pragma unroll
            for (int m = 0; m < 4; ++m)
#pragma unroll
                for (int bj = 0; bj < 2; ++bj) { const int r = u.pm * 256 + ai * 128 + wr * 64 + m * 16 + fr, c0 = u.pn * 256 + bj * 128 + wc * 32 + 8 * fq;
                    gq[m][bj] = ldu4nt(P + (size_t)r * NINP + OFF_GA + c0); tq[m][bj] = ldu4nt(t1 + (size_t)r * ND + c0); }
#pragma unroll
            for (int m = 0; m < 4; ++m) { const int r = u.pm * 256 + ai * 128 + wr * 64 + m * 16 + fr;
#pragma unroll
                for (int bj = 0; bj < 2; ++bj) { const int c0 = u.pn * 256 + bj * 128 + wc * 32 + 8 * fq;
                    const f32x4 g0 = bf4_unpack((u32x2){gq[m][bj].x, gq[m][bj].y}), g1 = bf4_unpack((u32x2){gq[m][bj].z, gq[m][bj].w});
                    const f32x4 t0 = bf4_unpack((u32x2){tq[m][bj].x, tq[m][bj].y}), t1v = bf4_unpack((u32x2){tq[m][bj].z, tq[m][bj].w}), a0 = acc[ai][bj][m][0], a1 = acc[ai][bj][m][1]; f32x4 o0, o1;
#pragma unroll
                    for (int j = 0; j < 4; ++j) { o0[j] = sigmoidf_(g0[j]) * a0[j] + t0[j]; o1[j] = sigmoidf_(g1[j]) * a1[j] + t1v[j]; }
                    u32x4 w; w.x = cvt_pk_bf16(o0[0], o0[1]); w.y = cvt_pk_bf16(o0[2], o0[3]); w.z = cvt_pk_bf16(o1[0], o1[1]); w.w = cvt_pk_bf16(o1[2], o1[3]);
                    *(u32x4*)(mx + (size_t)r * ND + c0) = w; } } }
    }
};
struct EpiWout {
    static constexpr bool PERM = true; float* z1; const float* x; const float* mod;
    __device__ __forceinline__ void operator()(const f32x4 (&acc)[2][2][4][2], const Unit& u, int wr, int wc, int fr, int fq) const {
        const int b = u.pm >> 3;
        EPI_COLS_PERM(mod + (size_t)b * NMOD + 2 * ND + u.pn * 256)
#pragma unroll
        for (int ai = 0; ai < 2; ++ai)
#pragma unroll
            for (int mh = 0; mh < 2; ++mh) { f32x4 xq[2][2][2];
#pragma unroll
                for (int m2 = 0; m2 < 2; ++m2)
#pragma unroll
                    for (int bj = 0; bj < 2; ++bj)
#pragma unroll
                        for (int n = 0; n < 2; ++n) xq[m2][bj][n] = ld4nt(x + (size_t)(u.pm * 256 + ai * 128 + wr * 64 + (mh * 2 + m2) * 16 + fr) * ND + u.pn * 256 + bj * 128 + wc * 32 + 8 * fq + 4 * n);
#pragma unroll
                for (int m2 = 0; m2 < 2; ++m2) { const int m = mh * 2 + m2, r = u.pm * 256 + ai * 128 + wr * 64 + m * 16 + fr;
#pragma unroll
                    for (int bj = 0; bj < 2; ++bj)
#pragma unroll
                        for (int n = 0; n < 2; ++n) { const int c = u.pn * 256 + bj * 128 + wc * 32 + 8 * fq + 4 * n;
                            *(f32x4*)(z1 + (size_t)r * ND + c) = xq[m2][bj][n] * DN_ALPHA + cv[bj][n] * acc[ai][bj][m][n]; } } }
    }
};
struct EpiGU {
    static constexpr bool PERM = true; fp8_t* act; const float* b_gu; LAS unsigned char* lds;
    __device__ __forceinline__ void operator()(const f32x4 (&acc)[2][2][4][2], const Unit& u, int wr, int wc, int fr, int fq) const {
        const float* bias = b_gu + (size_t)u.e * (2 * DFF) + u.pn * 256 + wc * 32 + 8 * fq;
        LAS unsigned char* const buf = lds + LDS_EPI + wr * 9216;
#pragma unroll
        for (int ai = 0; ai < 2; ++ai) {
#pragma unroll
            for (int bj = 0; bj < 2; ++bj) { const f32x4 c0v = ld4(bias + bj * 128), c1v = ld4(bias + bj * 128 + 4);
#pragma unroll
                for (int m = 0; m < 4; ++m) {
                    const f32x4 v0 = acc[ai][bj][m][0] * W8_INV + c0v, v1 = acc[ai][bj][m][1] * W8_INV + c1v;
                    float o[4];
#pragma unroll
                    for (int j = 0; j < 4; ++j) { const float gt = fminf(j < 2 ? v0[2 * j] : v1[2 * j - 4], SW_LIMIT); const float up = fminf(fmaxf(j < 2 ? v0[2 * j + 1] : v1[2 * j - 3], -SW_LIMIT), SW_LIMIT);
                        o[j] = (up + 1.0f) * (gt * __builtin_amdgcn_rcpf(1.0f + __builtin_amdgcn_exp2f(gt * (-SW_ALPHA * 1.4426950408889634f)))); }
                    *(LAS unsigned*)(buf + (m * 16 + fr) * 144 + bj * 64 + wc * 16 + fq * 4) = pack4_fp8(o[0], o[1], o[2], o[3]); } }
            asm volatile("s_waitcnt lgkmcnt(0)" ::: "memory"); __builtin_amdgcn_s_barrier(); asm volatile("" ::: "memory");
            {   const int l2 = fr + 16 * fq;
#pragma unroll
                for (int i = 0; i < 2; ++i) { const int idx = wc * 64 + l2 + i * 256, row = idx >> 3, ck = idx & 7;
                    const u32x4 w = *(const LAS u32x4*)(buf + row * 144 + ck * 16);
                    *(u32x4*)(act + (size_t)(u.pm * 256 + ai * 128 + wr * 64 + row) * DFF + u.pn * 128 + ck * 16) = w; } }
            asm volatile("s_waitcnt lgkmcnt(0)" ::: "memory"); __builtin_amdgcn_s_barrier(); asm volatile("" ::: "memory");
        }
    }
};
struct EpiDown {
    static constexpr bool PERM = true; bf16_t* yb; const float* b_down;
    __device__ __forceinline__ void operator()(const f32x4 (&acc)[2][2][4][2], const Unit& u, int wr, int wc, int fr, int fq) const {
        const float* bias = b_down + (size_t)u.e * ND + u.pn * 256 + wc * 32 + 8 * fq;
#pragma unroll
        for (int bj = 0; bj < 2; ++bj) { const f32x4 c0v = ld4(bias + bj * 128), c1v = ld4(bias + bj * 128 + 4); const int c0 = u.pn * 256 + bj * 128 + wc * 32 + 8 * fq;
#pragma unroll
            for (int ai = 0; ai < 2; ++ai)
#pragma unroll
                for (int m = 0; m < 4; ++m) { const int r = u.pm * 256 + ai * 128 + wr * 64 + m * 16 + fr;
                    const f32x4 v0 = acc[ai][bj][m][0] * W8_INV + c0v, v1 = acc[ai][bj][m][1] * W8_INV + c1v;
                    u32x4 w; w.x = cvt_pk_bf16(v0[0], v0[1]); w.y = cvt_pk_bf16(v0[2], v0[3]); w.z = cvt_pk_bf16(v1[0], v1[1]); w.w = cvt_pk_bf16(v1[2], v1[3]);
                    *(u32x4*)(yb + (size_t)r * ND + c0) = w; } }
    }
};

struct WinRestOrder {
    int c; size_t a_tile, b_tile;
    __device__ bool next(int i, Unit& u) const {
        if (i > 0 || c < 0 || c >= 64) return false;
        u.pm = c >> 1; u.pn = 23 + (c & 1); u.e = 0; u.aoff = (unsigned)((size_t)u.pm * a_tile); u.boff = (unsigned)((size_t)u.pn * b_tile); return true;
    }
};
struct PoolOrder {
    int G, c;
    __device__ bool next(int i, Unit& u) const {
        const int L = i * G + c; if (c < 0 || L >= 256) return false;
        u.pm = L >> 3; u.pn = L & 7; u.e = 0;
        u.aoff = (unsigned)(((size_t)u.pm * 256 * NC + (size_t)(u.pn >> 1) * 256) * 2); u.boff = (unsigned)((size_t)u.pn * 256 * 256 * 2); return true;
    }
};
struct MoeOrder {
    int G, c, nN, ntiles; const LAS unsigned* tile_e; size_t a_tile, b_expert, b_tile;
    __device__ bool next(int i, Unit& u) const {
        const int L = i * G + c; if (L >= ntiles * nN) return false;
        u.pm = L / nN; u.pn = L % nN; u.e = __builtin_amdgcn_readfirstlane((int)tile_e[u.pm]);
        u.aoff = (unsigned)((size_t)u.pm * a_tile); u.boff = (unsigned)((size_t)u.e * b_expert + (size_t)u.pn * b_tile); return true;
    }
};

__device__ __forceinline__ void cvt_block_T(const float* src, int ld_src, bf16_t* dst, int ld_dst, int lane) {
    const int k8 = lane & 7, nq = lane >> 3;
    const float* s = src + (size_t)(k8 * 8) * ld_src + nq * 4;
    f32x4 v[8];
#pragma unroll
    for (int j = 0; j < 8; ++j) v[j] = __builtin_nontemporal_load((const f32x4*)(s + (size_t)j * ld_src));
#pragma unroll
    for (int i = 0; i < 4; ++i) { u32x4 w; w.x = cvt_pk_bf16(v[0][i], v[1][i]); w.y = cvt_pk_bf16(v[2][i], v[3][i]); w.z = cvt_pk_bf16(v[4][i], v[5][i]); w.w = cvt_pk_bf16(v[6][i], v[7][i]);
        *(u32x4*)(dst + (size_t)(nq * 4 + i) * ld_dst + k8 * 8) = w; }
}
__device__ __forceinline__ void cvt_block_T2(const float* src, int ld_src, bf16_t* dst, int ld_dst, int lane) {
    const int k8 = lane & 7, nq = lane >> 3;
    const float* s = src + (size_t)(k8 * 8) * ld_src + nq * 4;
    f32x4 v[8], w2[8];
#pragma unroll
    for (int j = 0; j < 8; ++j) { v[j] = ld4(s + (size_t)j * ld_src); w2[j] = ld4(s + (size_t)j * ld_src + 32); }
#pragma unroll
    for (int i = 0; i < 4; ++i) { u32x4 w; w.x = cvt_pk_bf16(v[0][i], v[1][i]); w.y = cvt_pk_bf16(v[2][i], v[3][i]); w.z = cvt_pk_bf16(v[4][i], v[5][i]); w.w = cvt_pk_bf16(v[6][i], v[7][i]);
        *(u32x4*)(dst + (size_t)(nq * 4 + i) * ld_dst + k8 * 8) = w; }
#pragma unroll
    for (int i = 0; i < 4; ++i) { u32x4 w; w.x = cvt_pk_bf16(w2[0][i], w2[1][i]); w.y = cvt_pk_bf16(w2[2][i], w2[3][i]); w.z = cvt_pk_bf16(w2[4][i], w2[5][i]); w.w = cvt_pk_bf16(w2[6][i], w2[7][i]);
        *(u32x4*)(dst + (size_t)(32 + nq * 4 + i) * ld_dst + k8 * 8) = w; }
}

__device__ __forceinline__ void cvt8_load(f32x4 (&v)[16], const float* s, int ld_src) {
#pragma unroll
    for (int j = 0; j < 16; ++j) v[j] = __builtin_nontemporal_load((const f32x4*)(s + (size_t)j * ld_src));
}
template <bool NT = true>
__device__ __forceinline__ void cvt8_store(const f32x4 (&v)[16], fp8_t* d, int ld_dst) {
#pragma unroll
    for (int i = 0; i < 4; ++i) { u32x4 w; w.x = pack4_fp8(v[0][i] * W8_SCALE, v[1][i] * W8_SCALE, v[2][i] * W8_SCALE, v[3][i] * W8_SCALE); w.y = pack4_fp8(v[4][i] * W8_SCALE, v[5][i] * W8_SCALE, v[6][i] * W8_SCALE, v[7][i] * W8_SCALE);
        w.z = pack4_fp8(v[8][i] * W8_SCALE, v[9][i] * W8_SCALE, v[10][i] * W8_SCALE, v[11][i] * W8_SCALE); w.w = pack4_fp8(v[12][i] * W8_SCALE, v[13][i] * W8_SCALE, v[14][i] * W8_SCALE, v[15][i] * W8_SCALE);
        if constexpr (NT) __builtin_nontemporal_store(w, (u32x4*)(d + (size_t)i * ld_dst)); else *(u32x4*)(d + (size_t)i * ld_dst) = w; }
}
__device__ __forceinline__ void cvt8_block_T(const float* src, int ld_src, fp8_t* dst, int ld_dst, int lane) {
    const int k16 = lane & 7, nq = lane >> 3;
    f32x4 v[16]; cvt8_load(v, src + (size_t)(k16 * 16) * ld_src + nq * 4, ld_src);
    cvt8_store<false>(v, dst + (size_t)(nq * 4) * ld_dst + k16 * 16, ld_dst);
}
__device__ __forceinline__ void cvt_wave_T8x8(const float* src, int ld_src, fp8_t* dst, int ld_dst, int lane) {
    const int k16 = lane & 7, nq = lane >> 3;
    const float* s = src + (size_t)(k16 * 16) * ld_src + nq * 4; fp8_t* d = dst + (size_t)(nq * 4) * ld_dst + k16 * 16;
    f32x4 va[16], vb[16];
    cvt8_load(va, s, ld_src);
#pragma unroll
    for (int i = 0; i < 8; i += 2) {
        cvt8_load(vb, s + (i + 1) * 32, ld_src);
        cvt8_store(va, d + (size_t)(i * 32) * ld_dst, ld_dst);
        if (i + 2 < 8) cvt8_load(va, s + (i + 2) * 32, ld_src);
        cvt8_store(vb, d + (size_t)((i + 1) * 32) * ld_dst, ld_dst);
    }
}

__device__ __forceinline__ void phase0(const Params& p, LAS unsigned char* lds, const int wave) {
    const int tid = phase_tid(wave);
    const int bid = blockIdx.x, lane = tid & 63, wv = tid >> 6;
    LAS float* cond = (LAS float*)lds;
    if (bid < 192) {
        for (int i = tid; i < NB * ND; i += NTHREADS) { const int b = i >> 11, k = i & 2047; const float cv = p.c[i]; cond[k * 4 + b] = cv / (1.0f + expf(-cv)); }
        __syncthreads();
        const int gid = bid * NTHREADS + tid, ks = gid / 3072, j4 = gid % 3072;
        f32x4 a0 = {0.f, 0.f, 0.f, 0.f}, a1 = a0, a2 = a0, a3 = a0;
        const float* wp = p.w_ada + (size_t)(ks * 64) * NMOD + j4 * 4;
#pragma unroll 16
        for (int kk = 0; kk < 64; ++kk) { const f32x4 w = __builtin_nontemporal_load((const f32x4*)(wp + (size_t)kk * NMOD)); const f32x4 cd = *(const LAS f32x4*)(cond + (ks * 64 + kk) * 4);
            a0 += w * cd[0]; a1 += w * cd[1]; a2 += w * cd[2]; a3 += w * cd[3]; }
        *(f32x4*)(p.modp + (size_t)(ks * 4 + 0) * NMOD + j4 * 4) = a0; *(f32x4*)(p.modp + (size_t)(ks * 4 + 1) * NMOD + j4 * 4) = a1;
        *(f32x4*)(p.modp + (size_t)(ks * 4 + 2) * NMOD + j4 * 4) = a2; *(f32x4*)(p.modp + (size_t)(ks * 4 + 3) * NMOD + j4 * 4) = a3;
    }
    const int gw = bid * NWAVES + wv, GW = gridDim.x * NWAVES;
    constexpr int I_IN = 16 * 265, I_RW = 16 * 64, I_PL = 4 * 4 * 16, I_OUT = 32 * 64, I_ALL = I_IN + I_RW + I_PL + I_OUT;
    for (int it = gw; it < I_ALL; it += GW) {
        if (it < I_IN) { const int kb = it / 265, nb = it % 265; cvt8_block_T(p.w_in + (size_t)(kb * 128) * NIN + nb * 32, NIN, p.wt_in + (size_t)(nb * 32) * ND + kb * 128, ND, lane); }
        else if (it < I_IN + I_RW) { const int j = it - I_IN, kb = j / 64, nb = j % 64; cvt_block_T(p.w_rwkv_out + (size_t)(kb * 64) * ND + nb * 32, ND, p.wt_rwkv + (size_t)(nb * 32) * NC + kb * 64, NC, lane); }
        else if (it < I_IN + I_RW + I_PL) { const int j = it - I_IN - I_RW, g = j / 64, kb = (j % 64) / 16, nb = j % 16;
            cvt_block_T(p.w_pool + (size_t)g * 256 * 512 + (size_t)(kb * 64) * 512 + nb * 32, 512, p.wt_pool + (size_t)g * 512 * 256 + (size_t)(nb * 32) * 256 + kb * 64, 256, lane); }
        else { const int j = it - I_IN - I_RW - I_PL, kb = j / 64, nb = j % 64; cvt_block_T(p.w_out + (size_t)(kb * 64) * ND + nb * 32, ND, p.wt_out + (size_t)(nb * 32) * ND + kb * 64, ND, lane); }
    }
    for (int idx = bid * NTHREADS + tid; idx < LORA_N * (LORA_K / 8); idx += gridDim.x * NTHREADS) {
        const int n = idx / (LORA_K / 8), k0 = (idx % (LORA_K / 8)) * 8; float v[8];
#pragma unroll
        for (int j = 0; j < 8; ++j) { const int k = k0 + j; float x = 0.f;
            if (n < 1024) { if (k < 64) x = p.w_decay_up[k * NC + n]; }
            else if (n < 2048) { if (k >= 64 && k < 128) x = p.w_iclr_up[(k - 64) * NC + (n - 1024)]; }
            else { if (k >= 128 && k < 288) x = p.w_glora_up[(k - 128) * NC + (n - 2048)]; }
            v[j] = x; }
        u32x4 w; w.x = cvt_pk_bf16(v[0], v[1]); w.y = cvt_pk_bf16(v[2], v[3]); w.z = cvt_pk_bf16(v[4], v[5]); w.w = cvt_pk_bf16(v[6], v[7]);
        *(u32x4*)(p.bt_lora + (size_t)n * LORA_K + k0) = w;
    }
}

__device__ __forceinline__ void phase1(const Params& p, LAS unsigned char* lds, const int wave) {
    const int tid = phase_tid(wave);
    const int bid = blockIdx.x;
    if (tid < 192) { const int idx = bid * 192 + tid, b = idx / NMOD, j = idx % NMOD; float s = p.b_ada[j];
        for (int ks = 0; ks < KS_MOD; ++ks) s += p.modp[(size_t)(ks * 4 + b) * NMOD + j];
        p.mod[idx] = s; }
    LAS float* ss = (LAS float*)lds;
    const int m0 = bid * 32, b = m0 >> 11;
    {   const int j = tid * 8; f32x4 s0 = ld4(p.b_ada + j), s1 = ld4(p.b_ada + j + 4);
#pragma unroll 8
        for (int ks = 0; ks < KS_MOD; ++ks) { s0 += ld4(p.modp + (size_t)(ks * 4 + b) * NMOD + j); s1 += ld4(p.modp + (size_t)(ks * 4 + b) * NMOD + j + 4); }
        *(LAS f32x4*)(ss + j) = s0; *(LAS f32x4*)(ss + j + 4) = s1; }
    __syncthreads();
    const int k = (tid & 255) * 8, rh = tid >> 8;
    const f32x4 sh0 = *(const LAS f32x4*)(ss + k), sh1v = *(const LAS f32x4*)(ss + k + 4), sc0 = *(const LAS f32x4*)(ss + ND + k) + 1.0f, sc1v = *(const LAS f32x4*)(ss + ND + k + 4) + 1.0f;
#pragma unroll 4
    for (int i = 0; i < 16; ++i) { const size_t m = (size_t)(m0 + 2 * i + rh); const f32x4 x0 = ld4nt(p.x + m * ND + k), x1 = ld4nt(p.x + m * ND + k + 4); const f32x4 h0 = x0 * sc0 + sh0, h1 = x1 * sc1v + sh1v;
        u32x2 w; w.x = pack4_fp8(h0[0], h0[1], h0[2], h0[3]); w.y = pack4_fp8(h1[0], h1[1], h1[2], h1[3]); *(u32x2*)(p.hb + m * ND + k) = w; }
    __syncthreads();
}

__device__ __forceinline__ void phase3(const Params& p, LAS unsigned char* lds, const int wave) {
    const int tid = phase_tid(wave);
    const int bid = blockIdx.x, m0 = bid * 32, t0 = m0 & (NT - 1), hist = t0 > 0 ? 15 : 0;
    constexpr int TC = OFF_GA - OFF_WD, TCH = TC / 8;
    LAS bf16_t* T = (LAS bf16_t*)lds;
    for (int idx = tid; idx < 47 * TCH; idx += NTHREADS) { const int r = idx / TCH, ck = idx % TCH;
        if (r >= 15 - hist) *(LAS u32x4*)(T + r * TC + ck * 8) = ldu4nt(p.P + (size_t)(m0 - 15 + r) * NINP + OFF_WD + ck * 8); }
    __syncthreads();
    for (int idx = tid; idx < 32 * (LORA_K / 8); idx += NTHREADS) { const int i = idx / (LORA_K / 8), j0 = (idx % (LORA_K / 8)) * 8; u32x4 w = {0u, 0u, 0u, 0u};
        if (j0 < 288) { const u32x4 cu = *(const LAS u32x4*)(T + (15 + i) * TC + j0); u32x4 pu = {0u, 0u, 0u, 0u}; if (t0 + i > 0) pu = *(const LAS u32x4*)(T + (14 + i) * TC + j0);
            const f32x4 c0 = bf4_unpack((u32x2){cu.x, cu.y}), c1 = bf4_unpack((u32x2){cu.z, cu.w}), q0 = bf4_unpack((u32x2){pu.x, pu.y}), q1 = bf4_unpack((u32x2){pu.z, pu.w});
            const f32x4 s0 = c0 + (q0 - c0) * ld4(p.mu_shift + OFF_WD + j0), s1 = c1 + (q1 - c1) * ld4(p.mu_shift + OFF_WD + j0 + 4); float v[8];
#pragma unroll
            for (int j = 0; j < 8; ++j) { const float x = j < 4 ? s0[j] : s1[j - 4];
                v[j] = j0 < 64 ? (1.0f - 2.0f * __builtin_amdgcn_rcpf(1.0f + __builtin_amdgcn_exp2f(x * 2.8853900817779268f))) : (j0 < 128 ? x : sigmoidf_(x)); }
            w.x = cvt_pk_bf16(v[0], v[1]); w.y = cvt_pk_bf16(v[2], v[3]); w.z = cvt_pk_bf16(v[4], v[5]); w.w = cvt_pk_bf16(v[6], v[7]); }
        *(u32x4*)(p.a_lora + (size_t)(m0 + i) * LORA_K + j0) = w; }
    for (int idx = tid; idx < 32 * (NC / 8); idx += NTHREADS) { const int i = idx >> 7, c = (idx & 127) * 8; const int win = 2 << (c >> 8), t = t0 + i, n = (t + 1) < win ? (t + 1) : win;
        const LAS bf16_t* up = T + (15 + i) * TC + (OFF_POOL - OFF_WD) + c; f32x4 a0 = {0.f, 0.f, 0.f, 0.f}, a1 = a0;
        for (int q = 0; q < n; ++q) { const u32x4 uu = *(const LAS u32x4*)(up - q * TC); a0 += bf4_unpack((u32x2){uu.x, uu.y}); a1 += bf4_unpack((u32x2){uu.z, uu.w}); }
        const u32x4 u0 = *(const LAS u32x4*)(up); const float rn = 1.0f / (float)n;
        const f32x4 d0 = a0 * rn - bf4_unpack((u32x2){u0.x, u0.y}), d1 = a1 * rn - bf4_unpack((u32x2){u0.z, u0.w});
        u32x4 w; w.x = cvt_pk_bf16(d0[0], d0[1]); w.y = cvt_pk_bf16(d0[2], d0[3]); w.z = cvt_pk_bf16(d1[0], d1[1]); w.w = cvt_pk_bf16(d1[2], d1[3]);
        *(u32x4*)(p.dp + (size_t)(m0 + i) * NC + c) = w; }
    __syncthreads();
}

__device__ __forceinline__ float row8_allsum(float x) {
    x += dpp_f<0x141>(x); x += dpp_f<0x1B>(x); x += dpp_f<0xB1>(x); return x;
}
__device__ __forceinline__ void scan_head(const Params& p, LAS unsigned char* lds, int bh, const int wave) {
    const int tid = phase_tid(wave);
    const int lane = tid & 63;
    const int b = bh >> 4, h = bh & 15;
    constexpr int L_AW = 0, L_W = 16384, L_BK = 32768, L_Y = 65536, L_V = 81920, L_G = 106496, L_SC = 131072, L_CS = 131840, L_Z = 132352, L_DUMMY = 132864, L_CST = 133888;
    constexpr int NCH = NT / 32;
    if (tid < 128) *(LAS unsigned*)(lds + L_Z + tid * 4) = 0u;
    {
        const int a8 = tid >> 6, cc = tid & 63, gch = h * HS + cc;
        const float* src = a8 == 0 ? p.mu_shift + OFF_R : a8 == 1 ? p.mu_shift + OFF_K : a8 == 2 ? p.mu_shift + OFF_V : a8 == 3 ? p.k_k : a8 == 4 ? p.k_a : a8 == 5 ? p.r_k : a8 == 6 ? p.lnx_g : p.lnx_b;
        *(LAS float*)(lds + L_CST + a8 * 256 + cc * 4) = src[gch]; }
    __syncthreads();
#define CST4(a8, u_) (*(const LAS f32x4*)(lds + L_CST + (a8) * 256 + (c8 + 4 * (u_)) * 4))
    const int ht = tid - 256, ls = (ht >> 3) & 31, c8 = (ht & 7) * 8, ch0 = h * HS + c8;
    f32x4 pr[2], pk[2], pv[2], qr[2], qk[2], qv[2], dc[2], ic[2], gt[2]; u32x4 pr8, pk8, pv8, qr8, qk8, qv8, ic8, gt8;
    const f32x4 zero4 = {0.f, 0.f, 0.f, 0.f};
#define SCAN_ISSUE(chunk) do { int ch = ch0; asm volatile("" : "+v"(ch)); const int t_ = (chunk) * 32 + ls; const size_t m_ = (size_t)b * NT + t_; const bf16_t* row_ = p.P + m_ * NINP + ch; \
        pr8 = *(const u32x4*)(row_ + OFF_R); pk8 = *(const u32x4*)(row_ + OFF_K); pv8 = *(const u32x4*)(row_ + OFF_V); \
        if (t_ > 0) { qr8 = *(const u32x4*)(row_ - NINP + OFF_R); qk8 = *(const u32x4*)(row_ - NINP + OFF_K); qv8 = *(const u32x4*)(row_ - NINP + OFF_V); } else { qr8 = (u32x4){0u, 0u, 0u, 0u}; qk8 = qr8; qv8 = qr8; } \
        ic8 = ldu4nt(p.iclr + m_ * NC + ch); gt8 = ldu4nt(p.gg + m_ * NC + ch); \
        _Pragma("unroll") for (int u_ = 0; u_ < 2; ++u_) dc[u_] = ld4nt(p.dec + m_ * NC + ch + 4 * u_); } while (0)
#define SCAN_UNPACK() do { ic[0] = bf4_unpack((u32x2){ic8.x, ic8.y}); ic[1] = bf4_unpack((u32x2){ic8.z, ic8.w}); gt[0] = bf4_unpack((u32x2){gt8.x, gt8.y}); gt[1] = bf4_unpack((u32x2){gt8.z, gt8.w}); pr[0] = bf4_unpack((u32x2){pr8.x, pr8.y}); pr[1] = bf4_unpack((u32x2){pr8.z, pr8.w}); pk[0] = bf4_unpack((u32x2){pk8.x, pk8.y}); pk[1] = bf4_unpack((u32x2){pk8.z, pk8.w}); \
        pv[0] = bf4_unpack((u32x2){pv8.x, pv8.y}); pv[1] = bf4_unpack((u32x2){pv8.z, pv8.w}); qr[0] = bf4_unpack((u32x2){qr8.x, qr8.y}); qr[1] = bf4_unpack((u32x2){qr8.z, qr8.w}); \
        qk[0] = bf4_unpack((u32x2){qk8.x, qk8.y}); qk[1] = bf4_unpack((u32x2){qk8.z, qk8.w}); qv[0] = bf4_unpack((u32x2){qv8.x, qv8.y}); qv[1] = bf4_unpack((u32x2){qv8.z, qv8.w}); } while (0)
#define SCAN_STAGE(chunk) do { SCAN_UNPACK(); int ch = ch0; asm volatile("" : "+v"(ch)); const int bp_ = (chunk) & 1, vb_ = (chunk) % 3; f32x4 r_[2], k_[2], v_[2], kk_[2], km_[2], bb_[2]; float ss_ = 0.f; \
        _Pragma("unroll") for (int u_ = 0; u_ < 2; ++u_) { const f32x4 mu_r = CST4(0, u_), mu_k = CST4(1, u_), mu_v = CST4(2, u_); \
            r_[u_] = pr[u_] + (qr[u_] - pr[u_]) * mu_r; k_[u_] = pk[u_] + (qk[u_] - pk[u_]) * mu_k; v_[u_] = pv[u_] + (qv[u_] - pv[u_]) * mu_v; \
            kk_[u_] = k_[u_] * CST4(3, u_); ss_ += dot4(kk_[u_], kk_[u_]); } \
        ss_ = row8_allsum(ss_); const float inv_ = 1.0f / fmaxf(sqrtf(ss_), 1e-12f); float br_ = 0.f, kr_ = 0.f, rk_ = 0.f; \
        _Pragma("unroll") for (int u_ = 0; u_ < 2; ++u_) { kk_[u_] = kk_[u_] * inv_; km_[u_] = k_[u_] * ((ic[u_] - 1.0f) * CST4(4, u_) + 1.0f); bb_[u_] = kk_[u_] * ic[u_]; \
            br_ += dot4(bb_[u_], r_[u_]); kr_ += dot4(km_[u_], r_[u_]); rk_ += dot4(r_[u_] * km_[u_], CST4(5, u_)); } \
        br_ = row8_allsum(br_); kr_ = row8_allsum(kr_); rk_ = row8_allsum(rk_); \
          \
        const int pp_ = ls >> 1, odd_ = ls & 1; float c1_ = 0.f, c2_ = 0.f, c3_ = 0.f, c4_ = 0.f; \
        _Pragma("unroll") for (int u_ = 0; u_ < 2; ++u_) { const int k0_ = c8 + 4 * u_; const int pos_ = (k0_ >> 5) * 32 + ((k0_ & 15) >> 2) * 8 + ((k0_ >> 4) & 1) * 4; \
            const f32x4 a_ = -kk_[u_], wr_ = dc[u_] * r_[u_] + a_ * br_; f32x4 pw_, pb_, pk_; \
            _Pragma("unroll") for (int j_ = 0; j_ < 4; ++j_) { pw_[j_] = dpp_f<0x118>(dc[u_][j_]); pb_[j_] = dpp_f<0x118>(bb_[u_][j_]); pk_[j_] = dpp_f<0x118>(km_[u_][j_]); } \
            const f32x4 x0_ = odd_ ? pw_ * a_ : a_, x1_ = odd_ ? pw_ * wr_ : wr_; \
            u32x2 wa_, ww_; wa_.x = cvt_pk_bf16(x0_[0], x0_[1]); wa_.y = cvt_pk_bf16(x0_[2], x0_[3]); ww_.x = cvt_pk_bf16(x1_[0], x1_[1]); ww_.y = cvt_pk_bf16(x1_[2], x1_[3]); \
            *(LAS u32x2*)(lds + L_AW + bp_ * 8192 + pp_ * 512 + odd_ * 256 + pos_ * 2) = wa_; *(LAS u32x2*)(lds + L_AW + bp_ * 8192 + pp_ * 512 + odd_ * 256 + 128 + pos_ * 2) = ww_; \
            if (odd_) { *(LAS f32x4*)(lds + L_W + bp_ * 8192 + pp_ * 256 + k0_ * 4) = pw_ * dc[u_]; \
                *(LAS f32x4*)(lds + L_BK + bp_ * 16384 + pp_ * 1024 + k0_ * 4) = pb_ * dc[u_]; *(LAS f32x4*)(lds + L_BK + bp_ * 16384 + pp_ * 1024 + 256 + k0_ * 4) = pk_ * dc[u_]; \
                *(LAS f32x4*)(lds + L_BK + bp_ * 16384 + pp_ * 1024 + 512 + k0_ * 4) = bb_[u_]; *(LAS f32x4*)(lds + L_BK + bp_ * 16384 + pp_ * 1024 + 768 + k0_ * 4) = km_[u_]; \
                c1_ += dot4(pb_, a_); c2_ += dot4(pk_, a_); c3_ += dot4(pb_, wr_); c4_ += dot4(pk_, wr_); } \
            *(LAS f32x4*)(lds + L_V + vb_ * 8192 + ls * 256 + k0_ * 4) = v_[u_]; *(LAS f32x4*)(lds + L_G + vb_ * 8192 + ls * 256 + k0_ * 4) = gt[u_]; } \
        c1_ = row8_allsum(c1_); c2_ = row8_allsum(c2_); c3_ = row8_allsum(c3_); c4_ = row8_allsum(c4_); \
        if ((ht & 7) == 0) { *(LAS f32x2*)(lds + L_SC + vb_ * 256 + ls * 8) = (f32x2){kr_, rk_}; if (odd_) *(LAS f32x4*)(lds + L_CS + bp_ * 256 + pp_ * 16) = (f32x4){c1_, c2_, c3_, c4_}; } } while (0)
#define SCAN_POST(chunk) do { int ch = ch0; asm volatile("" : "+v"(ch)); const int bp_ = (chunk) & 1, vb_ = (chunk) % 3; const f32x2 sc_ = *(const LAS f32x2*)(lds + L_SC + vb_ * 256 + ls * 8); f32x4 y_[2], v_[2]; float s_ = 0.f; \
        _Pragma("unroll") for (int u_ = 0; u_ < 2; ++u_) { v_[u_] = *(const LAS f32x4*)(lds + L_V + vb_ * 8192 + ls * 256 + (c8 + 4 * u_) * 4); \
            y_[u_] = *(const LAS f32x4*)(lds + L_Y + bp_ * 8192 + ls * 256 + (c8 + 4 * u_) * 4) + v_[u_] * sc_[0]; s_ += (y_[u_][0] + y_[u_][1]) + (y_[u_][2] + y_[u_][3]); } \
        const float mean_ = row8_allsum(s_) * (1.0f / 64.0f); float q_ = 0.f; \
        _Pragma("unroll") for (int u_ = 0; u_ < 2; ++u_) { y_[u_] = y_[u_] - mean_; q_ += dot4(y_[u_], y_[u_]); } \
        const float rstd_ = rsqrtf(row8_allsum(q_) * (1.0f / 64.0f) + GN_EPS); const size_t m_ = (size_t)b * NT + (chunk) * 32 + ls; u32x4 o_; \
        _Pragma("unroll") for (int u_ = 0; u_ < 2; ++u_) { const f32x4 g_ = *(const LAS f32x4*)(lds + L_G + vb_ * 8192 + ls * 256 + (c8 + 4 * u_) * 4); \
            const f32x4 yn_ = y_[u_] * rstd_ * CST4(6, u_) + CST4(7, u_); const f32x4 f_ = (yn_ + v_[u_] * sc_[1]) * g_; \
            if (u_ == 0) { o_.x = cvt_pk_bf16(f_[0], f_[1]); o_.y = cvt_pk_bf16(f_[2], f_[3]); } else { o_.z = cvt_pk_bf16(f_[0], f_[1]); o_.w = cvt_pk_bf16(f_[2], f_[3]); } } \
        *(u32x4*)(p.yr + m_ * NC + ch) = o_; } while (0)
    const int ri = lane & 15, rg = lane >> 4, sel = ri & 3;
    f32x4 X0 = zero4, X1 = zero4, X2 = zero4, X3 = zero4;
    if (wave >= 4) { SCAN_ISSUE(0); SCAN_STAGE(0); }
    __syncthreads();
    for (int chunk = 0; chunk < NCH; ++chunk) {
        if (wave < 4) {
            __builtin_amdgcn_s_setprio(3);
            const int bp = chunk & 1, vb = chunk % 3;
            const LAS unsigned char* awp = lds + L_AW + bp * 8192 + sel * 128 + rg * 16;
            const LAS unsigned char* wwp = lds + L_W + bp * 8192 + rg * 16;
            const LAS unsigned char* abp = lds + L_BK + bp * 16384 + rg * 256 + ri * 4;
            const LAS unsigned char* vp = lds + L_V + vb * 8192 + (16 * wave + ri) * 4;
            const LAS unsigned char* csp = lds + L_CS + bp * 256;
            LAS unsigned char* yp = (rg == 0) ? (lds + L_Y + bp * 8192 + (16 * wave + ri) * 4) : ((rg == 2) ? (lds + L_Y + bp * 8192 + 256 + (16 * wave + ri) * 4) : (lds + L_DUMMY + tid * 4));
            const int y_st = (rg & 1) ? 0 : 512;
#define SCAN_LD(S, pi) do { S##a0 = *(const LAS bf16x8*)(awp + (pi) * 512); S##a1 = *(const LAS bf16x8*)(awp + (pi) * 512 + 64); \
                S##w0 = *(const LAS f32x4*)(wwp + (pi) * 256); S##w1 = *(const LAS f32x4*)(wwp + (pi) * 256 + 64); S##w2 = *(const LAS f32x4*)(wwp + (pi) * 256 + 128); S##w3 = *(const LAS f32x4*)(wwp + (pi) * 256 + 192); \
                S##b0 = *(const LAS float*)(abp + (pi) * 1024); S##b1 = *(const LAS float*)(abp + (pi) * 1024 + 64); S##b2 = *(const LAS float*)(abp + (pi) * 1024 + 128); S##b3 = *(const LAS float*)(abp + (pi) * 1024 + 192); \
                S##vt = *(const LAS float*)(vp + (pi) * 512); S##vu = *(const LAS float*)(vp + (pi) * 512 + 256); S##cs = *(const LAS f32x4*)(csp + (pi) * 16); } while (0)
#define SCAN_STEP(S, pi) do { u32x4 xa, xc; \
                xa.x = cvt_pk_bf16(X0[0], X0[1]); xa.y = cvt_pk_bf16(X0[2], X0[3]); xa.z = cvt_pk_bf16(X1[0], X1[1]); xa.w = cvt_pk_bf16(X1[2], X1[3]); \
                xc.x = cvt_pk_bf16(X2[0], X2[1]); xc.y = cvt_pk_bf16(X2[2], X2[3]); xc.z = cvt_pk_bf16(X3[0], X3[1]); xc.w = cvt_pk_bf16(X3[2], X3[3]); \
                const f32x4 d0 = __builtin_amdgcn_mfma_f32_16x16x32_bf16(S##a0, __builtin_bit_cast(bf16x8, xa), zero4, 0, 0, 0); \
                const f32x4 d1 = __builtin_amdgcn_mfma_f32_16x16x32_bf16(S##a1, __builtin_bit_cast(bf16x8, xc), zero4, 0, 0, 0); \
                const f32x4 d = d0 + d1; const float sat = d[0]; \
                const float sau = d[2] + sat * S##cs[0] + S##vt * S##cs[1], yu = d[3] + sat * S##cs[2] + S##vt * S##cs[3]; \
                const float bsel = (rg == 0) ? sat : ((rg == 1) ? S##vt : ((rg == 2) ? sau : S##vu)); \
                X0 = __builtin_amdgcn_mfma_f32_16x16x4f32(S##b0, bsel, X0 * S##w0, 0, 0, 0); \
                X1 = __builtin_amdgcn_mfma_f32_16x16x4f32(S##b1, bsel, X1 * S##w1, 0, 0, 0); \
                X2 = __builtin_amdgcn_mfma_f32_16x16x4f32(S##b2, bsel, X2 * S##w2, 0, 0, 0); \
                X3 = __builtin_amdgcn_mfma_f32_16x16x4f32(S##b3, bsel, X3 * S##w3, 0, 0, 0); \
                *(LAS float*)(yp + (pi) * y_st) = (rg == 0) ? d[1] : yu; } while (0)
            bf16x8 Pa0, Pa1, Qa0, Qa1; f32x4 Pw0, Pw1, Pw2, Pw3, Qw0, Qw1, Qw2, Qw3, Pcs, Qcs; float Pb0, Pb1, Pb2, Pb3, Pvt, Pvu, Qb0, Qb1, Qb2, Qb3, Qvt, Qvu;
            SCAN_LD(P, 0);
#pragma unroll 1
            for (int pi = 0; pi < 16; pi += 2) {
                SCAN_LD(Q, pi + 1);
                SCAN_STEP(P, pi);
                if (pi + 2 < 16) SCAN_LD(P, pi + 2);
                SCAN_STEP(Q, pi + 1);
            }
#undef SCAN_LD
#undef SCAN_STEP
        } else {
            if (chunk + 1 < NCH) SCAN_ISSUE(chunk + 1);
            if (chunk > 0) SCAN_POST(chunk - 1);
            if (chunk + 1 < NCH) SCAN_STAGE(chunk + 1);
        }
        __syncthreads();
    }
    if (wave >= 4) SCAN_POST(NCH - 1);
    __syncthreads();
#undef SCAN_ISSUE
#undef CST4
#undef SCAN_STAGE
#undef SCAN_UNPACK
#undef SCAN_POST
}
__device__ __forceinline__ void conv_queue(const Params& p, LAS unsigned char* lds, const int wave, const int cw, const int n_defer = N_DEFER) {
    const int tid = phase_tid(wave);
    const int lane = tid & 63, wv = tid >> 6;
    LAS int* slot = (LAS int*)(lds + LDS_MISC);
    constexpr int N_GU = NE * 16 * 2, N_DN = NE * 16, N_ALL = N_GU + N_DN;
    for (;;) {
        __syncthreads();
        if (tid == 0) *slot = (int)atomicAdd(&p.ctl[cw], 1u);
        __syncthreads();
        const int it = *slot;
        if (it >= N_ALL - n_defer) break;
        if (it < N_GU) { const int e = it >> 5, rem = it & 31, kb = rem >> 1, nh = rem & 1;
            const float* src = p.w_gu + (size_t)e * ND * (2 * DFF) + (size_t)(kb * 128) * (2 * DFF) + nh * 2048;
            fp8_t* dst = p.wt_gu + (size_t)e * (2 * DFF) * ND + (size_t)(nh * 2048) * ND + kb * 128;
            cvt_wave_T8x8(src + wv * 256, 2 * DFF, dst + (size_t)(wv * 256) * ND, ND, lane); }
        else { const int j = it - N_GU, e = j >> 4, kb = j & 15;
            const float* src = p.w_down + (size_t)e * DFF * ND + (size_t)(kb * 128) * ND;
            fp8_t* dst = p.wt_down + (size_t)e * ND * DFF + kb * 128;
            cvt_wave_T8x8(src + wv * 256, ND, dst + (size_t)(wv * 256) * DFF, DFF, lane); }
    }
}

__device__ __forceinline__ void conv_queue_tail(const Params& p, LAS unsigned char* lds, const int wave) {
    const int tid = phase_tid(wave);
    const int lane = tid & 63, wv = tid >> 6;
    LAS int* slot = (LAS int*)(lds + LDS_MISC + 1024);
    for (;;) {
        __syncthreads();
        if (tid == 0) *slot = (int)atomicAdd(&p.ctl[CW_CONV3], 1u);
        __syncthreads();
        const int it = *slot;
        if (it >= N_DEFER * 8) break;
        const int j = NE * 16 - N_DEFER + (it >> 3), sub = it & 7, e = j >> 4, kb = j & 15, k16 = lane & 7, nq = lane >> 3;
        const float* src = p.w_down + (size_t)e * DFF * ND + (size_t)(kb * 128 + k16 * 16) * ND + sub * 256 + wv * 32 + nq * 4;
        fp8_t* dst = p.wt_down + (size_t)e * ND * DFF + (size_t)(sub * 256 + wv * 32 + nq * 4) * DFF + kb * 128 + k16 * 16;
        f32x4 cv[16]; cvt8_load(cv, src, ND); cvt8_store(cv, dst, DFF);
    }
}

__device__ __forceinline__ void phase8(const Params& p, LAS unsigned char* lds, const int wave) {
    const int tid = phase_tid(wave);
    const int bid = blockIdx.x, lane = tid & 63, wv = tid >> 6;
    constexpr int HP = ND + 4;
    LAS float* hs = (LAS float*)lds;
    LAS float* lg = hs + 16 * HP;
    LAS float* part = lg + 16 * 32;
    LAS float* topv = part + 4 * 16 * 32;
    LAS int* topi = (LAS int*)(topv + 64);
    const int b = (bid * 32) >> 11;
    const float* sh2 = p.mod + (size_t)b * NMOD + 3 * ND; const float* sc2 = p.mod + (size_t)b * NMOD + 4 * ND;
    for (int pass = 0; pass < 2; ++pass) {
        const int mb = bid * 32 + pass * 16;
        for (int rr = 0; rr < 2; ++rr) { const int r = wv * 2 + rr; const size_t m = (size_t)(mb + r);
            f32x4 z[8]; float s = 0.f;
#pragma unroll
            for (int j = 0; j < 4; ++j) { z[2 * j] = ld4nt(p.z1 + m * ND + j * 512 + lane * 8); z[2 * j + 1] = ld4nt(p.z1 + m * ND + j * 512 + lane * 8 + 4);
                s += ((z[2 * j][0] + z[2 * j][1]) + (z[2 * j][2] + z[2 * j][3])) + ((z[2 * j + 1][0] + z[2 * j + 1][1]) + (z[2 * j + 1][2] + z[2 * j + 1][3])); }
            const float mean = wave_allsum(s) * (1.0f / ND); float qv = 0.f;
#pragma unroll
            for (int j = 0; j < 8; ++j) { const f32x4 d = z[j] - mean; qv += dot4(d, d); }
            const float rstd = rsqrtf(wave_allsum(qv) * (1.0f / ND) + LN_EPS);
            if (lane == 0) *(f32x2*)(p.lnst + m * 2) = (f32x2){mean, rstd};
#pragma unroll
            for (int j = 0; j < 8; ++j) { const int k = (j >> 1) * 512 + lane * 8 + (j & 1) * 4;
                const f32x4 x1 = (z[j] - mean) * rstd * ld4(p.ln1_g + k) + ld4(p.ln1_b + k);
                const f32x4 h = x1 * (ld4(sc2 + k) + 1.0f) + ld4(sh2 + k);
                *(unsigned*)(p.h2 + m * ND + k) = pack4_fp8(h[0], h[1], h[2], h[3]);
                *(LAS f32x4*)(hs + r * HP + k) = h; } }
        __syncthreads();
        {
            const int kq = wv >> 1, ntl = wv & 1, ar = lane & 15, ak = lane >> 4;
            f32x4 acc = {0.f, 0.f, 0.f, 0.f};
            const LAS float* ap = hs + ar * HP + kq * 512 + ak; const float* bp = p.w_router + (size_t)(kq * 512 + ak) * NE + ntl * 16 + ar;
#pragma unroll 1
            for (int kb = 0; kb < 128; kb += 32) { float bq[32];
#pragma unroll
                for (int j = 0; j < 32; ++j) bq[j] = bp[(size_t)(kb + j) * 4 * NE];
#pragma unroll
                for (int j = 0; j < 32; ++j) acc = __builtin_amdgcn_mfma_f32_16x16x4f32(ap[(kb + j) * 4], bq[j], acc, 0, 0, 0); }
#pragma unroll
            for (int j = 0; j < 4; ++j) part[(kq * 16 + ak * 4 + j) * 32 + ntl * 16 + ar] = acc[j]; }
        __syncthreads();
        {   const int r = tid >> 5, e = tid & 31;
            lg[r * 32 + e] = p.b_router[e] + (part[(0 * 16 + r) * 32 + e] + part[(1 * 16 + r) * 32 + e]) + (part[(2 * 16 + r) * 32 + e] + part[(3 * 16 + r) * 32 + e]); }
        __syncthreads();
        {
            const int r = tid >> 5, e = tid & 31; const LAS float* l = lg + r * 32; const float mine = l[e]; int rank = 0;
#pragma unroll
            for (int q = 0; q < 8; ++q) { const f32x4 o = *(const LAS f32x4*)(l + q * 4);
#pragma unroll
                for (int j = 0; j < 4; ++j) rank += (o[j] > mine || (o[j] == mine && (q * 4 + j) < e)) ? 1 : 0; }
            if (rank < 4) { topv[r * 4 + rank] = mine; topi[r * 4 + rank] = e; } }
        __syncthreads();
        if (tid < 64) { const int r = tid >> 2, k = tid & 3, m = mb + r; const f32x4 tv = *(const LAS f32x4*)(topv + r * 4); const int ei = topi[r * 4 + k];
            const float e0 = 1.0f, e1 = expf(tv[1] - tv[0]), e2 = expf(tv[2] - tv[0]), e3 = expf(tv[3] - tv[0]); const float sum = (e0 + e1) + (e2 + e3);
            const float mineexp = k == 0 ? e0 : (k == 1 ? e1 : (k == 2 ? e2 : e3));
            const unsigned rk = atomicAdd(&p.ctl[CW_CNT + 64 * ei], 1u);
            p.sel[m * 4 + k] = ei; p.rnk[m * 4 + k] = (int)rk; p.prob[m * 4 + k] = mineexp / sum; }
        __syncthreads();
    }
}

__device__ __forceinline__ void phase9(const Params& p, LAS unsigned char* lds, const int wave) {
    const int tid = phase_tid(wave);
    const int bid = blockIdx.x, lane = tid & 63, wv = tid >> 6;
    LAS int* seg = (LAS int*)lds;
    if (tid == 0) { int s = 0;
        for (int e = 0; e < NE; ++e) { seg[e] = s; const int c = (int)xb_ld(&p.ctl[CW_CNT + 64 * e]); s += (c + 255) & ~255; }
        seg[NE] = s;
        if (bid == 0) { int t = 0;
            for (int e = 0; e < NE; ++e) { const int nt = (seg[e + 1] - seg[e]) >> 8; for (int i = 0; i < nt; ++i) p.ctl[CW_TILEE + t + i] = (unsigned)e; t += nt; }
            p.ctl[CW_NTILES] = (unsigned)t; } }
    __syncthreads();
    {
        const int gw = bid * NWAVES + wv; i32x4 e4[4], r4[4]; u32x4 v0[4], v1[4];
#pragma unroll
        for (int i = 0; i < 4; ++i) { const int m = gw + i * 2048; e4[i] = *(const i32x4*)(p.sel + m * 4); r4[i] = *(const i32x4*)(p.rnk + m * 4);
            const u32x4* src = (const u32x4*)(p.h2 + (size_t)m * ND); v0[i] = src[lane]; v1[i] = src[64 + lane]; }
#pragma unroll
        for (int i = 0; i < 4; ++i) { const int m = gw + i * 2048; i32x4 dd;
#pragma unroll
            for (int k = 0; k < 4; ++k) { dd[k] = seg[e4[i][k]] + r4[i][k]; u32x4* q = (u32x4*)(p.xb + (size_t)dd[k] * ND); q[lane] = v0[i]; q[64 + lane] = v1[i]; }
            if (lane == 0) *(i32x4*)(p.dest + m * 4) = dd; } }
    __syncthreads();
}

__device__ __forceinline__ void phase13(const Params& p, const int wave) {
    const int tid = phase_tid(wave);
    const int bid = blockIdx.x, lane0 = tid & 63, wv = wave;
    const int GW = gridDim.x * NWAVES;
    for (int m = bid * NWAVES + wv; m < NM; m += GW) { const int b = m >> 11;
        int lane = lane0; asm volatile("" : "+v"(lane));
        const float* g2 = p.mod + (size_t)b * NMOD + 5 * ND;
        int d[4]; float pr[4]; const f32x2 st = *(const f32x2*)(p.lnst + (size_t)m * 2);
#pragma unroll
        for (int k = 0; k < 4; ++k) { d[k] = p.dest[m * 4 + k]; pr[k] = p.prob[m * 4 + k]; }
        f32x4 z[8]; float s = 0.f; u32x4 yq[4][4];
#pragma unroll
        for (int j = 0; j < 4; ++j) {
#pragma unroll
            for (int k = 0; k < 4; ++k) yq[j][k] = ldu4nt(p.yb + (size_t)d[k] * ND + j * 512 + lane * 8);
            z[2 * j] = ld4nt(p.z1 + (size_t)m * ND + j * 512 + lane * 8); z[2 * j + 1] = ld4nt(p.z1 + (size_t)m * ND + j * 512 + lane * 8 + 4); }
#pragma unroll
        for (int j = 0; j < 4; ++j) { const int c = j * 512 + lane * 8; f32x4 f0 = {0.f, 0.f, 0.f, 0.f}, f1 = f0;
#pragma unroll
            for (int k = 0; k < 4; ++k) { f0 += bf4_unpack((u32x2){yq[j][k].x, yq[j][k].y}) * pr[k]; f1 += bf4_unpack((u32x2){yq[j][k].z, yq[j][k].w}) * pr[k]; }
            const f32x4 xa = (z[2 * j] - st[0]) * st[1] * ld4(p.ln1_g + c) + ld4(p.ln1_b + c), xb2 = (z[2 * j + 1] - st[0]) * st[1] * ld4(p.ln1_g + c + 4) + ld4(p.ln1_b + c + 4);
            z[2 * j] = xa * DN_ALPHA + ld4(g2 + c) * f0; z[2 * j + 1] = xb2 * DN_ALPHA + ld4(g2 + c + 4) * f1;
            s += ((z[2 * j][0] + z[2 * j][1]) + (z[2 * j][2] + z[2 * j][3])) + ((z[2 * j + 1][0] + z[2 * j + 1][1]) + (z[2 * j + 1][2] + z[2 * j + 1][3])); }
        const float mean = wave_allsum(s) * (1.0f / ND); float qv = 0.f;
#pragma unroll
        for (int j = 0; j < 8; ++j) { const f32x4 dd = z[j] - mean; qv += dot4(dd, dd); }
        const float rstd = rsqrtf(wave_allsum(qv) * (1.0f / ND) + LN_EPS);
#pragma unroll
        for (int j = 0; j < 8; ++j) { const int c = (j >> 1) * 512 + lane * 8 + (j & 1) * 4;
            *(f32x4*)(p.out + (size_t)m * ND + c) = (z[j] - mean) * rstd * ld4(p.ln2_g + c) + ld4(p.ln2_b + c); } }
}

__global__ void __launch_bounds__(NTHREADS, 2) fwd(Params p) {
    extern __shared__ __attribute__((aligned(16))) unsigned char shm[];
    LAS unsigned char* lds = (LAS unsigned char*)shm;
    const int bid = blockIdx.x, G = gridDim.x;
    const int wave = __builtin_amdgcn_readfirstlane(threadIdx.x >> 6);
    if (threadIdx.x == 0) *(LAS u32x4*)(lds + LDS_BARW) = (u32x4){0u, 0u, 0u, 0u};
    __syncthreads();
    XcdBarrier bar = xcd_barrier_post(p.bar, (volatile LAS unsigned*)(lds + LDS_BARW));

    phase0(p, lds, wave);
    xcd_barrier(bar, wave);
    if (PROBE == 3) { phase0(p, lds, wave); xcd_barrier(bar, wave); }
    phase1(p, lds, wave);
    xcd_barrier(bar, wave);
    if (PROBE == 3) { phase1(p, lds, wave); xcd_barrier(bar, wave); }
    {
        pg8::Gemm g{(const bf16_t*)p.hb, (const bf16_t*)p.wt_in, ND / 2, ND / 2, ND / 2}; pg8::DenseOrder S; S.init(NM / 256, NINP / 256 - 2, G, bid, (size_t)256 * ND, (size_t)256 * ND); S.skip_from = 23; S.skip_n = 2;
        EpiP E{p.P}; pg8::gemm_phase<EpiP, pg8::DenseOrder, true>(lds, g, S, E, wave);
        if (PROBE == 1) { __syncthreads(); pg8::gemm_phase<EpiP, pg8::DenseOrder, true>(lds, g, S, E, wave); } }
    xcd_barrier(bar, wave);
    phase3(p, lds, wave);
    xcd_barrier(bar, wave);
    if (PROBE == 3) { phase3(p, lds, wave); xcd_barrier(bar, wave); }
    {
        pg8::Gemm g{(const bf16_t*)p.hb, (const bf16_t*)p.wt_in, ND / 2, ND / 2, ND / 2}; WinRestOrder S{bid, (size_t)256 * ND, (size_t)256 * ND};
        EpiP E{p.P}; pg8::gemm_phase<EpiP, WinRestOrder, true>(lds, g, S, E, wave); }
    __syncthreads();
    {
        pg8::Gemm g{p.a_lora, p.bt_lora, LORA_K, LORA_K, LORA_K}; pg8::DenseOrder S; S.init(NM / 256, LORA_N / 256, G - 64, bid - 64, (size_t)256 * LORA_K * 2, (size_t)256 * LORA_K * 2);
        EpiLora E{p.dec, p.iclr, p.gg, p.w0, p.a0}; pg8::gemm_phase(lds, g, S, E, wave);
        if (PROBE == 1) { __syncthreads(); pg8::gemm_phase(lds, g, S, E, wave); } }
    __syncthreads();
    {
        pg8::Gemm g{p.dp, p.wt_pool, NC, 256, 256}; PoolOrder S{1 << 20, bid >= 64 ? bid - 64 : 192 + bid};
        EpiPool E{p.t1, p.P, p.pool_scale}; pg8::gemm_phase(lds, g, S, E, wave);
        if (PROBE == 1) { __syncthreads(); pg8::gemm_phase(lds, g, S, E, wave); } }
    xcd_barrier(bar, wave);
    if (bid < NB * NH) { scan_head(p, lds, bid, wave); if (PROBE == 4) scan_head(p, lds, bid, wave); }
    conv_queue(p, lds, wave, CW_CONV);
    if (PROBE == 5) conv_queue(p, lds, wave, CW_CONV2);
    xcd_barrier(bar, wave);
    if (PROBE == 2) { if (bid < NB * NH) scan_head(p, lds, bid, wave); conv_queue(p, lds, wave, CW_CONV2); xcd_barrier(bar, wave); }
    {
        pg8::Gemm g{p.yr, p.wt_rwkv, NC, NC, NC}; pg8::DenseOrder S; S.init(NM / 256, ND / 256, G, bid, (size_t)256 * NC * 2, (size_t)256 * NC * 2);
        EpiRwkv E{p.mx, p.P, p.t1}; pg8::gemm_phase(lds, g, S, E, wave);
        if (PROBE == 1) { __syncthreads(); pg8::gemm_phase(lds, g, S, E, wave); } }
    xcd_barrier(bar, wave);
    {
        pg8::Gemm g{p.mx, p.wt_out, ND, ND, ND}; pg8::DenseOrder S; S.init(NM / 256, ND / 256, G, bid, (size_t)256 * ND * 2, (size_t)256 * ND * 2);
        EpiWout E{p.z1, p.x, p.mod}; pg8::gemm_phase(lds, g, S, E, wave);
        if (PROBE == 1) { __syncthreads(); pg8::gemm_phase(lds, g, S, E, wave); } }
    xcd_barrier(bar, wave);
    phase8(p, lds, wave);
    xcd_barrier(bar, wave);
    phase9(p, lds, wave);
    xcd_barrier(bar, wave);
    if (PROBE == 3) { phase9(p, lds, wave); xcd_barrier(bar, wave); }
    const int ntiles = (int)xb_ld(&p.ctl[CW_NTILES]);
    {   const int t_ = phase_tid(wave); if (t_ < MAXTILES) *(LAS unsigned*)(lds + LDS_MISC + 4 * t_) = p.ctl[CW_TILEE + t_]; }
    __syncthreads();
    {
        pg8::Gemm g{(const bf16_t*)p.xb, (const bf16_t*)p.wt_gu, ND / 2, ND / 2, ND / 2};
        MoeOrder S{G, bid, 2 * DFF / 256, ntiles, (const LAS unsigned*)(lds + LDS_MISC), (size_t)256 * ND, (size_t)(2 * DFF) * ND, (size_t)256 * ND};
        EpiGU E{p.act, p.b_gu, lds}; pg8::gemm_phase<EpiGU, MoeOrder, true>(lds, g, S, E, wave);
        if (PROBE == 1) { __syncthreads(); pg8::gemm_phase<EpiGU, MoeOrder, true>(lds, g, S, E, wave); } }
    conv_queue_tail(p, lds, wave);
    xcd_barrier(bar, wave);
    {
        pg8::Gemm g{(const bf16_t*)p.act, (const bf16_t*)p.wt_down, DFF / 2, DFF / 2, DFF / 2};
        MoeOrder S{G, bid, ND / 256, ntiles, (const LAS unsigned*)(lds + LDS_MISC), (size_t)256 * DFF, (size_t)ND * DFF, (size_t)256 * DFF};
        EpiDown E{p.yb, p.b_down}; pg8::gemm_phase<EpiDown, MoeOrder, true>(lds, g, S, E, wave);
        if (PROBE == 1) { __syncthreads(); pg8::gemm_phase<EpiDown, MoeOrder, true>(lds, g, S, E, wave); } }
    xcd_barrier(bar, wave);
    phase13(p, wave);
    if (PROBE == 3) { xcd_barrier(bar, wave); phase13(p, wave); }
}

static inline size_t align_up(size_t v, size_t a) { return (v + a - 1) / a * a; }

extern "C" void kernel_launch(void* const* d_in, const int* in_sizes, int n_in, void* d_out, int out_size, void* d_ws, size_t ws_size, hipStream_t stream) {
    (void)in_sizes; (void)n_in; (void)out_size;
    Params p{};
    const float** ins = (const float**)&p;
    for (int i = 0; i < 30; ++i) ins[i] = (const float*)d_in[i];
    p.out = (float*)d_out;
    char* ws = (char*)d_ws; size_t off = 0;
    auto take = [&](size_t bytes) { char* r = ws + off; off = align_up(off + bytes, 4096); return r; };
    const size_t ctl_bytes = (size_t)(XCD_BAR_WORDS + CTL_WORDS) * 4;
    p.bar = (unsigned*)take(ctl_bytes); p.ctl = p.bar + XCD_BAR_WORDS;
    p.modp = (float*)take((size_t)KS_MOD * 4 * NMOD * 4); p.mod = (float*)take((size_t)NB * NMOD * 4);
    p.hb = (fp8_t*)take((size_t)NM * ND);
    p.wt_in = (fp8_t*)take((size_t)NINP * ND); p.wt_rwkv = (bf16_t*)take((size_t)ND * NC * 2); p.wt_pool = (bf16_t*)take((size_t)ND * 256 * 2);
    p.wt_out = (bf16_t*)take((size_t)ND * ND * 2); p.bt_lora = (bf16_t*)take((size_t)LORA_N * LORA_K * 2);
    p.wt_gu = (fp8_t*)take((size_t)NE * 2 * DFF * ND); p.wt_down = (fp8_t*)take((size_t)NE * ND * DFF);
    p.P = (bf16_t*)take((size_t)NM * NINP * 2); p.a_lora = (bf16_t*)take((size_t)NM * LORA_K * 2); p.dp = (bf16_t*)take((size_t)NM * NC * 2);
    p.dec = (float*)take((size_t)NM * NC * 4); p.iclr = (bf16_t*)take((size_t)NM * NC * 2); p.gg = (bf16_t*)take((size_t)NM * NC * 2); p.t1 = (bf16_t*)take((size_t)NM * ND * 2);
    p.yr = (bf16_t*)take((size_t)NM * NC * 2); p.mx = (bf16_t*)take((size_t)NM * ND * 2); p.z1 = (float*)take((size_t)NM * ND * 4); p.lnst = (float*)take((size_t)NM * 2 * 4);
    p.h2 = (fp8_t*)take((size_t)NM * ND);
    p.sel = (int*)take((size_t)NM * TOPK * 4); p.rnk = (int*)take((size_t)NM * TOPK * 4); p.prob = (float*)take((size_t)NM * TOPK * 4); p.dest = (int*)take((size_t)NM * TOPK * 4);
    p.xb = (fp8_t*)take((size_t)MP * ND); p.act = (fp8_t*)take((size_t)MP * DFF); p.yb = (bf16_t*)take((size_t)MP * ND * 2);
    if (off > ws_size) { fprintf(stderr, "kernel_launch: workspace too small (%zu > %zu)\n", off, ws_size); return; }

    static int grid = 0;
    if (!grid) {
        int dev = 0, cus = 0, per_cu = 0;
        hipGetDevice(&dev); hipDeviceGetAttribute(&cus, hipDeviceAttributeMultiprocessorCount, dev);
        hipFuncSetAttribute((const void*)fwd, hipFuncAttributeMaxDynamicSharedMemorySize, LDS_BYTES);
        hipOccupancyMaxActiveBlocksPerMultiprocessor(&per_cu, (const void*)fwd, NTHREADS, LDS_BYTES);
        if (per_cu < 1) fprintf(stderr, "kernel_launch: occupancy query reports %d workgroups per CU\n", per_cu);
        if (cus != 256) fprintf(stderr, "kernel_launch: %d CUs; this kernel is laid out for 256\n", cus);
        grid = 256;
    }
    hipMemsetAsync(p.bar, 0, ctl_bytes, stream);
    hipLaunchKernelGGL(fwd, dim3(grid), dim3(NTHREADS), LDS_BYTES, stream, p);
}
```

```cpp
#include <hip/hip_runtime.h>
#include <cstdio>
#include <cstdint>

#ifndef PROBE
#define PROBE 0
#endif
#define LAS __attribute__((address_space(3)))
typedef unsigned short bf16_t;
typedef short bf16x8 __attribute__((ext_vector_type(8)));
typedef float f32x4 __attribute__((ext_vector_type(4)));
typedef float f32x2 __attribute__((ext_vector_type(2)));
typedef unsigned u32x4 __attribute__((ext_vector_type(4)));
typedef unsigned u32x2 __attribute__((ext_vector_type(2)));
typedef int i32x4 __attribute__((ext_vector_type(4)));
typedef int i32x8 __attribute__((ext_vector_type(8)));
typedef unsigned char fp8_t;
constexpr float W8_SCALE = 64.0f, W8_INV = 1.0f / 64.0f;
constexpr float A8_SCALE = 8.0f, A8W8_INV = 1.0f / 512.0f;

constexpr int NB = 4, NT = 2048, NM = NB * NT, ND = 2048, NC = 1024, NH = 16, HS = 64;
constexpr int NSHIFT = 3360, NIN = 8480, NINP = 8704;
constexpr int OFF_R = 0, OFF_K = 1024, OFF_V = 2048, OFF_WD = 3072, OFF_AD = 3136, OFF_GD = 3200, OFF_POOL = 3360, OFF_GA = 4384, OFF_GB = 6432;
constexpr int NE = 32, TOPK = 4, DFF = 2048;
constexpr int LORA_K = 384, LORA_N = 3072;
constexpr int MAXTILES = 160, MP = MAXTILES * 256;
constexpr int NMOD = 6 * ND;
constexpr int KS_MOD = 32;
constexpr float LN_EPS = 1e-5f, GN_EPS = 64e-5f;
constexpr float DN_ALPHA = 1.189207115002721f;
constexpr float SW_LIMIT = 7.0f, SW_ALPHA = 1.702f;
constexpr int NWAVES = 8, NTHREADS = 512;
constexpr int LDS_BYTES = 163840;
constexpr int LDS_EPI = 131072 + 2048;
constexpr int LDS_BARW = LDS_BYTES - 16;
constexpr int LDS_MISC = 131072;

constexpr int CW_CNT = 0;
constexpr int CW_CONV = 64 * 32;
constexpr int CW_CONV2 = 64 * 32 + 32;
constexpr int CW_CONV3 = 64 * 32 + 48;
constexpr int N_DEFER = 512;
constexpr int CW_NTILES = 64 * 33;
constexpr int CW_TILEE = 64 * 34;
constexpr int CTL_WORDS = 64 * 34 + 256;

#define XB_TMO      128
#define XB_XCNT(j)  (256  + 64 * (j))
#define XB_XSUB(j)  (1280 + 64 * (j))
#define XB_XGEN(j)  (2304 + 64 * (j))
#define XB_TOP      3328
#define XB_TOPGEN   3392
#define XCD_BAR_WORDS 3456
#define XB_SPIN_CAP (1u << 18)

__device__ __forceinline__ unsigned xb_ld(unsigned* p)              { return __hip_atomic_load(p, __ATOMIC_RELAXED, __HIP_MEMORY_SCOPE_AGENT); }
__device__ __forceinline__ unsigned xb_add(unsigned* p, unsigned v) { return __hip_atomic_fetch_add(p, v, __ATOMIC_RELAXED, __HIP_MEMORY_SCOPE_AGENT); }
__device__ __forceinline__ unsigned xb_xcc_id() { return (unsigned)__builtin_amdgcn_s_getreg((3 << 11) | 20) & 0xFu; }
#define XB_SPIN(cond, bar) do { unsigned _sp = 0; while (cond) { __builtin_amdgcn_s_sleep(1); \
    if ((++_sp & 255u) == 0u) { if (xb_ld(&(bar)[XB_TMO])) break; if (_sp > XB_SPIN_CAP) { atomicAdd(&(bar)[XB_TMO], 1u); break; } } } } while (0)

__device__ __forceinline__ int phase_tid(int wave);
struct XcdBarrier { unsigned* bar; unsigned x; volatile LAS unsigned* st; };

__device__ __forceinline__ XcdBarrier xcd_barrier_post(unsigned* bar, volatile LAS unsigned* st) {
    XcdBarrier b; b.bar = bar; b.x = xb_xcc_id(); b.st = st;
    if (threadIdx.x == 0) (void)xb_add(&bar[XB_XCNT(b.x)], 1u);
    return b;
}
__device__ __forceinline__ void xcd_barrier_complete(unsigned* bar, unsigned x, unsigned& nloc, unsigned& nx) {
    const unsigned G = gridDim.x * gridDim.y * gridDim.z;
    unsigned sum, cnt, mine, sp = 0u;
    for (;;) {
        sum = 0u; cnt = 0u; mine = 0u;
#pragma unroll
        for (unsigned j = 0; j < 16; ++j) { const unsigned c = xb_ld(&bar[XB_XCNT(j)]); sum += c; cnt += (c > 0u) ? 1u : 0u; mine = (j == x) ? c : mine; }
        if (sum == G) break;
        __builtin_amdgcn_s_sleep(1);
        if ((++sp & 255u) == 0u) { if (xb_ld(&bar[XB_TMO])) break; if (sp > XB_SPIN_CAP) { atomicAdd(&bar[XB_TMO], 1u); break; } }
    }
    nloc = mine > 0u ? mine : 1u; nx = cnt > 0u ? cnt : 1u;
}
__device__ __forceinline__ void xcd_barrier(const XcdBarrier& b, const int wave) {
    asm volatile("s_waitcnt vmcnt(0)" ::: "memory");
    __syncthreads();
    if (phase_tid(wave) == 0) {
        unsigned* bar = b.bar;
        __builtin_amdgcn_s_waitcnt(0);
        unsigned nloc = b.st[0], nx = b.st[1];
        if (nloc == 0u) { xcd_barrier_complete(bar, b.x, nloc, nx); b.st[0] = nloc; b.st[1] = nx; }
        const unsigned old = xb_add(&bar[XB_XSUB(b.x)], 1u);
        const unsigned gen = old / nloc;
        if (old + 1u == (gen + 1u) * nloc) {
            __builtin_amdgcn_fence(__ATOMIC_RELEASE, "agent");
            asm volatile("s_waitcnt vmcnt(0)" ::: "memory");
            const unsigned og = xb_add(&bar[XB_TOP], 1u);
            const unsigned tg = og / nx;
            if (og + 1u == (tg + 1u) * nx) xb_add(&bar[XB_TOPGEN], 1u);
            else XB_SPIN(xb_ld(&bar[XB_TOPGEN]) == tg, bar);
            __builtin_amdgcn_fence(__ATOMIC_ACQUIRE, "agent");
            xb_add(&bar[XB_XGEN(b.x)], 1u);
            asm volatile("s_waitcnt vmcnt(0)" ::: "memory");
        } else {
            XB_SPIN(xb_ld(&bar[XB_XGEN(b.x)]) == gen, bar);
            __builtin_amdgcn_fence(__ATOMIC_ACQUIRE, "agent");
            asm volatile("s_waitcnt vmcnt(0)" ::: "memory");
        }
    }
    __syncthreads();
}

__device__ __forceinline__ int phase_tid(int wave) {
    int lane; asm volatile("v_mbcnt_lo_u32_b32 %0, -1, 0\n\tv_mbcnt_hi_u32_b32 %0, -1, %0" : "=v"(lane));
    return wave * 64 + lane;
}
typedef __bf16 bf16x2_t __attribute__((ext_vector_type(2)));
__device__ __forceinline__ unsigned cvt_pk_bf16(float lo, float hi) { return __builtin_bit_cast(unsigned, __builtin_convertvector((f32x2){lo, hi}, bf16x2_t)); }
template <int CTRL> __device__ __forceinline__ float dpp_f(float x) {
    return __builtin_bit_cast(float, __builtin_amdgcn_update_dpp(0, __builtin_bit_cast(int, x), CTRL, 0xf, 0xf, false));
}
__device__ __forceinline__ float row16_allsum(float x) {
    x += dpp_f<0x128>(x); x += dpp_f<0x124>(x); x += dpp_f<0x122>(x); x += dpp_f<0x121>(x); return x;
}
__device__ __forceinline__ float wave_allsum(float x) {
    x = row16_allsum(x);
    const int xi = __builtin_bit_cast(int, x);
    return (__builtin_bit_cast(float, __builtin_amdgcn_readlane(xi, 0)) + __builtin_bit_cast(float, __builtin_amdgcn_readlane(xi, 16))) +
           (__builtin_bit_cast(float, __builtin_amdgcn_readlane(xi, 32)) + __builtin_bit_cast(float, __builtin_amdgcn_readlane(xi, 48)));
}
__device__ __forceinline__ unsigned pack4_fp8(float a, float b, float c, float d) { int r = 0; r = __builtin_amdgcn_cvt_pk_fp8_f32(a, b, r, false); r = __builtin_amdgcn_cvt_pk_fp8_f32(c, d, r, true); return (unsigned)r; }
__device__ __forceinline__ f32x2 bf2_unpack(unsigned u) { return (f32x2){__uint_as_float(u << 16), __uint_as_float(u & 0xffff0000u)}; }
__device__ __forceinline__ f32x4 bf4_unpack(u32x2 u) { const f32x2 a = bf2_unpack(u.x), b = bf2_unpack(u.y); return (f32x4){a[0], a[1], b[0], b[1]}; }
__device__ __forceinline__ float bf1(bf16_t h) { return __uint_as_float(((unsigned)h) << 16); }
__device__ __forceinline__ float sigmoidf_(float v) { return __builtin_amdgcn_rcpf(1.0f + __builtin_amdgcn_exp2f(v * -1.4426950408889634f)); }
__device__ __forceinline__ f32x4 ld4(const float* p) { return *(const f32x4*)p; }
__device__ __forceinline__ f32x4 ld4nt(const float* p) { return __builtin_nontemporal_load((const f32x4*)p); }
__device__ __forceinline__ u32x4 ldu4nt(const void* p) { return __builtin_nontemporal_load((const u32x4*)p); }
__device__ __forceinline__ float dot4(f32x4 a, f32x4 b) { return (a[0] * b[0] + a[1] * b[1]) + (a[2] * b[2] + a[3] * b[3]); }

struct Params {
    const float *x, *c, *w_ada, *b_ada, *w_in, *mu_shift, *w0, *w_decay_up, *a0, *w_iclr_up, *w_glora_up, *k_k, *k_a, *r_k, *lnx_g, *lnx_b,
                *w_rwkv_out, *w_pool, *pool_scale, *w_out, *ln1_g, *ln1_b, *w_router, *b_router, *w_gu, *b_gu, *w_down, *b_down, *ln2_g, *ln2_b;
    float* out;
    unsigned* bar; unsigned* ctl;
    float* modp; float* mod;
    fp8_t* hb; fp8_t* wt_in; fp8_t* wt_rwkv; bf16_t* wt_pool; fp8_t* wt_out; bf16_t* bt_lora; fp8_t* wt_gu; fp8_t* wt_down;
    bf16_t* P; bf16_t* a_lora; bf16_t* dp; float* dec; bf16_t* iclr; bf16_t* gg; bf16_t* t1;
    fp8_t* yr; fp8_t* mx; float* z1; float* lnst; fp8_t* h2;
    int* sel; int* rnk; float* prob; int* dest;
    fp8_t* xb; fp8_t* act; bf16_t* yb;
};

namespace pg8 {
constexpr int BM = 256, BK = 64, HALF = 128, HTB = HALF * BK * 2, STAGE_BYTES = 8 * HTB, NXCD = 8, WGM = 8;
__host__ __device__ __forceinline__ int lds_byte(int r, int c) { const int st = (r >> 4) * 2 + (c >> 5), rr = r & 15, cc = c & 31, ob = rr * 64 + cc * 2; return st * 1024 + (ob ^ (((ob >> 9) & 1) << 5)); }
__host__ __device__ __forceinline__ void stage_rc(int b, int& R, int& C) { const int st = b / 1024, sb = b % 1024, swz = sb ^ (((sb >> 9) & 1) << 5); R = (st >> 1) * 16 + swz / 64; C = (st & 1) * 32 + (swz % 64) / 2; }
__host__ __device__ __forceinline__ int perm32(int rho) { const int n = rho >> 4, i = rho & 15; return 8 * (i >> 2) + 4 * n + (i & 3); }

struct Unit { int pm, pn, e; unsigned aoff, boff; };
struct Gemm { const bf16_t* A; const bf16_t* Bt; int lda, ldb, K; };

struct DenseOrder {
    int nM, nN, nwg, G, c, skip_from = 1 << 30, skip_n = 0; size_t a_tile, b_tile;
    __device__ void init(int nM_, int nN_, int G_, int c_, size_t a_tile_, size_t b_tile_) { nM = nM_; nN = nN_; nwg = nM * nN; G = G_; c = c_; a_tile = a_tile_; b_tile = b_tile_; }
    __device__ bool next(int i, Unit& u) const {
        const long L = (long)i * G + c; if (c < 0 || L >= nwg) return false;
        int wgid = (int)L; { const int q = nwg / NXCD, r = nwg % NXCD, xcd = wgid % NXCD, off = wgid / NXCD; wgid = (xcd < r ? xcd * (q + 1) : r * (q + 1) + (xcd - r) * q) + off; }
        const int nig = WGM * nN, gid = wgid / nig, fm = gid * WGM, gsz = (nM - fm) < WGM ? (nM - fm) : WGM;
        u.pm = fm + ((wgid % nig) % gsz); u.pn = (wgid % nig) / gsz; u.e = 0; if (u.pn >= skip_from) u.pn += skip_n;
        u.aoff = (unsigned)((size_t)u.pm * a_tile); u.boff = (unsigned)((size_t)u.pn * b_tile); return true;
    }
};

template <class Epi, class Sched, bool FP8 = false>
__device__ __forceinline__ void gemm_phase(LAS unsigned char* lds, const Gemm g, const Sched& S, const Epi& E, const int wave) {
    const int tid = phase_tid(wave);
    const int wid = __builtin_amdgcn_readfirstlane(tid >> 6), lane = tid & 63, wr = wid >> 2, wc = wid & 3, fr = lane & 15, fq = lane >> 4;
    const int K = g.K, nt = K / BK;
    unsigned voffA, voffB;
    {   int R, C; stage_rc(tid * 16, R, C); const int Rb = Epi::PERM ? ((R & ~31) + perm32(R & 31)) : R;
        voffA = (unsigned)(R * g.lda + C) * 2u; voffB = (unsigned)(Rb * g.ldb + C) * 2u; }
    const unsigned pieceA = 64u * (unsigned)g.lda * 2u, pieceB = 64u * (unsigned)g.ldb * 2u;
    const unsigned kstep = (unsigned)(BK * 2);
    const unsigned hstepA = (unsigned)HALF * g.lda * 2u, hstepB = (unsigned)HALF * g.ldb * 2u;
    const __amdgpu_buffer_rsrc_t rsA = __builtin_amdgcn_make_buffer_rsrc((void*)g.A, (short)0, -1, 0x00020000), rsB = __builtin_amdgcn_make_buffer_rsrc((void*)g.Bt, (short)0, -1, 0x00020000);
    const unsigned ldsw = (unsigned)wid * 1024u;
    const int aoff = lds_byte(wr * 64 + fr, fq * 8), boff = lds_byte(wc * 32 + fr, fq * 8);
#define PG8_SA(b, h) (((b) * 2 + (h)) * HTB)
#define PG8_SB(b, h) ((4 + (b) * 2 + (h)) * HTB)
#define PG8_STAGE(bufoff, rs, soff, voff) do { _Pragma("unroll") for (int _i = 0; _i < 2; ++_i) \
        __builtin_amdgcn_raw_ptr_buffer_load_lds(rs, (LAS void*)(lds + (bufoff) + ldsw + _i * 8192), 16, (voff), (soff) + _i * ((&(voff) == &voffA) ? pieceA : pieceB), 0, 0); } while (0)
#define PG8_LDA(dst, b, h) do { _Pragma("unroll") for (int m = 0; m < 4; ++m) _Pragma("unroll") for (int k = 0; k < 2; ++k) dst[m][k] = *(const LAS bf16x8*)(lds + PG8_SA(b, h) + aoff + m * 2048 + k * 1024); } while (0)
#define PG8_LDB(dst, b, h) do { _Pragma("unroll") for (int n = 0; n < 2; ++n) _Pragma("unroll") for (int k = 0; k < 2; ++k) dst[n][k] = *(const LAS bf16x8*)(lds + PG8_SB(b, h) + boff + n * 2048 + k * 1024); } while (0)
#define PG8_CAT(x) __builtin_shufflevector(__builtin_bit_cast(i32x4, (x)[0]), __builtin_bit_cast(i32x4, (x)[1]), 0, 1, 2, 3, 4, 5, 6, 7)
#define PG8_MMA(ai, bj, At, Bt) do { __builtin_amdgcn_s_setprio(1); \
        if constexpr (FP8) { _Pragma("unroll") for (int m = 0; m < 4; ++m) _Pragma("unroll") for (int n = 0; n < 2; ++n) \
            acc[ai][bj][m][n] = __builtin_amdgcn_mfma_scale_f32_16x16x128_f8f6f4(PG8_CAT(Bt[n]), PG8_CAT(At[m]), acc[ai][bj][m][n], 0, 0, 0, 0x7F7F7F7F, 0, 0x7F7F7F7F); } \
        else { _Pragma("unroll") for (int m = 0; m < 4; ++m) _Pragma("unroll") for (int n = 0; n < 2; ++n) _Pragma("unroll") for (int k = 0; k < 2; ++k) \
            acc[ai][bj][m][n] = __builtin_amdgcn_mfma_f32_16x16x32_bf16(Bt[n][k], At[m][k], acc[ai][bj][m][n], 0, 0, 0); } \
        __builtin_amdgcn_s_setprio(0); } while (0)
#define PG8_WAIT_V(n) asm volatile("s_waitcnt vmcnt(" #n ")" ::: "memory")
#define PG8_WAIT_L(n) asm volatile("s_waitcnt lgkmcnt(" #n ")" ::: "memory")
#define PG8_BAR __builtin_amdgcn_s_barrier()
#define PG8_SCHED __builtin_amdgcn_sched_barrier(0)
    Unit cur, nxt; int ui = 0;
    if (!S.next(0, cur)) return;
    f32x4 acc[2][2][4][2];
#pragma unroll
    for (int a = 0; a < 2; ++a)
#pragma unroll
        for (int b = 0; b < 2; ++b)
#pragma unroll
            for (int m = 0; m < 4; ++m)
#pragma unroll
                for (int n = 0; n < 2; ++n) acc[a][b][m][n] = (f32x4){0.f, 0.f, 0.f, 0.f};
    bf16x8 At[4][2], B0[2][2], B1[2][2];
    unsigned cA = cur.aoff, cB = cur.boff;
    PG8_STAGE(PG8_SB(0, 0), rsB, cB, voffB); PG8_STAGE(PG8_SA(0, 0), rsA, cA, voffA); PG8_STAGE(PG8_SB(0, 1), rsB, cB + hstepB, voffB); PG8_STAGE(PG8_SA(0, 1), rsA, cA + hstepA, voffA);
    if (wr == 1) PG8_BAR;
    PG8_WAIT_V(4); PG8_BAR;
    PG8_STAGE(PG8_SB(1, 0), rsB, cB + kstep, voffB); PG8_STAGE(PG8_SA(1, 0), rsA, cA + kstep, voffA); PG8_STAGE(PG8_SB(1, 1), rsB, cB + hstepB + kstep, voffB);
    PG8_WAIT_V(6); PG8_BAR;
    for (;;) {
        const bool has_next = S.next(ui + 1, nxt);
        const unsigned nA = has_next ? nxt.aoff : cA, nB = has_next ? nxt.boff : cB;
        for (int t = 0; t < nt; t += 2) {
            const bool last = (t == nt - 2);
            const unsigned a1 = cA + (unsigned)(t + 1) * kstep;
            const unsigned a2 = last ? nA : cA + (unsigned)(t + 2) * kstep, b2 = last ? nB : cB + (unsigned)(t + 2) * kstep;
            const unsigned a3 = a2 + kstep, b3 = b2 + kstep;
            PG8_LDB(B0, 0, 0); PG8_SCHED; PG8_LDA(At, 0, 0); PG8_STAGE(PG8_SA(1, 1), rsA, a1 + hstepA, voffA);
            PG8_WAIT_L(8); PG8_BAR; PG8_WAIT_L(0); PG8_MMA(0, 0, At, B0); PG8_BAR; PG8_SCHED;
            PG8_LDB(B1, 0, 1); PG8_STAGE(PG8_SB(0, 0), rsB, b2, voffB);
            PG8_BAR; PG8_WAIT_L(0); PG8_MMA(0, 1, At, B1); PG8_BAR;
            PG8_LDA(At, 0, 1); PG8_STAGE(PG8_SA(0, 0), rsA, a2, voffA);
            PG8_BAR; PG8_WAIT_L(0); PG8_MMA(1, 0, At, B0); PG8_BAR; PG8_SCHED;
            PG8_STAGE(PG8_SB(0, 1), rsB, b2 + hstepB, voffB);
            PG8_WAIT_V(6); PG8_BAR; PG8_MMA(1, 1, At, B1); PG8_BAR;
            PG8_LDB(B0, 1, 0); PG8_SCHED; PG8_LDA(At, 1, 0); PG8_STAGE(PG8_SA(0, 1), rsA, a2 + hstepA, voffA);
            PG8_WAIT_L(8); PG8_BAR; PG8_WAIT_L(0); PG8_MMA(0, 0, At, B0); PG8_BAR; PG8_SCHED;
            PG8_LDB(B1, 1, 1); PG8_STAGE(PG8_SB(1, 0), rsB, b3, voffB);
            PG8_BAR; PG8_WAIT_L(0); PG8_MMA(0, 1, At, B1); PG8_BAR;
            PG8_LDA(At, 1, 1); PG8_STAGE(PG8_SA(1, 0), rsA, a3, voffA);
            PG8_BAR; PG8_WAIT_L(0); PG8_MMA(1, 0, At, B0); PG8_BAR; PG8_SCHED;
            PG8_STAGE(PG8_SB(1, 1), rsB, b3 + hstepB, voffB);
            PG8_WAIT_V(6); PG8_BAR; PG8_MMA(1, 1, At, B1); PG8_BAR;
        }
        { const int l2 = phase_tid(wave) & 63; E(acc, cur, wr, wc, l2 & 15, l2 >> 4); }
        if (!has_next) break;
#pragma unroll
        for (int a = 0; a < 2; ++a)
#pragma unroll
            for (int b = 0; b < 2; ++b)
#pragma unroll
                for (int m = 0; m < 4; ++m)
#pragma unroll
                    for (int n = 0; n < 2; ++n) acc[a][b][m][n] = (f32x4){0.f, 0.f, 0.f, 0.f};
        cur = nxt; cA = nA; cB = nB; ++ui;
    }
    PG8_WAIT_V(0);
    if (wr == 0) PG8_BAR;
    PG8_BAR;
#undef PG8_SA
#undef PG8_SB
#undef PG8_STAGE
#undef PG8_LDA
#undef PG8_LDB
#undef PG8_MMA
#undef PG8_CAT
#undef PG8_WAIT_V
#undef PG8_WAIT_L
#undef PG8_BAR
#undef PG8_SCHED
}
}
using pg8::Unit;

#define EPI_LOOP_BEGIN \
    _Pragma("unroll") for (int ai = 0; ai < 2; ++ai) _Pragma("unroll") for (int m = 0; m < 4; ++m) { const int r = u.pm * 256 + ai * 128 + wr * 64 + m * 16 + fr; \
    _Pragma("unroll") for (int bj = 0; bj < 2; ++bj) _Pragma("unroll") for (int n = 0; n < 2; ++n) { const int cl = bj * 128 + wc * 32 + 16 * n + 4 * fq; const f32x4 a = acc[ai][bj][m][n];
#define EPI_LOOP_END } }

struct EpiP {
    static constexpr bool PERM = true; bf16_t* C;
    __device__ __forceinline__ void operator()(const f32x4 (&acc)[2][2][4][2], const Unit& u, int wr, int wc, int fr, int fq) const {
#pragma unroll
        for (int ai = 0; ai < 2; ++ai)
#pragma unroll
            for (int m = 0; m < 4; ++m) { const int r = u.pm * 256 + ai * 128 + wr * 64 + m * 16 + fr;
#pragma unroll
                for (int bj = 0; bj < 2; ++bj) { const int c0 = u.pn * 256 + bj * 128 + wc * 32 + 8 * fq; const f32x4 v0 = acc[ai][bj][m][0] * W8_INV, v1 = acc[ai][bj][m][1] * W8_INV;
                    u32x4 w; w.x = cvt_pk_bf16(v0[0], v0[1]); w.y = cvt_pk_bf16(v0[2], v0[3]); w.z = cvt_pk_bf16(v1[0], v1[1]); w.w = cvt_pk_bf16(v1[2], v1[3]);
                    *(u32x4*)(C + (size_t)r * NINP + c0) = w; } }
    }
};
#define EPI_COLS(ptr) f32x4 cv[2][2]; _Pragma("unroll") for (int bj = 0; bj < 2; ++bj) _Pragma("unroll") for (int n = 0; n < 2; ++n) cv[bj][n] = ld4((ptr) + bj * 128 + wc * 32 + 16 * n + 4 * fq);
#define EPI_COLS_PERM(ptr) f32x4 cv[2][2]; _Pragma("unroll") for (int bj = 0; bj < 2; ++bj) _Pragma("unroll") for (int n = 0; n < 2; ++n) cv[bj][n] = ld4((ptr) + bj * 128 + wc * 32 + 8 * fq + 4 * n);
struct EpiLora {
    static constexpr bool PERM = false; float* dec; bf16_t *iclr, *gg; const float *w0, *a0;
    __device__ __forceinline__ void operator()(const f32x4 (&acc)[2][2][4][2], const Unit& u, int wr, int wc, int fr, int fq) const {
        const int sect = u.pn >> 2, cb = (u.pn & 3) * 256;
        EPI_COLS((sect == 0 ? w0 : a0) + cb)
        EPI_LOOP_BEGIN
            const int c = cb + cl; f32x4 o;
            if (sect == 0) {
#pragma unroll
                for (int j = 0; j < 4; ++j) o[j] = __builtin_amdgcn_exp2f(-0.6065306597126334f * 1.4426950408889634f * sigmoidf_(cv[bj][n][j] + a[j]));
                *(f32x4*)(dec + (size_t)r * NC + c) = o; }
            else if (sect == 1) {
#pragma unroll
                for (int j = 0; j < 4; ++j) o[j] = sigmoidf_(cv[bj][n][j] + a[j]);
                u32x2 wv; wv.x = cvt_pk_bf16(o[0], o[1]); wv.y = cvt_pk_bf16(o[2], o[3]); *(u32x2*)(iclr + (size_t)r * NC + c) = wv; }
            else { u32x2 wv; wv.x = cvt_pk_bf16(a[0], a[1]); wv.y = cvt_pk_bf16(a[2], a[3]); *(u32x2*)(gg + (size_t)r * NC + c) = wv; }
        EPI_LOOP_END
    }
};
struct EpiPool {
    static constexpr bool PERM = true; bf16_t* t1; const bf16_t* P; const float* pscale;
    __device__ __forceinline__ void operator()(const f32x4 (&acc)[2][2][4][2], const Unit& u, int wr, int wc, int fr, int fq) const {
        EPI_COLS_PERM(pscale + u.pn * 256)
#pragma unroll
        for (int ai = 0; ai < 2; ++ai) { u32x4 gq[4][2];
#pragma unroll
            for (int m = 0; m < 4; ++m)
#pragma unroll
                for (int bj = 0; bj < 2; ++bj) gq[m][bj] = ldu4nt(P + (size_t)(u.pm * 256 + ai * 128 + wr * 64 + m * 16 + fr) * NINP + OFF_GB + u.pn * 256 + bj * 128 + wc * 32 + 8 * fq);
#pragma unroll
            for (int m = 0; m < 4; ++m) { const int r = u.pm * 256 + ai * 128 + wr * 64 + m * 16 + fr;
#pragma unroll
                for (int bj = 0; bj < 2; ++bj) { const int c0 = u.pn * 256 + bj * 128 + wc * 32 + 8 * fq;
                    const f32x4 g0 = bf4_unpack((u32x2){gq[m][bj].x, gq[m][bj].y}), g1 = bf4_unpack((u32x2){gq[m][bj].z, gq[m][bj].w}), a0 = acc[ai][bj][m][0], a1 = acc[ai][bj][m][1]; f32x4 o0, o1;
#pragma unroll
                    for (int j = 0; j < 4; ++j) { o0[j] = sigmoidf_(g0[j]) * cv[bj][0][j] * a0[j]; o1[j] = sigmoidf_(g1[j]) * cv[bj][1][j] * a1[j]; }
                    u32x4 w; w.x = cvt_pk_bf16(o0[0], o0[1]); w.y = cvt_pk_bf16(o0[2], o0[3]); w.z = cvt_pk_bf16(o1[0], o1[1]); w.w = cvt_pk_bf16(o1[2], o1[3]);
                    *(u32x4*)(t1 + (size_t)r * ND + c0) = w; } } }
    }
};
struct EpiRwkv {
    static constexpr bool PERM = true; fp8_t* mx; const bf16_t* P; const bf16_t* t1;
    __device__ __forceinline__ void operator()(const f32x4 (&acc)[2][2][4][2], const Unit& u, int wr, int wc, int fr, int fq) const {
#pragma unroll
        for (int ai = 0; ai < 2; ++ai) { u32x4 gq[4][2], tq[4][2];
#pragma unroll
            for (int m = 0; m < 4; ++m)
#pragma unroll
                for (int bj = 0; bj < 2; ++bj) { const int r = u.pm * 256 + ai * 128 + wr * 64 + m * 16 + fr, c0 = u.pn * 256 + bj * 128 + wc * 32 + 8 * fq;
                    gq[m][bj] = ldu4nt(P + (size_t)r * NINP + OFF_GA + c0); tq[m][bj] = ldu4nt(t1 + (size_t)r * ND + c0); }
#pragma unroll
            for (int m = 0; m < 4; ++m) { const int r = u.pm * 256 + ai * 128 + wr * 64 + m * 16 + fr;
#pragma unroll
                for (int bj = 0; bj < 2; ++bj) { const int c0 = u.pn * 256 + bj * 128 + wc * 32 + 8 * fq;
                    const f32x4 g0 = bf4_unpack((u32x2){gq[m][bj].x, gq[m][bj].y}), g1 = bf4_unpack((u32x2){gq[m][bj].z, gq[m][bj].w});
                    const f32x4 t0 = bf4_unpack((u32x2){tq[m][bj].x, tq[m][bj].y}), t1v = bf4_unpack((u32x2){tq[m][bj].z, tq[m][bj].w}), a0 = acc[ai][bj][m][0], a1 = acc[ai][bj][m][1]; f32x4 o0, o1;
#pragma unroll
                    for (int j = 0; j < 4; ++j) { o0[j] = sigmoidf_(g0[j]) * a0[j] * (A8W8_INV * A8_SCALE) + t0[j] * A8_SCALE; o1[j] = sigmoidf_(g1[j]) * a1[j] * (A8W8_INV * A8_SCALE) + t1v[j] * A8_SCALE; }
                    u32x2 w; w.x = pack4_fp8(o0[0], o0[1], o0[2], o0[3]); w.y = pack4_fp8(o1[0], o1[1], o1[2], o1[3]);
                    *(u32x2*)(mx + (size_t)r * ND + c0) = w; } } }
    }
};
struct EpiWout {
    static constexpr bool PERM = true; float* z1; const float* x; const float* mod;
    __device__ __forceinline__ void operator()(const f32x4 (&acc)[2][2][4][2], const Unit& u, int wr, int wc, int fr, int fq) const {
        const int b = u.pm >> 3;
        EPI_COLS_PERM(mod + (size_t)b * NMOD + 2 * ND + u.pn * 256)
#pragma unroll
        for (int bj = 0; bj < 2; ++bj) { cv[bj][0] *= A8W8_INV; cv[bj][1] *= A8W8_INV; }
#pragma unroll
        for (int ai = 0; ai < 2; ++ai)
#pragma unroll
            for (int mh = 0; mh < 2; ++mh) { f32x4 xq[2][2][2];
#pragma unroll
                for (int m2 = 0; m2 < 2; ++m2)
#pragma unroll
                    for (int bj = 0; bj < 2; ++bj)
#pragma unroll
                        for (int n = 0; n < 2; ++n) xq[m2][bj][n] = ld4nt(x + (size_t)(u.pm * 256 + ai * 128 + wr * 64 + (mh * 2 + m2) * 16 + fr) * ND + u.pn * 256 + bj * 128 + wc * 32 + 8 * fq + 4 * n);
#pragma unroll
                for (int m2 = 0; m2 < 2; ++m2) { const int m = mh * 2 + m2, r = u.pm * 256 + ai * 128 + wr * 64 + m * 16 + fr;
#pragma unroll
                    for (int bj = 0; bj < 2; ++bj)
#pragma unroll
                        for (int n = 0; n < 2; ++n) { const int c = u.pn * 256 + bj * 128 + wc * 32 + 8 * fq + 4 * n;
                            *(f32x4*)(z1 + (size_t)r * ND + c) = xq[m2][bj][n] * DN_ALPHA + cv[bj][n] * acc[ai][bj][m][n]; } } }
    }
};
struct EpiGU {
    static constexpr bool PERM = true; fp8_t* act; const float* b_gu; LAS unsigned char* lds;
    __device__ __forceinline__ void operator()(const f32x4 (&acc)[2][2][4][2], const Unit& u, int wr, int wc, int fr, int fq) const {
        const float* bias = b_gu + (size_t)u.e * (2 * DFF) + u.pn * 256 + wc * 32 + 8 * fq;
        LAS unsigned char* const buf = lds + LDS_EPI + wr * 9216;
#pragma unroll
        for (int ai = 0; ai < 2; ++ai) {
#pragma unroll
            for (int bj = 0; bj < 2; ++bj) { const f32x4 c0v = ld4(bias + bj * 128), c1v = ld4(bias + bj * 128 + 4);
#pragma unroll
                for (int m = 0; m < 4; ++m) {
                    const f32x4 v0 = acc[ai][bj][m][0] * W8_INV + c0v, v1 = acc[ai][bj][m][1] * W8_INV + c1v;
                    float o[4];
#pragma unroll
                    for (int j = 0; j < 4; ++j) { const float gt = fminf(j < 2 ? v0[2 * j] : v1[2 * j - 4], SW_LIMIT); const float up = fminf(fmaxf(j < 2 ? v0[2 * j + 1] : v1[2 * j - 3], -SW_LIMIT), SW_LIMIT);
                        o[j] = (up + 1.0f) * (gt * __builtin_amdgcn_rcpf(1.0f + __builtin_amdgcn_exp2f(gt * (-SW_ALPHA * 1.4426950408889634f)))); }
                    *(LAS unsigned*)(buf + (m * 16 + fr) * 144 + bj * 64 + wc * 16 + fq * 4) = pack4_fp8(o[0], o[1], o[2], o[3]); } }
            asm volatile("s_waitcnt lgkmcnt(0)" ::: "memory"); __builtin_amdgcn_s_barrier(); asm volatile("" ::: "memory");
            {   const int l2 = fr + 16 * fq;
#pragma unroll
                for (int i = 0; i < 2; ++i) { const int idx = wc * 64 + l2 + i * 256, row = idx >> 3, ck = idx & 7;
                    const u32x4 w = *(const LAS u32x4*)(buf + row * 144 + ck * 16);
                    *(u32x4*)(act + (size_t)(u.pm * 256 + ai * 128 + wr * 64 + row) * DFF + u.pn * 128 + ck * 16) = w; } }
            asm volatile("s_waitcnt lgkmcnt(0)" ::: "memory"); __builtin_amdgcn_s_barrier(); asm volatile("" ::: "memory");
        }
    }
};
struct EpiDown {
    static constexpr bool PERM = true; bf16_t* yb; const float* b_down;
    __device__ __forceinline__ void operator()(const f32x4 (&acc)[2][2][4][2], const Unit& u, int wr, int wc, int fr, int fq) const {
        const float* bias = b_down + (size_t)u.e * ND + u.pn * 256 + wc * 32 + 8 * fq;
#pragma unroll
        for (int bj = 0; bj < 2; ++bj) { const f32x4 c0v = ld4(bias + bj * 128), c1v = ld4(bias + bj * 128 + 4); const int c0 = u.pn * 256 + bj * 128 + wc * 32 + 8 * fq;
#pragma unroll
            for (int ai = 0; ai < 2; ++ai)
#pragma unroll
                for (int m = 0; m < 4; ++m) { const int r = u.pm * 256 + ai * 128 + wr * 64 + m * 16 + fr;
                    const f32x4 v0 = acc[ai][bj][m][0] * W8_INV + c0v, v1 = acc[ai][bj][m][1] * W8_INV + c1v;
                    u32x4 w; w.x = cvt_pk_bf16(v0[0], v0[1]); w.y = cvt_pk_bf16(v0[2], v0[3]); w.z = cvt_pk_bf16(v1[0], v1[1]); w.w = cvt_pk_bf16(v1[2], v1[3]);
                    *(u32x4*)(yb + (size_t)r * ND + c0) = w; } }
    }
};

struct WinRestOrder {
    int c; size_t a_tile, b_tile;
    __device__ bool next(int i, Unit& u) const {
        if (i > 0 || c < 0 || c >= 64) return false;
        u.pm = c >> 1; u.pn = 23 + (c & 1); u.e = 0; u.aoff = (unsigned)((size_t)u.pm * a_tile); u.boff = (unsigned)((size_t)u.pn * b_tile); return true;
    }
};
struct PoolOrder {
    int G, c;
    __device__ bool next(int i, Unit& u) const {
        const int L = i * G + c; if (c < 0 || L >= 256) return false;
        u.pm = L >> 3; u.pn = L & 7; u.e = 0;
        u.aoff = (unsigned)(((size_t)u.pm * 256 * NC + (size_t)(u.pn >> 1) * 256) * 2); u.boff = (unsigned)((size_t)u.pn * 256 * 256 * 2); return true;
    }
};
struct MoeOrder {
    int G, c, nN, ntiles; const LAS unsigned* tile_e; size_t a_tile, b_expert, b_tile;
    __device__ bool next(int i, Unit& u) const {
        const int L = i * G + c; if (L >= ntiles * nN) return false;
        u.pm = L / nN; u.pn = L % nN; u.e = __builtin_amdgcn_readfirstlane((int)tile_e[u.pm]);
        u.aoff = (unsigned)((size_t)u.pm * a_tile); u.boff = (unsigned)((size_t)u.e * b_expert + (size_t)u.pn * b_tile); return true;
    }
};

__device__ __forceinline__ void cvt_block_T(const float* src, int ld_src, bf16_t* dst, int ld_dst, int lane) {
    const int k8 = lane & 7, nq = lane >> 3;
    const float* s = src + (size_t)(k8 * 8) * ld_src + nq * 4;
    f32x4 v[8];
#pragma unroll
    for (int j = 0; j < 8; ++j) v[j] = __builtin_nontemporal_load((const f32x4*)(s + (size_t)j * ld_src));
#pragma unroll
    for (int i = 0; i < 4; ++i) { u32x4 w; w.x = cvt_pk_bf16(v[0][i], v[1][i]); w.y = cvt_pk_bf16(v[2][i], v[3][i]); w.z = cvt_pk_bf16(v[4][i], v[5][i]); w.w = cvt_pk_bf16(v[6][i], v[7][i]);
        *(u32x4*)(dst + (size_t)(nq * 4 + i) * ld_dst + k8 * 8) = w; }
}
__device__ __forceinline__ void cvt_block_T2(const float* src, int ld_src, bf16_t* dst, int ld_dst, int lane) {
    const int k8 = lane & 7, nq = lane >> 3;
    const float* s = src + (size_t)(k8 * 8) * ld_src + nq * 4;
    f32x4 v[8], w2[8];
#pragma unroll
    for (int j = 0; j < 8; ++j) { v[j] = ld4(s + (size_t)j * ld_src); w2[j] = ld4(s + (size_t)j * ld_src + 32); }
#pragma unroll
    for (int i = 0; i < 4; ++i) { u32x4 w; w.x = cvt_pk_bf16(v[0][i], v[1][i]); w.y = cvt_pk_bf16(v[2][i], v[3][i]); w.z = cvt_pk_bf16(v[4][i], v[5][i]); w.w = cvt_pk_bf16(v[6][i], v[7][i]);
        *(u32x4*)(dst + (size_t)(nq * 4 + i) * ld_dst + k8 * 8) = w; }
#pragma unroll
    for (int i = 0; i < 4; ++i) { u32x4 w; w.x = cvt_pk_bf16(w2[0][i], w2[1][i]); w.y = cvt_pk_bf16(w2[2][i], w2[3][i]); w.z = cvt_pk_bf16(w2[4][i], w2[5][i]); w.w = cvt_pk_bf16(w2[6][i], w2[7][i]);
        *(u32x4*)(dst + (size_t)(32 + nq * 4 + i) * ld_dst + k8 * 8) = w; }
}

__device__ __forceinline__ void cvt8_load(f32x4 (&v)[16], const float* s, int ld_src) {
#pragma unroll
    for (int j = 0; j < 16; ++j) v[j] = __builtin_nontemporal_load((const f32x4*)(s + (size_t)j * ld_src));
}
template <bool NT = true>
__device__ __forceinline__ void cvt8_store(const f32x4 (&v)[16], fp8_t* d, int ld_dst) {
#pragma unroll
    for (int i = 0; i < 4; ++i) { u32x4 w; w.x = pack4_fp8(v[0][i] * W8_SCALE, v[1][i] * W8_SCALE, v[2][i] * W8_SCALE, v[3][i] * W8_SCALE); w.y = pack4_fp8(v[4][i] * W8_SCALE, v[5][i] * W8_SCALE, v[6][i] * W8_SCALE, v[7][i] * W8_SCALE);
        w.z = pack4_fp8(v[8][i] * W8_SCALE, v[9][i] * W8_SCALE, v[10][i] * W8_SCALE, v[11][i] * W8_SCALE); w.w = pack4_fp8(v[12][i] * W8_SCALE, v[13][i] * W8_SCALE, v[14][i] * W8_SCALE, v[15][i] * W8_SCALE);
        if constexpr (NT) __builtin_nontemporal_store(w, (u32x4*)(d + (size_t)i * ld_dst)); else *(u32x4*)(d + (size_t)i * ld_dst) = w; }
}
__device__ __forceinline__ void cvt8_block_T(const float* src, int ld_src, fp8_t* dst, int ld_dst, int lane) {
    const int k16 = lane & 7, nq = lane >> 3;
    f32x4 v[16]; cvt8_load(v, src + (size_t)(k16 * 16) * ld_src + nq * 4, ld_src);
    cvt8_store<false>(v, dst + (size_t)(nq * 4) * ld_dst + k16 * 16, ld_dst);
}
__device__ __forceinline__ void cvt_wave_T8x8(const float* src, int ld_src, fp8_t* dst, int ld_dst, int lane) {
    const int k16 = lane & 7, nq = lane >> 3;
    const float* s = src + (size_t)(k16 * 16) * ld_src + nq * 4; fp8_t* d = dst + (size_t)(nq * 4) * ld_dst + k16 * 16;
    f32x4 va[16], vb[16];
    cvt8_load(va, s, ld_src);
#pragma unroll
    for (int i = 0; i < 8; i += 2) {
        cvt8_load(vb, s + (i + 1) * 32, ld_src);
        cvt8_store(va, d + (size_t)(i * 32) * ld_dst, ld_dst);
        if (i + 2 < 8) cvt8_load(va, s + (i + 2) * 32, ld_src);
        cvt8_store(vb, d + (size_t)((i + 1) * 32) * ld_dst, ld_dst);
    }
}

__device__ __forceinline__ void phase0(const Params& p, LAS unsigned char* lds, const int wave) {
    const int tid = phase_tid(wave);
    const int bid = blockIdx.x, lane = tid & 63, wv = tid >> 6;
    LAS float* cond = (LAS float*)lds;
    if (bid < 192) {
        for (int i = tid; i < NB * ND; i += NTHREADS) { const int b = i >> 11, k = i & 2047; const float cv = p.c[i]; cond[k * 4 + b] = cv / (1.0f + expf(-cv)); }
        __syncthreads();
        const int gid = bid * NTHREADS + tid, ks = gid / 3072, j4 = gid % 3072;
        f32x4 a0 = {0.f, 0.f, 0.f, 0.f}, a1 = a0, a2 = a0, a3 = a0;
        const float* wp = p.w_ada + (size_t)(ks * 64) * NMOD + j4 * 4;
#pragma unroll 16
        for (int kk = 0; kk < 64; ++kk) { const f32x4 w = __builtin_nontemporal_load((const f32x4*)(wp + (size_t)kk * NMOD)); const f32x4 cd = *(const LAS f32x4*)(cond + (ks * 64 + kk) * 4);
            a0 += w * cd[0]; a1 += w * cd[1]; a2 += w * cd[2]; a3 += w * cd[3]; }
        *(f32x4*)(p.modp + (size_t)(ks * 4 + 0) * NMOD + j4 * 4) = a0; *(f32x4*)(p.modp + (size_t)(ks * 4 + 1) * NMOD + j4 * 4) = a1;
        *(f32x4*)(p.modp + (size_t)(ks * 4 + 2) * NMOD + j4 * 4) = a2; *(f32x4*)(p.modp + (size_t)(ks * 4 + 3) * NMOD + j4 * 4) = a3;
    }
    const int gw = bid * NWAVES + wv, GW = gridDim.x * NWAVES;
    constexpr int I_IN = 16 * 265, I_RW = 8 * 64, I_PL = 4 * 4 * 16, I_OUT = 16 * 64, I_ALL = I_IN + I_RW + I_PL + I_OUT;
    for (int it = gw; it < I_ALL; it += GW) {
        if (it < I_IN) { const int kb = it / 265, nb = it % 265; cvt8_block_T(p.w_in + (size_t)(kb * 128) * NIN + nb * 32, NIN, p.wt_in + (size_t)(nb * 32) * ND + kb * 128, ND, lane); }
        else if (it < I_IN + I_RW) { const int j = it - I_IN, kb = j / 64, nb = j % 64; cvt8_block_T(p.w_rwkv_out + (size_t)(kb * 128) * ND + nb * 32, ND, p.wt_rwkv + (size_t)(nb * 32) * NC + kb * 128, NC, lane); }
        else if (it < I_IN + I_RW + I_PL) { const int j = it - I_IN - I_RW, g = j / 64, kb = (j % 64) / 16, nb = j % 16;
            cvt_block_T(p.w_pool + (size_t)g * 256 * 512 + (size_t)(kb * 64) * 512 + nb * 32, 512, p.wt_pool + (size_t)g * 512 * 256 + (size_t)(nb * 32) * 256 + kb * 64, 256, lane); }
        else { const int j = it - I_IN - I_RW - I_PL, kb = j / 64, nb = j % 64; cvt8_block_T(p.w_out + (size_t)(kb * 128) * ND + nb * 32, ND, p.wt_out + (size_t)(nb * 32) * ND + kb * 128, ND, lane); }
    }
    for (int idx = bid * NTHREADS + tid; idx < LORA_N * (LORA_K / 8); idx += gridDim.x * NTHREADS) {
        const int n = idx / (LORA_K / 8), k0 = (idx % (LORA_K / 8)) * 8; float v[8];
#pragma unroll
        for (int j = 0; j < 8; ++j) { const int k = k0 + j; float x = 0.f;
            if (n < 1024) { if (k < 64) x = p.w_decay_up[k * NC + n]; }
            else if (n < 2048) { if (k >= 64 && k < 128) x = p.w_iclr_up[(k - 64) * NC + (n - 1024)]; }
            else { if (k >= 128 && k < 288) x = p.w_glora_up[(k - 128) * NC + (n - 2048)]; }
            v[j] = x; }
        u32x4 w; w.x = cvt_pk_bf16(v[0], v[1]); w.y = cvt_pk_bf16(v[2], v[3]); w.z = cvt_pk_bf16(v[4], v[5]); w.w = cvt_pk_bf16(v[6], v[7]);
        *(u32x4*)(p.bt_lora + (size_t)n * LORA_K + k0) = w;
    }
}

__device__ __forceinline__ void phase1(const Params& p, LAS unsigned char* lds, const int wave) {
    const int tid = phase_tid(wave);
    const int bid = blockIdx.x;
    if (tid < 192) { const int idx = bid * 192 + tid, b = idx / NMOD, j = idx % NMOD; float s = p.b_ada[j];
        for (int ks = 0; ks < KS_MOD; ++ks) s += p.modp[(size_t)(ks * 4 + b) * NMOD + j];
        p.mod[idx] = s; }
    LAS float* ss = (LAS float*)lds;
    const int m0 = bid * 32, b = m0 >> 11;
    {   const int j = tid * 8; f32x4 s0 = ld4(p.b_ada + j), s1 = ld4(p.b_ada + j + 4);
#pragma unroll 8
        for (int ks = 0; ks < KS_MOD; ++ks) { s0 += ld4(p.modp + (size_t)(ks * 4 + b) * NMOD + j); s1 += ld4(p.modp + (size_t)(ks * 4 + b) * NMOD + j + 4); }
        *(LAS f32x4*)(ss + j) = s0; *(LAS f32x4*)(ss + j + 4) = s1; }
    __syncthreads();
    const int k = (tid & 255) * 8, rh = tid >> 8;
    const f32x4 sh0 = *(const LAS f32x4*)(ss + k), sh1v = *(const LAS f32x4*)(ss + k + 4), sc0 = *(const LAS f32x4*)(ss + ND + k) + 1.0f, sc1v = *(const LAS f32x4*)(ss + ND + k + 4) + 1.0f;
#pragma unroll 4
    for (int i = 0; i < 16; ++i) { const size_t m = (size_t)(m0 + 2 * i + rh); const f32x4 x0 = ld4nt(p.x + m * ND + k), x1 = ld4nt(p.x + m * ND + k + 4); const f32x4 h0 = x0 * sc0 + sh0, h1 = x1 * sc1v + sh1v;
        u32x2 w; w.x = pack4_fp8(h0[0], h0[1], h0[2], h0[3]); w.y = pack4_fp8(h1[0], h1[1], h1[2], h1[3]); *(u32x2*)(p.hb + m * ND + k) = w; }
    __syncthreads();
}

__device__ __forceinline__ void phase3(const Params& p, LAS unsigned char* lds, const int wave) {
    const int tid = phase_tid(wave);
    const int bid = blockIdx.x, m0 = bid * 32, t0 = m0 & (NT - 1), hist = t0 > 0 ? 15 : 0;
    constexpr int TC = OFF_GA - OFF_WD, TCH = TC / 8;
    LAS bf16_t* T = (LAS bf16_t*)lds;
    for (int idx = tid; idx < 47 * TCH; idx += NTHREADS) { const int r = idx / TCH, ck = idx % TCH;
        if (r >= 15 - hist) *(LAS u32x4*)(T + r * TC + ck * 8) = ldu4nt(p.P + (size_t)(m0 - 15 + r) * NINP + OFF_WD + ck * 8); }
    __syncthreads();
    for (int idx = tid; idx < 32 * (LORA_K / 8); idx += NTHREADS) { const int i = idx / (LORA_K / 8), j0 = (idx % (LORA_K / 8)) * 8; u32x4 w = {0u, 0u, 0u, 0u};
        if (j0 < 288) { const u32x4 cu = *(const LAS u32x4*)(T + (15 + i) * TC + j0); u32x4 pu = {0u, 0u, 0u, 0u}; if (t0 + i > 0) pu = *(const LAS u32x4*)(T + (14 + i) * TC + j0);
            const f32x4 c0 = bf4_unpack((u32x2){cu.x, cu.y}), c1 = bf4_unpack((u32x2){cu.z, cu.w}), q0 = bf4_unpack((u32x2){pu.x, pu.y}), q1 = bf4_unpack((u32x2){pu.z, pu.w});
            const f32x4 s0 = c0 + (q0 - c0) * ld4(p.mu_shift + OFF_WD + j0), s1 = c1 + (q1 - c1) * ld4(p.mu_shift + OFF_WD + j0 + 4); float v[8];
#pragma unroll
            for (int j = 0; j < 8; ++j) { const float x = j < 4 ? s0[j] : s1[j - 4];
                v[j] = j0 < 64 ? (1.0f - 2.0f * __builtin_amdgcn_rcpf(1.0f + __builtin_amdgcn_exp2f(x * 2.8853900817779268f))) : (j0 < 128 ? x : sigmoidf_(x)); }
            w.x = cvt_pk_bf16(v[0], v[1]); w.y = cvt_pk_bf16(v[2], v[3]); w.z = cvt_pk_bf16(v[4], v[5]); w.w = cvt_pk_bf16(v[6], v[7]); }
        *(u32x4*)(p.a_lora + (size_t)(m0 + i) * LORA_K + j0) = w; }
    for (int idx = tid; idx < 32 * (NC / 8); idx += NTHREADS) { const int i = idx >> 7, c = (idx & 127) * 8; const int win = 2 << (c >> 8), t = t0 + i, n = (t + 1) < win ? (t + 1) : win;
        const LAS bf16_t* up = T + (15 + i) * TC + (OFF_POOL - OFF_WD) + c; f32x4 a0 = {0.f, 0.f, 0.f, 0.f}, a1 = a0;
        for (int q = 0; q < n; ++q) { const u32x4 uu = *(const LAS u32x4*)(up - q * TC); a0 += bf4_unpack((u32x2){uu.x, uu.y}); a1 += bf4_unpack((u32x2){uu.z, uu.w}); }
        const u32x4 u0 = *(const LAS u32x4*)(up); const float rn = 1.0f / (float)n;
        const f32x4 d0 = a0 * rn - bf4_unpack((u32x2){u0.x, u0.y}), d1 = a1 * rn - bf4_unpack((u32x2){u0.z, u0.w});
        u32x4 w; w.x = cvt_pk_bf16(d0[0], d0[1]); w.y = cvt_pk_bf16(d0[2], d0[3]); w.z = cvt_pk_bf16(d1[0], d1[1]); w.w = cvt_pk_bf16(d1[2], d1[3]);
        *(u32x4*)(p.dp + (size_t)(m0 + i) * NC + c) = w; }
    __syncthreads();
}

__device__ __forceinline__ float row8_allsum(float x) {
    x += dpp_f<0x141>(x); x += dpp_f<0x1B>(x); x += dpp_f<0xB1>(x); return x;
}
__device__ __forceinline__ void scan_head(const Params& p, LAS unsigned char* lds, int bh, const int wave) {
    const int tid = phase_tid(wave);
    const int lane = tid & 63;
    const int b = bh >> 4, h = bh & 15;
    constexpr int L_AW = 0, L_W = 16384, L_BK = 32768, L_Y = 65536, L_V = 81920, L_G = 106496, L_SC = 131072, L_CS = 131840, L_Z = 132352, L_DUMMY = 132864, L_CST = 133888;
    constexpr int NCH = NT / 32;
    if (tid < 128) *(LAS unsigned*)(lds + L_Z + tid * 4) = 0u;
    {
        const int a8 = tid >> 6, cc = tid & 63, gch = h * HS + cc;
        const float* src = a8 == 0 ? p.mu_shift + OFF_R : a8 == 1 ? p.mu_shift + OFF_K : a8 == 2 ? p.mu_shift + OFF_V : a8 == 3 ? p.k_k : a8 == 4 ? p.k_a : a8 == 5 ? p.r_k : a8 == 6 ? p.lnx_g : p.lnx_b;
        *(LAS float*)(lds + L_CST + a8 * 256 + cc * 4) = src[gch]; }
    __syncthreads();
#define CST4(a8, u_) (*(const LAS f32x4*)(lds + L_CST + (a8) * 256 + (c8 + 4 * (u_)) * 4))
    const int ht = tid - 256, ls = (ht >> 3) & 31, c8 = (ht & 7) * 8, ch0 = h * HS + c8;
    f32x4 pr[2], pk[2], pv[2], qr[2], qk[2], qv[2], dc[2], ic[2], gt[2]; u32x4 pr8, pk8, pv8, qr8, qk8, qv8, ic8, gt8;
    const f32x4 zero4 = {0.f, 0.f, 0.f, 0.f};
#define SCAN_ISSUE(chunk) do { int ch = ch0; asm volatile("" : "+v"(ch)); const int t_ = (chunk) * 32 + ls; const size_t m_ = (size_t)b * NT + t_; const bf16_t* row_ = p.P + m_ * NINP + ch; \
        pr8 = *(const u32x4*)(row_ + OFF_R); pk8 = *(const u32x4*)(row_ + OFF_K); pv8 = *(const u32x4*)(row_ + OFF_V); \
        if (t_ > 0) { qr8 = *(const u32x4*)(row_ - NINP + OFF_R); qk8 = *(const u32x4*)(row_ - NINP + OFF_K); qv8 = *(const u32x4*)(row_ - NINP + OFF_V); } else { qr8 = (u32x4){0u, 0u, 0u, 0u}; qk8 = qr8; qv8 = qr8; } \
        ic8 = ldu4nt(p.iclr + m_ * NC + ch); gt8 = ldu4nt(p.gg + m_ * NC + ch); \
        _Pragma("unroll") for (int u_ = 0; u_ < 2; ++u_) dc[u_] = ld4nt(p.dec + m_ * NC + ch + 4 * u_); } while (0)
#define SCAN_UNPACK() do { ic[0] = bf4_unpack((u32x2){ic8.x, ic8.y}); ic[1] = bf4_unpack((u32x2){ic8.z, ic8.w}); gt[0] = bf4_unpack((u32x2){gt8.x, gt8.y}); gt[1] = bf4_unpack((u32x2){gt8.z, gt8.w}); pr[0] = bf4_unpack((u32x2){pr8.x, pr8.y}); pr[1] = bf4_unpack((u32x2){pr8.z, pr8.w}); pk[0] = bf4_unpack((u32x2){pk8.x, pk8.y}); pk[1] = bf4_unpack((u32x2){pk8.z, pk8.w}); \
        pv[0] = bf4_unpack((u32x2){pv8.x, pv8.y}); pv[1] = bf4_unpack((u32x2){pv8.z, pv8.w}); qr[0] = bf4_unpack((u32x2){qr8.x, qr8.y}); qr[1] = bf4_unpack((u32x2){qr8.z, qr8.w}); \
        qk[0] = bf4_unpack((u32x2){qk8.x, qk8.y}); qk[1] = bf4_unpack((u32x2){qk8.z, qk8.w}); qv[0] = bf4_unpack((u32x2){qv8.x, qv8.y}); qv[1] = bf4_unpack((u32x2){qv8.z, qv8.w}); } while (0)
#define SCAN_STAGE(chunk) do { SCAN_UNPACK(); int ch = ch0; asm volatile("" : "+v"(ch)); const int bp_ = (chunk) & 1, vb_ = (chunk) % 3; f32x4 r_[2], k_[2], v_[2], kk_[2], km_[2], bb_[2]; float ss_ = 0.f; \
        _Pragma("unroll") for (int u_ = 0; u_ < 2; ++u_) { const f32x4 mu_r = CST4(0, u_), mu_k = CST4(1, u_), mu_v = CST4(2, u_); \
            r_[u_] = pr[u_] + (qr[u_] - pr[u_]) * mu_r; k_[u_] = pk[u_] + (qk[u_] - pk[u_]) * mu_k; v_[u_] = pv[u_] + (qv[u_] - pv[u_]) * mu_v; \
            kk_[u_] = k_[u_] * CST4(3, u_); ss_ += dot4(kk_[u_], kk_[u_]); } \
        ss_ = row8_allsum(ss_); const float inv_ = 1.0f / fmaxf(sqrtf(ss_), 1e-12f); float br_ = 0.f, kr_ = 0.f, rk_ = 0.f; \
        _Pragma("unroll") for (int u_ = 0; u_ < 2; ++u_) { kk_[u_] = kk_[u_] * inv_; km_[u_] = k_[u_] * ((ic[u_] - 1.0f) * CST4(4, u_) + 1.0f); bb_[u_] = kk_[u_] * ic[u_]; \
            br_ += dot4(bb_[u_], r_[u_]); kr_ += dot4(km_[u_], r_[u_]); rk_ += dot4(r_[u_] * km_[u_], CST4(5, u_)); } \
        br_ = row8_allsum(br_); kr_ = row8_allsum(kr_); rk_ = row8_allsum(rk_); \
          \
        const int pp_ = ls >> 1, odd_ = ls & 1; float c1_ = 0.f, c2_ = 0.f, c3_ = 0.f, c4_ = 0.f; \
        _Pragma("unroll") for (int u_ = 0; u_ < 2; ++u_) { const int k0_ = c8 + 4 * u_; const int pos_ = (k0_ >> 5) * 32 + ((k0_ & 15) >> 2) * 8 + ((k0_ >> 4) & 1) * 4; \
            const f32x4 a_ = -kk_[u_], wr_ = dc[u_] * r_[u_] + a_ * br_; f32x4 pw_, pb_, pk_; \
            _Pragma("unroll") for (int j_ = 0; j_ < 4; ++j_) { pw_[j_] = dpp_f<0x118>(dc[u_][j_]); pb_[j_] = dpp_f<0x118>(bb_[u_][j_]); pk_[j_] = dpp_f<0x118>(km_[u_][j_]); } \
            const f32x4 x0_ = odd_ ? pw_ * a_ : a_, x1_ = odd_ ? pw_ * wr_ : wr_; \
            u32x2 wa_, ww_; wa_.x = cvt_pk_bf16(x0_[0], x0_[1]); wa_.y = cvt_pk_bf16(x0_[2], x0_[3]); ww_.x = cvt_pk_bf16(x1_[0], x1_[1]); ww_.y = cvt_pk_bf16(x1_[2], x1_[3]); \
            *(LAS u32x2*)(lds + L_AW + bp_ * 8192 + pp_ * 512 + odd_ * 256 + pos_ * 2) = wa_; *(LAS u32x2*)(lds + L_AW + bp_ * 8192 + pp_ * 512 + odd_ * 256 + 128 + pos_ * 2) = ww_; \
            if (odd_) { *(LAS f32x4*)(lds + L_W + bp_ * 8192 + pp_ * 256 + k0_ * 4) = pw_ * dc[u_]; \
                *(LAS f32x4*)(lds + L_BK + bp_ * 16384 + pp_ * 1024 + k0_ * 4) = pb_ * dc[u_]; *(LAS f32x4*)(lds + L_BK + bp_ * 16384 + pp_ * 1024 + 256 + k0_ * 4) = pk_ * dc[u_]; \
                *(LAS f32x4*)(lds + L_BK + bp_ * 16384 + pp_ * 1024 + 512 + k0_ * 4) = bb_[u_]; *(LAS f32x4*)(lds + L_BK + bp_ * 16384 + pp_ * 1024 + 768 + k0_ * 4) = km_[u_]; \
                c1_ += dot4(pb_, a_); c2_ += dot4(pk_, a_); c3_ += dot4(pb_, wr_); c4_ += dot4(pk_, wr_); } \
            *(LAS f32x4*)(lds + L_V + vb_ * 8192 + ls * 256 + k0_ * 4) = v_[u_]; *(LAS f32x4*)(lds + L_G + vb_ * 8192 + ls * 256 + k0_ * 4) = gt[u_]; } \
        c1_ = row8_allsum(c1_); c2_ = row8_allsum(c2_); c3_ = row8_allsum(c3_); c4_ = row8_allsum(c4_); \
        if ((ht & 7) == 0) { *(LAS f32x2*)(lds + L_SC + vb_ * 256 + ls * 8) = (f32x2){kr_, rk_}; if (odd_) *(LAS f32x4*)(lds + L_CS + bp_ * 256 + pp_ * 16) = (f32x4){c1_, c2_, c3_, c4_}; } } while (0)
#define SCAN_POST(chunk) do { int ch = ch0; asm volatile("" : "+v"(ch)); const int bp_ = (chunk) & 1, vb_ = (chunk) % 3; const f32x2 sc_ = *(const LAS f32x2*)(lds + L_SC + vb_ * 256 + ls * 8); f32x4 y_[2], v_[2]; float s_ = 0.f; \
        _Pragma("unroll") for (int u_ = 0; u_ < 2; ++u_) { v_[u_] = *(const LAS f32x4*)(lds + L_V + vb_ * 8192 + ls * 256 + (c8 + 4 * u_) * 4); \
            y_[u_] = *(const LAS f32x4*)(lds + L_Y + bp_ * 8192 + ls * 256 + (c8 + 4 * u_) * 4) + v_[u_] * sc_[0]; s_ += (y_[u_][0] + y_[u_][1]) + (y_[u_][2] + y_[u_][3]); } \
        const float mean_ = row8_allsum(s_) * (1.0f / 64.0f); float q_ = 0.f; \
        _Pragma("unroll") for (int u_ = 0; u_ < 2; ++u_) { y_[u_] = y_[u_] - mean_; q_ += dot4(y_[u_], y_[u_]); } \
        const float rstd_ = rsqrtf(row8_allsum(q_) * (1.0f / 64.0f) + GN_EPS); const size_t m_ = (size_t)b * NT + (chunk) * 32 + ls; u32x2 o_; \
        _Pragma("unroll") for (int u_ = 0; u_ < 2; ++u_) { const f32x4 g_ = *(const LAS f32x4*)(lds + L_G + vb_ * 8192 + ls * 256 + (c8 + 4 * u_) * 4); \
            const f32x4 yn_ = y_[u_] * rstd_ * CST4(6, u_) + CST4(7, u_); const f32x4 f_ = (yn_ + v_[u_] * sc_[1]) * g_; \
            if (u_ == 0) o_.x = pack4_fp8(f_[0] * A8_SCALE, f_[1] * A8_SCALE, f_[2] * A8_SCALE, f_[3] * A8_SCALE); else o_.y = pack4_fp8(f_[0] * A8_SCALE, f_[1] * A8_SCALE, f_[2] * A8_SCALE, f_[3] * A8_SCALE); } \
        *(u32x2*)(p.yr + m_ * NC + ch) = o_; } while (0)
    const int ri = lane & 15, rg = lane >> 4, sel = ri & 3;
    f32x4 X0 = zero4, X1 = zero4, X2 = zero4, X3 = zero4;
    if (wave >= 4) { SCAN_ISSUE(0); SCAN_STAGE(0); }
    __syncthreads();
    for (int chunk = 0; chunk < NCH; ++chunk) {
        if (wave < 4) {
            __builtin_amdgcn_s_setprio(3);
            const int bp = chunk & 1, vb = chunk % 3;
            const LAS unsigned char* awp = lds + L_AW + bp * 8192 + sel * 128 + rg * 16;
            const LAS unsigned char* wwp = lds + L_W + bp * 8192 + rg * 16;
            const LAS unsigned char* abp = lds + L_BK + bp * 16384 + rg * 256 + ri * 4;
            const LAS unsigned char* vp = lds + L_V + vb * 8192 + (16 * wave + ri) * 4;
            const LAS unsigned char* csp = lds + L_CS + bp * 256;
            LAS unsigned char* yp = (rg == 0) ? (lds + L_Y + bp * 8192 + (16 * wave + ri) * 4) : ((rg == 2) ? (lds + L_Y + bp * 8192 + 256 + (16 * wave + ri) * 4) : (lds + L_DUMMY + tid * 4));
            const int y_st = (rg & 1) ? 0 : 512;
#define SCAN_LD(S, pi) do { S##a0 = *(const LAS bf16x8*)(awp + (pi) * 512); S##a1 = *(const LAS bf16x8*)(awp + (pi) * 512 + 64); \
                S##w0 = *(const LAS f32x4*)(wwp + (pi) * 256); S##w1 = *(const LAS f32x4*)(wwp + (pi) * 256 + 64); S##w2 = *(const LAS f32x4*)(wwp + (pi) * 256 + 128); S##w3 = *(const LAS f32x4*)(wwp + (pi) * 256 + 192); \
                S##b0 = *(const LAS float*)(abp + (pi) * 1024); S##b1 = *(const LAS float*)(abp + (pi) * 1024 + 64); S##b2 = *(const LAS float*)(abp + (pi) * 1024 + 128); S##b3 = *(const LAS float*)(abp + (pi) * 1024 + 192); \
                S##vt = *(const LAS float*)(vp + (pi) * 512); S##vu = *(const LAS float*)(vp + (pi) * 512 + 256); S##cs = *(const LAS f32x4*)(csp + (pi) * 16); } while (0)
#define SCAN_STEP(S, pi) do { u32x4 xa, xc; \
                xa.x = cvt_pk_bf16(X0[0], X0[1]); xa.y = cvt_pk_bf16(X0[2], X0[3]); xa.z = cvt_pk_bf16(X1[0], X1[1]); xa.w = cvt_pk_bf16(X1[2], X1[3]); \
                xc.x = cvt_pk_bf16(X2[0], X2[1]); xc.y = cvt_pk_bf16(X2[2], X2[3]); xc.z = cvt_pk_bf16(X3[0], X3[1]); xc.w = cvt_pk_bf16(X3[2], X3[3]); \
                const f32x4 d0 = __builtin_amdgcn_mfma_f32_16x16x32_bf16(S##a0, __builtin_bit_cast(bf16x8, xa), zero4, 0, 0, 0); \
                const f32x4 d1 = __builtin_amdgcn_mfma_f32_16x16x32_bf16(S##a1, __builtin_bit_cast(bf16x8, xc), zero4, 0, 0, 0); \
                const f32x4 d = d0 + d1; const float sat = d[0]; \
                const float sau = d[2] + sat * S##cs[0] + S##vt * S##cs[1], yu = d[3] + sat * S##cs[2] + S##vt * S##cs[3]; \
                const float bsel = (rg == 0) ? sat : ((rg == 1) ? S##vt : ((rg == 2) ? sau : S##vu)); \
                X0 = __builtin_amdgcn_mfma_f32_16x16x4f32(S##b0, bsel, X0 * S##w0, 0, 0, 0); \
                X1 = __builtin_amdgcn_mfma_f32_16x16x4f32(S##b1, bsel, X1 * S##w1, 0, 0, 0); \
                X2 = __builtin_amdgcn_mfma_f32_16x16x4f32(S##b2, bsel, X2 * S##w2, 0, 0, 0); \
                X3 = __builtin_amdgcn_mfma_f32_16x16x4f32(S##b3, bsel, X3 * S##w3, 0, 0, 0); \
                *(LAS float*)(yp + (pi) * y_st) = (rg == 0) ? d[1] : yu; } while (0)
            bf16x8 Pa0, Pa1, Qa0, Qa1; f32x4 Pw0, Pw1, Pw2, Pw3, Qw0, Qw1, Qw2, Qw3, Pcs, Qcs; float Pb0, Pb1, Pb2, Pb3, Pvt, Pvu, Qb0, Qb1, Qb2, Qb3, Qvt, Qvu;
            SCAN_LD(P, 0);
#pragma unroll 1
            for (int pi = 0; pi < 16; pi += 2) {
                SCAN_LD(Q, pi + 1);
                SCAN_STEP(P, pi);
                if (pi + 2 < 16) SCAN_LD(P, pi + 2);
                SCAN_STEP(Q, pi + 1);
            }
#undef SCAN_LD
#undef SCAN_STEP
        } else {
            if (chunk + 1 < NCH) SCAN_ISSUE(chunk + 1);
            if (chunk > 0) SCAN_POST(chunk - 1);
            if (chunk + 1 < NCH) SCAN_STAGE(chunk + 1);
        }
        __syncthreads();
    }
    if (wave >= 4) SCAN_POST(NCH - 1);
    __syncthreads();
#undef SCAN_ISSUE
#undef CST4
#undef SCAN_STAGE
#undef SCAN_UNPACK
#undef SCAN_POST
}
__device__ __forceinline__ void conv_queue(const Params& p, LAS unsigned char* lds, const int wave, const int cw, const int n_defer = N_DEFER) {
    const int tid = phase_tid(wave);
    const int lane = tid & 63, wv = tid >> 6;
    LAS int* slot = (LAS int*)(lds + LDS_MISC);
    constexpr int N_GU = NE * 16 * 2, N_DN = NE * 16, N_ALL = N_GU + N_DN;
    for (;;) {
        __syncthreads();
        if (tid == 0) *slot = (int)atomicAdd(&p.ctl[cw], 1u);
        __syncthreads();
        const int it = *slot;
        if (it >= N_ALL - n_defer) break;
        if (it < N_GU) { const int e = it >> 5, rem = it & 31, kb = rem >> 1, nh = rem & 1;
            const float* src = p.w_gu + (size_t)e * ND * (2 * DFF) + (size_t)(kb * 128) * (2 * DFF) + nh * 2048;
            fp8_t* dst = p.wt_gu + (size_t)e * (2 * DFF) * ND + (size_t)(nh * 2048) * ND + kb * 128;
            cvt_wave_T8x8(src + wv * 256, 2 * DFF, dst + (size_t)(wv * 256) * ND, ND, lane); }
        else { const int j = it - N_GU, e = j >> 4, kb = j & 15;
            const float* src = p.w_down + (size_t)e * DFF * ND + (size_t)(kb * 128) * ND;
            fp8_t* dst = p.wt_down + (size_t)e * ND * DFF + kb * 128;
            cvt_wave_T8x8(src + wv * 256, ND, dst + (size_t)(wv * 256) * DFF, DFF, lane); }
    }
}

__device__ __forceinline__ void conv_queue_tail(const Params& p, LAS unsigned char* lds, const int wave) {
    const int tid = phase_tid(wave);
    const int lane = tid & 63, wv = tid >> 6;
    LAS int* slot = (LAS int*)(lds + LDS_MISC + 1024);
    for (;;) {
        __syncthreads();
        if (tid == 0) *slot = (int)atomicAdd(&p.ctl[CW_CONV3], 1u);
        __syncthreads();
        const int it = *slot;
        if (it >= N_DEFER * 8) break;
        const int j = NE * 16 - N_DEFER + (it >> 3), sub = it & 7, e = j >> 4, kb = j & 15, k16 = lane & 7, nq = lane >> 3;
        const float* src = p.w_down + (size_t)e * DFF * ND + (size_t)(kb * 128 + k16 * 16) * ND + sub * 256 + wv * 32 + nq * 4;
        fp8_t* dst = p.wt_down + (size_t)e * ND * DFF + (size_t)(sub * 256 + wv * 32 + nq * 4) * DFF + kb * 128 + k16 * 16;
        f32x4 cv[16]; cvt8_load(cv, src, ND); cvt8_store(cv, dst, DFF);
    }
}

__device__ __forceinline__ void phase8(const Params& p, LAS unsigned char* lds, const int wave) {
    const int tid = phase_tid(wave);
    const int bid = blockIdx.x, lane = tid & 63, wv = tid >> 6;
    constexpr int HP = ND + 4;
    LAS float* hs = (LAS float*)lds;
    LAS float* lg = hs + 16 * HP;
    LAS float* part = lg + 16 * 32;
    LAS float* topv = part + 4 * 16 * 32;
    LAS int* topi = (LAS int*)(topv + 64);
    const int b = (bid * 32) >> 11;
    const float* sh2 = p.mod + (size_t)b * NMOD + 3 * ND; const float* sc2 = p.mod + (size_t)b * NMOD + 4 * ND;
    for (int pass = 0; pass < 2; ++pass) {
        const int mb = bid * 32 + pass * 16;
        for (int rr = 0; rr < 2; ++rr) { const int r = wv * 2 + rr; const size_t m = (size_t)(mb + r);
            f32x4 z[8]; float s = 0.f;
#pragma unroll
            for (int j = 0; j < 4; ++j) { z[2 * j] = ld4nt(p.z1 + m * ND + j * 512 + lane * 8); z[2 * j + 1] = ld4nt(p.z1 + m * ND + j * 512 + lane * 8 + 4);
                s += ((z[2 * j][0] + z[2 * j][1]) + (z[2 * j][2] + z[2 * j][3])) + ((z[2 * j + 1][0] + z[2 * j + 1][1]) + (z[2 * j + 1][2] + z[2 * j + 1][3])); }
            const float mean = wave_allsum(s) * (1.0f / ND); float qv = 0.f;
#pragma unroll
            for (int j = 0; j < 8; ++j) { const f32x4 d = z[j] - mean; qv += dot4(d, d); }
            const float rstd = rsqrtf(wave_allsum(qv) * (1.0f / ND) + LN_EPS);
            if (lane == 0) *(f32x2*)(p.lnst + m * 2) = (f32x2){mean, rstd};
#pragma unroll
            for (int j = 0; j < 8; ++j) { const int k = (j >> 1) * 512 + lane * 8 + (j & 1) * 4;
                const f32x4 x1 = (z[j] - mean) * rstd * ld4(p.ln1_g + k) + ld4(p.ln1_b + k);
                const f32x4 h = x1 * (ld4(sc2 + k) + 1.0f) + ld4(sh2 + k);
                *(unsigned*)(p.h2 + m * ND + k) = pack4_fp8(h[0], h[1], h[2], h[3]);
                *(LAS f32x4*)(hs + r * HP + k) = h; } }
        __syncthreads();
        {
            const int kq = wv >> 1, ntl = wv & 1, ar = lane & 15, ak = lane >> 4;
            f32x4 acc = {0.f, 0.f, 0.f, 0.f};
            const LAS float* ap = hs + ar * HP + kq * 512 + ak; const float* bp = p.w_router + (size_t)(kq * 512 + ak) * NE + ntl * 16 + ar;
#pragma unroll 1
            for (int kb = 0; kb < 128; kb += 32) { float bq[32];
#pragma unroll
                for (int j = 0; j < 32; ++j) bq[j] = bp[(size_t)(kb + j) * 4 * NE];
#pragma unroll
                for (int j = 0; j < 32; ++j) acc = __builtin_amdgcn_mfma_f32_16x16x4f32(ap[(kb + j) * 4], bq[j], acc, 0, 0, 0); }
#pragma unroll
            for (int j = 0; j < 4; ++j) part[(kq * 16 + ak * 4 + j) * 32 + ntl * 16 + ar] = acc[j]; }
        __syncthreads();
        {   const int r = tid >> 5, e = tid & 31;
            lg[r * 32 + e] = p.b_router[e] + (part[(0 * 16 + r) * 32 + e] + part[(1 * 16 + r) * 32 + e]) + (part[(2 * 16 + r) * 32 + e] + part[(3 * 16 + r) * 32 + e]); }
        __syncthreads();
        {
            const int r = tid >> 5, e = tid & 31; const LAS float* l = lg + r * 32; const float mine = l[e]; int rank = 0;
#pragma unroll
            for (int q = 0; q < 8; ++q) { const f32x4 o = *(const LAS f32x4*)(l + q * 4);
#pragma unroll
                for (int j = 0; j < 4; ++j) rank += (o[j] > mine || (o[j] == mine && (q * 4 + j) < e)) ? 1 : 0; }
            if (rank < 4) { topv[r * 4 + rank] = mine; topi[r * 4 + rank] = e; } }
        __syncthreads();
        if (tid < 64) { const int r = tid >> 2, k = tid & 3, m = mb + r; const f32x4 tv = *(const LAS f32x4*)(topv + r * 4); const int ei = topi[r * 4 + k];
            const float e0 = 1.0f, e1 = expf(tv[1] - tv[0]), e2 = expf(tv[2] - tv[0]), e3 = expf(tv[3] - tv[0]); const float sum = (e0 + e1) + (e2 + e3);
            const float mineexp = k == 0 ? e0 : (k == 1 ? e1 : (k == 2 ? e2 : e3));
            const unsigned rk = atomicAdd(&p.ctl[CW_CNT + 64 * ei], 1u);
            p.sel[m * 4 + k] = ei; p.rnk[m * 4 + k] = (int)rk; p.prob[m * 4 + k] = mineexp / sum; }
        __syncthreads();
    }
}

__device__ __forceinline__ void phase9(const Params& p, LAS unsigned char* lds, const int wave) {
    const int tid = phase_tid(wave);
    const int bid = blockIdx.x, lane = tid & 63, wv = tid >> 6;
    LAS int* seg = (LAS int*)lds;
    if (tid == 0) { int s = 0;
        for (int e = 0; e < NE; ++e) { seg[e] = s; const int c = (int)xb_ld(&p.ctl[CW_CNT + 64 * e]); s += (c + 255) & ~255; }
        seg[NE] = s;
        if (bid == 0) { int t = 0;
            for (int e = 0; e < NE; ++e) { const int nt = (seg[e + 1] - seg[e]) >> 8; for (int i = 0; i < nt; ++i) p.ctl[CW_TILEE + t + i] = (unsigned)e; t += nt; }
            p.ctl[CW_NTILES] = (unsigned)t; } }
    __syncthreads();
    {
        const int gw = bid * NWAVES + wv; i32x4 e4[4], r4[4]; u32x4 v0[4], v1[4];
#pragma unroll
        for (int i = 0; i < 4; ++i) { const int m = gw + i * 2048; e4[i] = *(const i32x4*)(p.sel + m * 4); r4[i] = *(const i32x4*)(p.rnk + m * 4);
            const u32x4* src = (const u32x4*)(p.h2 + (size_t)m * ND); v0[i] = src[lane]; v1[i] = src[64 + lane]; }
#pragma unroll
        for (int i = 0; i < 4; ++i) { const int m = gw + i * 2048; i32x4 dd;
#pragma unroll
            for (int k = 0; k < 4; ++k) { dd[k] = seg[e4[i][k]] + r4[i][k]; u32x4* q = (u32x4*)(p.xb + (size_t)dd[k] * ND); q[lane] = v0[i]; q[64 + lane] = v1[i]; }
            if (lane == 0) *(i32x4*)(p.dest + m * 4) = dd; } }
    __syncthreads();
}

__device__ __forceinline__ void phase13(const Params& p, const int wave) {
    const int tid = phase_tid(wave);
    const int bid = blockIdx.x, lane0 = tid & 63, wv = wave;
    const int GW = gridDim.x * NWAVES;
    for (int m = bid * NWAVES + wv; m < NM; m += GW) { const int b = m >> 11;
        int lane = lane0; asm volatile("" : "+v"(lane));
        const float* g2 = p.mod + (size_t)b * NMOD + 5 * ND;
        int d[4]; float pr[4]; const f32x2 st = *(const f32x2*)(p.lnst + (size_t)m * 2);
#pragma unroll
        for (int k = 0; k < 4; ++k) { d[k] = p.dest[m * 4 + k]; pr[k] = p.prob[m * 4 + k]; }
        f32x4 z[8]; float s = 0.f; u32x4 yq[4][4];
#pragma unroll
        for (int j = 0; j < 4; ++j) {
#pragma unroll
            for (int k = 0; k < 4; ++k) yq[j][k] = ldu4nt(p.yb + (size_t)d[k] * ND + j * 512 + lane * 8);
            z[2 * j] = ld4nt(p.z1 + (size_t)m * ND + j * 512 + lane * 8); z[2 * j + 1] = ld4nt(p.z1 + (size_t)m * ND + j * 512 + lane * 8 + 4); }
#pragma unroll
        for (int j = 0; j < 4; ++j) { const int c = j * 512 + lane * 8; f32x4 f0 = {0.f, 0.f, 0.f, 0.f}, f1 = f0;
#pragma unroll
            for (int k = 0; k < 4; ++k) { f0 += bf4_unpack((u32x2){yq[j][k].x, yq[j][k].y}) * pr[k]; f1 += bf4_unpack((u32x2){yq[j][k].z, yq[j][k].w}) * pr[k]; }
            const f32x4 xa = (z[2 * j] - st[0]) * st[1] * ld4(p.ln1_g + c) + ld4(p.ln1_b + c), xb2 = (z[2 * j + 1] - st[0]) * st[1] * ld4(p.ln1_g + c + 4) + ld4(p.ln1_b + c + 4);
            z[2 * j] = xa * DN_ALPHA + ld4(g2 + c) * f0; z[2 * j + 1] = xb2 * DN_ALPHA + ld4(g2 + c + 4) * f1;
            s += ((z[2 * j][0] + z[2 * j][1]) + (z[2 * j][2] + z[2 * j][3])) + ((z[2 * j + 1][0] + z[2 * j + 1][1]) + (z[2 * j + 1][2] + z[2 * j + 1][3])); }
        const float mean = wave_allsum(s) * (1.0f / ND); float qv = 0.f;
#pragma unroll
        for (int j = 0; j < 8; ++j) { const f32x4 dd = z[j] - mean; qv += dot4(dd, dd); }
        const float rstd = rsqrtf(wave_allsum(qv) * (1.0f / ND) + LN_EPS);
#pragma unroll
        for (int j = 0; j < 8; ++j) { const int c = (j >> 1) * 512 + lane * 8 + (j & 1) * 4;
            *(f32x4*)(p.out + (size_t)m * ND + c) = (z[j] - mean) * rstd * ld4(p.ln2_g + c) + ld4(p.ln2_b + c); } }
}

__global__ void __launch_bounds__(NTHREADS, 2) fwd(Params p) {
    extern __shared__ __attribute__((aligned(16))) unsigned char shm[];
    LAS unsigned char* lds = (LAS unsigned char*)shm;
    const int bid = blockIdx.x, G = gridDim.x;
    const int wave = __builtin_amdgcn_readfirstlane(threadIdx.x >> 6);
    if (threadIdx.x == 0) *(LAS u32x4*)(lds + LDS_BARW) = (u32x4){0u, 0u, 0u, 0u};
    __syncthreads();
    XcdBarrier bar = xcd_barrier_post(p.bar, (volatile LAS unsigned*)(lds + LDS_BARW));

    phase0(p, lds, wave);
    xcd_barrier(bar, wave);
    if (PROBE == 3) { phase0(p, lds, wave); xcd_barrier(bar, wave); }
    phase1(p, lds, wave);
    xcd_barrier(bar, wave);
    if (PROBE == 3) { phase1(p, lds, wave); xcd_barrier(bar, wave); }
    {
        pg8::Gemm g{(const bf16_t*)p.hb, (const bf16_t*)p.wt_in, ND / 2, ND / 2, ND / 2}; pg8::DenseOrder S; S.init(NM / 256, NINP / 256 - 2, G, bid, (size_t)256 * ND, (size_t)256 * ND); S.skip_from = 23; S.skip_n = 2;
        EpiP E{p.P}; pg8::gemm_phase<EpiP, pg8::DenseOrder, true>(lds, g, S, E, wave);
        if (PROBE == 1) { __syncthreads(); pg8::gemm_phase<EpiP, pg8::DenseOrder, true>(lds, g, S, E, wave); } }
    xcd_barrier(bar, wave);
    phase3(p, lds, wave);
    xcd_barrier(bar, wave);
    if (PROBE == 3) { phase3(p, lds, wave); xcd_barrier(bar, wave); }
    {
        pg8::Gemm g{(const bf16_t*)p.hb, (const bf16_t*)p.wt_in, ND / 2, ND / 2, ND / 2}; WinRestOrder S{bid, (size_t)256 * ND, (size_t)256 * ND};
        EpiP E{p.P}; pg8::gemm_phase<EpiP, WinRestOrder, true>(lds, g, S, E, wave); }
    __syncthreads();
    {
        pg8::Gemm g{p.a_lora, p.bt_lora, LORA_K, LORA_K, LORA_K}; pg8::DenseOrder S; S.init(NM / 256, LORA_N / 256, G - 64, bid - 64, (size_t)256 * LORA_K * 2, (size_t)256 * LORA_K * 2);
        EpiLora E{p.dec, p.iclr, p.gg, p.w0, p.a0}; pg8::gemm_phase(lds, g, S, E, wave);
        if (PROBE == 1) { __syncthreads(); pg8::gemm_phase(lds, g, S, E, wave); } }
    __syncthreads();
    {
        pg8::Gemm g{p.dp, p.wt_pool, NC, 256, 256}; PoolOrder S{1 << 20, bid >= 64 ? bid - 64 : 192 + bid};
        EpiPool E{p.t1, p.P, p.pool_scale}; pg8::gemm_phase(lds, g, S, E, wave);
        if (PROBE == 1) { __syncthreads(); pg8::gemm_phase(lds, g, S, E, wave); } }
    xcd_barrier(bar, wave);
    if (bid < NB * NH) { scan_head(p, lds, bid, wave); if (PROBE == 4) scan_head(p, lds, bid, wave); }
    conv_queue(p, lds, wave, CW_CONV);
    if (PROBE == 5) conv_queue(p, lds, wave, CW_CONV2);
    xcd_barrier(bar, wave);
    if (PROBE == 2) { if (bid < NB * NH) scan_head(p, lds, bid, wave); conv_queue(p, lds, wave, CW_CONV2); xcd_barrier(bar, wave); }
    {
        pg8::Gemm g{(const bf16_t*)p.yr, (const bf16_t*)p.wt_rwkv, NC / 2, NC / 2, NC / 2}; pg8::DenseOrder S; S.init(NM / 256, ND / 256, G, bid, (size_t)256 * NC, (size_t)256 * NC);
        EpiRwkv E{p.mx, p.P, p.t1}; pg8::gemm_phase<EpiRwkv, pg8::DenseOrder, true>(lds, g, S, E, wave);
        if (PROBE == 1) { __syncthreads(); pg8::gemm_phase<EpiRwkv, pg8::DenseOrder, true>(lds, g, S, E, wave); } }
    xcd_barrier(bar, wave);
    {
        pg8::Gemm g{(const bf16_t*)p.mx, (const bf16_t*)p.wt_out, ND / 2, ND / 2, ND / 2}; pg8::DenseOrder S; S.init(NM / 256, ND / 256, G, bid, (size_t)256 * ND, (size_t)256 * ND);
        EpiWout E{p.z1, p.x, p.mod}; pg8::gemm_phase<EpiWout, pg8::DenseOrder, true>(lds, g, S, E, wave);
        if (PROBE == 1) { __syncthreads(); pg8::gemm_phase<EpiWout, pg8::DenseOrder, true>(lds, g, S, E, wave); } }
    xcd_barrier(bar, wave);
    phase8(p, lds, wave);
    xcd_barrier(bar, wave);
    phase9(p, lds, wave);
    xcd_barrier(bar, wave);
    if (PROBE == 3) { phase9(p, lds, wave); xcd_barrier(bar, wave); }
    const int ntiles = (int)xb_ld(&p.ctl[CW_NTILES]);
    {   const int t_ = phase_tid(wave); if (t_ < MAXTILES) *(LAS unsigned*)(lds + LDS_MISC + 4 * t_) = p.ctl[CW_TILEE + t_]; }
    __syncthreads();
    {
        pg8::Gemm g{(const bf16_t*)p.xb, (const bf16_t*)p.wt_gu, ND / 2, ND / 2, ND / 2};
        MoeOrder S{G, bid, 2 * DFF / 256, ntiles, (const LAS unsigned*)(lds + LDS_MISC), (size_t)256 * ND, (size_t)(2 * DFF) * ND, (size_t)256 * ND};
        EpiGU E{p.act, p.b_gu, lds}; pg8::gemm_phase<EpiGU, MoeOrder, true>(lds, g, S, E, wave);
        if (PROBE == 1) { __syncthreads(); pg8::gemm_phase<EpiGU, MoeOrder, true>(lds, g, S, E, wave); } }
    conv_queue_tail(p, lds, wave);
    xcd_barrier(bar, wave);
    {
        pg8::Gemm g{(const bf16_t*)p.act, (const bf16_t*)p.wt_down, DFF / 2, DFF / 2, DFF / 2};
        MoeOrder S{G, bid, ND / 256, ntiles, (const LAS unsigned*)(lds + LDS_MISC), (size_t)256 * DFF, (size_t)ND * DFF, (size_t)256 * DFF};
        EpiDown E{p.yb, p.b_down}; pg8::gemm_phase<EpiDown, MoeOrder, true>(lds, g, S, E, wave);
        if (PROBE == 1) { __syncthreads(); pg8::gemm_phase<EpiDown, MoeOrder, true>(lds, g, S, E, wave); } }
    xcd_barrier(bar, wave);
    phase13(p, wave);
    if (PROBE == 3) { xcd_barrier(bar, wave); phase13(p, wave); }
}

static inline size_t align_up(size_t v, size_t a) { return (v + a - 1) / a * a; }

extern "C" void kernel_launch(void* const* d_in, const int* in_sizes, int n_in, void* d_out, int out_size, void* d_ws, size_t ws_size, hipStream_t stream) {
    (void)in_sizes; (void)n_in; (void)out_size;
    Params p{};
    const float** ins = (const float**)&p;
    for (int i = 0; i < 30; ++i) ins[i] = (const float*)d_in[i];
    p.out = (float*)d_out;
    char* ws = (char*)d_ws; size_t off = 0;
    auto take = [&](size_t bytes) { char* r = ws + off; off = align_up(off + bytes, 4096); return r; };
    const size_t ctl_bytes = (size_t)(XCD_BAR_WORDS + CTL_WORDS) * 4;
    p.bar = (unsigned*)take(ctl_bytes); p.ctl = p.bar + XCD_BAR_WORDS;
    p.modp = (float*)take((size_t)KS_MOD * 4 * NMOD * 4); p.mod = (float*)take((size_t)NB * NMOD * 4);
    p.hb = (fp8_t*)take((size_t)NM * ND);
    p.wt_in = (fp8_t*)take((size_t)NINP * ND); p.wt_rwkv = (fp8_t*)take((size_t)ND * NC); p.wt_pool = (bf16_t*)take((size_t)ND * 256 * 2);
    p.wt_out = (fp8_t*)take((size_t)ND * ND); p.bt_lora = (bf16_t*)take((size_t)LORA_N * LORA_K * 2);
    p.wt_gu = (fp8_t*)take((size_t)NE * 2 * DFF * ND); p.wt_down = (fp8_t*)take((size_t)NE * ND * DFF);
    p.P = (bf16_t*)take((size_t)NM * NINP * 2); p.a_lora = (bf16_t*)take((size_t)NM * LORA_K * 2); p.dp = (bf16_t*)take((size_t)NM * NC * 2);
    p.dec = (float*)take((size_t)NM * NC * 4); p.iclr = (bf16_t*)take((size_t)NM * NC * 2); p.gg = (bf16_t*)take((size_t)NM * NC * 2); p.t1 = (bf16_t*)take((size_t)NM * ND * 2);
    p.yr = (fp8_t*)take((size_t)NM * NC); p.mx = (fp8_t*)take((size_t)NM * ND); p.z1 = (float*)take((size_t)NM * ND * 4); p.lnst = (float*)take((size_t)NM * 2 * 4);
    p.h2 = (fp8_t*)take((size_t)NM * ND);
    p.sel = (int*)take((size_t)NM * TOPK * 4); p.rnk = (int*)take((size_t)NM * TOPK * 4); p.prob = (float*)take((size_t)NM * TOPK * 4); p.dest = (int*)take((size_t)NM * TOPK * 4);
    p.xb = (fp8_t*)take((size_t)MP * ND); p.act = (fp8_t*)take((size_t)MP * DFF); p.yb = (bf16_t*)take((size_t)MP * ND * 2);
    if (off > ws_size) { fprintf(stderr, "kernel_launch: workspace too small (%zu > %zu)\n", off, ws_size); return; }

    static int grid = 0;
    if (!grid) {
        int dev = 0, cus = 0, per_cu = 0;
        hipGetDevice(&dev); hipDeviceGetAttribute(&cus, hipDeviceAttributeMultiprocessorCount, dev);
        hipFuncSetAttribute((const void*)fwd, hipFuncAttributeMaxDynamicSharedMemorySize, LDS_BYTES);
        hipOccupancyMaxActiveBlocksPerMultiprocessor(&per_cu, (const void*)fwd, NTHREADS, LDS_BYTES);
        if (per_cu < 1) fprintf(stderr, "kernel_launch: occupancy query reports %d workgroups per CU\n", per_cu);
        if (cus != 256) fprintf(stderr, "kernel_launch: %d CUs; this kernel is laid out for 256\n", cus);
        grid = 256;
    }
    hipMemsetAsync(p.bar, 0, ctl_bytes, stream);
    hipLaunchKernelGGL(fwd, dim3(grid), dim3(NTHREADS), LDS_BYTES, stream, p);
}
```
